# Optimizing an MI355X kernel written in HIP

```python
import math
import jax, jax.numpy as jnp
from jax import lax
import numpy as np

D_MODEL = 1024
BATCH = 4
SEQ = 4096
DEPTH = 4

A_HEADS = 8
A_HEAD_DIM = 64
A_WIDTH = A_HEADS * A_HEAD_DIM
IDX_HEADS = 8
IDX_DIM = 64
TOPK_MAX = 256
Q_BLOCK = 128
REL_BUCKETS = 32
REL_MAX_DIST = 128
B_HEADS = 4
B_KEY_DIM = 64
B_VAL_DIM = 128
B_KEY_WIDTH = B_HEADS * B_KEY_DIM
B_VAL_WIDTH = B_HEADS * B_VAL_DIM
GATE_RANK = 16
GATE_NORMALIZER = 16.0
GLA_CHUNK = 64
LRU_WIDTH = D_MODEL
LRU_BLOCKS = 4
LRU_BLOCK_DIM = LRU_WIDTH // LRU_BLOCKS
CONV_WIDTH = 4
LRU_C = 8.0
EPS = 1e-6

N_EVEN = (DEPTH + 1) // 2
N_ODD = DEPTH // 2

EVEN_SPLIT_SIZES = (
    A_WIDTH, A_WIDTH, A_WIDTH, A_WIDTH,
    IDX_HEADS * IDX_DIM, IDX_DIM, IDX_HEADS,
    B_KEY_WIDTH, B_KEY_WIDTH, B_VAL_WIDTH,
    B_VAL_WIDTH, GATE_RANK,
)
EVEN_IN = sum(EVEN_SPLIT_SIZES)
MIX_WIDTH_EVEN = A_WIDTH + B_VAL_WIDTH

kernel_name = "hybrid_dsa_gla_rglru_sandwich"


def split_points(sizes):
    pts, acc = [], 0
    for sz in sizes[:-1]:
        acc += sz
        pts.append(acc)
    return pts


def rmsnorm(x, w):
    xf = x.astype(jnp.float32)
    y = xf * lax.rsqrt(jnp.mean(xf * xf, axis=-1, keepdims=True) + EPS)
    return (y * w.astype(jnp.float32)).astype(x.dtype)


def t5_bucket(rel):
    n = jnp.maximum(rel, 0)
    max_exact = REL_BUCKETS // 2
    nf = jnp.maximum(n, 1).astype(jnp.float32)
    large = max_exact + (jnp.log(nf / max_exact) / math.log(REL_MAX_DIST / max_exact)
                         * (REL_BUCKETS - max_exact)).astype(jnp.int32)
    large = jnp.minimum(large, REL_BUCKETS - 1)
    return jnp.where(n < max_exact, n, large)


def dsa_attention(q, k, v, q_idx, k_idx, w_idx, rel_table):
    b, s, h, dh = q.shape
    topk = min(TOPK_MAX, s // 4)
    nblk = s // Q_BLOCK
    key_pos = jnp.arange(s)

    def to_blocks(t):
        return jnp.moveaxis(t.reshape(b, nblk, Q_BLOCK, *t.shape[2:]), 1, 0)

    def block_fn(args):
        qb, qib, wb, blk = args
        q_pos = blk * Q_BLOCK + jnp.arange(Q_BLOCK)
        causal = key_pos[None, :] <= q_pos[:, None]
        il = jnp.einsum('bthd,bsd->bths', qib, k_idx).astype(jnp.float32) * IDX_DIM ** -0.5
        score = jnp.einsum('bth,bths->bts', wb.astype(jnp.float32), jax.nn.relu(il))
        score = jnp.where(causal[None], score, -jnp.inf)
        _, idx = lax.top_k(score, topk)
        valid = idx <= q_pos[None, :, None]
        k_sel = jax.vmap(lambda kk, ii: kk[ii])(k, idx)
        v_sel = jax.vmap(lambda vv, ii: vv[ii])(v, idx)
        bias = rel_table[t5_bucket(q_pos[None, :, None] - idx)].astype(jnp.float32)
        logits = jnp.einsum('bthd,btkhd->bthk', qb, k_sel).astype(jnp.float32) * dh ** -0.5
        logits = logits + jnp.moveaxis(bias, -1, -2)
        logits = jnp.where(valid[:, :, None, :], logits, -jnp.inf)
        p = jax.nn.softmax(logits, axis=-1).astype(v.dtype)
        return jnp.einsum('bthk,btkhd->bthd', p, v_sel)

    outs = lax.map(block_fn, (to_blocks(q), to_blocks(q_idx), to_blocks(w_idx),
                              jnp.arange(nblk)))
    return jnp.moveaxis(outs, 0, 1).reshape(b, s, h, dh)


def gla_chunked(q, k, v, log_a):
    b, s, h, dk = q.shape
    dv = v.shape[-1]
    c = GLA_CHUNK
    n = s // c
    f32 = jnp.float32

    def chunk(t):
        return t.astype(f32).reshape(b, n, c, h, t.shape[-1])

    qc = chunk(q) * dk ** -0.5
    kc, vc, gc = chunk(k), chunk(v), chunk(log_a)
    G = jnp.cumsum(gc, axis=2)
    G_last = G[:, :, -1:]
    q_dec = qc * jnp.exp(G)
    k_dec = kc * jnp.exp(-G)
    k_tail = kc * jnp.exp(G_last - G)
    A = jnp.einsum('bnihd,bnjhd->bnhij', q_dec, k_dec)
    mask = jnp.tril(jnp.ones((c, c), dtype=bool))
    A = jnp.where(mask, A, 0.0)
    o_intra = jnp.einsum('bnhij,bnjhv->bnihv', A, vc)
    chunk_state = jnp.einsum('bnjhd,bnjhv->bnhdv', k_tail, vc)
    decay = jnp.exp(G_last[:, :, 0])

    def step(S, inp):
        d, u = inp
        return d[..., None] * S + u, S

    S0 = jnp.zeros((b, h, dk, dv), f32)
    _, S_prev = lax.scan(step, S0, (jnp.moveaxis(decay, 1, 0), jnp.moveaxis(chunk_state, 1, 0)))
    S_prev = jnp.moveaxis(S_prev, 0, 1)
    o_inter = jnp.einsum('bnihd,bnhdv->bnihv', q_dec, S_prev)
    return (o_intra + o_inter).reshape(b, s, h, dv)


def head_rmsnorm(o):
    of = o.astype(jnp.float32)
    return of * lax.rsqrt(jnp.mean(of * of, axis=-1, keepdims=True) + EPS)


def causal_dwconv(x, w, bias):
    s = x.shape[1]
    xp = jnp.pad(x, ((0, 0), (CONV_WIDTH - 1, 0), (0, 0)))
    y = xp[:, 0:s] * w[0]
    for j in range(1, CONV_WIDTH):
        y = y + xp[:, j:j + s] * w[j]
    return y + bias


def rglru(x, w_a, b_a, w_x, b_x, lam):
    b, s, w = x.shape
    xb = x.reshape(b, s, LRU_BLOCKS, LRU_BLOCK_DIM)
    r = jax.nn.sigmoid((jnp.einsum('bsnd,nde->bsne', xb, w_a).reshape(b, s, w) + b_a).astype(jnp.float32))
    i = jax.nn.sigmoid((jnp.einsum('bsnd,nde->bsne', xb, w_x).reshape(b, s, w) + b_x).astype(jnp.float32))
    log_a = -LRU_C * r * jax.nn.softplus(-lam.astype(jnp.float32))
    a = jnp.exp(log_a)
    mult = jnp.sqrt(-jnp.expm1(2.0 * log_a))
    u = mult * (i * x.astype(jnp.float32))

    def combine(e1, e2):
        a1, b1 = e1
        a2, b2 = e2
        return a1 * a2, a2 * b1 + b2

    _, hs = lax.associative_scan(combine, (a, u), axis=1)
    return hs.astype(x.dtype)


def setup_inputs(seed: int = 0) -> dict:
    key = jax.random.key(seed)
    ks = jax.random.split(key, 20)
    f32 = jnp.float32

    def nrm(k, shape, scale):
        return jax.random.normal(k, shape, f32) * scale

    u = jax.random.uniform(ks[16], (N_ODD, LRU_WIDTH), f32, 0.9, 0.999)
    a0 = u ** (1.0 / LRU_C)
    return {
        'x': nrm(ks[0], (BATCH, SEQ, D_MODEL), 1.0),
        'rel_bias': nrm(ks[1], (REL_BUCKETS, A_HEADS), 0.2),
        'pre_norm': 1.0 + nrm(ks[2], (DEPTH, D_MODEL), 0.05),
        'post_norm': 1.0 + nrm(ks[3], (DEPTH, D_MODEL), 0.05),
        'even_w_in': nrm(ks[4], (N_EVEN, D_MODEL, EVEN_IN), D_MODEL ** -0.5),
        'even_gate_w2': nrm(ks[5], (N_EVEN, GATE_RANK, B_KEY_WIDTH), GATE_RANK ** -0.5),
        'even_gate_b2': nrm(ks[6], (N_EVEN, B_KEY_WIDTH), 0.1),
        'even_w_out': nrm(ks[7], (N_EVEN, MIX_WIDTH_EVEN, D_MODEL), MIX_WIDTH_EVEN ** -0.5),
        'odd_w_in': nrm(ks[8], (N_ODD, D_MODEL, 2 * LRU_WIDTH), D_MODEL ** -0.5),
        'odd_conv_w': nrm(ks[9], (N_ODD, CONV_WIDTH, LRU_WIDTH), CONV_WIDTH ** -0.5),
        'odd_conv_b': nrm(ks[10], (N_ODD, LRU_WIDTH), 0.02),
        'odd_w_a': nrm(ks[11], (N_ODD, LRU_BLOCKS, LRU_BLOCK_DIM, LRU_BLOCK_DIM), LRU_BLOCK_DIM ** -0.5),
        'odd_b_a': nrm(ks[12], (N_ODD, LRU_WIDTH), 0.02),
        'odd_w_x': nrm(ks[13], (N_ODD, LRU_BLOCKS, LRU_BLOCK_DIM, LRU_BLOCK_DIM), LRU_BLOCK_DIM ** -0.5),
        'odd_b_x': nrm(ks[14], (N_ODD, LRU_WIDTH), 0.02),
        'odd_lambda': jnp.log(a0) - jnp.log1p(-a0),
        'odd_w_out': nrm(ks[15], (N_ODD, LRU_WIDTH, D_MODEL), LRU_WIDTH ** -0.5),
    }


def reference(x, rel_bias, pre_norm, post_norm, even_w_in, even_gate_w2, even_gate_b2,
              even_w_out, odd_w_in, odd_conv_w, odd_conv_b, odd_w_a, odd_b_a, odd_w_x,
              odd_b_x, odd_lambda, odd_w_out):
    b, s, _ = x.shape
    even_pts = split_points(EVEN_SPLIT_SIZES)
    for layer in range(DEPTH):
        h = rmsnorm(x, pre_norm[layer])
        if layer % 2 == 0:
            e = layer // 2
            proj = h @ even_w_in[e]
            (aq, ak, av, ag, iq, ik, iw, bq, bk, bv, bg, blr) = jnp.split(proj, even_pts, axis=-1)
            a_out = dsa_attention(
                aq.reshape(b, s, A_HEADS, A_HEAD_DIM),
                ak.reshape(b, s, A_HEADS, A_HEAD_DIM),
                av.reshape(b, s, A_HEADS, A_HEAD_DIM),
                iq.reshape(b, s, IDX_HEADS, IDX_DIM), ik,
                iw * IDX_HEADS ** -0.5, rel_bias)
            a_out = a_out.reshape(b, s, A_WIDTH) * jax.nn.silu(ag)
            gate_logit = (blr @ even_gate_w2[e] + even_gate_b2[e]).astype(jnp.float32)
            log_a = jax.nn.log_sigmoid(gate_logit) / GATE_NORMALIZER
            g_out = gla_chunked(
                bq.reshape(b, s, B_HEADS, B_KEY_DIM),
                bk.reshape(b, s, B_HEADS, B_KEY_DIM),
                bv.reshape(b, s, B_HEADS, B_VAL_DIM),
                log_a.reshape(b, s, B_HEADS, B_KEY_DIM))
            g_out = head_rmsnorm(g_out).reshape(b, s, B_VAL_WIDTH).astype(x.dtype) * jax.nn.silu(bg)
            mix = jnp.concatenate([a_out, g_out], axis=-1) @ even_w_out[e]
        else:
            o = layer // 2
            proj = h @ odd_w_in[o]
            xr, g = jnp.split(proj, [LRU_WIDTH], axis=-1)
            xr = causal_dwconv(xr, odd_conv_w[o], odd_conv_b[o])
            hr = rglru(xr, odd_w_a[o], odd_b_a[o], odd_w_x[o], odd_b_x[o], odd_lambda[o])
            mix = (hr * jax.nn.silu(g)) @ odd_w_out[o]
        x = x + rmsnorm(mix, post_norm[layer])
    return x
```

```cpp
#include <hip/hip_runtime.h>
#include <stdint.h>
#include <stdio.h>

#ifndef N_LAUNCHES
#define N_LAUNCHES 1
#endif

#define LAS __attribute__((address_space(3)))
typedef unsigned short bf16_t;
typedef short bf16x8 __attribute__((ext_vector_type(8)));
typedef float f32x4 __attribute__((ext_vector_type(4)));
typedef float f32x2 __attribute__((ext_vector_type(2)));
typedef float f32x16 __attribute__((ext_vector_type(16)));
typedef unsigned u32x4 __attribute__((ext_vector_type(4)));
typedef unsigned u32x2 __attribute__((ext_vector_type(2)));
typedef unsigned long long u64;

constexpr int NB = 4, SEQ = 4096, T = NB * SEQ, DM = 1024;
constexpr int EVEN_IN = 4184, NE = 4352;
constexpr int NTHREADS = 512;
constexpr float EPS = 1e-6f;
constexpr float NEG_INF = -__builtin_inff();

constexpr size_t MB = 1024 * 1024;
constexpr size_t WS_CTL   = 0;
constexpr size_t CTL_BYTES = 65536;
constexpr size_t WS_WEIN  = WS_CTL + CTL_BYTES;
constexpr size_t WS_WEOUT = WS_WEIN + (size_t)2 * NE * 1024 * 2;
constexpr size_t WS_WOIN  = WS_WEOUT + 4 * MB;
constexpr size_t WS_WOG   = WS_WOIN + 8 * MB;
constexpr size_t WS_WOOUT = WS_WOG + 2 * MB;
constexpr size_t WS_TAB   = WS_WOOUT + 4 * MB;
constexpr size_t WS_XS    = WS_TAB + 4096;
constexpr size_t WS_H     = WS_XS + 65536;
constexpr size_t WS_MIXIN = WS_H + 32 * MB;
constexpr size_t WS_ACT   = WS_MIXIN + 32 * MB;
constexpr size_t WS_Q     = WS_ACT;
constexpr size_t WS_K     = WS_Q + 16 * MB;
constexpr size_t WS_VT    = WS_K + 16 * MB;
constexpr size_t WS_AG    = WS_VT + 16 * MB;
constexpr size_t WS_MIX   = WS_ACT;
constexpr size_t WS_IQ    = WS_AG + 16 * MB;
constexpr size_t WS_BQ    = WS_IQ + 16 * MB;
constexpr size_t WS_BK    = WS_BQ + 8 * MB;
constexpr size_t WS_BV    = WS_BK + 8 * MB;
constexpr size_t WS_BG    = WS_BV + 16 * MB;
constexpr size_t WS_IK    = WS_BG + 16 * MB;
constexpr size_t WS_IW    = WS_IK + 2 * MB;
constexpr size_t WS_BLR   = WS_IW + MB / 2;
constexpr size_t WS_MASK  = WS_BLR + MB;
constexpr size_t WS_SPREV = WS_MASK + 8 * MB;
constexpr size_t WS_DECAY = WS_SPREV + 16 * MB;
constexpr size_t WS_EVEN_END = WS_DECAY + MB / 4;
constexpr size_t WS_XR    = WS_ACT;
constexpr size_t WS_U     = WS_XR;
constexpr size_t WS_GS    = WS_XR + 32 * MB;
constexpr size_t WS_XC    = WS_GS + 32 * MB;
constexpr size_t WS_LOGA  = WS_XC + 32 * MB;
constexpr size_t WS_ODD_END = WS_LOGA + 32 * MB;
constexpr size_t WS_END   = WS_EVEN_END > WS_ODD_END ? WS_EVEN_END : WS_ODD_END;
static_assert(WS_END <= (size_t)256 * MB, "workspace map exceeds 256 MiB");

__device__ __forceinline__ float bf2f(unsigned v) { return __uint_as_float(v << 16); }
__device__ __forceinline__ unsigned cvt_pk_bf16(float lo, float hi) { unsigned r; asm("v_cvt_pk_bf16_f32 %0, %1, %2" : "=v"(r) : "v"(lo), "v"(hi)); return r; }
__device__ __forceinline__ bf16_t f2bf(float f) { return (bf16_t)cvt_pk_bf16(f, f); }
__device__ __forceinline__ float silu_f(float x) { return x / (1.0f + __expf(-x)); }
__device__ __forceinline__ float sigmoid_f(float x) { return 1.0f / (1.0f + __expf(-x)); }
__device__ __forceinline__ size_t slab_idx(int row, int ch) { return ((size_t)((row >> 12) * 64 + (ch >> 4)) * SEQ + (row & 4095)) * 16 + (ch & 15); }
__device__ __forceinline__ float log1p_01(float y) { const float ser = y * (1.0f - y * (0.5f - y * (0.33333334f - y * 0.25f))); return y < 0.03125f ? ser : __logf(1.0f + y); }
__device__ __forceinline__ float bflo(unsigned w) { return __uint_as_float(w << 16); }
__device__ __forceinline__ float bfhi(unsigned w) { return __uint_as_float(w & 0xFFFF0000u); }

__device__ __forceinline__ int opaque_tid() { int t = threadIdx.x; asm volatile("" : "+v"(t)); return t; }

__device__ __forceinline__ int wave_sum_i32(int v) {
    v += __builtin_amdgcn_update_dpp(0, v, 0xB1, 0xF, 0xF, true);
    v += __builtin_amdgcn_update_dpp(0, v, 0x4E, 0xF, 0xF, true);
    v += __builtin_amdgcn_update_dpp(0, v, 0x141, 0xF, 0xF, true);
    v += __builtin_amdgcn_update_dpp(0, v, 0x140, 0xF, 0xF, true);
    return __builtin_amdgcn_readlane(v, 0) + __builtin_amdgcn_readlane(v, 16) + __builtin_amdgcn_readlane(v, 32) + __builtin_amdgcn_readlane(v, 48);
}

__device__ __forceinline__ float wave_max_f32(float v) {
    v = fmaxf(v, __uint_as_float((unsigned)__builtin_amdgcn_update_dpp(0, (int)__float_as_uint(v), 0xB1, 0xF, 0xF, true)));
    v = fmaxf(v, __uint_as_float((unsigned)__builtin_amdgcn_update_dpp(0, (int)__float_as_uint(v), 0x4E, 0xF, 0xF, true)));
    v = fmaxf(v, __uint_as_float((unsigned)__builtin_amdgcn_update_dpp(0, (int)__float_as_uint(v), 0x141, 0xF, 0xF, true)));
    v = fmaxf(v, __uint_as_float((unsigned)__builtin_amdgcn_update_dpp(0, (int)__float_as_uint(v), 0x140, 0xF, 0xF, true)));
    const float a = __uint_as_float((unsigned)__builtin_amdgcn_readlane((int)__float_as_uint(v), 0)), b = __uint_as_float((unsigned)__builtin_amdgcn_readlane((int)__float_as_uint(v), 16));
    const float c = __uint_as_float((unsigned)__builtin_amdgcn_readlane((int)__float_as_uint(v), 32)), d = __uint_as_float((unsigned)__builtin_amdgcn_readlane((int)__float_as_uint(v), 48));
    return fmaxf(fmaxf(a, b), fmaxf(c, d));
}
__device__ __forceinline__ int wave_prefix_sum_i32(int v) {
    v += __builtin_amdgcn_update_dpp(0, v, 0x111, 0xF, 0xF, true);
    v += __builtin_amdgcn_update_dpp(0, v, 0x112, 0xF, 0xF, true);
    v += __builtin_amdgcn_update_dpp(0, v, 0x114, 0xF, 0xF, true);
    v += __builtin_amdgcn_update_dpp(0, v, 0x118, 0xF, 0xF, true);
    v += __builtin_amdgcn_update_dpp(0, v, 0x142, 0xA, 0xF, false);
    v += __builtin_amdgcn_update_dpp(0, v, 0x143, 0xC, 0xF, false);
    return v;
}

#define XB_TMO      128
#define XB_XCNT(j)  (256  + 64 * (j))
#define XB_XSUB(j)  (1280 + 64 * (j))
#define XB_XGEN(j)  (2304 + 64 * (j))
#define XB_TOP      3328
#define XB_TOPGEN   3392
#define XCD_BAR_WORDS 3456
#define XB_SPIN_CAP (1u << 18)

__device__ __forceinline__ unsigned xb_ld(unsigned* p)              { return __hip_atomic_load(p, __ATOMIC_RELAXED, __HIP_MEMORY_SCOPE_AGENT); }
__device__ __forceinline__ unsigned xb_add(unsigned* p, unsigned v) { return __hip_atomic_fetch_add(p, v, __ATOMIC_RELAXED, __HIP_MEMORY_SCOPE_AGENT); }
__device__ __forceinline__ unsigned xb_xcc_id() { return (unsigned)__builtin_amdgcn_s_getreg((3 << 11) | 20) & 0xFu; }
#define XB_SPIN(cond, bar) do { unsigned _sp = 0; while (cond) { __builtin_amdgcn_s_sleep(1); \
    if ((++_sp & 255u) == 0u) { if (xb_ld(&(bar)[XB_TMO])) break; if (_sp > XB_SPIN_CAP) { atomicAdd(&(bar)[XB_TMO], 1u); break; } } } } while (0)

struct XcdBarrier { unsigned* bar; unsigned x; volatile LAS unsigned* st; };

__device__ __forceinline__ XcdBarrier xcd_barrier_post(unsigned* bar, volatile LAS unsigned* st) {
    XcdBarrier b; b.bar = bar; b.x = xb_xcc_id(); b.st = st;
    if (threadIdx.x == 0) (void)xb_add(&bar[XB_XCNT(b.x)], 1u);
    return b;
}
__device__ __forceinline__ void xcd_barrier_complete(unsigned* bar, unsigned x, unsigned& nloc, unsigned& nx) {
    const unsigned G = gridDim.x * gridDim.y * gridDim.z;
    unsigned sum, cnt, mine, sp = 0u;
    for (;;) {
        sum = 0u; cnt = 0u; mine = 0u;
#pragma unroll
        for (unsigned j = 0; j < 16; ++j) { const unsigned c = xb_ld(&bar[XB_XCNT(j)]); sum += c; cnt += (c > 0u) ? 1u : 0u; mine = (j == x) ? c : mine; }
        if (sum == G) break;
        __builtin_amdgcn_s_sleep(1);
        if ((++sp & 255u) == 0u) { if (xb_ld(&bar[XB_TMO])) break; if (sp > XB_SPIN_CAP) { atomicAdd(&bar[XB_TMO], 1u); break; } }
    }
    nloc = mine > 0u ? mine : 1u; nx = cnt > 0u ? cnt : 1u;
}
__device__ __forceinline__ void xcd_barrier(const XcdBarrier& b) {
    asm volatile("s_waitcnt vmcnt(0)" ::: "memory");
    __syncthreads();
    if (threadIdx.x == 0) {
        unsigned* bar = b.bar;
        __builtin_amdgcn_s_waitcnt(0);
        unsigned nloc = b.st[0], nx = b.st[1];
        if (nloc == 0u) { xcd_barrier_complete(bar, b.x, nloc, nx); b.st[0] = nloc; b.st[1] = nx; }
        const unsigned old = xb_add(&bar[XB_XSUB(b.x)], 1u);
        const unsigned gen = old / nloc;
        if (old + 1u == (gen + 1u) * nloc) {
            __builtin_amdgcn_fence(__ATOMIC_RELEASE, "agent");
            asm volatile("s_waitcnt vmcnt(0)" ::: "memory");
            const unsigned og = xb_add(&bar[XB_TOP], 1u);
            const unsigned tg = og / nx;
            if (og + 1u == (tg + 1u) * nx) xb_add(&bar[XB_TOPGEN], 1u);
            else XB_SPIN(xb_ld(&bar[XB_TOPGEN]) == tg, bar);
            __builtin_amdgcn_fence(__ATOMIC_ACQUIRE, "agent");
            xb_add(&bar[XB_XGEN(b.x)], 1u);
            asm volatile("s_waitcnt vmcnt(0)" ::: "memory");
        } else {
            XB_SPIN(xb_ld(&bar[XB_XGEN(b.x)]) == gen, bar);
            __builtin_amdgcn_fence(__ATOMIC_ACQUIRE, "agent");
            asm volatile("s_waitcnt vmcnt(0)" ::: "memory");
        }
    }
    __syncthreads();
}

namespace pg8 {
constexpr int BM = 256, BK = 64, HALF = 128, HTB = HALF * BK * 2, STAGE_BYTES = 8 * HTB, NXCD = 8, WGM = 8;
__host__ __device__ __forceinline__ int lds_byte(int r, int c) { const int st = (r >> 4) * 2 + (c >> 5), rr = r & 15, cc = c & 31, ob = rr * 64 + cc * 2; return st * 1024 + (ob ^ (((ob >> 9) & 1) << 5)); }
__host__ __device__ __forceinline__ void stage_rc(int b, int& R, int& C) { const int st = b / 1024, sb = b % 1024, swz = sb ^ (((sb >> 9) & 1) << 5); R = (st >> 1) * 16 + swz / 64; C = (st & 1) * 32 + (swz % 64) / 2; }
__host__ __device__ __forceinline__ int perm32(int rho) { const int n = rho >> 4, i = rho & 15; return 8 * (i >> 2) + 4 * n + (i & 3); }

struct Unit { int pm, pn; };
struct Gemm { const bf16_t* A; const bf16_t* Bt; int M, N, K, lda, a_div, a_step; };

struct StaticOrder {
    int nM, nN, nwg, G, c;
    __host__ __device__ void init(int M, int N, int G_, int c_) { nM = M / BM; nN = N / BM; nwg = nM * nN; G = G_; c = c_; }
    __host__ __device__ bool next(int i, Unit& u) const {
        const long L = (long)i * G + c; if (L >= nwg) return false;
        int wgid = (int)L; { const int q = nwg / NXCD, r = nwg % NXCD, xcd = wgid % NXCD, off = wgid / NXCD; wgid = (xcd < r ? xcd * (q + 1) : r * (q + 1) + (xcd - r) * q) + off; }
        const int nig = WGM * nN, gid = wgid / nig, fm = gid * WGM, gsz = (nM - fm) < WGM ? (nM - fm) : WGM;
        u.pm = fm + ((wgid % nig) % gsz); u.pn = (wgid % nig) / gsz; return true;
    }
};

template <class Epi>
__device__ __forceinline__ void gemm_phase(LAS unsigned char* lds, const Gemm g, const StaticOrder& S, const Epi& E) {
    const int tid = opaque_tid(), wid = __builtin_amdgcn_readfirstlane(tid >> 6), lane = tid & 63, wr = wid >> 2, wc = wid & 3, fr = lane & 15, fq = lane >> 4;
    const int K = g.K, nt = K / BK, lda = g.lda;
    unsigned voffA[2], voffB[2];
#pragma unroll
    for (int i = 0; i < 2; ++i) { int R, C; stage_rc(tid * 16 + i * 8192, R, C); const int Rb = Epi::PERM ? ((R & ~31) + perm32(R & 31)) : R;
        voffA[i] = (unsigned)(R * lda + C) * 2u; voffB[i] = (unsigned)(Rb * K + C) * 2u; }
    const size_t kstep = (size_t)(BK * 2);
    const size_t hstepA = (size_t)HALF * lda * 2, hstepB = (size_t)HALF * K * 2;
    const size_t tstepA = 2 * hstepA, tstepB = 2 * hstepB;
    const unsigned ldsw = (unsigned)wid * 1024u;
    const int aoff = lds_byte(wr * 64 + fr, fq * 8), boff = lds_byte(wc * 32 + fr, fq * 8);
#define PG8_SA(b, h) (((b) * 2 + (h)) * HTB)
#define PG8_SB(b, h) ((4 + (b) * 2 + (h)) * HTB)
#define PG8_STAGE(bufoff, gbase, voff) do { _Pragma("unroll") for (int _i = 0; _i < 2; ++_i) \
        __builtin_amdgcn_global_load_lds((const unsigned*)((const char*)(gbase) + (voff)[_i]), (LAS unsigned*)(lds + (bufoff) + ldsw + _i * 8192), 16, 0, 0); } while (0)
#define PG8_LDA(dst, b, h) do { _Pragma("unroll") for (int m = 0; m < 4; ++m) _Pragma("unroll") for (int k = 0; k < 2; ++k) dst[m][k] = *(const LAS bf16x8*)(lds + PG8_SA(b, h) + aoff + m * 2048 + k * 1024); } while (0)
#define PG8_LDB(dst, b, h) do { _Pragma("unroll") for (int n = 0; n < 2; ++n) _Pragma("unroll") for (int k = 0; k < 2; ++k) dst[n][k] = *(const LAS bf16x8*)(lds + PG8_SB(b, h) + boff + n * 2048 + k * 1024); } while (0)
#define PG8_MMA(ai, bj, At, Bt) do { __builtin_amdgcn_s_setprio(1); _Pragma("unroll") for (int m = 0; m < 4; ++m) _Pragma("unroll") for (int n = 0; n < 2; ++n) _Pragma("unroll") for (int k = 0; k < 2; ++k) \
        acc[ai][bj][m][n] = __builtin_amdgcn_mfma_f32_16x16x32_bf16(Bt[n][k], At[m][k], acc[ai][bj][m][n], 0, 0, 0); __builtin_amdgcn_s_setprio(0); } while (0)
#define PG8_WAIT_V(n) asm volatile("s_waitcnt vmcnt(" #n ")" ::: "memory")
#define PG8_WAIT_L(n) asm volatile("s_waitcnt lgkmcnt(" #n ")" ::: "memory")
#define PG8_BAR __builtin_amdgcn_s_barrier()
#define PG8_SCHED __builtin_amdgcn_sched_barrier(0)
    Unit cur, nxt; int ui = 0;
    if (!S.next(0, cur)) return;
    f32x4 acc[2][2][4][2];
#pragma unroll
    for (int a = 0; a < 2; ++a)
#pragma unroll
        for (int b = 0; b < 2; ++b)
#pragma unroll
            for (int m = 0; m < 4; ++m)
#pragma unroll
                for (int n = 0; n < 2; ++n) acc[a][b][m][n] = (f32x4){0.f, 0.f, 0.f, 0.f};
    bf16x8 At[4][2], B0[2][2], B1[2][2];
    const char* cA = (const char*)g.A + (size_t)cur.pm * tstepA + (size_t)(cur.pn / g.a_div) * g.a_step; const char* cB = (const char*)g.Bt + (size_t)cur.pn * tstepB;
    PG8_STAGE(PG8_SB(0, 0), cB, voffB); PG8_STAGE(PG8_SA(0, 0), cA, voffA); PG8_STAGE(PG8_SB(0, 1), cB + hstepB, voffB); PG8_STAGE(PG8_SA(0, 1), cA + hstepA, voffA);
    if (wr == 1) PG8_BAR;
    PG8_WAIT_V(4); PG8_BAR;
    PG8_STAGE(PG8_SB(1, 0), cB + kstep, voffB); PG8_STAGE(PG8_SA(1, 0), cA + kstep, voffA); PG8_STAGE(PG8_SB(1, 1), cB + hstepB + kstep, voffB);
    PG8_WAIT_V(6); PG8_BAR;
    for (;;) {
        const bool has_next = S.next(ui + 1, nxt);
        const char* nA = has_next ? (const char*)g.A + (size_t)nxt.pm * tstepA + (size_t)(nxt.pn / g.a_div) * g.a_step : cA; const char* nB = has_next ? (const char*)g.Bt + (size_t)nxt.pn * tstepB : cB;
        for (int t = 0; t < nt; t += 2) {
            const bool last = (t == nt - 2);
            const char* a1 = cA + (size_t)(t + 1) * kstep;
            const char* a2 = last ? nA : cA + (size_t)(t + 2) * kstep; const char* b2 = last ? nB : cB + (size_t)(t + 2) * kstep;
            const char* a3 = a2 + kstep; const char* b3 = b2 + kstep;
            PG8_LDB(B0, 0, 0); PG8_SCHED; PG8_LDA(At, 0, 0); PG8_STAGE(PG8_SA(1, 1), a1 + hstepA, voffA);
            PG8_WAIT_L(8); PG8_BAR; PG8_WAIT_L(0); PG8_MMA(0, 0, At, B0); PG8_BAR; PG8_SCHED;
            PG8_LDB(B1, 0, 1); PG8_STAGE(PG8_SB(0, 0), b2, voffB);
            PG8_BAR; PG8_WAIT_L(0); PG8_MMA(0, 1, At, B1); PG8_BAR;
            PG8_LDA(At, 0, 1); PG8_STAGE(PG8_SA(0, 0), a2, voffA);
            PG8_BAR; PG8_WAIT_L(0); PG8_MMA(1, 0, At, B0); PG8_BAR; PG8_SCHED;
            PG8_STAGE(PG8_SB(0, 1), b2 + hstepB, voffB);
            PG8_WAIT_V(6); PG8_BAR; PG8_MMA(1, 1, At, B1); PG8_BAR;
            PG8_LDB(B0, 1, 0); PG8_SCHED; PG8_LDA(At, 1, 0); PG8_STAGE(PG8_SA(0, 1), a2 + hstepA, voffA);
            PG8_WAIT_L(8); PG8_BAR; PG8_WAIT_L(0); PG8_MMA(0, 0, At, B0); PG8_BAR; PG8_SCHED;
            PG8_LDB(B1, 1, 1); PG8_STAGE(PG8_SB(1, 0), b3, voffB);
            PG8_BAR; PG8_WAIT_L(0); PG8_MMA(0, 1, At, B1); PG8_BAR;
            PG8_LDA(At, 1, 1); PG8_STAGE(PG8_SA(1, 0), a3, voffA);
            PG8_BAR; PG8_WAIT_L(0); PG8_MMA(1, 0, At, B0); PG8_BAR; PG8_SCHED;
            PG8_STAGE(PG8_SB(1, 1), b3 + hstepB, voffB);
            PG8_WAIT_V(6); PG8_BAR; PG8_MMA(1, 1, At, B1); PG8_BAR;
        }
        E(acc, cur, wr, wc, fr, fq);
        if (!has_next) break;
#pragma unroll
        for (int a = 0; a < 2; ++a)
#pragma unroll
            for (int b = 0; b < 2; ++b)
#pragma unroll
                for (int m = 0; m < 4; ++m)
#pragma unroll
                    for (int n = 0; n < 2; ++n) acc[a][b][m][n] = (f32x4){0.f, 0.f, 0.f, 0.f};
        cur = nxt; cA = nA; cB = nB; ++ui;
    }
    PG8_WAIT_V(0);
    if (wr == 0) PG8_BAR;
    PG8_BAR;
#undef PG8_SA
#undef PG8_SB
#undef PG8_STAGE
#undef PG8_LDA
#undef PG8_LDB
#undef PG8_MMA
#undef PG8_WAIT_V
#undef PG8_WAIT_L
#undef PG8_BAR
#undef PG8_SCHED
}
}

struct EpiMix {
    static constexpr bool PERM = true;
    bf16_t* C;
    __device__ __forceinline__ void operator()(const f32x4 (&acc)[2][2][4][2], const pg8::Unit& u, int wr, int wc, int fr, int fq) const {
#pragma unroll
        for (int ai = 0; ai < 2; ++ai)
#pragma unroll
            for (int m = 0; m < 4; ++m) { const int row = u.pm * 256 + ai * 128 + wr * 64 + m * 16 + fr;
#pragma unroll
                for (int bj = 0; bj < 2; ++bj) { const f32x4 v0 = acc[ai][bj][m][0], v1 = acc[ai][bj][m][1];
                    u32x4 w; w.x = cvt_pk_bf16(v0[0], v0[1]); w.y = cvt_pk_bf16(v0[2], v0[3]); w.z = cvt_pk_bf16(v1[0], v1[1]); w.w = cvt_pk_bf16(v1[2], v1[3]);
                    *(u32x4*)(C + (size_t)row * 1024 + u.pn * 256 + bj * 128 + wc * 32 + 8 * fq) = w; } }
    }
};

constexpr float LOG2E_F = 1.4426950408889634f;
constexpr float IW_SCALE = 0.35355339059327373f * 0.125f;

struct EpiEvenIn {
    static constexpr bool PERM = true;
    bf16_t *Q, *Kb, *VT, *AG, *IQ, *BQ, *BK, *BV, *BG, *IK; float *IW, *BLR;
    __device__ __forceinline__ void operator()(const f32x4 (&acc)[2][2][4][2], const pg8::Unit& u, int wr, int wc, int fr, int fq) const {
        const int pn = u.pn;
        bf16_t* dst = Q; int ld = 512, col0 = 0, mode = 0;
        if (pn < 2) { dst = Q; col0 = pn * 256; }
        else if (pn < 4) { dst = Kb; col0 = (pn - 2) * 256; }
        else if (pn < 6) { mode = 2; col0 = (pn - 4) * 256; }
        else if (pn < 8) { dst = AG; col0 = (pn - 6) * 256; mode = 1; }
        else if (pn < 10) { dst = IQ; col0 = (pn - 8) * 256; }
        else if (pn == 10) { dst = BQ; ld = 256; }
        else if (pn == 11) { dst = BK; ld = 256; }
        else if (pn < 14) { dst = BV; col0 = (pn - 12) * 256; }
        else if (pn < 16) { dst = BG; col0 = (pn - 14) * 256; mode = 1; }
        else mode = 3;
#pragma unroll
        for (int ai = 0; ai < 2; ++ai)
#pragma unroll
            for (int m = 0; m < 4; ++m) {
                const int row = u.pm * 256 + ai * 128 + wr * 64 + m * 16 + fr;
#pragma unroll
                for (int bj = 0; bj < 2; ++bj) {
                    const int cb = bj * 128 + wc * 32 + 8 * fq;
                    f32x4 v0 = acc[ai][bj][m][0], v1 = acc[ai][bj][m][1];
                    if (mode <= 1) {
                        if (mode == 1) {
#pragma unroll
                            for (int j = 0; j < 4; ++j) { v0[j] = silu_f(v0[j]); v1[j] = silu_f(v1[j]); }
                        }
                        u32x4 w; w.x = cvt_pk_bf16(v0[0], v0[1]); w.y = cvt_pk_bf16(v0[2], v0[3]); w.z = cvt_pk_bf16(v1[0], v1[1]); w.w = cvt_pk_bf16(v1[2], v1[3]);
                        *(u32x4*)(dst + (size_t)row * ld + col0 + cb) = w;
                    } else if (mode == 2) {
                        const int c = col0 + cb, head = c >> 6, d = c & 63, b = row >> 12, s = row & 4095;
                        bf16_t* p = VT + ((size_t)(b * 8 + head) * 64 + d) * 4096 + s;
#pragma unroll
                        for (int j = 0; j < 4; ++j) { p[(size_t)j * 4096] = f2bf(v0[j]); p[(size_t)(j + 4) * 4096] = f2bf(v1[j]); }
                    } else {
                        if (cb < 64) {
                            u32x4 w; w.x = cvt_pk_bf16(v0[0], v0[1]); w.y = cvt_pk_bf16(v0[2], v0[3]); w.z = cvt_pk_bf16(v1[0], v1[1]); w.w = cvt_pk_bf16(v1[2], v1[3]);
                            const int q = cb >> 3, bb = row >> 12, sq = row & 4095;
                            *(u32x4*)(IK + ((((size_t)(bb * 128 + (sq >> 5)) * 4 + (q >> 1)) * 2 + (q & 1)) * 32 + (sq & 31)) * 8) = w;
                        } else if (cb == 64) {
                            *(f32x4*)(IW + (size_t)row * 8) = v0 * IW_SCALE; *(f32x4*)(IW + (size_t)row * 8 + 4) = v1 * IW_SCALE;
                        } else if (cb == 72 || cb == 80) {
                            *(f32x4*)(BLR + (size_t)row * 16 + (cb - 72)) = v0; *(f32x4*)(BLR + (size_t)row * 16 + (cb - 72) + 4) = v1;
                        }
                    }
                }
            }
    }
};

struct EpiOddIn {
    static constexpr bool PERM = true;
    bf16_t *XR, *GS;
    __device__ __forceinline__ void operator()(const f32x4 (&acc)[2][2][4][2], const pg8::Unit& u, int wr, int wc, int fr, int fq) const {
        const int pn = u.pn; const bool gate = pn >= 4;
        bf16_t* dst = gate ? GS : XR; const int col0 = (pn & 3) * 256;
#pragma unroll
        for (int ai = 0; ai < 2; ++ai)
#pragma unroll
            for (int m = 0; m < 4; ++m) {
                const int row = u.pm * 256 + ai * 128 + wr * 64 + m * 16 + fr;
#pragma unroll
                for (int bj = 0; bj < 2; ++bj) {
                    const int cb = bj * 128 + wc * 32 + 8 * fq;
                    f32x4 v0 = acc[ai][bj][m][0], v1 = acc[ai][bj][m][1];
                    if (gate) {
#pragma unroll
                        for (int j = 0; j < 4; ++j) { v0[j] = silu_f(v0[j]); v1[j] = silu_f(v1[j]); }
                    }
                    u32x4 w; w.x = cvt_pk_bf16(v0[0], v0[1]); w.y = cvt_pk_bf16(v0[2], v0[3]); w.z = cvt_pk_bf16(v1[0], v1[1]); w.w = cvt_pk_bf16(v1[2], v1[3]);
                    if (gate) *(u32x4*)(GS + slab_idx(row, col0 + cb)) = w;
                    else *(u32x4*)(XR + (size_t)row * 1024 + col0 + cb) = w;
                }
            }
    }
};

struct EpiGates {
    static constexpr bool PERM = true;
    const float *b_a, *b_x, *lam; const bf16_t* XC; bf16_t* LOGA; bf16_t* U;
    __device__ __forceinline__ void operator()(const f32x4 (&acc)[2][2][4][2], const pg8::Unit& u, int wr, int wc, int fr, int fq) const {
        const int chb = (u.pn >> 1) * 256 + (u.pn & 1) * 128 + wc * 32 + 8 * fq;
#pragma unroll
        for (int nh = 0; nh < 2; ++nh) {
            const int ch0 = chb + 4 * nh;
            const f32x4 lm = *(const f32x4*)(lam + ch0);
            const f32x4 nba = *(const f32x4*)(b_a + ch0) * (-LOG2E_F), nbx = *(const f32x4*)(b_x + ch0) * (-LOG2E_F);
            f32x4 c8;
#pragma unroll
            for (int j = 0; j < 4; ++j) c8[j] = (-8.0f * LOG2E_F) * (fmaxf(-lm[j], 0.f) + log1p_01(__expf(-fabsf(lm[j]))));
#pragma unroll
            for (int ai = 0; ai < 2; ++ai)
#pragma unroll
                for (int m = 0; m < 4; ++m) {
                    const int row = u.pm * 256 + ai * 128 + wr * 64 + m * 16 + fr;
                    const u32x2 xw = *(const u32x2*)(XC + (size_t)row * 1024 + ch0);
                    const float xv[4] = {bflo(xw.x), bfhi(xw.x), bflo(xw.y), bfhi(xw.y)};
                    f32x4 la; float uu[4];
#pragma unroll
                    for (int j = 0; j < 4; ++j) {
                        const float r = __builtin_amdgcn_rcpf(1.0f + __builtin_amdgcn_exp2f(__builtin_fmaf(acc[ai][0][m][nh][j], -LOG2E_F, nba[j])));
                        const float ig = __builtin_amdgcn_rcpf(1.0f + __builtin_amdgcn_exp2f(__builtin_fmaf(acc[ai][1][m][nh][j], -LOG2E_F, nbx[j])));
                        const float l2 = c8[j] * r, av = __builtin_amdgcn_exp2f(l2);
                        la[j] = l2;
                        uu[j] = __builtin_amdgcn_sqrtf(fmaxf(__builtin_fmaf(-av, av, 1.0f), 0.f)) * ig * xv[j];
                    }
                    { u32x2 lw; lw.x = cvt_pk_bf16(la[0], la[1]); lw.y = cvt_pk_bf16(la[2], la[3]); *(u32x2*)(LOGA + slab_idx(row, ch0)) = lw; }
                    u32x2 w; w.x = cvt_pk_bf16(uu[0], uu[1]); w.y = cvt_pk_bf16(uu[2], uu[3]);
                    *(u32x2*)(U + slab_idx(row, ch0)) = w;
                }
        }
    }
};

struct Args {
    const float* x; const float* rel_bias; const float* pre_norm; const float* post_norm;
    const float* even_w_in; const float* even_gate_w2; const float* even_gate_b2; const float* even_w_out;
    const float* odd_w_in; const float* odd_conv_w; const float* odd_conv_b; const float* odd_w_a; const float* odd_b_a;
    const float* odd_w_x; const float* odd_b_x; const float* odd_lambda; const float* odd_w_out;
    float* out; unsigned char* ws; int ph_lo, ph_hi;
};

typedef const Args __attribute__((address_space(4)))* ArgsP;
__device__ __forceinline__ ArgsP get_args() { ArgsP p = (ArgsP)__builtin_amdgcn_kernarg_segment_ptr(); asm volatile("" : "+s"(p)); return p; }

constexpr int WT_EIN = 2 * 68 * 16, WT_EOUT = 2 * 256, WT_OIN = 2 * 512, WT_OOUT = 2 * 256, WT_GATE = 2 * 128, WT_ALL = WT_EIN + WT_EOUT + WT_OIN + WT_OOUT + WT_GATE;
__device__ __forceinline__ void wtile_decode(int T, ArgsP ap, unsigned char* ws, int nl, int wn, const float*& colp, int& ld, bf16_t*& drow, int& K, const float*& ksc) {
    ksc = nullptr;
    if (T < WT_EIN) { const int e = T / 1088, r = T % 1088, tn = r % 68, tk = r / 68; K = 1024; ld = EVEN_IN;
        const int n = tn * 64 + nl; int c; bool ok = true; if (n < 2560) c = n; else if (n < 4096) c = n + 72; else if (n < 4168) c = n - 1536; else if (n < 4184) c = n; else { c = 0; ok = false; }
        ksc = ap->pre_norm + (size_t)(2 * e) * DM + tk * 64;
        colp = ok ? ap->even_w_in + ((size_t)e * 1024 + tk * 64) * EVEN_IN + c : nullptr;
        drow = (bf16_t*)(ws + WS_WEIN) + ((size_t)e * NE + tn * 64 + wn) * 1024 + tk * 64; return; }
    T -= WT_EIN;
    if (T < WT_EOUT) { const int e = T / 256, r = T % 256, tn = r % 16, tk = r / 16; K = 1024; ld = 1024;
        colp = ap->even_w_out + ((size_t)e * 1024 + tk * 64) * 1024 + tn * 64 + nl; drow = (bf16_t*)(ws + WS_WEOUT) + ((size_t)e * 1024 + tn * 64 + wn) * 1024 + tk * 64; return; }
    T -= WT_EOUT;
    if (T < WT_OIN) { const int e = T / 512, r = T % 512, tn = r % 32, tk = r / 32; K = 1024; ld = 2048;
        ksc = ap->pre_norm + (size_t)(2 * e + 1) * DM + tk * 64;
        colp = ap->odd_w_in + ((size_t)e * 1024 + tk * 64) * 2048 + tn * 64 + nl; drow = (bf16_t*)(ws + WS_WOIN) + ((size_t)e * 2048 + tn * 64 + wn) * 1024 + tk * 64; return; }
    T -= WT_OIN;
    if (T < WT_OOUT) { const int e = T / 256, r = T % 256, tn = r % 16, tk = r / 16; K = 1024; ld = 1024;
        colp = ap->odd_w_out + ((size_t)e * 1024 + tk * 64) * 1024 + tn * 64 + nl; drow = (bf16_t*)(ws + WS_WOOUT) + ((size_t)e * 1024 + tn * 64 + wn) * 1024 + tk * 64; return; }
    T -= WT_OOUT;
    {
        const int o = T / 128, r = T % 128, tn = r % 32, tk = r / 32; K = 256; ld = 256;
        const int cp = tn * 64, nb = cp >> 9, j = (cp >> 8) & 1, gs = (cp >> 7) & 1, e0 = j * 128 + (cp & 127);
        const float* src = gs ? ap->odd_w_x : ap->odd_w_a;
        colp = src + (((size_t)(o * 4 + nb)) * 256 + tk * 64) * 256 + e0 + nl; drow = (bf16_t*)(ws + WS_WOG) + ((size_t)o * 2048 + cp + wn) * 256 + tk * 64; }
}
__device__ __forceinline__ void weight_phase(LAS float* tile, ArgsP ap, unsigned char* ws) {
    const int tid = opaque_tid(), G = gridDim.x, nl = tid & 63, k0 = tid >> 6, wn = tid >> 3, wk = (tid & 7) * 8;
    float r[8]; const float* colp; const float* ksc; bf16_t* drow; int ld, K;
#define WT_LOAD() do { _Pragma("unroll") for (int i = 0; i < 8; ++i) r[i] = colp ? colp[(size_t)(k0 + 8 * i) * ld] * (ksc ? ksc[k0 + 8 * i] : 1.0f) : 0.f; } while (0)
    int T = blockIdx.x;
    if (T < WT_ALL) { wtile_decode(T, ap, ws, nl, wn, colp, ld, drow, K, ksc); WT_LOAD(); }
    for (; T < WT_ALL; T += G) {
        bf16_t* dcur = drow;
#pragma unroll
        for (int i = 0; i < 8; ++i) tile[(k0 + 8 * i) * 65 + nl] = r[i];
        __syncthreads();
        if (T + G < WT_ALL) { wtile_decode(T + G, ap, ws, nl, wn, colp, ld, drow, K, ksc); WT_LOAD(); }
        float v[8];
#pragma unroll
        for (int j = 0; j < 8; ++j) v[j] = tile[(wk + j) * 65 + wn];
        u32x4 w; w.x = cvt_pk_bf16(v[0], v[1]); w.y = cvt_pk_bf16(v[2], v[3]); w.z = cvt_pk_bf16(v[4], v[5]); w.w = cvt_pk_bf16(v[6], v[7]);
        *(u32x4*)(dcur + wk) = w;
        __syncthreads();
    }
#undef WT_LOAD
}

__device__ __forceinline__ int t5_bucket(int n) {
    if (n < 16) return n;
    int v = 16 + (int)(__logf((float)n / 16.0f) / 2.0794415416798357f * 16.0f);
    return v < 31 ? v : 31;
}

__device__ __forceinline__ void norm_phase(const float* xin, const bf16_t* xh_in, const float* s_in, const bf16_t* mix, const float* postw, bf16_t* xh_out, float* s_out, float* outf) {
    const int tid0 = opaque_tid(), lane = tid0 & 63, wave = tid0 >> 6;
    for (int row = blockIdx.x * 8 + wave; row < T; row += gridDim.x * 8) {
        f32x4 xv[4];
        if (xin) {
#pragma unroll
            for (int i = 0; i < 4; ++i) xv[i] = *(const f32x4*)(xin + (size_t)row * DM + lane * 4 + 256 * i);
        } else {
            const float sc = s_in[row];
#pragma unroll
            for (int i = 0; i < 4; ++i) { const u32x2 xw = *(const u32x2*)(xh_in + (size_t)row * DM + lane * 4 + 256 * i); xv[i] = (f32x4){bflo(xw.x), bfhi(xw.x), bflo(xw.y), bfhi(xw.y)} * sc; }
        }
        if (mix) {
            f32x4 mv[4]; float ss = 0.f;
#pragma unroll
            for (int i = 0; i < 4; ++i) { const u32x2 mw = *(const u32x2*)(mix + (size_t)row * DM + lane * 4 + 256 * i); mv[i] = (f32x4){bflo(mw.x), bfhi(mw.x), bflo(mw.y), bfhi(mw.y)};
                ss += mv[i][0] * mv[i][0] + mv[i][1] * mv[i][1] + mv[i][2] * mv[i][2] + mv[i][3] * mv[i][3]; }
#pragma unroll
            for (int o = 32; o >= 1; o >>= 1) ss += __shfl_xor(ss, o);
            const float r = rsqrtf(ss * (1.0f / DM) + EPS);
#pragma unroll
            for (int i = 0; i < 4; ++i) { const f32x4 w = *(const f32x4*)(postw + lane * 4 + 256 * i); xv[i] += mv[i] * r * w; }
        }
        if (outf) {
#pragma unroll
            for (int i = 0; i < 4; ++i) *(f32x4*)(outf + (size_t)row * DM + lane * 4 + 256 * i) = xv[i];
        } else {
            float ss = 0.f;
#pragma unroll
            for (int i = 0; i < 4; ++i) ss += xv[i][0] * xv[i][0] + xv[i][1] * xv[i][1] + xv[i][2] * xv[i][2] + xv[i][3] * xv[i][3];
#pragma unroll
            for (int o = 32; o >= 1; o >>= 1) ss += __shfl_xor(ss, o);
            const float ms = ss * (1.0f / DM) + EPS, r = rsqrtf(ms);
            if (lane == 0) s_out[row] = ms * r;
#pragma unroll
            for (int i = 0; i < 4; ++i) { const f32x4 y = xv[i] * r;
                u32x2 o2; o2.x = cvt_pk_bf16(y[0], y[1]); o2.y = cvt_pk_bf16(y[2], y[3]); *(u32x2*)(xh_out + (size_t)row * DM + lane * 4 + 256 * i) = o2; }
        }
    }
}

constexpr int NM_LD = 1032;
__device__ __forceinline__ void norm_misc_phase(LAS unsigned char* lds, const float* xin, const bf16_t* xh_in, const float* s_in, const bf16_t* mix, const float* postw, bf16_t* xh_out, float* s_out,
                                                const bf16_t* Wm  , bf16_t* IK, float* IW, float* BLR) {
    const int tid0 = opaque_tid(), lane = tid0 & 63, wave = __builtin_amdgcn_readfirstlane(tid0 >> 6);
    LAS bf16_t* xs = (LAS bf16_t*)lds;
    for (int pq = blockIdx.x; pq < T / 64; pq += gridDim.x) {
        for (int i = 0; i < 8; ++i) {
            const int rl = wave * 8 + i, row = pq * 64 + rl;
            f32x4 xv[4];
            if (xin) {
#pragma unroll
                for (int k = 0; k < 4; ++k) xv[k] = *(const f32x4*)(xin + (size_t)row * DM + lane * 4 + 256 * k);
            } else {
                const float sc = s_in[row];
#pragma unroll
                for (int k = 0; k < 4; ++k) { const u32x2 xw = *(const u32x2*)(xh_in + (size_t)row * DM + lane * 4 + 256 * k); xv[k] = (f32x4){bflo(xw.x), bfhi(xw.x), bflo(xw.y), bfhi(xw.y)} * sc; }
            }
            if (mix) {
                f32x4 mv[4]; float ss = 0.f;
#pragma unroll
                for (int k = 0; k < 4; ++k) { const u32x2 mw = *(const u32x2*)(mix + (size_t)row * DM + lane * 4 + 256 * k); mv[k] = (f32x4){bflo(mw.x), bfhi(mw.x), bflo(mw.y), bfhi(mw.y)};
                    ss += mv[k][0] * mv[k][0] + mv[k][1] * mv[k][1] + mv[k][2] * mv[k][2] + mv[k][3] * mv[k][3]; }
#pragma unroll
                for (int o = 32; o >= 1; o >>= 1) ss += __shfl_xor(ss, o);
                const float r = rsqrtf(ss * (1.0f / DM) + EPS);
#pragma unroll
                for (int k = 0; k < 4; ++k) { const f32x4 w = *(const f32x4*)(postw + lane * 4 + 256 * k); xv[k] += mv[k] * r * w; }
            }
            float ss = 0.f;
#pragma unroll
            for (int k = 0; k < 4; ++k) ss += xv[k][0] * xv[k][0] + xv[k][1] * xv[k][1] + xv[k][2] * xv[k][2] + xv[k][3] * xv[k][3];
#pragma unroll
            for (int o = 32; o >= 1; o >>= 1) ss += __shfl_xor(ss, o);
            const float ms = ss * (1.0f / DM) + EPS, r = rsqrtf(ms);
            if (lane == 0) s_out[row] = ms * r;
#pragma unroll
            for (int k = 0; k < 4; ++k) { const f32x4 y = xv[k] * r;
                u32x2 o2; o2.x = cvt_pk_bf16(y[0], y[1]); o2.y = cvt_pk_bf16(y[2], y[3]);
                *(u32x2*)(xh_out + (size_t)row * DM + lane * 4 + 256 * k) = o2; *(LAS u32x2*)(xs + rl * NM_LD + lane * 4 + 256 * k) = o2; }
        }
        __syncthreads();
        if (wave < 6) {
            const int n = lane & 15, kq = lane >> 4;
            f32x4 acc[4];
#pragma unroll
            for (int mt = 0; mt < 4; ++mt) acc[mt] = (f32x4){0.f, 0.f, 0.f, 0.f};
            const bf16_t* wrow = Wm + (size_t)(16 * wave + n) * 1024 + 8 * kq;
            for (int ks = 0; ks < 32; ks += 4) {
                bf16x8 bf[4];
#pragma unroll
                for (int u = 0; u < 4; ++u) bf[u] = *(const bf16x8*)(wrow + (ks + u) * 32);
#pragma unroll
                for (int u = 0; u < 4; ++u)
#pragma unroll
                    for (int mt = 0; mt < 4; ++mt) { const bf16x8 af = *(const LAS bf16x8*)(xs + (16 * mt + n) * NM_LD + (ks + u) * 32 + 8 * kq);
                        acc[mt] = __builtin_amdgcn_mfma_f32_16x16x32_bf16(af, bf[u], acc[mt], 0, 0, 0); }
            }
#pragma unroll
            for (int mt = 0; mt < 4; ++mt)
#pragma unroll
                for (int j = 0; j < 4; ++j) { const int row = pq * 64 + 16 * mt + 4 * kq + j; const float v = acc[mt][j];
                    if (wave < 4) { const int cc = 16 * wave + n, q = cc >> 3, bb = row >> 12, sq = row & 4095;
                        IK[((((size_t)(bb * 128 + (sq >> 5)) * 4 + (q >> 1)) * 2 + (q & 1)) * 32 + (sq & 31)) * 8 + (cc & 7)] = f2bf(v); }
                    else if (wave == 4) { if (n < 8) IW[(size_t)row * 8 + n] = v * IW_SCALE; else BLR[(size_t)row * 16 + (n - 8)] = v; }
                    else { if (n < 8) BLR[(size_t)row * 16 + 8 + n] = v; } }
        }
        __syncthreads();
    }
}

#define IDX_AF(AF, b_, t0_) do { \
        const int qi_ = 2 * ((c >> 2) & 1) + (c >> 4), hh_ = (c & 3) + 4 * ((c >> 3) & 1);   \
        _Pragma("unroll") for (int mt = 0; mt < 2; ++mt) { const size_t tq_ = (size_t)(b_) * SEQ + (t0_) + 4 * mt + qi_; \
            _Pragma("unroll") for (int ks = 0; ks < 4; ++ks) AF[mt][ks] = *(const bf16x8*)(IQ + tq_ * 512 + hh_ * 64 + ks * 16 + 8 * g); } } while (0)
#define IDX_WV(WV, b_, t0_) do { \
        _Pragma("unroll") for (int mt = 0; mt < 2; ++mt) _Pragma("unroll") for (int qq = 0; qq < 2; ++qq) { const size_t tq_ = (size_t)(b_) * SEQ + (t0_) + 4 * mt + 2 * g + qq; \
            const f32x4 w0_ = *(const f32x4*)(IW + tq_ * 8), w1_ = *(const f32x4*)(IW + tq_ * 8 + 4); \
            WV[mt][qq][0] = w0_[0]; WV[mt][qq][1] = w0_[1]; WV[mt][qq][2] = w0_[2]; WV[mt][qq][3] = w0_[3]; WV[mt][qq][4] = w1_[0]; WV[mt][qq][5] = w1_[1]; WV[mt][qq][6] = w1_[2]; WV[mt][qq][7] = w1_[3]; } } while (0)

__device__ __forceinline__ void indexer_phase(LAS float* sc, const bf16_t* IQ, const bf16_t* IK, const float* IW, u64* MASK, int wave, int lane) {
    const int g = lane >> 5, c = lane & 31, G = gridDim.x;
    bf16x8 af[2][4];
#define IDX_ITEM(k_) ((k_) * G + (((k_) & 1) ? (G - 1 - (int)blockIdx.x) : (int)blockIdx.x))
    { const int it0 = IDX_ITEM(0); if (it0 < 2048) IDX_AF(af, it0 & 3, (511 - (it0 >> 2)) * 8); }
        for (int kk = 0; kk * G < 2048; ++kk) {
    const int it = IDX_ITEM(kk); if (it >= 2048) break;
    const int b = it & 3, t0 = (511 - (it >> 2)) * 8;
    float wv[2][2][8];
    IDX_WV(wv, b, t0);
    const int ntiles = (t0 + 8 + 31) >> 5;
    const bf16_t* ikb = IK + (size_t)b * 128 * 2048 + (size_t)(g * 32 + c) * 8;
#define IDX_LOAD(buf, kt_) do { if ((kt_) < ntiles) { _Pragma("unroll") for (int ks = 0; ks < 4; ++ks) buf[ks] = *(const bf16x8*)(ikb + (size_t)(kt_) * 2048 + ks * 512); } } while (0)
#define IDX_TILE(buf, kt_) do { if ((kt_) < ntiles) { const int key = (kt_) * 32 + c; f32x16 a0, a1; \
        _Pragma("unroll") for (int r = 0; r < 16; ++r) { a0[r] = 0.f; a1[r] = 0.f; } \
        _Pragma("unroll") for (int ks = 0; ks < 4; ++ks) { a0 = __builtin_amdgcn_mfma_f32_32x32x16_bf16(af[0][ks], buf[ks], a0, 0, 0, 0); a1 = __builtin_amdgcn_mfma_f32_32x32x16_bf16(af[1][ks], buf[ks], a1, 0, 0, 0); } \
        _Pragma("unroll") for (int qq = 0; qq < 2; ++qq) { float s0 = 0.f, s1 = 0.f; \
            _Pragma("unroll") for (int h = 0; h < 8; ++h) { s0 += wv[0][qq][h] * fmaxf(a0[8 * qq + h], 0.f); s1 += wv[1][qq][h] * fmaxf(a1[8 * qq + h], 0.f); } \
            sc[(0 + 2 * g + qq) * 4096 + key] = s0; sc[(4 + 2 * g + qq) * 4096 + key] = s1; } } } while (0)
    {
        bf16x8 b0[4], b1[4], b2[4];
        IDX_LOAD(b0, wave); IDX_LOAD(b1, wave + 8);
        for (int kt = wave; kt < ntiles; kt += 24) {
            IDX_LOAD(b2, kt + 16); IDX_TILE(b0, kt);
            IDX_LOAD(b0, kt + 24); IDX_TILE(b1, kt + 8);
            IDX_LOAD(b1, kt + 32); IDX_TILE(b2, kt + 16);
        }
    }
#undef IDX_LOAD
#undef IDX_TILE
    __syncthreads();
    bf16x8 afn[2][4];
    { const int itn = IDX_ITEM(kk + 1); if ((kk + 1) * G < 2048 && itn < 2048) IDX_AF(afn, itn & 3, (511 - (itn >> 2)) * 8); }
    {
        const int t = t0 + wave, nvalid = t + 1, nreg = (nvalid + 63) >> 6, ngrp = (nreg + 7) >> 3;
        const int gfull = nvalid >> 9;
        LAS float* myrow = sc + wave * 4096;
        float sf[64];
#pragma unroll
        for (int jj = 0; jj < 8; ++jj) {
            if (jj < gfull) {
#pragma unroll
                for (int j8 = 0; j8 < 8; ++j8) sf[jj * 8 + j8] = myrow[64 * (jj * 8 + j8) + lane];
            } else if (jj < ngrp) {
#pragma unroll
                for (int j8 = 0; j8 < 8; ++j8) { const int j = jj * 8 + j8, kk = 64 * j + lane; const float v = myrow[kk]; sf[j] = (kk < nvalid) ? v : NEG_INF; }
            } else {
#pragma unroll
                for (int j8 = 0; j8 < 8; ++j8) sf[jj * 8 + j8] = NEG_INF;
            }
        }
        float thr_f = NEG_INF; int need = 0; bool ties = false;
#define CNT_GEF(valf, out) do { int c_ = 0; _Pragma("unroll") for (int jj = 0; jj < 8; ++jj) if (jj < ngrp) { _Pragma("unroll") for (int j8 = 0; j8 < 8; ++j8) c_ += (sf[jj * 8 + j8] >= (valf)) ? 1 : 0; } \
            (out) = wave_sum_i32(c_); } while (0)
        if (nvalid > 256) {
            float mx = NEG_INF, mn = -NEG_INF;
#pragma unroll
            for (int jj = 0; jj < 8; ++jj) { if (jj < gfull) {
#pragma unroll
                for (int j8 = 0; j8 < 8; ++j8) { const float v = sf[jj * 8 + j8]; mx = fmaxf(mx, v); mn = fminf(mn, v); } }
              else if (jj < ngrp) {
#pragma unroll
                for (int j8 = 0; j8 < 8; ++j8) { const float v = sf[jj * 8 + j8]; mx = fmaxf(mx, v); mn = fminf(mn, v == NEG_INF ? -NEG_INF : v); } } }
            mx = wave_max_f32(mx); mn = -wave_max_f32(-mn);
            const float scale = (mx > mn) ? 3839.0f / (mx - mn) : 0.f;
            LAS unsigned* hist = (LAS unsigned*)myrow;
#pragma unroll
            for (int k = 0; k < 16; ++k) *(LAS u32x4*)(hist + 4 * lane + 256 * k) = (u32x4){0u, 0u, 0u, 0u};
            __builtin_amdgcn_fence(__ATOMIC_RELEASE, "wavefront");
#pragma unroll
            for (int jj = 0; jj < 8; ++jj) { if (jj < gfull) {
#pragma unroll
                for (int j8 = 0; j8 < 8; ++j8) { const float v = sf[jj * 8 + j8];
                    int bn = (int)((v - mn) * scale); bn = bn > 3839 ? 3839 : bn; __hip_atomic_fetch_add(hist + (bn >> 6) * 68 + (bn & 63), 1u, __ATOMIC_RELAXED, __HIP_MEMORY_SCOPE_WAVEFRONT); } }
              else if (jj < ngrp) {
#pragma unroll
                for (int j8 = 0; j8 < 8; ++j8) { const float v = sf[jj * 8 + j8];
                    if (v != NEG_INF) { int bn = (int)((v - mn) * scale); bn = bn > 3839 ? 3839 : bn; __hip_atomic_fetch_add(hist + (bn >> 6) * 68 + (bn & 63), 1u, __ATOMIC_RELAXED, __HIP_MEMORY_SCOPE_WAVEFRONT); } } } }
            __builtin_amdgcn_fence(__ATOMIC_ACQ_REL, "wavefront");
            int cs = 0;
            if (lane < 60) {
#pragma unroll
                for (int k = 0; k < 16; ++k) { const u32x4 h4 = *(const LAS u32x4*)(hist + lane * 68 + 4 * k); cs += (int)((h4.x + h4.y) + (h4.z + h4.w)); }
            }
            int C, Bl, cnt_above, nA;
            {
                const int pre = wave_prefix_sum_i32(cs), tot = __builtin_amdgcn_readlane(pre, 63), suf = tot - pre + cs;
                const u64 mk = __ballot(suf >= 256);
                C = 63 - __builtin_clzll(mk);
                const int above_c = __builtin_amdgcn_readlane(suf, C) - __builtin_amdgcn_readlane(cs, C);
                const int bs = (int)hist[C * 68 + lane];
                const int pre2 = wave_prefix_sum_i32(bs), tot2 = __builtin_amdgcn_readlane(pre2, 63), suf2 = tot2 - pre2 + bs;
                const u64 mk2 = __ballot(suf2 >= 256 - above_c);
                Bl = 63 - __builtin_clzll(mk2);
                nA = __builtin_amdgcn_readlane(bs, Bl);
                cnt_above = above_c + __builtin_amdgcn_readlane(suf2, Bl) - nA;
            }
            const int binA = C * 64 + Bl, need1 = 256 - cnt_above;
            if (nA <= 64) {
                unsigned cv = 0u; int pos = 0;
                const float invs = (mx - mn) * (1.0f / 3839.0f), lo_f = mn + ((float)binA - 0.5f) * invs, hi_f = mn + ((float)binA + 1.5f) * invs;
#pragma unroll
                for (int jj = 0; jj < 8; ++jj) if (jj < ngrp) {
#pragma unroll
                    for (int j8 = 0; j8 < 8; ++j8) { const float v = sf[jj * 8 + j8];
                        u64 m = __ballot(v >= lo_f && v < hi_f);
                        if (m) { int bn = (int)((v - mn) * scale); bn = bn > 3839 ? 3839 : bn; m = __ballot(v >= lo_f && v < hi_f && bn == binA); }
                        while (m) { const int l = __builtin_ctzll(m); m &= m - 1ull; const unsigned uu = (unsigned)__builtin_amdgcn_readlane((int)__float_as_uint(v), l);
                            const unsigned kv = (uu & 0x80000000u) ? ~uu : (uu | 0x80000000u); if (lane == pos) cv = kv; ++pos; } } }
                unsigned tc = 0u;
                for (int bit = 31; bit >= 0; --bit) { const unsigned cand = tc | (1u << bit); if (__popcll(__ballot(cv >= cand)) >= need1) tc = cand; }
                thr_f = __uint_as_float((tc & 0x80000000u) ? (tc ^ 0x80000000u) : ~tc);
                const int cgt = cnt_above + __popcll(__ballot(cv > tc)), ceq = __popcll(__ballot(cv == tc));
                need = 256 - cgt; ties = (ceq != need);
            } else {
                unsigned tc = 0u;
                for (int bit = 31; bit >= 0; --bit) { const unsigned cand = tc | (1u << bit); const float cf = __uint_as_float((cand & 0x80000000u) ? (cand ^ 0x80000000u) : ~cand);
                    int cnt; CNT_GEF(cf, cnt); if (cnt >= 256) tc = cand; }
                thr_f = __uint_as_float((tc & 0x80000000u) ? (tc ^ 0x80000000u) : ~tc);
                int cge, cg = 0;
                CNT_GEF(thr_f, cge);
#pragma unroll
                for (int jj = 0; jj < 8; ++jj) if (jj < ngrp) {
#pragma unroll
                    for (int j8 = 0; j8 < 8; ++j8) cg += (sf[jj * 8 + j8] > thr_f) ? 1 : 0; }
                const int cgt = wave_sum_i32(cg);
                need = 256 - cgt; ties = ((cge - cgt) != need);
            }
        }
#undef CNT_GEF
        u64 myword = 0ull;
        if (nvalid <= 256) {
#pragma unroll
            for (int j = 0; j < 4; ++j) { const u64 mm = __ballot(64 * j + lane < nvalid); if (lane == j) myword = mm; }
        } else if (!ties) {
#pragma unroll
            for (int jj = 0; jj < 8; ++jj) if (jj < ngrp) {
#pragma unroll
                for (int j8 = 0; j8 < 8; ++j8) { const int j = jj * 8 + j8; const u64 mm = __ballot(sf[j] >= thr_f); if (lane == j) myword = mm; if ((j & 3) == 3) __builtin_amdgcn_sched_barrier(0); } }
        } else {
            int base = 0;
#pragma unroll
            for (int j = 0; j < 64; ++j) { const bool eq = sf[j] == thr_f; const u64 em = __ballot(eq);
                const int rank = base + (int)__builtin_amdgcn_mbcnt_hi((unsigned)(em >> 32), __builtin_amdgcn_mbcnt_lo((unsigned)em, 0u));
                const u64 mm = __ballot(sf[j] > thr_f || (eq && rank < need)); base += __popcll(em);
                if (lane == j) myword = mm; __builtin_amdgcn_sched_barrier(0); }
        }
        LAS u64* mst = (LAS u64*)(sc + 32768);
        mst[lane * 8 + wave] = myword;
    }
    __syncthreads();
    { const int tid_ = wave * 64 + lane, kt_ = tid_ >> 3, q_ = tid_ & 7; const LAS u64* mst = (const LAS u64*)(sc + 32768);
      MASK[((size_t)b * 64 + kt_) * SEQ + t0 + q_] = mst[kt_ * 8 + q_]; }
#pragma unroll
    for (int mt = 0; mt < 2; ++mt) {
#pragma unroll
        for (int ks = 0; ks < 4; ++ks) af[mt][ks] = afn[mt][ks];
    }
    }
}
#undef IDX_AF
#undef IDX_WV
#undef IDX_ITEM

constexpr int GL_BLR = 0;
constexpr int GL_W2  = GL_BLR + 4096;
constexpr int GL_GP  = GL_W2 + 4096;
constexpr int GL_QD  = GL_GP + 2048;
constexpr int GL_KD  = GL_QD + 64 * 72 * 2;
constexpr int GL_KT  = GL_KD + 64 * 72 * 2;
constexpr int GL_VT  = GL_KT + 64 * 72 * 2;
constexpr int GL_P   = GL_VT + 128 * 72 * 2;
constexpr int GL_O   = GL_P + 64 * 72 * 2;
constexpr int GL_END = GL_O + 64 * 132 * 4;

__device__ __forceinline__ void gla_stage_vt(LAS bf16_t* vt, const u32x4 (&vraw)[2], int tid) {
#pragma unroll
    for (int rep = 0; rep < 2; ++rep) { const int idx = tid + 512 * rep, j = idx >> 4, dv8 = (idx & 15) * 8;
        const u32x4 w = vraw[rep];
        vt[(dv8 + 0) * 72 + j] = (bf16_t)(w.x & 0xFFFF); vt[(dv8 + 1) * 72 + j] = (bf16_t)(w.x >> 16);
        vt[(dv8 + 2) * 72 + j] = (bf16_t)(w.y & 0xFFFF); vt[(dv8 + 3) * 72 + j] = (bf16_t)(w.y >> 16);
        vt[(dv8 + 4) * 72 + j] = (bf16_t)(w.z & 0xFFFF); vt[(dv8 + 5) * 72 + j] = (bf16_t)(w.z >> 16);
        vt[(dv8 + 6) * 72 + j] = (bf16_t)(w.w & 0xFFFF); vt[(dv8 + 7) * 72 + j] = (bf16_t)(w.w >> 16); }
}
__device__ __forceinline__ void gla_prep_state(LAS unsigned char* lds, const float* gw2, const float* gb2, int b, int hh, int n,
                                               bf16_t* BQ, bf16_t* BK, const bf16_t* BV, const float* BLR, float* DECAY) {
    const int tid = opaque_tid(), d = tid & 63, jg = tid >> 6;
    const size_t tok0 = (size_t)b * SEQ + n * 64;
    LAS float* blr = (LAS float*)(lds + GL_BLR); LAS float* w2s = (LAS float*)(lds + GL_W2); LAS float* gp = (LAS float*)(lds + GL_GP);
    LAS bf16_t* kt = (LAS bf16_t*)(lds + GL_KT); LAS bf16_t* vt = (LAS bf16_t*)(lds + GL_VT);
    bf16_t kraw[8], qraw[8]; u32x4 vraw[2];
#pragma unroll
    for (int i = 0; i < 8; ++i) { kraw[i] = BK[(tok0 + 8 * jg + i) * 256 + hh * 64 + d]; qraw[i] = BQ[(tok0 + 8 * jg + i) * 256 + hh * 64 + d]; }
#pragma unroll
    for (int rep = 0; rep < 2; ++rep) { const int idx = tid + 512 * rep; vraw[rep] = *(const u32x4*)(BV + (tok0 + (idx >> 4)) * 512 + hh * 128 + (idx & 15) * 8); }
    if (tid < 256) { *(LAS f32x4*)(blr + tid * 4) = *(const f32x4*)(BLR + tok0 * 16 + tid * 4); }
    else { const int q = tid - 256, r = q >> 4, d4 = (q & 15) * 4; *(LAS f32x4*)(w2s + r * 64 + d4) = *(const f32x4*)(gw2 + (size_t)r * 256 + hh * 64 + d4); }
    __syncthreads();
    float cs[8];
    { const float b2 = gb2[hh * 64 + d]; float run = 0.f; float w2c[16];
#pragma unroll
      for (int r = 0; r < 16; ++r) w2c[r] = w2s[r * 64 + d];
#pragma unroll
      for (int i = 0; i < 8; ++i) { float z = b2;
#pragma unroll
          for (int q = 0; q < 4; ++q) { const f32x4 bl = *(const LAS f32x4*)(blr + (8 * jg + i) * 16 + 4 * q);
              z += bl[0] * w2c[4 * q + 0]; z += bl[1] * w2c[4 * q + 1]; z += bl[2] * w2c[4 * q + 2]; z += bl[3] * w2c[4 * q + 3]; }
          const float la = -(fmaxf(-z, 0.f) + __logf(1.0f + __expf(-fabsf(z)))) * (1.0f / 16.0f);
          run += la; cs[i] = run; }
      gp[jg * 64 + d] = run; }
    __syncthreads();
    float off = 0.f, glast = 0.f;
#pragma unroll
    for (int j = 0; j < 8; ++j) { const float v = gp[j * 64 + d]; if (j < jg) off += v; glast += v; }
    const float eglast = __expf(glast);
    if (jg == 0) DECAY[((size_t)(b * 4 + hh) * 64 + n) * 64 + d] = eglast;
    unsigned ktw[4];
#pragma unroll
    for (int i = 0; i < 8; i += 2) {
        float ktv[2];
#pragma unroll
        for (int ii = 0; ii < 2; ++ii) { const int j = 8 * jg + i + ii; const float G = off + cs[i + ii];
            const float kv = bf2f(kraw[i + ii]), qv = bf2f(qraw[i + ii]);
            const float eg = __expf(G), eng = __builtin_amdgcn_rcpf(eg), kdv = kv * eng;
            ktv[ii] = kdv * eglast;
            BQ[(tok0 + j) * 256 + hh * 64 + d] = (bf16_t)(cvt_pk_bf16(qv * 0.125f * eg, 0.f) & 0xFFFFu);
            BK[(tok0 + j) * 256 + hh * 64 + d] = (bf16_t)(cvt_pk_bf16(kdv, 0.f) & 0xFFFFu); }
        ktw[i >> 1] = cvt_pk_bf16(ktv[0], ktv[1]);
    }
    *(LAS u32x4*)(kt + d * 72 + 8 * jg) = (u32x4){ktw[0], ktw[1], ktw[2], ktw[3]};
    gla_stage_vt(vt, vraw, tid);
    __syncthreads();
}
__device__ __forceinline__ void gla_prep_out(LAS unsigned char* lds, int b, int hh, int n, const bf16_t* BQ, const bf16_t* BK, const bf16_t* BV) {
    const int tid = opaque_tid(), row = tid >> 3, ch = (tid & 7) * 8;
    const size_t tok0 = (size_t)b * SEQ + n * 64;
    LAS bf16_t* qd = (LAS bf16_t*)(lds + GL_QD); LAS bf16_t* kd = (LAS bf16_t*)(lds + GL_KD); LAS bf16_t* vt = (LAS bf16_t*)(lds + GL_VT);
    u32x4 vraw[2];
    const u32x4 qw = *(const u32x4*)(BQ + (tok0 + row) * 256 + hh * 64 + ch), kw = *(const u32x4*)(BK + (tok0 + row) * 256 + hh * 64 + ch);
#pragma unroll
    for (int rep = 0; rep < 2; ++rep) { const int idx = tid + 512 * rep; vraw[rep] = *(const u32x4*)(BV + (tok0 + (idx >> 4)) * 512 + hh * 128 + (idx & 15) * 8); }
    *(LAS u32x4*)(qd + row * 72 + ch) = qw; *(LAS u32x4*)(kd + row * 72 + ch) = kw;
    gla_stage_vt(vt, vraw, tid);
    __syncthreads();
}

__device__ __forceinline__ void gla_state_item(LAS unsigned char* lds, const float* gw2, const float* gb2, int item, bf16_t* BQ, bf16_t* BK, const bf16_t* BV, const float* BLR, float* DECAY, float* GSTATE) {
    const int b = item >> 8, hh = (item >> 6) & 3, n = item & 63;
    gla_prep_state(lds, gw2, gb2, b, hh, n, BQ, BK, BV, BLR, DECAY);
    const int tid1 = opaque_tid(), lane = tid1 & 63, wave = tid1 >> 6, g = lane >> 5, c = lane & 31, mt = wave >> 1, nt = wave & 1;
    LAS bf16_t* kt = (LAS bf16_t*)(lds + GL_KT); LAS bf16_t* vt = (LAS bf16_t*)(lds + GL_VT);
    f32x16 acc;
#pragma unroll
    for (int r = 0; r < 16; ++r) acc[r] = 0.f;
#pragma unroll
    for (int ks = 0; ks < 4; ++ks) { const bf16x8 af = *(const LAS bf16x8*)(vt + (32 * mt + c) * 72 + ks * 16 + 8 * g); const bf16x8 bf = *(const LAS bf16x8*)(kt + (32 * nt + c) * 72 + ks * 16 + 8 * g);
        acc = __builtin_amdgcn_mfma_f32_32x32x16_bf16(af, bf, acc, 0, 0, 0); }
    float* dst = GSTATE + ((size_t)(b * 4 + hh) * 64 + n) * 8192;
#pragma unroll
    for (int r = 0; r < 16; ++r) { const int dv = 32 * mt + (r & 3) + 8 * (r >> 2) + 4 * g; dst[dv * 64 + 32 * nt + c] = acc[r]; }
    __syncthreads();
}

__device__ __forceinline__ void gla_out_item(LAS unsigned char* lds, const float* gw2, const float* gb2, int item, const bf16_t* BQ, const bf16_t* BK, const bf16_t* BV, const float* BLR, const bf16_t* BG,
                                              const bf16_t* SPREV, bf16_t* MIXIN) {
    const int b = item >> 8, hh = (item >> 6) & 3, n = item & 63;
    const int tid = opaque_tid(), lane = tid & 63, wave = tid >> 6, g = lane >> 5, c = lane & 31;
    bf16x8 spf[4]; u32x4 g0, g1;
    { const bf16_t* sp = SPREV + ((size_t)(b * 4 + hh) * 64 + n) * 8192 + (size_t)(32 * (wave & 3) + c) * 64 + 8 * g;
#pragma unroll
      for (int ks = 0; ks < 4; ++ks) spf[ks] = *(const bf16x8*)(sp + ks * 16);
      const size_t tokg = (size_t)b * SEQ + n * 64 + (tid >> 3);
      g0 = *(const u32x4*)(BG + tokg * 512 + hh * 128 + (tid & 7) * 16); g1 = *(const u32x4*)(BG + tokg * 512 + hh * 128 + (tid & 7) * 16 + 8); }
    gla_prep_out(lds, b, hh, n, BQ, BK, BV);
    LAS bf16_t* qd = (LAS bf16_t*)(lds + GL_QD); LAS bf16_t* kd = (LAS bf16_t*)(lds + GL_KD); LAS bf16_t* vt = (LAS bf16_t*)(lds + GL_VT); LAS bf16_t* P = (LAS bf16_t*)(lds + GL_P);
    LAS float* o = (LAS float*)(lds + GL_O);
    if (wave < 4) {
        const int mt = wave >> 1, nt = wave & 1;
        f32x16 acc;
#pragma unroll
        for (int r = 0; r < 16; ++r) acc[r] = 0.f;
        if (!(mt == 0 && nt == 1)) {
#pragma unroll
            for (int ks = 0; ks < 4; ++ks) { const bf16x8 af = *(const LAS bf16x8*)(qd + (32 * mt + c) * 72 + ks * 16 + 8 * g); const bf16x8 bf = *(const LAS bf16x8*)(kd + (32 * nt + c) * 72 + ks * 16 + 8 * g);
                acc = __builtin_amdgcn_mfma_f32_32x32x16_bf16(af, bf, acc, 0, 0, 0); }
        }
#pragma unroll
        for (int r = 0; r < 16; ++r) { const int i = 32 * mt + (r & 3) + 8 * (r >> 2) + 4 * g, j = 32 * nt + c; P[i * 72 + j] = f2bf(j <= i ? acc[r] : 0.f); }
    }
    __syncthreads();
    {
        const int mt = wave >> 2, nt = wave & 3;
        f32x16 acc;
#pragma unroll
        for (int r = 0; r < 16; ++r) acc[r] = 0.f;
#pragma unroll
        for (int ks = 0; ks < 4; ++ks) { const bf16x8 af = *(const LAS bf16x8*)(P + (32 * mt + c) * 72 + ks * 16 + 8 * g); const bf16x8 bf = *(const LAS bf16x8*)(vt + (32 * nt + c) * 72 + ks * 16 + 8 * g);
            acc = __builtin_amdgcn_mfma_f32_32x32x16_bf16(af, bf, acc, 0, 0, 0); }
#pragma unroll
        for (int ks = 0; ks < 4; ++ks) { const bf16x8 af = *(const LAS bf16x8*)(qd + (32 * mt + c) * 72 + ks * 16 + 8 * g); acc = __builtin_amdgcn_mfma_f32_32x32x16_bf16(af, spf[ks], acc, 0, 0, 0); }
#pragma unroll
        for (int r = 0; r < 16; ++r) { const int i = 32 * mt + (r & 3) + 8 * (r >> 2) + 4 * g; o[i * 132 + 32 * nt + c] = acc[r]; }
    }
    __syncthreads();
    {
        const int row = tid >> 3, part = tid & 7; float v[16]; float ss = 0.f;
#pragma unroll
        for (int k = 0; k < 16; ++k) { v[k] = o[row * 132 + part * 16 + k]; ss += v[k] * v[k]; }
        ss += __shfl_xor(ss, 1); ss += __shfl_xor(ss, 2); ss += __shfl_xor(ss, 4);
        const float r = rsqrtf(ss * (1.0f / 128.0f) + EPS);
        const size_t tok = (size_t)b * SEQ + n * 64 + row;
        const float gv[16] = {bflo(g0.x), bfhi(g0.x), bflo(g0.y), bfhi(g0.y), bflo(g0.z), bfhi(g0.z), bflo(g0.w), bfhi(g0.w),
                              bflo(g1.x), bfhi(g1.x), bflo(g1.y), bfhi(g1.y), bflo(g1.z), bfhi(g1.z), bflo(g1.w), bfhi(g1.w)};
        unsigned w[8];
#pragma unroll
        for (int k = 0; k < 8; ++k) w[k] = cvt_pk_bf16(v[2 * k] * r * gv[2 * k], v[2 * k + 1] * r * gv[2 * k + 1]);
        bf16_t* dp = MIXIN + tok * 1024 + 512 + hh * 128 + part * 16;
        *(u32x4*)dp = (u32x4){w[0], w[1], w[2], w[3]}; *(u32x4*)(dp + 8) = (u32x4){w[4], w[5], w[6], w[7]};
    }
    __syncthreads();
}

constexpr int AT_K0 = 0, AT_V0 = 9216, AT_STAGE = 18432, AT_BT = 2 * AT_STAGE;
constexpr float LOG2E = 1.4426950408889634f, AT_C1 = 0.125f * LOG2E, AT_THR = 8.0f;

template <bool NEAR>
__device__ __forceinline__ void attn_tile(const LAS bf16_t* Kt, const LAS bf16_t* Vt, const LAS float* btl, const bf16x8 (&qf)[4], f32x16& O0, f32x16& O1, float& m_ref, f32x16& Lt,
                                          u64 mw, int tq, int key0, int g, int c) {
    const int pc = (c & 0x13) | ((c & 4) << 1) | ((c & 8) >> 1);
    f32x16 s0, s1;
#pragma unroll
    for (int r = 0; r < 16; ++r) { s0[r] = 0.f; s1[r] = 0.f; }
#pragma unroll
    for (int ks = 0; ks < 4; ++ks) {
        const bf16x8 k0 = *(const LAS bf16x8*)(Kt + pc * 72 + ks * 16 + 8 * g), k1 = *(const LAS bf16x8*)(Kt + (32 + pc) * 72 + ks * 16 + 8 * g);
        s0 = __builtin_amdgcn_mfma_f32_32x32x16_bf16(k0, qf[ks], s0, 0, 0, 0); s1 = __builtin_amdgcn_mfma_f32_32x32x16_bf16(k1, qf[ks], s1, 0, 0, 0);
    }
    const unsigned w0 = (unsigned)mw >> (8 * g), w1 = (unsigned)(mw >> 32) >> (8 * g);
    float x0[16], x1[16];
#pragma unroll
    for (int r = 0; r < 16; ++r) {
        if (NEAR) { const LAS float* pb = btl + (tq - key0 - 8 * g + 96 - 63);
            x0[r] = s0[r] * AT_C1 + pb[63 - (16 * (r >> 3) + (r & 7))]; x1[r] = s1[r] * AT_C1 + pb[63 - (16 * (r >> 3) + (r & 7) + 32)]; }
        else { x0[r] = s0[r]; x1[r] = s1[r]; }
    }
    float mx = x0[0];
    asm("v_max3_f32 %0, %1, %2, %3" : "=v"(mx) : "v"(x0[0]), "v"(x1[0]), "v"(x0[1]));
#pragma unroll
    for (int r = 1; r < 15; r += 1) asm("v_max3_f32 %0, %1, %2, %3" : "=v"(mx) : "v"(mx), "v"(x1[r]), "v"(x0[r + 1]));
    asm("v_max_f32 %0, %1, %2" : "=v"(mx) : "v"(mx), "v"(x1[15]));
    if (!NEAR) mx *= AT_C1;
    if (__any(mx > m_ref + AT_THR)) {
        float ms = NEG_INF;
#pragma unroll
        for (int r = 0; r < 16; ++r) { const int bp = 16 * (r >> 3) + (r & 7);
            const float a0 = ((w0 >> bp) & 1u) ? x0[r] : NEG_INF, a1 = ((w1 >> bp) & 1u) ? x1[r] : NEG_INF; ms = fmaxf(ms, fmaxf(a0, a1)); }
        if (!NEAR) ms *= AT_C1;
        { const auto sw = __builtin_amdgcn_permlane32_swap(__float_as_uint(ms), __float_as_uint(ms), false, false); ms = fmaxf(__uint_as_float(sw[0]), __uint_as_float(sw[1])); }
        const float m_new = fmaxf(m_ref, ms);
        const float alpha = (m_new == NEG_INF) ? 1.0f : __builtin_amdgcn_exp2f(m_ref - m_new);
#pragma unroll
        for (int r = 0; r < 16; ++r) { O0[r] *= alpha; O1[r] *= alpha; Lt[r] *= alpha; }
        m_ref = m_new;
    }
    const float nm = (m_ref == NEG_INF) ? 0.f : -m_ref;
#pragma unroll
    for (int r = 0; r < 16; ++r) { const int bp = 16 * (r >> 3) + (r & 7);
        const float e0 = __builtin_amdgcn_exp2f(NEAR ? (x0[r] + nm) : __builtin_fmaf(x0[r], AT_C1, nm)), e1 = __builtin_amdgcn_exp2f(NEAR ? (x1[r] + nm) : __builtin_fmaf(x1[r], AT_C1, nm));
        unsigned b0, b1;
        asm("v_bfe_i32 %0, %1, %2, 1" : "=v"(b0) : "v"(w0), "n"(bp)); asm("v_bfe_i32 %0, %1, %2, 1" : "=v"(b1) : "v"(w1), "n"(bp));
        x0[r] = __uint_as_float(__float_as_uint(e0) & b0); x1[r] = __uint_as_float(__float_as_uint(e1) & b1); }
#pragma unroll
    for (int s = 0; s < 4; ++s) {
        const float* xp = (s < 2) ? x0 : x1; const int o = 8 * (s & 1);
        u32x4 w; w.x = cvt_pk_bf16(xp[o + 0], xp[o + 1]); w.y = cvt_pk_bf16(xp[o + 2], xp[o + 3]); w.z = cvt_pk_bf16(xp[o + 4], xp[o + 5]); w.w = cvt_pk_bf16(xp[o + 6], xp[o + 7]);
        const bf16x8 pb = *(bf16x8*)&w;
        const bf16x8 v0 = *(const LAS bf16x8*)(Vt + c * 72 + s * 16 + 8 * g), v1 = *(const LAS bf16x8*)(Vt + (32 + c) * 72 + s * 16 + 8 * g);
        O0 = __builtin_amdgcn_mfma_f32_32x32x16_bf16(v0, pb, O0, 0, 0, 0); O1 = __builtin_amdgcn_mfma_f32_32x32x16_bf16(v1, pb, O1, 0, 0, 0);
        const u32x4 onew = (u32x4){0x3F803F80u, 0x3F803F80u, 0x3F803F80u, 0x3F803F80u};
        Lt = __builtin_amdgcn_mfma_f32_32x32x16_bf16(*(const bf16x8*)&onew, pb, Lt, 0, 0, 0);
    }
}

__device__ __forceinline__ void attn_item(LAS unsigned char* lds, const bf16_t* Q, const bf16_t* Kb, const bf16_t* VT, const bf16_t* AG, const u64* MASK, const float* btab, bf16_t* MIXIN,
                                          int b, int head, int qb, int tid) {
    const int lane = tid & 63, wave = __builtin_amdgcn_readfirstlane(tid >> 6), g = lane >> 5, c = lane & 31;
    const int tq0 = qb * 256 + wave * 32, tq = tq0 + c;
    const size_t tokq = (size_t)b * SEQ + tq;
    LAS float* btl = (LAS float*)(lds + AT_BT);
    if (tid < 320) { const int rel = tid - 96; btl[tid] = (rel >= 0 && rel < 128) ? (btab[rel * 8 + head] - btab[127 * 8 + head]) * LOG2E : 0.f; }
    bf16x8 qf[4];
#pragma unroll
    for (int ks = 0; ks < 4; ++ks) qf[ks] = *(const bf16x8*)(Q + tokq * 512 + head * 64 + ks * 16 + 8 * g);
    f32x16 O0, O1;
#pragma unroll
    for (int r = 0; r < 16; ++r) { O0[r] = 0.f; O1[r] = 0.f; }
    float m_ref = NEG_INF; f32x16 Lt;
#pragma unroll
    for (int r = 0; r < 16; ++r) Lt[r] = 0.f;
    const int nt = 4 * qb + 4, my_last = 4 * qb + (wave >> 1);
    const int srow = tid >> 3, sch = tid & 7, sto = (srow * 72 + 8 * sch) * 2;
    const bf16_t* kg = Kb + ((size_t)b * SEQ + srow) * 512 + head * 64 + 8 * sch;
    const bf16_t* vg = VT + ((size_t)(b * 8 + head) * 64 + srow) * 4096 + 8 * sch;
    const u64* Mrow = MASK + (size_t)b * 64 * SEQ + tq;
    { const u32x4 kr = *(const u32x4*)kg, vr = *(const u32x4*)vg; *(LAS u32x4*)(lds + AT_K0 + sto) = kr; *(LAS u32x4*)(lds + AT_V0 + sto) = vr; }
    u64 mw = Mrow[0];
    __syncthreads();
    int ks_near = (tq0 - 175 + 63) >> 6; ks_near = ks_near < 0 ? 0 : ks_near;
#define AT_ITER(BODY) do { const bool more = (kt + 1 < nt); u32x4 kr, vr; u64 mwn = 0ull; \
        if (more) { kr = *(const u32x4*)(kg + (size_t)(kt + 1) * 64 * 512); vr = *(const u32x4*)(vg + (kt + 1) * 64); if (kt + 1 <= my_last) mwn = Mrow[(size_t)(kt + 1) * SEQ]; } \
        { const LAS bf16_t* Kt = (const LAS bf16_t*)(lds + (kt & 1) * AT_STAGE + AT_K0); const LAS bf16_t* Vt = (const LAS bf16_t*)(lds + (kt & 1) * AT_STAGE + AT_V0); BODY; } \
        if (more) { *(LAS u32x4*)(lds + ((kt + 1) & 1) * AT_STAGE + AT_K0 + sto) = kr; *(LAS u32x4*)(lds + ((kt + 1) & 1) * AT_STAGE + AT_V0 + sto) = vr; } \
        mw = mwn; __syncthreads(); } while (0)
    int kt = 0;
    for (; kt < ks_near; ++kt) AT_ITER(attn_tile<false>(Kt, Vt, btl, qf, O0, O1, m_ref, Lt, mw, tq, 64 * kt, g, c));
    for (; kt <= my_last; ++kt) AT_ITER(attn_tile<true>(Kt, Vt, btl, qf, O0, O1, m_ref, Lt, mw, tq, 64 * kt, g, c));
    for (; kt < nt; ++kt) AT_ITER((void)Kt; (void)Vt);
#undef AT_ITER
    const float inv = 1.0f / Lt[0];
#pragma unroll
    for (int mt = 0; mt < 2; ++mt)
#pragma unroll
        for (int rq = 0; rq < 4; ++rq) { const int d0 = 32 * mt + 8 * rq + 4 * g;
            const u32x2 gw = *(const u32x2*)(AG + tokq * 512 + head * 64 + d0);
            const float o0 = (mt ? O1[4 * rq + 0] : O0[4 * rq + 0]) * inv * bflo(gw.x), o1 = (mt ? O1[4 * rq + 1] : O0[4 * rq + 1]) * inv * bfhi(gw.x);
            const float o2 = (mt ? O1[4 * rq + 2] : O0[4 * rq + 2]) * inv * bflo(gw.y), o3 = (mt ? O1[4 * rq + 3] : O0[4 * rq + 3]) * inv * bfhi(gw.y);
            u32x2 ow; ow.x = cvt_pk_bf16(o0, o1); ow.y = cvt_pk_bf16(o2, o3);
            *(u32x2*)(MIXIN + tokq * 1024 + head * 64 + d0) = ow; }
}

constexpr int LDS_BYTES = 147456;
constexpr int MISC_OFF = 131072 + 8192;
constexpr int NPH = 26;

__global__ void __launch_bounds__(NTHREADS, 2) fwd_kernel(Args a) {
    extern __shared__ __attribute__((aligned(16))) unsigned char lds_raw[];
    LAS unsigned char* lds = (LAS unsigned char*)lds_raw;
    const int G = gridDim.x, wg = blockIdx.x;
    volatile LAS unsigned* misc = (volatile LAS unsigned*)(lds + MISC_OFF);
    if (threadIdx.x < 4) misc[threadIdx.x] = 0u;
    __syncthreads();
    XcdBarrier bar; bar.bar = nullptr; bar.x = 0; bar.st = misc;
    if (N_LAUNCHES == 1) bar = xcd_barrier_post((unsigned*)(get_args()->ws + WS_CTL), misc);
    int lo, hi; { ArgsP ap = get_args(); lo = ap->ph_lo; hi = ap->ph_hi; }
#define WSP(type, off) ((type*)(wsl + (off)))
#define IN(k) (lo <= (k) && (k) < hi)
#define SEAM(k) do { if (N_LAUNCHES == 1 && IN(k) && IN((k) + 1)) { XcdBarrier b_ = bar; asm volatile("" : "+s"(b_.bar), "+s"(b_.x)); xcd_barrier(b_); } } while (0)

    if (IN(0)) {
        ArgsP ap = get_args(); unsigned char* wsl = ap->ws;
        weight_phase((LAS float*)lds, ap, wsl);
        if (wg == 0) for (int i = opaque_tid(); i < 1024; i += NTHREADS) { const int rel = i >> 3, h = i & 7; WSP(float, WS_TAB)[i] = ap->rel_bias[t5_bucket(rel) * 8 + h]; }
    }
    SEAM(0);

#define LAYER_BODY(LAYER_) { constexpr int layer = (LAYER_); \
        const int pb = 1 + 6 * layer, e = layer >> 1; \
        constexpr bool even = (layer & 1) == 0; \
        if (IN(pb + 0)) { \
            ArgsP ap = get_args(); unsigned char* wsl = ap->ws; \
            const bf16_t* Wm = WSP(bf16_t, WS_WEIN) + ((size_t)e * NE + 4096) * 1024; \
            if (layer == 0) norm_misc_phase(lds, ap->x, nullptr, nullptr, nullptr, nullptr, WSP(bf16_t, WS_H), WSP(float, WS_XS), Wm, WSP(bf16_t, WS_IK), WSP(float, WS_IW), WSP(float, WS_BLR)); \
            else if (even) norm_misc_phase(lds, nullptr, WSP(bf16_t, WS_H), WSP(float, WS_XS), WSP(bf16_t, WS_MIX), ap->post_norm + (layer - 1) * DM, WSP(bf16_t, WS_H), WSP(float, WS_XS), Wm, WSP(bf16_t, WS_IK), WSP(float, WS_IW), WSP(float, WS_BLR)); \
            else norm_phase(nullptr, WSP(bf16_t, WS_H), WSP(float, WS_XS), WSP(bf16_t, WS_MIX), ap->post_norm + (layer - 1) * DM, WSP(bf16_t, WS_H), WSP(float, WS_XS), nullptr); \
        } \
        SEAM(pb + 0); \
        if (even) { \
            if (IN(pb + 1)) { \
                ArgsP ap = get_args(); unsigned char* wsl = ap->ws; \
                pg8::Gemm gm{WSP(bf16_t, WS_H), WSP(bf16_t, WS_WEIN) + (size_t)e * NE * 1024, T, 4096, 1024, 1024, 1 << 30, 0}; pg8::StaticOrder S; S.init(T, 4096, G, wg); \
                EpiEvenIn E{WSP(bf16_t, WS_Q), WSP(bf16_t, WS_K), WSP(bf16_t, WS_VT), WSP(bf16_t, WS_AG), WSP(bf16_t, WS_IQ), WSP(bf16_t, WS_BQ), WSP(bf16_t, WS_BK), WSP(bf16_t, WS_BV), WSP(bf16_t, WS_BG), \
                            WSP(bf16_t, WS_IK), WSP(float, WS_IW), WSP(float, WS_BLR)}; \
                pg8::gemm_phase(lds, gm, S, E); \
            } \
            SEAM(pb + 1); \
            if (IN(pb + 2)) { \
                ArgsP ap = get_args(); unsigned char* wsl = ap->ws; \
                { const int tid = opaque_tid(), lane = tid & 63, wave = __builtin_amdgcn_readfirstlane(tid >> 6); \
                  indexer_phase((LAS float*)lds, WSP(bf16_t, WS_IQ), WSP(bf16_t, WS_IK), WSP(float, WS_IW), WSP(u64, WS_MASK), wave, lane); } \
                { const float* gw2 = ap->even_gate_w2 + (size_t)e * 16 * 256; const float* gb2 = ap->even_gate_b2 + (size_t)e * 256; \
                  for (int it = wg; it < 1024; it += G) gla_state_item(lds, gw2, gb2, it, WSP(bf16_t, WS_BQ), WSP(bf16_t, WS_BK), WSP(bf16_t, WS_BV), WSP(float, WS_BLR), WSP(float, WS_DECAY), WSP(float, WS_MIXIN)); } \
            } \
            SEAM(pb + 2); \
            if (IN(pb + 3)) { \
                ArgsP ap = get_args(); unsigned char* wsl = ap->ws; \
                const float* GSTATE = WSP(float, WS_MIXIN); const float* DECAY = WSP(float, WS_DECAY); bf16_t* SPREV = WSP(bf16_t, WS_SPREV); \
                for (int el = wg * NTHREADS + opaque_tid(); el < 16 * 8192; el += G * NTHREADS) { \
                    const int bh = el >> 13, rem = el & 8191, dk = rem & 63; float Sv = 0.f; \
                    for (int n = 0; n < 64; ++n) { const size_t o = ((size_t)bh * 64 + n) * 8192 + rem; SPREV[o] = f2bf(Sv); Sv = DECAY[((size_t)bh * 64 + n) * 64 + dk] * Sv + GSTATE[o]; } \
                } \
            } \
            SEAM(pb + 3); \
            if (IN(pb + 4)) { \
                ArgsP ap = get_args(); unsigned char* wsl = ap->ws; \
                { const int tid = opaque_tid(); \
                  for (int it = wg; it < 512; it += G) { const int idx = it & 255, b = idx & 3, head = (idx >> 2) & 7, qbp = idx >> 5, qb = (it < 256) ? 15 - qbp : qbp; \
                      attn_item(lds, WSP(bf16_t, WS_Q), WSP(bf16_t, WS_K), WSP(bf16_t, WS_VT), WSP(bf16_t, WS_AG), WSP(u64, WS_MASK), WSP(float, WS_TAB), WSP(bf16_t, WS_MIXIN), b, head, qb, tid); } } \
                __syncthreads(); \
                { const float* gw2 = ap->even_gate_w2 + (size_t)e * 16 * 256; const float* gb2 = ap->even_gate_b2 + (size_t)e * 256; \
                  for (int it = wg; it < 1024; it += G) gla_out_item(lds, gw2, gb2, it, WSP(bf16_t, WS_BQ), WSP(bf16_t, WS_BK), WSP(bf16_t, WS_BV), WSP(float, WS_BLR), WSP(bf16_t, WS_BG), WSP(bf16_t, WS_SPREV), WSP(bf16_t, WS_MIXIN)); } \
            } \
            SEAM(pb + 4); \
        } else { \
            if (IN(pb + 1)) { \
                ArgsP ap = get_args(); unsigned char* wsl = ap->ws; \
                pg8::Gemm gm{WSP(bf16_t, WS_H), WSP(bf16_t, WS_WOIN) + (size_t)e * 2048 * 1024, T, 2048, 1024, 1024, 1 << 30, 0}; pg8::StaticOrder S; S.init(T, 2048, G, wg); \
                EpiOddIn E{WSP(bf16_t, WS_XR), WSP(bf16_t, WS_GS)}; \
                pg8::gemm_phase(lds, gm, S, E); \
            } \
            SEAM(pb + 1); \
            if (IN(pb + 2)) { \
                ArgsP ap = get_args(); unsigned char* wsl = ap->ws; \
                const bf16_t* XR = WSP(bf16_t, WS_XR); bf16_t* XC = WSP(bf16_t, WS_XC); \
                const float* cw = ap->odd_conv_w + (size_t)e * 4 * 1024; const float* cb = ap->odd_conv_b + (size_t)e * 1024; \
                { const int tid = opaque_tid(), c8 = (tid & 127) * 8; float wq[4][8], bq[8];   \
_Pragma("unroll") \
                  for (int k = 0; k < 8; ++k) { bq[k] = cb[c8 + k]; _Pragma("unroll") for (int j = 0; j < 4; ++j) wq[j][k] = cw[j * 1024 + c8 + k]; } \
                  for (int run = wg * 4 + (tid >> 7); run < T / 8; run += G * 4) { \
                    const int tok0 = run * 8, s0 = tok0 & 4095; float xw[11][8]; \
_Pragma("unroll") \
                    for (int i = 0; i < 11; ++i) { u32x4 w = (u32x4){0u, 0u, 0u, 0u}; if (s0 - 3 + i >= 0) w = *(const u32x4*)(XR + (size_t)(tok0 - 3 + i) * 1024 + c8); \
                        xw[i][0] = bflo(w.x); xw[i][1] = bfhi(w.x); xw[i][2] = bflo(w.y); xw[i][3] = bfhi(w.y); xw[i][4] = bflo(w.z); xw[i][5] = bfhi(w.z); xw[i][6] = bflo(w.w); xw[i][7] = bfhi(w.w); } \
_Pragma("unroll") \
                    for (int o = 0; o < 8; ++o) { float acc[8]; \
_Pragma("unroll") \
                        for (int k = 0; k < 8; ++k) acc[k] = bq[k] + wq[0][k] * xw[o][k] + wq[1][k] * xw[o + 1][k] + wq[2][k] * xw[o + 2][k] + wq[3][k] * xw[o + 3][k]; \
                        u32x4 ow; ow.x = cvt_pk_bf16(acc[0], acc[1]); ow.y = cvt_pk_bf16(acc[2], acc[3]); ow.z = cvt_pk_bf16(acc[4], acc[5]); ow.w = cvt_pk_bf16(acc[6], acc[7]); \
                        *(u32x4*)(XC + (size_t)(tok0 + o) * 1024 + c8) = ow; } \
                  } } \
            } \
            SEAM(pb + 2); \
            if (IN(pb + 3)) { \
                ArgsP ap = get_args(); unsigned char* wsl = ap->ws; \
                pg8::Gemm gm{WSP(bf16_t, WS_XC), WSP(bf16_t, WS_WOG) + (size_t)e * 2048 * 256, T, 2048, 256, 1024, 2, 512}; pg8::StaticOrder S; S.init(T, 2048, G, wg); \
                EpiGates E{ap->odd_b_a + (size_t)e * 1024, ap->odd_b_x + (size_t)e * 1024, ap->odd_lambda + (size_t)e * 1024, WSP(bf16_t, WS_XC), WSP(bf16_t, WS_LOGA), WSP(bf16_t, WS_U)}; \
                pg8::gemm_phase(lds, gm, S, E); \
            } \
            SEAM(pb + 3); \
            if (IN(pb + 4)) { \
                ArgsP ap = get_args(); unsigned char* wsl = ap->ws; \
                const bf16_t* LOGA = WSP(bf16_t, WS_LOGA); const bf16_t* U = WSP(bf16_t, WS_U); const bf16_t* GS = WSP(bf16_t, WS_GS); bf16_t* MIXIN = WSP(bf16_t, WS_MIXIN); \
                LAS float* sl = (LAS float*)lds; LAS float* hl = sl + 512; \
                const int tid = opaque_tid(); \
                for (int it = wg; it < 256; it += G) { \
                      \
                    const int xq = (it & 7) * 8 + ((it >> 3) >> 2), b = xq >> 4, ch = ((xq & 15) * 4 + ((it >> 3) & 3)) * 16 + (tid & 15), jc = tid >> 4; \
                    const size_t base = ((size_t)b * SEQ + jc * 128) * 1024 + ch, sbase = slab_idx(b * SEQ + jc * 128, ch); \
                    float hsum = 0.f, lsum = 0.f; \
                    for (int s0 = 0; s0 < 128; s0 += 16) { float la[16], uu[16]; \
                        _Pragma("unroll") for (int k = 0; k < 16; ++k) { la[k] = bf2f(LOGA[sbase + (size_t)(s0 + k) * 16]); uu[k] = bf2f(U[sbase + (size_t)(s0 + k) * 16]); } \
                        _Pragma("unroll") for (int k = 0; k < 16; ++k) { hsum = __builtin_amdgcn_exp2f(la[k]) * hsum + uu[k]; lsum += la[k]; } } \
                    sl[tid] = lsum; hl[tid] = hsum; \
                    __syncthreads(); \
                    float hin = 0.f; \
                    for (int cj = 0; cj < jc; ++cj) hin = __builtin_amdgcn_exp2f(sl[cj * 16 + (tid & 15)]) * hin + hl[cj * 16 + (tid & 15)]; \
                    float hv = hin; \
                    for (int s0 = 0; s0 < 128; s0 += 16) { float la[16], uu[16], gg[16]; \
                        _Pragma("unroll") for (int k = 0; k < 16; ++k) { la[k] = bf2f(LOGA[sbase + (size_t)(s0 + k) * 16]); uu[k] = bf2f(U[sbase + (size_t)(s0 + k) * 16]); gg[k] = bf2f(GS[sbase + (size_t)(s0 + k) * 16]); } \
                        _Pragma("unroll") for (int k = 0; k < 16; ++k) { hv = __builtin_amdgcn_exp2f(la[k]) * hv + uu[k]; MIXIN[base + (size_t)(s0 + k) * 1024] = f2bf(hv * gg[k]); } } \
                    __syncthreads(); \
                } \
            } \
            SEAM(pb + 4); \
        } \
        if (IN(pb + 5)) { \
            ArgsP ap = get_args(); unsigned char* wsl = ap->ws; \
            const bf16_t* W = (even ? WSP(bf16_t, WS_WEOUT) : WSP(bf16_t, WS_WOOUT)) + (size_t)e * 1024 * 1024; \
            pg8::Gemm gm{WSP(bf16_t, WS_MIXIN), W, T, 1024, 1024, 1024, 1 << 30, 0}; pg8::StaticOrder S; S.init(T, 1024, G, wg); \
            EpiMix E{WSP(bf16_t, WS_MIX)}; \
            pg8::gemm_phase(lds, gm, S, E); \
        } \
        SEAM(pb + 5); \
    }
    LAYER_BODY(0)
    LAYER_BODY(1)
    LAYER_BODY(2)
    LAYER_BODY(3)
#undef LAYER_BODY
    if (IN(25)) { ArgsP ap = get_args(); unsigned char* wsl = ap->ws; norm_phase(nullptr, WSP(bf16_t, WS_H), WSP(float, WS_XS), WSP(bf16_t, WS_MIX), ap->post_norm + 3 * DM, nullptr, nullptr, ap->out); }
#undef IN
#undef SEAM
#undef WSP
}

extern "C" void kernel_launch(void* const* d_in, const int* in_sizes, int n_in, void* d_out, int out_size, void* d_ws, size_t ws_size, hipStream_t stream) {
    static int grid = 0;
    if (grid == 0) {
        if (n_in != 17 || out_size != T * DM || ws_size < WS_END) { fprintf(stderr, "kernel_launch: unexpected sizes (n_in %d, out %d, ws %zu, need %zu)\n", n_in, out_size, ws_size, (size_t)WS_END); grid = -1; return; }
        int dev = 0, cus = 0, per_cu = 0;
        if (hipGetDevice(&dev) != hipSuccess || hipDeviceGetAttribute(&cus, hipDeviceAttributeMultiprocessorCount, dev) != hipSuccess) { grid = -1; return; }
        if (hipFuncSetAttribute((const void*)fwd_kernel, hipFuncAttributeMaxDynamicSharedMemorySize, LDS_BYTES) != hipSuccess) { fprintf(stderr, "kernel_launch: hipFuncSetAttribute failed\n"); grid = -1; return; }
        if (hipOccupancyMaxActiveBlocksPerMultiprocessor(&per_cu, (const void*)fwd_kernel, NTHREADS, LDS_BYTES) != hipSuccess || per_cu < 1) { fprintf(stderr, "kernel_launch: occupancy query says %d\n", per_cu); }
        (void)hipGetLastError();
        grid = cus;
    }
    if (grid < 0) return;
    (void)hipMemsetAsync((char*)d_ws + WS_CTL, 0, CTL_BYTES, stream);
    Args a{};
    a.x = (const float*)d_in[0]; a.rel_bias = (const float*)d_in[1]; a.pre_norm = (const float*)d_in[2]; a.post_norm = (const float*)d_in[3];
    a.even_w_in = (const float*)d_in[4]; a.even_gate_w2 = (const float*)d_in[5]; a.even_gate_b2 = (const float*)d_in[6]; a.even_w_out = (const float*)d_in[7];
    a.odd_w_in = (const float*)d_in[8]; a.odd_conv_w = (const float*)d_in[9]; a.odd_conv_b = (const float*)d_in[10]; a.odd_w_a = (const float*)d_in[11]; a.odd_b_a = (const float*)d_in[12];
    a.odd_w_x = (const float*)d_in[13]; a.odd_b_x = (const float*)d_in[14]; a.odd_lambda = (const float*)d_in[15]; a.odd_w_out = (const float*)d_in[16];
    a.out = (float*)d_out; a.ws = (unsigned char*)d_ws;
    if (N_LAUNCHES == 1) {
        a.ph_lo = 0; a.ph_hi = NPH;
        hipLaunchKernelGGL(fwd_kernel, dim3(grid), dim3(NTHREADS), LDS_BYTES, stream, a);
    } else {
        for (int ph = 0; ph < NPH; ++ph) { a.ph_lo = ph; a.ph_hi = ph + 1; hipLaunchKernelGGL(fwd_kernel, dim3(grid), dim3(NTHREADS), LDS_BYTES, stream, a); }
    }
}
```

```cpp
#include <hip/hip_runtime.h>
#include <stdint.h>
#include <stdio.h>

#ifndef N_LAUNCHES
#define N_LAUNCHES 1
#endif

#define LAS __attribute__((address_space(3)))
typedef unsigned short bf16_t;
typedef short bf16x8 __attribute__((ext_vector_type(8)));
typedef float f32x4 __attribute__((ext_vector_type(4)));
typedef float f32x2 __attribute__((ext_vector_type(2)));
typedef float f32x16 __attribute__((ext_vector_type(16)));
typedef unsigned u32x4 __attribute__((ext_vector_type(4)));
typedef unsigned u32x2 __attribute__((ext_vector_type(2)));
typedef unsigned long long u64;

constexpr int NB = 4, SEQ = 4096, T = NB * SEQ, DM = 1024;
constexpr int EVEN_IN = 4184, NE = 4352;
constexpr int NTHREADS = 512;
constexpr float EPS = 1e-6f;
constexpr float NEG_INF = -__builtin_inff();

constexpr size_t MB = 1024 * 1024;
constexpr size_t WS_CTL   = 0;
constexpr size_t CTL_BYTES = 65536;
constexpr size_t WS_WEIN  = WS_CTL + CTL_BYTES;
constexpr size_t WS_WEOUT = WS_WEIN + (size_t)2 * NE * 1024 * 2;
constexpr size_t WS_WOIN  = WS_WEOUT + 4 * MB;
constexpr size_t WS_WOG   = WS_WOIN + 8 * MB;
constexpr size_t WS_WOOUT = WS_WOG + 2 * MB;
constexpr size_t WS_TAB   = WS_WOOUT + 4 * MB;
constexpr size_t WS_XS    = WS_TAB + 4096;
constexpr size_t WS_H     = WS_XS + 65536;
constexpr size_t WS_MIXIN = WS_H + 32 * MB;
constexpr size_t WS_ACT   = WS_MIXIN + 32 * MB;
constexpr size_t WS_Q     = WS_ACT;
constexpr size_t WS_K     = WS_Q + 16 * MB;
constexpr size_t WS_VT    = WS_K + 16 * MB;
constexpr size_t WS_AG    = WS_VT + 16 * MB;
constexpr size_t WS_MIX   = WS_ACT;
constexpr size_t WS_IQ    = WS_AG + 16 * MB;
constexpr size_t WS_BQ    = WS_IQ + 16 * MB;
constexpr size_t WS_BK    = WS_BQ + 8 * MB;
constexpr size_t WS_BV    = WS_BK + 8 * MB;
constexpr size_t WS_BG    = WS_BV + 16 * MB;
constexpr size_t WS_IK    = WS_BG + 16 * MB;
constexpr size_t WS_IW    = WS_IK + 2 * MB;
constexpr size_t WS_BLR   = WS_IW + MB / 2;
constexpr size_t WS_MASK  = WS_BLR + MB;
constexpr size_t WS_SPREV = WS_MASK + 8 * MB;
constexpr size_t WS_DECAY = WS_SPREV + 16 * MB;
constexpr size_t WS_EVEN_END = WS_DECAY + MB / 4;
constexpr size_t WS_XR    = WS_ACT;
constexpr size_t WS_U     = WS_XR;
constexpr size_t WS_GS    = WS_XR + 32 * MB;
constexpr size_t WS_XC    = WS_GS + 32 * MB;
constexpr size_t WS_LOGA  = WS_XC + 32 * MB;
constexpr size_t WS_ODD_END = WS_LOGA + 32 * MB;
constexpr size_t WS_END   = WS_EVEN_END > WS_ODD_END ? WS_EVEN_END : WS_ODD_END;
static_assert(WS_END <= (size_t)256 * MB, "workspace map exceeds 256 MiB");

__device__ __forceinline__ float bf2f(unsigned v) { return __uint_as_float(v << 16); }
typedef __bf16 bf16pair_t __attribute__((ext_vector_type(2)));
typedef float f32pair_t __attribute__((ext_vector_type(2)));
__device__ __forceinline__ unsigned cvt_pk_bf16(float lo, float hi) { const f32pair_t v = {lo, hi}; const bf16pair_t b = __builtin_convertvector(v, bf16pair_t); return __builtin_bit_cast(unsigned, b); }
__device__ __forceinline__ bf16_t f2bf(float f) { return (bf16_t)cvt_pk_bf16(f, f); }
__device__ __forceinline__ float silu_f(float x) { return x / (1.0f + __expf(-x)); }
__device__ __forceinline__ float sigmoid_f(float x) { return 1.0f / (1.0f + __expf(-x)); }
__device__ __forceinline__ size_t slab_idx(int row, int ch) { return ((size_t)((row >> 12) * 64 + (ch >> 4)) * SEQ + (row & 4095)) * 16 + (ch & 15); }
__device__ __forceinline__ float log1p_01(float y) { const float ser = y * (1.0f - y * (0.5f - y * (0.33333334f - y * 0.25f))); return y < 0.03125f ? ser : __logf(1.0f + y); }
__device__ __forceinline__ float bflo(unsigned w) { return __uint_as_float(w << 16); }
__device__ __forceinline__ float bfhi(unsigned w) { return __uint_as_float(w & 0xFFFF0000u); }

__device__ __forceinline__ int opaque_tid() { int t = threadIdx.x; asm volatile("" : "+v"(t)); return t; }

__device__ __forceinline__ int wave_sum_i32(int v) {
    v += __builtin_amdgcn_update_dpp(0, v, 0xB1, 0xF, 0xF, true);
    v += __builtin_amdgcn_update_dpp(0, v, 0x4E, 0xF, 0xF, true);
    v += __builtin_amdgcn_update_dpp(0, v, 0x141, 0xF, 0xF, true);
    v += __builtin_amdgcn_update_dpp(0, v, 0x140, 0xF, 0xF, true);
    return __builtin_amdgcn_readlane(v, 0) + __builtin_amdgcn_readlane(v, 16) + __builtin_amdgcn_readlane(v, 32) + __builtin_amdgcn_readlane(v, 48);
}

__device__ __forceinline__ float wave_max_f32(float v) {
    v = fmaxf(v, __uint_as_float((unsigned)__builtin_amdgcn_update_dpp(0, (int)__float_as_uint(v), 0xB1, 0xF, 0xF, true)));
    v = fmaxf(v, __uint_as_float((unsigned)__builtin_amdgcn_update_dpp(0, (int)__float_as_uint(v), 0x4E, 0xF, 0xF, true)));
    v = fmaxf(v, __uint_as_float((unsigned)__builtin_amdgcn_update_dpp(0, (int)__float_as_uint(v), 0x141, 0xF, 0xF, true)));
    v = fmaxf(v, __uint_as_float((unsigned)__builtin_amdgcn_update_dpp(0, (int)__float_as_uint(v), 0x140, 0xF, 0xF, true)));
    const float a = __uint_as_float((unsigned)__builtin_amdgcn_readlane((int)__float_as_uint(v), 0)), b = __uint_as_float((unsigned)__builtin_amdgcn_readlane((int)__float_as_uint(v), 16));
    const float c = __uint_as_float((unsigned)__builtin_amdgcn_readlane((int)__float_as_uint(v), 32)), d = __uint_as_float((unsigned)__builtin_amdgcn_readlane((int)__float_as_uint(v), 48));
    return fmaxf(fmaxf(a, b), fmaxf(c, d));
}
__device__ __forceinline__ int wave_prefix_sum_i32(int v) {
    v += __builtin_amdgcn_update_dpp(0, v, 0x111, 0xF, 0xF, true);
    v += __builtin_amdgcn_update_dpp(0, v, 0x112, 0xF, 0xF, true);
    v += __builtin_amdgcn_update_dpp(0, v, 0x114, 0xF, 0xF, true);
    v += __builtin_amdgcn_update_dpp(0, v, 0x118, 0xF, 0xF, true);
    v += __builtin_amdgcn_update_dpp(0, v, 0x142, 0xA, 0xF, false);
    v += __builtin_amdgcn_update_dpp(0, v, 0x143, 0xC, 0xF, false);
    return v;
}

#define XB_TMO      128
#define XB_XCNT(j)  (256  + 64 * (j))
#define XB_XSUB(j)  (1280 + 64 * (j))
#define XB_XGEN(j)  (2304 + 64 * (j))
#define XB_TOP      3328
#define XB_TOPGEN   3392
#define XCD_BAR_WORDS 3456
#define XB_SPIN_CAP (1u << 18)

__device__ __forceinline__ unsigned xb_ld(unsigned* p)              { return __hip_atomic_load(p, __ATOMIC_RELAXED, __HIP_MEMORY_SCOPE_AGENT); }
__device__ __forceinline__ unsigned xb_add(unsigned* p, unsigned v) { return __hip_atomic_fetch_add(p, v, __ATOMIC_RELAXED, __HIP_MEMORY_SCOPE_AGENT); }
__device__ __forceinline__ unsigned xb_xcc_id() { return (unsigned)__builtin_amdgcn_s_getreg((3 << 11) | 20) & 0xFu; }
#define XB_SPIN(cond, bar) do { unsigned _sp = 0; while (cond) { __builtin_amdgcn_s_sleep(1); \
    if ((++_sp & 255u) == 0u) { if (xb_ld(&(bar)[XB_TMO])) break; if (_sp > XB_SPIN_CAP) { atomicAdd(&(bar)[XB_TMO], 1u); break; } } } } while (0)

struct XcdBarrier { unsigned* bar; unsigned x; volatile LAS unsigned* st; };

__device__ __forceinline__ XcdBarrier xcd_barrier_post(unsigned* bar, volatile LAS unsigned* st) {
    XcdBarrier b; b.bar = bar; b.x = xb_xcc_id(); b.st = st;
    if (threadIdx.x == 0) (void)xb_add(&bar[XB_XCNT(b.x)], 1u);
    return b;
}
__device__ __forceinline__ void xcd_barrier_complete(unsigned* bar, unsigned x, unsigned& nloc, unsigned& nx) {
    const unsigned G = gridDim.x * gridDim.y * gridDim.z;
    unsigned sum, cnt, mine, sp = 0u;
    for (;;) {
        sum = 0u; cnt = 0u; mine = 0u;
#pragma unroll
        for (unsigned j = 0; j < 16; ++j) { const unsigned c = xb_ld(&bar[XB_XCNT(j)]); sum += c; cnt += (c > 0u) ? 1u : 0u; mine = (j == x) ? c : mine; }
        if (sum == G) break;
        __builtin_amdgcn_s_sleep(1);
        if ((++sp & 255u) == 0u) { if (xb_ld(&bar[XB_TMO])) break; if (sp > XB_SPIN_CAP) { atomicAdd(&bar[XB_TMO], 1u); break; } }
    }
    nloc = mine > 0u ? mine : 1u; nx = cnt > 0u ? cnt : 1u;
}
__device__ __forceinline__ void xcd_barrier(const XcdBarrier& b) {
    asm volatile("s_waitcnt vmcnt(0)" ::: "memory");
    __syncthreads();
    if (threadIdx.x == 0) {
        unsigned* bar = b.bar;
        __builtin_amdgcn_s_waitcnt(0);
        unsigned nloc = b.st[0], nx = b.st[1];
        if (nloc == 0u) { xcd_barrier_complete(bar, b.x, nloc, nx); b.st[0] = nloc; b.st[1] = nx; }
        const unsigned old = xb_add(&bar[XB_XSUB(b.x)], 1u);
        const unsigned gen = old / nloc;
        if (old + 1u == (gen + 1u) * nloc) {
            __builtin_amdgcn_fence(__ATOMIC_RELEASE, "agent");
            asm volatile("s_waitcnt vmcnt(0)" ::: "memory");
            const unsigned og = xb_add(&bar[XB_TOP], 1u);
            const unsigned tg = og / nx;
            if (og + 1u == (tg + 1u) * nx) xb_add(&bar[XB_TOPGEN], 1u);
            else XB_SPIN(xb_ld(&bar[XB_TOPGEN]) == tg, bar);
            __builtin_amdgcn_fence(__ATOMIC_ACQUIRE, "agent");
            xb_add(&bar[XB_XGEN(b.x)], 1u);
            asm volatile("s_waitcnt vmcnt(0)" ::: "memory");
        } else {
            XB_SPIN(xb_ld(&bar[XB_XGEN(b.x)]) == gen, bar);
            __builtin_amdgcn_fence(__ATOMIC_ACQUIRE, "agent");
            asm volatile("s_waitcnt vmcnt(0)" ::: "memory");
        }
    }
    __syncthreads();
}

namespace pg8 {
constexpr int BM = 256, BK = 64, HALF = 128, HTB = HALF * BK * 2, STAGE_BYTES = 8 * HTB, NXCD = 8, WGM = 8;
__host__ __device__ __forceinline__ int lds_byte(int r, int c) { const int st = (r >> 4) * 2 + (c >> 5), rr = r & 15, cc = c & 31, ob = rr * 64 + cc * 2; return st * 1024 + (ob ^ (((ob >> 9) & 1) << 5)); }
__host__ __device__ __forceinline__ void stage_rc(int b, int& R, int& C) { const int st = b / 1024, sb = b % 1024, swz = sb ^ (((sb >> 9) & 1) << 5); R = (st >> 1) * 16 + swz / 64; C = (st & 1) * 32 + (swz % 64) / 2; }
__host__ __device__ __forceinline__ int perm32(int rho) { const int n = rho >> 4, i = rho & 15; return 8 * (i >> 2) + 4 * n + (i & 3); }

struct Unit { int pm, pn; };
struct Gemm { const bf16_t* A; const bf16_t* Bt; int M, N, K, lda, a_div, a_step; };

struct StaticOrder {
    int nM, nN, nwg, G, c;
    __host__ __device__ void init(int M, int N, int G_, int c_) { nM = M / BM; nN = N / BM; nwg = nM * nN; G = G_; c = c_; }
    __host__ __device__ bool next(int i, Unit& u) const {
        const long L = (long)i * G + c; if (L >= nwg) return false;
        int wgid = (int)L; { const int q = nwg / NXCD, r = nwg % NXCD, xcd = wgid % NXCD, off = wgid / NXCD; wgid = (xcd < r ? xcd * (q + 1) : r * (q + 1) + (xcd - r) * q) + off; }
        const int nig = WGM * nN, gid = wgid / nig, fm = gid * WGM, gsz = (nM - fm) < WGM ? (nM - fm) : WGM;
        u.pm = fm + ((wgid % nig) % gsz); u.pn = (wgid % nig) / gsz; return true;
    }
};

template <class Epi>
__device__ __forceinline__ void gemm_phase(LAS unsigned char* lds, const Gemm g, const StaticOrder& S, const Epi& E) {
    const int tid = opaque_tid(), wid = __builtin_amdgcn_readfirstlane(tid >> 6), lane = tid & 63, wr = wid >> 2, wc = wid & 3, fr = lane & 15, fq = lane >> 4;
    const int K = g.K, nt = K / BK, lda = g.lda;
    unsigned voffA[2], voffB[2];
#pragma unroll
    for (int i = 0; i < 2; ++i) { int R, C; stage_rc(tid * 16 + i * 8192, R, C); const int Rb = Epi::PERM ? ((R & ~31) + perm32(R & 31)) : R;
        voffA[i] = (unsigned)(R * lda + C) * 2u; voffB[i] = (unsigned)(Rb * K + C) * 2u; }
    const size_t kstep = (size_t)(BK * 2);
    const size_t hstepA = (size_t)HALF * lda * 2, hstepB = (size_t)HALF * K * 2;
    const size_t tstepA = 2 * hstepA, tstepB = 2 * hstepB;
    const unsigned ldsw = (unsigned)wid * 1024u;
    const int aoff = lds_byte(wr * 64 + fr, fq * 8), boff = lds_byte(wc * 32 + fr, fq * 8);
#define PG8_SA(b, h) (((b) * 2 + (h)) * HTB)
#define PG8_SB(b, h) ((4 + (b) * 2 + (h)) * HTB)
#define PG8_STAGE(bufoff, gbase, voff) do { _Pragma("unroll") for (int _i = 0; _i < 2; ++_i) \
        __builtin_amdgcn_global_load_lds((const unsigned*)((const char*)(gbase) + (voff)[_i]), (LAS unsigned*)(lds + (bufoff) + ldsw + _i * 8192), 16, 0, 0); } while (0)
#define PG8_LDA(dst, b, h) do { _Pragma("unroll") for (int m = 0; m < 4; ++m) _Pragma("unroll") for (int k = 0; k < 2; ++k) dst[m][k] = *(const LAS bf16x8*)(lds + PG8_SA(b, h) + aoff + m * 2048 + k * 1024); } while (0)
#define PG8_LDB(dst, b, h) do { _Pragma("unroll") for (int n = 0; n < 2; ++n) _Pragma("unroll") for (int k = 0; k < 2; ++k) dst[n][k] = *(const LAS bf16x8*)(lds + PG8_SB(b, h) + boff + n * 2048 + k * 1024); } while (0)
#define PG8_MMA(ai, bj, At, Bt) do { __builtin_amdgcn_s_setprio(1); _Pragma("unroll") for (int m = 0; m < 4; ++m) _Pragma("unroll") for (int n = 0; n < 2; ++n) _Pragma("unroll") for (int k = 0; k < 2; ++k) \
        acc[ai][bj][m][n] = __builtin_amdgcn_mfma_f32_16x16x32_bf16(Bt[n][k], At[m][k], acc[ai][bj][m][n], 0, 0, 0); __builtin_amdgcn_s_setprio(0); } while (0)
#define PG8_WAIT_V(n) asm volatile("s_waitcnt vmcnt(" #n ")" ::: "memory")
#define PG8_WAIT_L(n) asm volatile("s_waitcnt lgkmcnt(" #n ")" ::: "memory")
#define PG8_BAR __builtin_amdgcn_s_barrier()
#define PG8_SCHED __builtin_amdgcn_sched_barrier(0)
    Unit cur, nxt; int ui = 0;
    if (!S.next(0, cur)) return;
    f32x4 acc[2][2][4][2];
#pragma unroll
    for (int a = 0; a < 2; ++a)
#pragma unroll
        for (int b = 0; b < 2; ++b)
#pragma unroll
            for (int m = 0; m < 4; ++m)
#pragma unroll
                for (int n = 0; n < 2; ++n) acc[a][b][m][n] = (f32x4){0.f, 0.f, 0.f, 0.f};
    bf16x8 At[4][2], B0[2][2], B1[2][2];
    const char* cA = (const char*)g.A + (size_t)cur.pm * tstepA + (size_t)(cur.pn / g.a_div) * g.a_step; const char* cB = (const char*)g.Bt + (size_t)cur.pn * tstepB;
    PG8_STAGE(PG8_SB(0, 0), cB, voffB); PG8_STAGE(PG8_SA(0, 0), cA, voffA); PG8_STAGE(PG8_SB(0, 1), cB + hstepB, voffB); PG8_STAGE(PG8_SA(0, 1), cA + hstepA, voffA);
    if (wr == 1) PG8_BAR;
    PG8_WAIT_V(4); PG8_BAR;
    PG8_STAGE(PG8_SB(1, 0), cB + kstep, voffB); PG8_STAGE(PG8_SA(1, 0), cA + kstep, voffA); PG8_STAGE(PG8_SB(1, 1), cB + hstepB + kstep, voffB);
    PG8_WAIT_V(6); PG8_BAR;
    for (;;) {
        const bool has_next = S.next(ui + 1, nxt);
        const char* nA = has_next ? (const char*)g.A + (size_t)nxt.pm * tstepA + (size_t)(nxt.pn / g.a_div) * g.a_step : cA; const char* nB = has_next ? (const char*)g.Bt + (size_t)nxt.pn * tstepB : cB;
        for (int t = 0; t < nt; t += 2) {
            const bool last = (t == nt - 2);
            const char* a1 = cA + (size_t)(t + 1) * kstep;
            const char* a2 = last ? nA : cA + (size_t)(t + 2) * kstep; const char* b2 = last ? nB : cB + (size_t)(t + 2) * kstep;
            const char* a3 = a2 + kstep; const char* b3 = b2 + kstep;
            PG8_LDB(B0, 0, 0); PG8_SCHED; PG8_LDA(At, 0, 0); PG8_STAGE(PG8_SA(1, 1), a1 + hstepA, voffA);
            PG8_WAIT_L(8); PG8_BAR; PG8_WAIT_L(0); PG8_MMA(0, 0, At, B0); PG8_BAR; PG8_SCHED;
            PG8_LDB(B1, 0, 1); PG8_STAGE(PG8_SB(0, 0), b2, voffB);
            PG8_BAR; PG8_WAIT_L(0); PG8_MMA(0, 1, At, B1); PG8_BAR;
            PG8_LDA(At, 0, 1); PG8_STAGE(PG8_SA(0, 0), a2, voffA);
            PG8_BAR; PG8_WAIT_L(0); PG8_MMA(1, 0, At, B0); PG8_BAR; PG8_SCHED;
            PG8_STAGE(PG8_SB(0, 1), b2 + hstepB, voffB);
            PG8_WAIT_V(6); PG8_BAR; PG8_MMA(1, 1, At, B1); PG8_BAR;
            PG8_LDB(B0, 1, 0); PG8_SCHED; PG8_LDA(At, 1, 0); PG8_STAGE(PG8_SA(0, 1), a2 + hstepA, voffA);
            PG8_WAIT_L(8); PG8_BAR; PG8_WAIT_L(0); PG8_MMA(0, 0, At, B0); PG8_BAR; PG8_SCHED;
            PG8_LDB(B1, 1, 1); PG8_STAGE(PG8_SB(1, 0), b3, voffB);
            PG8_BAR; PG8_WAIT_L(0); PG8_MMA(0, 1, At, B1); PG8_BAR;
            PG8_LDA(At, 1, 1); PG8_STAGE(PG8_SA(1, 0), a3, voffA);
            PG8_BAR; PG8_WAIT_L(0); PG8_MMA(1, 0, At, B0); PG8_BAR; PG8_SCHED;
            PG8_STAGE(PG8_SB(1, 1), b3 + hstepB, voffB);
            PG8_WAIT_V(6); PG8_BAR; PG8_MMA(1, 1, At, B1); PG8_BAR;
        }
        E(acc, cur, wr, wc, fr, fq);
        if (!has_next) break;
#pragma unroll
        for (int a = 0; a < 2; ++a)
#pragma unroll
            for (int b = 0; b < 2; ++b)
#pragma unroll
                for (int m = 0; m < 4; ++m)
#pragma unroll
                    for (int n = 0; n < 2; ++n) acc[a][b][m][n] = (f32x4){0.f, 0.f, 0.f, 0.f};
        cur = nxt; cA = nA; cB = nB; ++ui;
    }
    PG8_WAIT_V(0);
    if (wr == 0) PG8_BAR;
    PG8_BAR;
#undef PG8_SA
#undef PG8_SB
#undef PG8_STAGE
#undef PG8_LDA
#undef PG8_LDB
#undef PG8_MMA
#undef PG8_WAIT_V
#undef PG8_WAIT_L
#undef PG8_BAR
#undef PG8_SCHED
}
}

struct EpiMix {
    static constexpr bool PERM = true;
    bf16_t* C;
    __device__ __forceinline__ void operator()(const f32x4 (&acc)[2][2][4][2], const pg8::Unit& u, int wr, int wc, int fr, int fq) const {
#pragma unroll
        for (int ai = 0; ai < 2; ++ai)
#pragma unroll
            for (int m = 0; m < 4; ++m) { const int row = u.pm * 256 + ai * 128 + wr * 64 + m * 16 + fr;
#pragma unroll
                for (int bj = 0; bj < 2; ++bj) { const f32x4 v0 = acc[ai][bj][m][0], v1 = acc[ai][bj][m][1];
                    u32x4 w; w.x = cvt_pk_bf16(v0[0], v0[1]); w.y = cvt_pk_bf16(v0[2], v0[3]); w.z = cvt_pk_bf16(v1[0], v1[1]); w.w = cvt_pk_bf16(v1[2], v1[3]);
                    *(u32x4*)(C + (size_t)row * 1024 + u.pn * 256 + bj * 128 + wc * 32 + 8 * fq) = w; } }
    }
};

constexpr float LOG2E_F = 1.4426950408889634f;
constexpr float IW_SCALE = 0.35355339059327373f * 0.125f;

struct EpiEvenIn {
    static constexpr bool PERM = true;
    bf16_t *Q, *Kb, *VT, *AG, *IQ, *BQ, *BK, *BV, *BG, *IK; float *IW, *BLR;
    __device__ __forceinline__ void operator()(const f32x4 (&acc)[2][2][4][2], const pg8::Unit& u, int wr, int wc, int fr, int fq) const {
        const int pn = u.pn;
        bf16_t* dst = Q; int ld = 512, col0 = 0, mode = 0;
        if (pn < 2) { dst = Q; col0 = pn * 256; }
        else if (pn < 4) { dst = Kb; col0 = (pn - 2) * 256; }
        else if (pn < 6) { mode = 2; col0 = (pn - 4) * 256; }
        else if (pn < 8) { dst = AG; col0 = (pn - 6) * 256; mode = 1; }
        else if (pn < 10) { dst = IQ; col0 = (pn - 8) * 256; }
        else if (pn == 10) { dst = BQ; ld = 256; }
        else if (pn == 11) { dst = BK; ld = 256; }
        else if (pn < 14) { dst = BV; col0 = (pn - 12) * 256; }
        else if (pn < 16) { dst = BG; col0 = (pn - 14) * 256; mode = 1; }
        else mode = 3;
#pragma unroll
        for (int ai = 0; ai < 2; ++ai)
#pragma unroll
            for (int m = 0; m < 4; ++m) {
                const int row = u.pm * 256 + ai * 128 + wr * 64 + m * 16 + fr;
#pragma unroll
                for (int bj = 0; bj < 2; ++bj) {
                    const int cb = bj * 128 + wc * 32 + 8 * fq;
                    f32x4 v0 = acc[ai][bj][m][0], v1 = acc[ai][bj][m][1];
                    if (mode <= 1) {
                        if (mode == 1) {
#pragma unroll
                            for (int j = 0; j < 4; ++j) { v0[j] = silu_f(v0[j]); v1[j] = silu_f(v1[j]); }
                        }
                        u32x4 w; w.x = cvt_pk_bf16(v0[0], v0[1]); w.y = cvt_pk_bf16(v0[2], v0[3]); w.z = cvt_pk_bf16(v1[0], v1[1]); w.w = cvt_pk_bf16(v1[2], v1[3]);
                        *(u32x4*)(dst + (size_t)row * ld + col0 + cb) = w;
                    } else if (mode == 2) {
                        const int c = col0 + cb, head = c >> 6, d = c & 63, b = row >> 12, s = row & 4095;
                        bf16_t* p = VT + ((size_t)(b * 8 + head) * 64 + d) * 4096 + s;
#pragma unroll
                        for (int j = 0; j < 4; ++j) { p[(size_t)j * 4096] = f2bf(v0[j]); p[(size_t)(j + 4) * 4096] = f2bf(v1[j]); }
                    } else {
                        if (cb < 64) {
                            u32x4 w; w.x = cvt_pk_bf16(v0[0], v0[1]); w.y = cvt_pk_bf16(v0[2], v0[3]); w.z = cvt_pk_bf16(v1[0], v1[1]); w.w = cvt_pk_bf16(v1[2], v1[3]);
                            const int q = cb >> 3, bb = row >> 12, sq = row & 4095;
                            *(u32x4*)(IK + ((((size_t)(bb * 128 + (sq >> 5)) * 4 + (q >> 1)) * 2 + (q & 1)) * 32 + (sq & 31)) * 8) = w;
                        } else if (cb == 64) {
                            *(f32x4*)(IW + (size_t)row * 8) = v0 * IW_SCALE; *(f32x4*)(IW + (size_t)row * 8 + 4) = v1 * IW_SCALE;
                        } else if (cb == 72 || cb == 80) {
                            *(f32x4*)(BLR + (size_t)row * 16 + (cb - 72)) = v0; *(f32x4*)(BLR + (size_t)row * 16 + (cb - 72) + 4) = v1;
                        }
                    }
                }
            }
    }
};

struct EpiOddIn {
    static constexpr bool PERM = true;
    bf16_t *XR, *GS;
    __device__ __forceinline__ void operator()(const f32x4 (&acc)[2][2][4][2], const pg8::Unit& u, int wr, int wc, int fr, int fq) const {
        const int pn = u.pn; const bool gate = pn >= 4;
        bf16_t* dst = gate ? GS : XR; const int col0 = (pn & 3) * 256;
#pragma unroll
        for (int ai = 0; ai < 2; ++ai)
#pragma unroll
            for (int m = 0; m < 4; ++m) {
                const int row = u.pm * 256 + ai * 128 + wr * 64 + m * 16 + fr;
#pragma unroll
                for (int bj = 0; bj < 2; ++bj) {
                    const int cb = bj * 128 + wc * 32 + 8 * fq;
                    f32x4 v0 = acc[ai][bj][m][0], v1 = acc[ai][bj][m][1];
                    if (gate) {
#pragma unroll
                        for (int j = 0; j < 4; ++j) { v0[j] = silu_f(v0[j]); v1[j] = silu_f(v1[j]); }
                    }
                    u32x4 w; w.x = cvt_pk_bf16(v0[0], v0[1]); w.y = cvt_pk_bf16(v0[2], v0[3]); w.z = cvt_pk_bf16(v1[0], v1[1]); w.w = cvt_pk_bf16(v1[2], v1[3]);
                    if (gate) *(u32x4*)(GS + slab_idx(row, col0 + cb)) = w;
                    else *(u32x4*)(XR + (size_t)row * 1024 + col0 + cb) = w;
                }
            }
    }
};

struct EpiGates {
    static constexpr bool PERM = true;
    const float *b_a, *b_x, *lam; const bf16_t* XC; bf16_t* LOGA; bf16_t* U;
    __device__ __forceinline__ void operator()(const f32x4 (&acc)[2][2][4][2], const pg8::Unit& u, int wr, int wc, int fr, int fq) const {
        const int chb = (u.pn >> 1) * 256 + (u.pn & 1) * 128 + wc * 32 + 8 * fq;
#pragma unroll
        for (int nh = 0; nh < 2; ++nh) {
            const int ch0 = chb + 4 * nh;
            const f32x4 lm = *(const f32x4*)(lam + ch0);
            const f32x4 nba = *(const f32x4*)(b_a + ch0) * (-LOG2E_F), nbx = *(const f32x4*)(b_x + ch0) * (-LOG2E_F);
            f32x4 c8;
#pragma unroll
            for (int j = 0; j < 4; ++j) c8[j] = (-8.0f * LOG2E_F) * (fmaxf(-lm[j], 0.f) + log1p_01(__expf(-fabsf(lm[j]))));
#pragma unroll
            for (int ai = 0; ai < 2; ++ai)
#pragma unroll
                for (int m = 0; m < 4; ++m) {
                    const int row = u.pm * 256 + ai * 128 + wr * 64 + m * 16 + fr;
                    const u32x2 xw = *(const u32x2*)(XC + (size_t)row * 1024 + ch0);
                    const float xv[4] = {bflo(xw.x), bfhi(xw.x), bflo(xw.y), bfhi(xw.y)};
                    f32x4 la; float uu[4];
#pragma unroll
                    for (int j = 0; j < 4; ++j) {
                        const float r = __builtin_amdgcn_rcpf(1.0f + __builtin_amdgcn_exp2f(__builtin_fmaf(acc[ai][0][m][nh][j], -LOG2E_F, nba[j])));
                        const float ig = __builtin_amdgcn_rcpf(1.0f + __builtin_amdgcn_exp2f(__builtin_fmaf(acc[ai][1][m][nh][j], -LOG2E_F, nbx[j])));
                        const float l2 = c8[j] * r, av = __builtin_amdgcn_exp2f(l2);
                        la[j] = l2;
                        uu[j] = __builtin_amdgcn_sqrtf(fmaxf(__builtin_fmaf(-av, av, 1.0f), 0.f)) * ig * xv[j];
                    }
                    { u32x2 lw; lw.x = cvt_pk_bf16(la[0], la[1]); lw.y = cvt_pk_bf16(la[2], la[3]); *(u32x2*)(LOGA + slab_idx(row, ch0)) = lw; }
                    u32x2 w; w.x = cvt_pk_bf16(uu[0], uu[1]); w.y = cvt_pk_bf16(uu[2], uu[3]);
                    *(u32x2*)(U + slab_idx(row, ch0)) = w;
                }
        }
    }
};

struct Args {
    const float* x; const float* rel_bias; const float* pre_norm; const float* post_norm;
    const float* even_w_in; const float* even_gate_w2; const float* even_gate_b2; const float* even_w_out;
    const float* odd_w_in; const float* odd_conv_w; const float* odd_conv_b; const float* odd_w_a; const float* odd_b_a;
    const float* odd_w_x; const float* odd_b_x; const float* odd_lambda; const float* odd_w_out;
    float* out; unsigned char* ws; int ph_lo, ph_hi;
};

typedef const Args __attribute__((address_space(4)))* ArgsP;
__device__ __forceinline__ ArgsP get_args() { ArgsP p = (ArgsP)__builtin_amdgcn_kernarg_segment_ptr(); asm volatile("" : "+s"(p)); return p; }

constexpr int WT_EIN = 2 * 68 * 16, WT_EOUT = 2 * 256, WT_OIN = 2 * 512, WT_OOUT = 2 * 256, WT_GATE = 2 * 128, WT_ALL = WT_EIN + WT_EOUT + WT_OIN + WT_OOUT + WT_GATE;
__device__ __forceinline__ void wtile_decode(int T, ArgsP ap, unsigned char* ws, int nl, int wn, const float*& colp, int& ld, bf16_t*& drow, int& K, const float*& ksc) {
    ksc = nullptr;
    if (T < WT_EIN) { const int e = T / 1088, r = T % 1088, tn = r % 68, tk = r / 68; K = 1024; ld = EVEN_IN;
        const int n = tn * 64 + nl; int c; bool ok = true; if (n < 2560) c = n; else if (n < 4096) c = n + 72; else if (n < 4168) c = n - 1536; else if (n < 4184) c = n; else { c = 0; ok = false; }
        ksc = ap->pre_norm + (size_t)(2 * e) * DM + tk * 64;
        colp = ok ? ap->even_w_in + ((size_t)e * 1024 + tk * 64) * EVEN_IN + c : nullptr;
        drow = (bf16_t*)(ws + WS_WEIN) + ((size_t)e * NE + tn * 64 + wn) * 1024 + tk * 64; return; }
    T -= WT_EIN;
    if (T < WT_EOUT) { const int e = T / 256, r = T % 256, tn = r % 16, tk = r / 16; K = 1024; ld = 1024;
        colp = ap->even_w_out + ((size_t)e * 1024 + tk * 64) * 1024 + tn * 64 + nl; drow = (bf16_t*)(ws + WS_WEOUT) + ((size_t)e * 1024 + tn * 64 + wn) * 1024 + tk * 64; return; }
    T -= WT_EOUT;
    if (T < WT_OIN) { const int e = T / 512, r = T % 512, tn = r % 32, tk = r / 32; K = 1024; ld = 2048;
        ksc = ap->pre_norm + (size_t)(2 * e + 1) * DM + tk * 64;
        colp = ap->odd_w_in + ((size_t)e * 1024 + tk * 64) * 2048 + tn * 64 + nl; drow = (bf16_t*)(ws + WS_WOIN) + ((size_t)e * 2048 + tn * 64 + wn) * 1024 + tk * 64; return; }
    T -= WT_OIN;
    if (T < WT_OOUT) { const int e = T / 256, r = T % 256, tn = r % 16, tk = r / 16; K = 1024; ld = 1024;
        colp = ap->odd_w_out + ((size_t)e * 1024 + tk * 64) * 1024 + tn * 64 + nl; drow = (bf16_t*)(ws + WS_WOOUT) + ((size_t)e * 1024 + tn * 64 + wn) * 1024 + tk * 64; return; }
    T -= WT_OOUT;
    {
        const int o = T / 128, r = T % 128, tn = r % 32, tk = r / 32; K = 256; ld = 256;
        const int cp = tn * 64, nb = cp >> 9, j = (cp >> 8) & 1, gs = (cp >> 7) & 1, e0 = j * 128 + (cp & 127);
        const float* src = gs ? ap->odd_w_x : ap->odd_w_a;
        colp = src + (((size_t)(o * 4 + nb)) * 256 + tk * 64) * 256 + e0 + nl; drow = (bf16_t*)(ws + WS_WOG) + ((size_t)o * 2048 + cp + wn) * 256 + tk * 64; }
}
__device__ __forceinline__ void weight_phase(LAS float* tile, ArgsP ap, unsigned char* ws) {
    const int tid = opaque_tid(), G = gridDim.x, nl = tid & 63, k0 = tid >> 6, wn = tid >> 3, wk = (tid & 7) * 8;
    float r[8]; const float* colp; const float* ksc; bf16_t* drow; int ld, K;
#define WT_LOAD() do { _Pragma("unroll") for (int i = 0; i < 8; ++i) r[i] = colp ? colp[(size_t)(k0 + 8 * i) * ld] * (ksc ? ksc[k0 + 8 * i] : 1.0f) : 0.f; } while (0)
    int T = blockIdx.x;
    if (T < WT_ALL) { wtile_decode(T, ap, ws, nl, wn, colp, ld, drow, K, ksc); WT_LOAD(); }
    for (; T < WT_ALL; T += G) {
        bf16_t* dcur = drow;
#pragma unroll
        for (int i = 0; i < 8; ++i) tile[(k0 + 8 * i) * 65 + nl] = r[i];
        __syncthreads();
        if (T + G < WT_ALL) { wtile_decode(T + G, ap, ws, nl, wn, colp, ld, drow, K, ksc); WT_LOAD(); }
        float v[8];
#pragma unroll
        for (int j = 0; j < 8; ++j) v[j] = tile[(wk + j) * 65 + wn];
        u32x4 w; w.x = cvt_pk_bf16(v[0], v[1]); w.y = cvt_pk_bf16(v[2], v[3]); w.z = cvt_pk_bf16(v[4], v[5]); w.w = cvt_pk_bf16(v[6], v[7]);
        *(u32x4*)(dcur + wk) = w;
        __syncthreads();
    }
#undef WT_LOAD
}

__device__ __forceinline__ int t5_bucket(int n) {
    if (n < 16) return n;
    int v = 16 + (int)(__logf((float)n / 16.0f) / 2.0794415416798357f * 16.0f);
    return v < 31 ? v : 31;
}

__device__ __forceinline__ void norm_phase(const float* xin, const bf16_t* xh_in, const float* s_in, const bf16_t* mix, const float* postw, bf16_t* xh_out, float* s_out, float* outf) {
    const int tid0 = opaque_tid(), lane = tid0 & 63, wave = tid0 >> 6;
    for (int row = blockIdx.x * 8 + wave; row < T; row += gridDim.x * 8) {
        f32x4 xv[4];
        if (xin) {
#pragma unroll
            for (int i = 0; i < 4; ++i) xv[i] = *(const f32x4*)(xin + (size_t)row * DM + lane * 4 + 256 * i);
        } else {
            const float sc = s_in[row];
#pragma unroll
            for (int i = 0; i < 4; ++i) { const u32x2 xw = *(const u32x2*)(xh_in + (size_t)row * DM + lane * 4 + 256 * i); xv[i] = (f32x4){bflo(xw.x), bfhi(xw.x), bflo(xw.y), bfhi(xw.y)} * sc; }
        }
        if (mix) {
            f32x4 mv[4]; float ss = 0.f;
#pragma unroll
            for (int i = 0; i < 4; ++i) { const u32x2 mw = *(const u32x2*)(mix + (size_t)row * DM + lane * 4 + 256 * i); mv[i] = (f32x4){bflo(mw.x), bfhi(mw.x), bflo(mw.y), bfhi(mw.y)};
                ss += mv[i][0] * mv[i][0] + mv[i][1] * mv[i][1] + mv[i][2] * mv[i][2] + mv[i][3] * mv[i][3]; }
#pragma unroll
            for (int o = 32; o >= 1; o >>= 1) ss += __shfl_xor(ss, o);
            const float r = rsqrtf(ss * (1.0f / DM) + EPS);
#pragma unroll
            for (int i = 0; i < 4; ++i) { const f32x4 w = *(const f32x4*)(postw + lane * 4 + 256 * i); xv[i] += mv[i] * r * w; }
        }
        if (outf) {
#pragma unroll
            for (int i = 0; i < 4; ++i) *(f32x4*)(outf + (size_t)row * DM + lane * 4 + 256 * i) = xv[i];
        } else {
            float ss = 0.f;
#pragma unroll
            for (int i = 0; i < 4; ++i) ss += xv[i][0] * xv[i][0] + xv[i][1] * xv[i][1] + xv[i][2] * xv[i][2] + xv[i][3] * xv[i][3];
#pragma unroll
            for (int o = 32; o >= 1; o >>= 1) ss += __shfl_xor(ss, o);
            const float ms = ss * (1.0f / DM) + EPS, r = rsqrtf(ms);
            if (lane == 0) s_out[row] = ms * r;
#pragma unroll
            for (int i = 0; i < 4; ++i) { const f32x4 y = xv[i] * r;
                u32x2 o2; o2.x = cvt_pk_bf16(y[0], y[1]); o2.y = cvt_pk_bf16(y[2], y[3]); *(u32x2*)(xh_out + (size_t)row * DM + lane * 4 + 256 * i) = o2; }
        }
    }
}

constexpr int NM_LD = 1032;
__device__ __forceinline__ void norm_misc_phase(LAS unsigned char* lds, const float* xin, const bf16_t* xh_in, const float* s_in, const bf16_t* mix, const float* postw, bf16_t* xh_out, float* s_out,
                                                const bf16_t* Wm  , bf16_t* IK, float* IW, float* BLR) {
    const int tid0 = opaque_tid(), lane = tid0 & 63, wave = __builtin_amdgcn_readfirstlane(tid0 >> 6);
    LAS bf16_t* xs = (LAS bf16_t*)lds;
    for (int pq = blockIdx.x; pq < T / 64; pq += gridDim.x) {
        for (int i = 0; i < 8; ++i) {
            const int rl = wave * 8 + i, row = pq * 64 + rl;
            f32x4 xv[4];
            if (xin) {
#pragma unroll
                for (int k = 0; k < 4; ++k) xv[k] = *(const f32x4*)(xin + (size_t)row * DM + lane * 4 + 256 * k);
            } else {
                const float sc = s_in[row];
#pragma unroll
                for (int k = 0; k < 4; ++k) { const u32x2 xw = *(const u32x2*)(xh_in + (size_t)row * DM + lane * 4 + 256 * k); xv[k] = (f32x4){bflo(xw.x), bfhi(xw.x), bflo(xw.y), bfhi(xw.y)} * sc; }
            }
            if (mix) {
                f32x4 mv[4]; float ss = 0.f;
#pragma unroll
                for (int k = 0; k < 4; ++k) { const u32x2 mw = *(const u32x2*)(mix + (size_t)row * DM + lane * 4 + 256 * k); mv[k] = (f32x4){bflo(mw.x), bfhi(mw.x), bflo(mw.y), bfhi(mw.y)};
                    ss += mv[k][0] * mv[k][0] + mv[k][1] * mv[k][1] + mv[k][2] * mv[k][2] + mv[k][3] * mv[k][3]; }
#pragma unroll
                for (int o = 32; o >= 1; o >>= 1) ss += __shfl_xor(ss, o);
                const float r = rsqrtf(ss * (1.0f / DM) + EPS);
#pragma unroll
                for (int k = 0; k < 4; ++k) { const f32x4 w = *(const f32x4*)(postw + lane * 4 + 256 * k); xv[k] += mv[k] * r * w; }
            }
            float ss = 0.f;
#pragma unroll
            for (int k = 0; k < 4; ++k) ss += xv[k][0] * xv[k][0] + xv[k][1] * xv[k][1] + xv[k][2] * xv[k][2] + xv[k][3] * xv[k][3];
#pragma unroll
            for (int o = 32; o >= 1; o >>= 1) ss += __shfl_xor(ss, o);
            const float ms = ss * (1.0f / DM) + EPS, r = rsqrtf(ms);
            if (lane == 0) s_out[row] = ms * r;
#pragma unroll
            for (int k = 0; k < 4; ++k) { const f32x4 y = xv[k] * r;
                u32x2 o2; o2.x = cvt_pk_bf16(y[0], y[1]); o2.y = cvt_pk_bf16(y[2], y[3]);
                *(u32x2*)(xh_out + (size_t)row * DM + lane * 4 + 256 * k) = o2; *(LAS u32x2*)(xs + rl * NM_LD + lane * 4 + 256 * k) = o2; }
        }
        __syncthreads();
        if (wave < 6) {
            const int n = lane & 15, kq = lane >> 4;
            f32x4 acc[4];
#pragma unroll
            for (int mt = 0; mt < 4; ++mt) acc[mt] = (f32x4){0.f, 0.f, 0.f, 0.f};
            const bf16_t* wrow = Wm + (size_t)(16 * wave + n) * 1024 + 8 * kq;
            for (int ks = 0; ks < 32; ks += 4) {
                bf16x8 bf[4];
#pragma unroll
                for (int u = 0; u < 4; ++u) bf[u] = *(const bf16x8*)(wrow + (ks + u) * 32);
#pragma unroll
                for (int u = 0; u < 4; ++u)
#pragma unroll
                    for (int mt = 0; mt < 4; ++mt) { const bf16x8 af = *(const LAS bf16x8*)(xs + (16 * mt + n) * NM_LD + (ks + u) * 32 + 8 * kq);
                        acc[mt] = __builtin_amdgcn_mfma_f32_16x16x32_bf16(af, bf[u], acc[mt], 0, 0, 0); }
            }
#pragma unroll
            for (int mt = 0; mt < 4; ++mt)
#pragma unroll
                for (int j = 0; j < 4; ++j) { const int row = pq * 64 + 16 * mt + 4 * kq + j; const float v = acc[mt][j];
                    if (wave < 4) { const int cc = 16 * wave + n, q = cc >> 3, bb = row >> 12, sq = row & 4095;
                        IK[((((size_t)(bb * 128 + (sq >> 5)) * 4 + (q >> 1)) * 2 + (q & 1)) * 32 + (sq & 31)) * 8 + (cc & 7)] = f2bf(v); }
                    else if (wave == 4) { if (n < 8) IW[(size_t)row * 8 + n] = v * IW_SCALE; else BLR[(size_t)row * 16 + (n - 8)] = v; }
                    else { if (n < 8) BLR[(size_t)row * 16 + 8 + n] = v; } }
        }
        __syncthreads();
    }
}

#define IDX_AF(AF, b_, t0_) do { \
        const int qi_ = 2 * ((c >> 2) & 1) + (c >> 4), hh_ = (c & 3) + 4 * ((c >> 3) & 1);   \
        _Pragma("unroll") for (int mt = 0; mt < 2; ++mt) { const size_t tq_ = (size_t)(b_) * SEQ + (t0_) + 4 * mt + qi_; \
            _Pragma("unroll") for (int ks = 0; ks < 4; ++ks) AF[mt][ks] = *(const bf16x8*)(IQ + tq_ * 512 + hh_ * 64 + ks * 16 + 8 * g); } } while (0)
#define IDX_WV(WV, b_, t0_) do { \
        _Pragma("unroll") for (int mt = 0; mt < 2; ++mt) _Pragma("unroll") for (int qq = 0; qq < 2; ++qq) { const size_t tq_ = (size_t)(b_) * SEQ + (t0_) + 4 * mt + 2 * g + qq; \
            const f32x4 w0_ = *(const f32x4*)(IW + tq_ * 8), w1_ = *(const f32x4*)(IW + tq_ * 8 + 4); \
            WV[mt][qq][0] = w0_[0]; WV[mt][qq][1] = w0_[1]; WV[mt][qq][2] = w0_[2]; WV[mt][qq][3] = w0_[3]; WV[mt][qq][4] = w1_[0]; WV[mt][qq][5] = w1_[1]; WV[mt][qq][6] = w1_[2]; WV[mt][qq][7] = w1_[3]; } } while (0)

__device__ __forceinline__ void indexer_phase(LAS float* sc, const bf16_t* IQ, const bf16_t* IK, const float* IW, u64* MASK, int wave, int lane) {
    const int g = lane >> 5, c = lane & 31, G = gridDim.x;
    bf16x8 af[2][4];
#define IDX_ITEM(k_) ((k_) * G + (((k_) & 1) ? (G - 1 - (int)blockIdx.x) : (int)blockIdx.x))
    { const int it0 = IDX_ITEM(0); if (it0 < 2048) IDX_AF(af, it0 & 3, (511 - (it0 >> 2)) * 8); }
        for (int kk = 0; kk * G < 2048; ++kk) {
    const int it = IDX_ITEM(kk); if (it >= 2048) break;
    const int b = it & 3, t0 = (511 - (it >> 2)) * 8;
    float wv[2][2][8];
    IDX_WV(wv, b, t0);
    const int ntiles = (t0 + 8 + 31) >> 5;
    const bf16_t* ikb = IK + (size_t)b * 128 * 2048 + (size_t)(g * 32 + c) * 8;
#define IDX_LOAD(buf, kt_) do { if ((kt_) < ntiles) { _Pragma("unroll") for (int ks = 0; ks < 4; ++ks) buf[ks] = *(const bf16x8*)(ikb + (size_t)(kt_) * 2048 + ks * 512); } } while (0)
#define IDX_TILE(buf, kt_) do { if ((kt_) < ntiles) { const int key = (kt_) * 32 + c; f32x16 a0, a1; \
        _Pragma("unroll") for (int r = 0; r < 16; ++r) { a0[r] = 0.f; a1[r] = 0.f; } \
        _Pragma("unroll") for (int ks = 0; ks < 4; ++ks) { a0 = __builtin_amdgcn_mfma_f32_32x32x16_bf16(af[0][ks], buf[ks], a0, 0, 0, 0); a1 = __builtin_amdgcn_mfma_f32_32x32x16_bf16(af[1][ks], buf[ks], a1, 0, 0, 0); } \
        _Pragma("unroll") for (int qq = 0; qq < 2; ++qq) { float s0 = 0.f, s1 = 0.f; \
            _Pragma("unroll") for (int h = 0; h < 8; ++h) { s0 += wv[0][qq][h] * fmaxf(a0[8 * qq + h], 0.f); s1 += wv[1][qq][h] * fmaxf(a1[8 * qq + h], 0.f); } \
            sc[(0 + 2 * g + qq) * 4096 + key] = s0; sc[(4 + 2 * g + qq) * 4096 + key] = s1; } } } while (0)
    {
        bf16x8 b0[4], b1[4], b2[4];
        IDX_LOAD(b0, wave); IDX_LOAD(b1, wave + 8);
        for (int kt = wave; kt < ntiles; kt += 24) {
            IDX_LOAD(b2, kt + 16); IDX_TILE(b0, kt);
            IDX_LOAD(b0, kt + 24); IDX_TILE(b1, kt + 8);
            IDX_LOAD(b1, kt + 32); IDX_TILE(b2, kt + 16);
        }
    }
#undef IDX_LOAD
#undef IDX_TILE
    __syncthreads();
    bf16x8 afn[2][4];
    { const int itn = IDX_ITEM(kk + 1); if ((kk + 1) * G < 2048 && itn < 2048) IDX_AF(afn, itn & 3, (511 - (itn >> 2)) * 8); }
    {
        const int t = t0 + wave, nvalid = t + 1, nreg = (nvalid + 63) >> 6, ngrp = (nreg + 7) >> 3;
        const int gfull = nvalid >> 9;
        LAS float* myrow = sc + wave * 4096;
        float sf[64];
#pragma unroll
        for (int jj = 0; jj < 8; ++jj) {
            if (jj < gfull) {
#pragma unroll
                for (int j8 = 0; j8 < 8; ++j8) sf[jj * 8 + j8] = myrow[64 * (jj * 8 + j8) + lane];
            } else if (jj < ngrp) {
#pragma unroll
                for (int j8 = 0; j8 < 8; ++j8) { const int j = jj * 8 + j8, kk = 64 * j + lane; const float v = myrow[kk]; sf[j] = (kk < nvalid) ? v : NEG_INF; }
            } else {
#pragma unroll
                for (int j8 = 0; j8 < 8; ++j8) sf[jj * 8 + j8] = NEG_INF;
            }
        }
        float thr_f = NEG_INF; int need = 0; bool ties = false;
#define CNT_GEF(valf, out) do { int c_ = 0; _Pragma("unroll") for (int jj = 0; jj < 8; ++jj) if (jj < ngrp) { _Pragma("unroll") for (int j8 = 0; j8 < 8; ++j8) c_ += (sf[jj * 8 + j8] >= (valf)) ? 1 : 0; } \
            (out) = wave_sum_i32(c_); } while (0)
        if (nvalid > 256) {
            float mx = NEG_INF, mn = -NEG_INF;
#pragma unroll
            for (int jj = 0; jj < 8; ++jj) { if (jj < gfull) {
#pragma unroll
                for (int j8 = 0; j8 < 8; ++j8) { const float v = sf[jj * 8 + j8]; mx = fmaxf(mx, v); mn = fminf(mn, v); } }
              else if (jj < ngrp) {
#pragma unroll
                for (int j8 = 0; j8 < 8; ++j8) { const float v = sf[jj * 8 + j8]; mx = fmaxf(mx, v); mn = fminf(mn, v == NEG_INF ? -NEG_INF : v); } } }
            mx = wave_max_f32(mx); mn = -wave_max_f32(-mn);
            const float scale = (mx > mn) ? 3839.0f / (mx - mn) : 0.f;
            LAS unsigned* hist = (LAS unsigned*)myrow;
#pragma unroll
            for (int k = 0; k < 16; ++k) *(LAS u32x4*)(hist + 4 * lane + 256 * k) = (u32x4){0u, 0u, 0u, 0u};
            __builtin_amdgcn_fence(__ATOMIC_RELEASE, "wavefront");
#pragma unroll
            for (int jj = 0; jj < 8; ++jj) { if (jj < gfull) {
#pragma unroll
                for (int j8 = 0; j8 < 8; ++j8) { const float v = sf[jj * 8 + j8];
                    int bn = (int)((v - mn) * scale); bn = bn > 3839 ? 3839 : bn; __hip_atomic_fetch_add(hist + (bn >> 6) * 68 + (bn & 63), 1u, __ATOMIC_RELAXED, __HIP_MEMORY_SCOPE_WAVEFRONT); } }
              else if (jj < ngrp) {
#pragma unroll
                for (int j8 = 0; j8 < 8; ++j8) { const float v = sf[jj * 8 + j8];
                    if (v != NEG_INF) { int bn = (int)((v - mn) * scale); bn = bn > 3839 ? 3839 : bn; __hip_atomic_fetch_add(hist + (bn >> 6) * 68 + (bn & 63), 1u, __ATOMIC_RELAXED, __HIP_MEMORY_SCOPE_WAVEFRONT); } } } }
            __builtin_amdgcn_fence(__ATOMIC_ACQ_REL, "wavefront");
            int cs = 0;
            if (lane < 60) {
#pragma unroll
                for (int k = 0; k < 16; ++k) { const u32x4 h4 = *(const LAS u32x4*)(hist + lane * 68 + 4 * k); cs += (int)((h4.x + h4.y) + (h4.z + h4.w)); }
            }
            int C, Bl, cnt_above, nA;
            {
                const int pre = wave_prefix_sum_i32(cs), tot = __builtin_amdgcn_readlane(pre, 63), suf = tot - pre + cs;
                const u64 mk = __ballot(suf >= 256);
                C = 63 - __builtin_clzll(mk);
                const int above_c = __builtin_amdgcn_readlane(suf, C) - __builtin_amdgcn_readlane(cs, C);
                const int bs = (int)hist[C * 68 + lane];
                const int pre2 = wave_prefix_sum_i32(bs), tot2 = __builtin_amdgcn_readlane(pre2, 63), suf2 = tot2 - pre2 + bs;
                const u64 mk2 = __ballot(suf2 >= 256 - above_c);
                Bl = 63 - __builtin_clzll(mk2);
                nA = __builtin_amdgcn_readlane(bs, Bl);
                cnt_above = above_c + __builtin_amdgcn_readlane(suf2, Bl) - nA;
            }
            const int binA = C * 64 + Bl, need1 = 256 - cnt_above;
            if (nA <= 64) {
                unsigned cv = 0u; int pos = 0;
                const float invs = (mx - mn) * (1.0f / 3839.0f), lo_f = mn + ((float)binA - 0.5f) * invs, hi_f = mn + ((float)binA + 1.5f) * invs;
#pragma unroll
                for (int jj = 0; jj < 8; ++jj) if (jj < ngrp) {
#pragma unroll
                    for (int j8 = 0; j8 < 8; ++j8) { const float v = sf[jj * 8 + j8];
                        u64 m = __ballot(v >= lo_f && v < hi_f);
                        if (m) { int bn = (int)((v - mn) * scale); bn = bn > 3839 ? 3839 : bn; m = __ballot(v >= lo_f && v < hi_f && bn == binA); }
                        while (m) { const int l = __builtin_ctzll(m); m &= m - 1ull; const unsigned uu = (unsigned)__builtin_amdgcn_readlane((int)__float_as_uint(v), l);
                            const unsigned kv = (uu & 0x80000000u) ? ~uu : (uu | 0x80000000u); if (lane == pos) cv = kv; ++pos; } } }
                unsigned tc = 0u;
                for (int bit = 31; bit >= 0; --bit) { const unsigned cand = tc | (1u << bit); if (__popcll(__ballot(cv >= cand)) >= need1) tc = cand; }
                thr_f = __uint_as_float((tc & 0x80000000u) ? (tc ^ 0x80000000u) : ~tc);
                const int cgt = cnt_above + __popcll(__ballot(cv > tc)), ceq = __popcll(__ballot(cv == tc));
                need = 256 - cgt; ties = (ceq != need);
            } else {
                unsigned tc = 0u;
                for (int bit = 31; bit >= 0; --bit) { const unsigned cand = tc | (1u << bit); const float cf = __uint_as_float((cand & 0x80000000u) ? (cand ^ 0x80000000u) : ~cand);
                    int cnt; CNT_GEF(cf, cnt); if (cnt >= 256) tc = cand; }
                thr_f = __uint_as_float((tc & 0x80000000u) ? (tc ^ 0x80000000u) : ~tc);
                int cge, cg = 0;
                CNT_GEF(thr_f, cge);
#pragma unroll
                for (int jj = 0; jj < 8; ++jj) if (jj < ngrp) {
#pragma unroll
                    for (int j8 = 0; j8 < 8; ++j8) cg += (sf[jj * 8 + j8] > thr_f) ? 1 : 0; }
                const int cgt = wave_sum_i32(cg);
                need = 256 - cgt; ties = ((cge - cgt) != need);
            }
        }
#undef CNT_GEF
        u64 myword = 0ull;
        if (nvalid <= 256) {
#pragma unroll
            for (int j = 0; j < 4; ++j) { const u64 mm = __ballot(64 * j + lane < nvalid); if (lane == j) myword = mm; }
        } else if (!ties) {
#pragma unroll
            for (int jj = 0; jj < 8; ++jj) if (jj < ngrp) {
#pragma unroll
                for (int j8 = 0; j8 < 8; ++j8) { const int j = jj * 8 + j8; const u64 mm = __ballot(sf[j] >= thr_f); if (lane == j) myword = mm; if ((j & 3) == 3) __builtin_amdgcn_sched_barrier(0); } }
        } else {
            int base = 0;
#pragma unroll
            for (int j = 0; j < 64; ++j) { const bool eq = sf[j] == thr_f; const u64 em = __ballot(eq);
                const int rank = base + (int)__builtin_amdgcn_mbcnt_hi((unsigned)(em >> 32), __builtin_amdgcn_mbcnt_lo((unsigned)em, 0u));
                const u64 mm = __ballot(sf[j] > thr_f || (eq && rank < need)); base += __popcll(em);
                if (lane == j) myword = mm; __builtin_amdgcn_sched_barrier(0); }
        }
        LAS u64* mst = (LAS u64*)(sc + 32768);
        mst[lane * 8 + wave] = myword;
    }
    __syncthreads();
    { const int tid_ = wave * 64 + lane, kt_ = tid_ >> 3, q_ = tid_ & 7; const LAS u64* mst = (const LAS u64*)(sc + 32768);
      MASK[((size_t)b * 64 + kt_) * SEQ + t0 + q_] = mst[kt_ * 8 + q_]; }
#pragma unroll
    for (int mt = 0; mt < 2; ++mt) {
#pragma unroll
        for (int ks = 0; ks < 4; ++ks) af[mt][ks] = afn[mt][ks];
    }
    }
}
#undef IDX_AF
#undef IDX_WV
#undef IDX_ITEM

constexpr int GL_BLR = 0;
constexpr int GL_W2  = GL_BLR + 4096;
constexpr int GL_GP  = GL_W2 + 4096;
constexpr int GL_QD  = GL_GP + 2048;
constexpr int GL_KD  = GL_QD + 64 * 72 * 2;
constexpr int GL_KT  = GL_KD + 64 * 72 * 2;
constexpr int GL_VT  = GL_KT + 64 * 72 * 2;
constexpr int GL_P   = GL_VT + 128 * 72 * 2;
constexpr int GL_O   = GL_P + 64 * 72 * 2;
constexpr int GL_END = GL_O + 64 * 132 * 4;

__device__ __forceinline__ void gla_stage_vt(LAS bf16_t* vt, const u32x4 (&vraw)[2], int tid) {
#pragma unroll
    for (int rep = 0; rep < 2; ++rep) { const int idx = tid + 512 * rep, j = idx >> 4, dv8 = (idx & 15) * 8;
        const u32x4 w = vraw[rep];
        vt[(dv8 + 0) * 72 + j] = (bf16_t)(w.x & 0xFFFF); vt[(dv8 + 1) * 72 + j] = (bf16_t)(w.x >> 16);
        vt[(dv8 + 2) * 72 + j] = (bf16_t)(w.y & 0xFFFF); vt[(dv8 + 3) * 72 + j] = (bf16_t)(w.y >> 16);
        vt[(dv8 + 4) * 72 + j] = (bf16_t)(w.z & 0xFFFF); vt[(dv8 + 5) * 72 + j] = (bf16_t)(w.z >> 16);
        vt[(dv8 + 6) * 72 + j] = (bf16_t)(w.w & 0xFFFF); vt[(dv8 + 7) * 72 + j] = (bf16_t)(w.w >> 16); }
}
__device__ __forceinline__ void gla_prep_state(LAS unsigned char* lds, const float* gw2, const float* gb2, int b, int hh, int n,
                                               bf16_t* BQ, bf16_t* BK, const bf16_t* BV, const float* BLR, float* DECAY) {
    const int tid = opaque_tid(), d = tid & 63, jg = tid >> 6;
    const size_t tok0 = (size_t)b * SEQ + n * 64;
    LAS float* blr = (LAS float*)(lds + GL_BLR); LAS float* w2s = (LAS float*)(lds + GL_W2); LAS float* gp = (LAS float*)(lds + GL_GP);
    LAS bf16_t* kt = (LAS bf16_t*)(lds + GL_KT); LAS bf16_t* vt = (LAS bf16_t*)(lds + GL_VT);
    bf16_t kraw[8], qraw[8]; u32x4 vraw[2];
#pragma unroll
    for (int i = 0; i < 8; ++i) { kraw[i] = BK[(tok0 + 8 * jg + i) * 256 + hh * 64 + d]; qraw[i] = BQ[(tok0 + 8 * jg + i) * 256 + hh * 64 + d]; }
#pragma unroll
    for (int rep = 0; rep < 2; ++rep) { const int idx = tid + 512 * rep; vraw[rep] = *(const u32x4*)(BV + (tok0 + (idx >> 4)) * 512 + hh * 128 + (idx & 15) * 8); }
    if (tid < 256) { *(LAS f32x4*)(blr + tid * 4) = *(const f32x4*)(BLR + tok0 * 16 + tid * 4); }
    else { const int q = tid - 256, r = q >> 4, d4 = (q & 15) * 4; *(LAS f32x4*)(w2s + r * 64 + d4) = *(const f32x4*)(gw2 + (size_t)r * 256 + hh * 64 + d4); }
    __syncthreads();
    float cs[8];
    { const float b2 = gb2[hh * 64 + d]; float run = 0.f; float w2c[16];
#pragma unroll
      for (int r = 0; r < 16; ++r) w2c[r] = w2s[r * 64 + d];
#pragma unroll
      for (int i = 0; i < 8; ++i) { float z = b2;
#pragma unroll
          for (int q = 0; q < 4; ++q) { const f32x4 bl = *(const LAS f32x4*)(blr + (8 * jg + i) * 16 + 4 * q);
              z += bl[0] * w2c[4 * q + 0]; z += bl[1] * w2c[4 * q + 1]; z += bl[2] * w2c[4 * q + 2]; z += bl[3] * w2c[4 * q + 3]; }
          const float la = -(fmaxf(-z, 0.f) + __logf(1.0f + __expf(-fabsf(z)))) * (1.0f / 16.0f);
          run += la; cs[i] = run; }
      gp[jg * 64 + d] = run; }
    __syncthreads();
    float off = 0.f, glast = 0.f;
#pragma unroll
    for (int j = 0; j < 8; ++j) { const float v = gp[j * 64 + d]; if (j < jg) off += v; glast += v; }
    const float eglast = __expf(glast);
    if (jg == 0) DECAY[((size_t)(b * 4 + hh) * 64 + n) * 64 + d] = eglast;
    unsigned ktw[4];
#pragma unroll
    for (int i = 0; i < 8; i += 2) {
        float ktv[2];
#pragma unroll
        for (int ii = 0; ii < 2; ++ii) { const int j = 8 * jg + i + ii; const float G = off + cs[i + ii];
            const float kv = bf2f(kraw[i + ii]), qv = bf2f(qraw[i + ii]);
            const float eg = __expf(G), eng = __builtin_amdgcn_rcpf(eg), kdv = kv * eng;
            ktv[ii] = kdv * eglast;
            BQ[(tok0 + j) * 256 + hh * 64 + d] = (bf16_t)(cvt_pk_bf16(qv * 0.125f * eg, 0.f) & 0xFFFFu);
            BK[(tok0 + j) * 256 + hh * 64 + d] = (bf16_t)(cvt_pk_bf16(kdv, 0.f) & 0xFFFFu); }
        ktw[i >> 1] = cvt_pk_bf16(ktv[0], ktv[1]);
    }
    *(LAS u32x4*)(kt + d * 72 + 8 * jg) = (u32x4){ktw[0], ktw[1], ktw[2], ktw[3]};
    gla_stage_vt(vt, vraw, tid);
    __syncthreads();
}
__device__ __forceinline__ void gla_prep_out(LAS unsigned char* lds, int b, int hh, int n, const bf16_t* BQ, const bf16_t* BK, const bf16_t* BV) {
    const int tid = opaque_tid(), row = tid >> 3, ch = (tid & 7) * 8;
    const size_t tok0 = (size_t)b * SEQ + n * 64;
    LAS bf16_t* qd = (LAS bf16_t*)(lds + GL_QD); LAS bf16_t* kd = (LAS bf16_t*)(lds + GL_KD); LAS bf16_t* vt = (LAS bf16_t*)(lds + GL_VT);
    u32x4 vraw[2];
    const u32x4 qw = *(const u32x4*)(BQ + (tok0 + row) * 256 + hh * 64 + ch), kw = *(const u32x4*)(BK + (tok0 + row) * 256 + hh * 64 + ch);
#pragma unroll
    for (int rep = 0; rep < 2; ++rep) { const int idx = tid + 512 * rep; vraw[rep] = *(const u32x4*)(BV + (tok0 + (idx >> 4)) * 512 + hh * 128 + (idx & 15) * 8); }
    *(LAS u32x4*)(qd + row * 72 + ch) = qw; *(LAS u32x4*)(kd + row * 72 + ch) = kw;
    gla_stage_vt(vt, vraw, tid);
    __syncthreads();
}

__device__ __forceinline__ void gla_state_item(LAS unsigned char* lds, const float* gw2, const float* gb2, int item, bf16_t* BQ, bf16_t* BK, const bf16_t* BV, const float* BLR, float* DECAY, float* GSTATE) {
    const int b = item >> 8, hh = (item >> 6) & 3, n = item & 63;
    gla_prep_state(lds, gw2, gb2, b, hh, n, BQ, BK, BV, BLR, DECAY);
    const int tid1 = opaque_tid(), lane = tid1 & 63, wave = tid1 >> 6, g = lane >> 5, c = lane & 31, mt = wave >> 1, nt = wave & 1;
    LAS bf16_t* kt = (LAS bf16_t*)(lds + GL_KT); LAS bf16_t* vt = (LAS bf16_t*)(lds + GL_VT);
    f32x16 acc;
#pragma unroll
    for (int r = 0; r < 16; ++r) acc[r] = 0.f;
#pragma unroll
    for (int ks = 0; ks < 4; ++ks) { const bf16x8 af = *(const LAS bf16x8*)(vt + (32 * mt + c) * 72 + ks * 16 + 8 * g); const bf16x8 bf = *(const LAS bf16x8*)(kt + (32 * nt + c) * 72 + ks * 16 + 8 * g);
        acc = __builtin_amdgcn_mfma_f32_32x32x16_bf16(af, bf, acc, 0, 0, 0); }
    float* dst = GSTATE + ((size_t)(b * 4 + hh) * 64 + n) * 8192;
#pragma unroll
    for (int r = 0; r < 16; ++r) { const int dv = 32 * mt + (r & 3) + 8 * (r >> 2) + 4 * g; dst[dv * 64 + 32 * nt + c] = acc[r]; }
    __syncthreads();
}

__device__ __forceinline__ void gla_out_item(LAS unsigned char* lds, const float* gw2, const float* gb2, int item, const bf16_t* BQ, const bf16_t* BK, const bf16_t* BV, const float* BLR, const bf16_t* BG,
                                              const bf16_t* SPREV, bf16_t* MIXIN) {
    const int b = item >> 8, hh = (item >> 6) & 3, n = item & 63;
    const int tid = opaque_tid(), lane = tid & 63, wave = tid >> 6, g = lane >> 5, c = lane & 31;
    bf16x8 spf[4]; u32x4 g0, g1;
    { const bf16_t* sp = SPREV + ((size_t)(b * 4 + hh) * 64 + n) * 8192 + (size_t)(32 * (wave & 3) + c) * 64 + 8 * g;
#pragma unroll
      for (int ks = 0; ks < 4; ++ks) spf[ks] = *(const bf16x8*)(sp + ks * 16);
      const size_t tokg = (size_t)b * SEQ + n * 64 + (tid >> 3);
      g0 = *(const u32x4*)(BG + tokg * 512 + hh * 128 + (tid & 7) * 16); g1 = *(const u32x4*)(BG + tokg * 512 + hh * 128 + (tid & 7) * 16 + 8); }
    gla_prep_out(lds, b, hh, n, BQ, BK, BV);
    LAS bf16_t* qd = (LAS bf16_t*)(lds + GL_QD); LAS bf16_t* kd = (LAS bf16_t*)(lds + GL_KD); LAS bf16_t* vt = (LAS bf16_t*)(lds + GL_VT); LAS bf16_t* P = (LAS bf16_t*)(lds + GL_P);
    LAS float* o = (LAS float*)(lds + GL_O);
    if (wave < 4) {
        const int mt = wave >> 1, nt = wave & 1;
        f32x16 acc;
#pragma unroll
        for (int r = 0; r < 16; ++r) acc[r] = 0.f;
        if (!(mt == 0 && nt == 1)) {
#pragma unroll
            for (int ks = 0; ks < 4; ++ks) { const bf16x8 af = *(const LAS bf16x8*)(qd + (32 * mt + c) * 72 + ks * 16 + 8 * g); const bf16x8 bf = *(const LAS bf16x8*)(kd + (32 * nt + c) * 72 + ks * 16 + 8 * g);
                acc = __builtin_amdgcn_mfma_f32_32x32x16_bf16(af, bf, acc, 0, 0, 0); }
        }
#pragma unroll
        for (int r = 0; r < 16; ++r) { const int i = 32 * mt + (r & 3) + 8 * (r >> 2) + 4 * g, j = 32 * nt + c; P[i * 72 + j] = f2bf(j <= i ? acc[r] : 0.f); }
    }
    __syncthreads();
    {
        const int mt = wave >> 2, nt = wave & 3;
        f32x16 acc;
#pragma unroll
        for (int r = 0; r < 16; ++r) acc[r] = 0.f;
#pragma unroll
        for (int ks = 0; ks < 4; ++ks) { const bf16x8 af = *(const LAS bf16x8*)(P + (32 * mt + c) * 72 + ks * 16 + 8 * g); const bf16x8 bf = *(const LAS bf16x8*)(vt + (32 * nt + c) * 72 + ks * 16 + 8 * g);
            acc = __builtin_amdgcn_mfma_f32_32x32x16_bf16(af, bf, acc, 0, 0, 0); }
#pragma unroll
        for (int ks = 0; ks < 4; ++ks) { const bf16x8 af = *(const LAS bf16x8*)(qd + (32 * mt + c) * 72 + ks * 16 + 8 * g); acc = __builtin_amdgcn_mfma_f32_32x32x16_bf16(af, spf[ks], acc, 0, 0, 0); }
#pragma unroll
        for (int r = 0; r < 16; ++r) { const int i = 32 * mt + (r & 3) + 8 * (r >> 2) + 4 * g; o[i * 132 + 32 * nt + c] = acc[r]; }
    }
    __syncthreads();
    {
        const int row = tid >> 3, part = tid & 7; float v[16]; float ss = 0.f;
#pragma unroll
        for (int k = 0; k < 16; ++k) { v[k] = o[row * 132 + part * 16 + k]; ss += v[k] * v[k]; }
        ss += __shfl_xor(ss, 1); ss += __shfl_xor(ss, 2); ss += __shfl_xor(ss, 4);
        const float r = rsqrtf(ss * (1.0f / 128.0f) + EPS);
        const size_t tok = (size_t)b * SEQ + n * 64 + row;
        const float gv[16] = {bflo(g0.x), bfhi(g0.x), bflo(g0.y), bfhi(g0.y), bflo(g0.z), bfhi(g0.z), bflo(g0.w), bfhi(g0.w),
                              bflo(g1.x), bfhi(g1.x), bflo(g1.y), bfhi(g1.y), bflo(g1.z), bfhi(g1.z), bflo(g1.w), bfhi(g1.w)};
        unsigned w[8];
#pragma unroll
        for (int k = 0; k < 8; ++k) w[k] = cvt_pk_bf16(v[2 * k] * r * gv[2 * k], v[2 * k + 1] * r * gv[2 * k + 1]);
        bf16_t* dp = MIXIN + tok * 1024 + 512 + hh * 128 + part * 16;
        *(u32x4*)dp = (u32x4){w[0], w[1], w[2], w[3]}; *(u32x4*)(dp + 8) = (u32x4){w[4], w[5], w[6], w[7]};
    }
    __syncthreads();
}

constexpr int AT_K0 = 0, AT_V0 = 9216, AT_STAGE = 18432, AT_BT = 2 * AT_STAGE;
constexpr float LOG2E = 1.4426950408889634f, AT_C1 = 0.125f * LOG2E, AT_THR = 8.0f;

template <bool NEAR>
__device__ __forceinline__ void attn_tile(const LAS bf16_t* Kt, const LAS bf16_t* Vt, const LAS float* btl, const bf16x8 (&qf)[4], bf16x8& qx, const bf16x8 kx, f32x16& O0, f32x16& O1, float& m_ref, f32x16& Lt,
                                          u64 mw, int tq, int key0, int g, int c) {
    const int pc = (c & 0x13) | ((c & 4) << 1) | ((c & 8) >> 1);
    f32x16 s0, s1;
#pragma unroll
    for (int r = 0; r < 16; ++r) { s0[r] = 0.f; s1[r] = 0.f; }
#pragma unroll
    for (int ks = 0; ks < 4; ++ks) {
        const bf16x8 k0 = *(const LAS bf16x8*)(Kt + pc * 72 + ks * 16 + 8 * g), k1 = *(const LAS bf16x8*)(Kt + (32 + pc) * 72 + ks * 16 + 8 * g);
        s0 = __builtin_amdgcn_mfma_f32_32x32x16_bf16(k0, qf[ks], s0, 0, 0, 0); s1 = __builtin_amdgcn_mfma_f32_32x32x16_bf16(k1, qf[ks], s1, 0, 0, 0);
    }
    s0 = __builtin_amdgcn_mfma_f32_32x32x16_bf16(kx, qx, s0, 0, 0, 0); s1 = __builtin_amdgcn_mfma_f32_32x32x16_bf16(kx, qx, s1, 0, 0, 0);
    const unsigned w0 = (unsigned)mw >> (8 * g), w1 = (unsigned)(mw >> 32) >> (8 * g);
    float x0[16], x1[16];
#pragma unroll
    for (int r = 0; r < 16; ++r) {
        if (NEAR) { const LAS float* pb = btl + (tq - key0 - 8 * g + 96 - 63);
            x0[r] = s0[r] + pb[63 - (16 * (r >> 3) + (r & 7))]; x1[r] = s1[r] + pb[63 - (16 * (r >> 3) + (r & 7) + 32)]; }
        else { x0[r] = s0[r]; x1[r] = s1[r]; }
    }
    float mx = fmaxf(fmaxf(x0[15], x0[14]), fmaxf(x1[15], x1[14]));
#pragma unroll
    for (int r = 0; r < 14; r += 1) asm("v_max3_f32 %0, %1, %2, %3" : "=v"(mx) : "v"(mx), "v"(x0[r]), "v"(x1[r]));
    if (__any(mx > AT_THR || mx < -64.0f)) {
        float ms = NEG_INF;
#pragma unroll
        for (int r = 0; r < 16; ++r) { const int bp = 16 * (r >> 3) + (r & 7);
            const float a0 = ((w0 >> bp) & 1u) ? x0[r] : NEG_INF, a1 = ((w1 >> bp) & 1u) ? x1[r] : NEG_INF; ms = fmaxf(ms, fmaxf(a0, a1)); }
        { const auto sw = __builtin_amdgcn_permlane32_swap(__float_as_uint(ms), __float_as_uint(ms), false, false); ms = fmaxf(__uint_as_float(sw[0]), __uint_as_float(sw[1])); }
        const bool empty = (Lt[0] == 0.f);
        float rel = (ms == NEG_INF) ? 0.f : (empty ? ms : fmaxf(ms, 0.f));
        const unsigned mb = cvt_pk_bf16(m_ref + rel, 0.f) << 16;
        const float m_new = __uint_as_float(mb), delta = m_new - m_ref;
        const float alpha = empty ? 1.0f : __builtin_amdgcn_exp2f(-delta);
#pragma unroll
        for (int r = 0; r < 16; ++r) { O0[r] *= alpha; O1[r] *= alpha; Lt[r] *= alpha; x0[r] -= delta; x1[r] -= delta; }
        m_ref = m_new;
        { u32x4 qw = (u32x4){0u, 0u, 0u, 0u}; if (g == 0) qw.x = (mb >> 16) ^ 0x8000u; qx = *(bf16x8*)&qw; }
    }
#pragma unroll
    for (int r = 0; r < 16; ++r) { const int bp = 16 * (r >> 3) + (r & 7);
        const float e0 = __builtin_amdgcn_exp2f(x0[r]), e1 = __builtin_amdgcn_exp2f(x1[r]);
        unsigned b0, b1;
        asm("v_bfe_i32 %0, %1, %2, 1" : "=v"(b0) : "v"(w0), "n"(bp)); asm("v_bfe_i32 %0, %1, %2, 1" : "=v"(b1) : "v"(w1), "n"(bp));
        x0[r] = __uint_as_float(__float_as_uint(e0) & b0); x1[r] = __uint_as_float(__float_as_uint(e1) & b1); }
#pragma unroll
    for (int s = 0; s < 4; ++s) {
        const float* xp = (s < 2) ? x0 : x1; const int o = 8 * (s & 1);
        u32x4 w; w.x = cvt_pk_bf16(xp[o + 0], xp[o + 1]); w.y = cvt_pk_bf16(xp[o + 2], xp[o + 3]); w.z = cvt_pk_bf16(xp[o + 4], xp[o + 5]); w.w = cvt_pk_bf16(xp[o + 6], xp[o + 7]);
        const bf16x8 pb = *(bf16x8*)&w;
        const bf16x8 v0 = *(const LAS bf16x8*)(Vt + c * 72 + s * 16 + 8 * g), v1 = *(const LAS bf16x8*)(Vt + (32 + c) * 72 + s * 16 + 8 * g);
        O0 = __builtin_amdgcn_mfma_f32_32x32x16_bf16(v0, pb, O0, 0, 0, 0); O1 = __builtin_amdgcn_mfma_f32_32x32x16_bf16(v1, pb, O1, 0, 0, 0);
        const u32x4 onew = (u32x4){0x3F803F80u, 0x3F803F80u, 0x3F803F80u, 0x3F803F80u};
        Lt = __builtin_amdgcn_mfma_f32_32x32x16_bf16(*(const bf16x8*)&onew, pb, Lt, 0, 0, 0);
    }
}

__device__ __forceinline__ void attn_item(LAS unsigned char* lds, const bf16_t* Q, const bf16_t* Kb, const bf16_t* VT, const bf16_t* AG, const u64* MASK, const float* btab, bf16_t* MIXIN,
                                          int b, int head, int qb, int tid) {
    const int lane = tid & 63, wave = __builtin_amdgcn_readfirstlane(tid >> 6), g = lane >> 5, c = lane & 31;
    const int tq0 = qb * 256 + wave * 32, tq = tq0 + c;
    const size_t tokq = (size_t)b * SEQ + tq;
    LAS float* btl = (LAS float*)(lds + AT_BT);
    if (tid < 320) { const int rel = tid - 96; btl[tid] = (rel >= 0 && rel < 128) ? (btab[rel * 8 + head] - btab[127 * 8 + head]) * LOG2E : 0.f; }
    bf16x8 qf[4];
#pragma unroll
    for (int ks = 0; ks < 4; ++ks) { const u32x4 qw = *(const u32x4*)(Q + tokq * 512 + head * 64 + ks * 16 + 8 * g);
        u32x4 sw; sw.x = cvt_pk_bf16(bflo(qw.x) * AT_C1, bfhi(qw.x) * AT_C1); sw.y = cvt_pk_bf16(bflo(qw.y) * AT_C1, bfhi(qw.y) * AT_C1);
        sw.z = cvt_pk_bf16(bflo(qw.z) * AT_C1, bfhi(qw.z) * AT_C1); sw.w = cvt_pk_bf16(bflo(qw.w) * AT_C1, bfhi(qw.w) * AT_C1); qf[ks] = *(bf16x8*)&sw; }
    bf16x8 qx, kx;
    { u32x4 z = (u32x4){0u, 0u, 0u, 0u}; qx = *(bf16x8*)&z; if (g == 0) z.x = 0x3F80u; kx = *(bf16x8*)&z; }
    f32x16 O0, O1;
#pragma unroll
    for (int r = 0; r < 16; ++r) { O0[r] = 0.f; O1[r] = 0.f; }
    float m_ref = 0.f; f32x16 Lt;
#pragma unroll
    for (int r = 0; r < 16; ++r) Lt[r] = 0.f;
    const int nt = 4 * qb + 4, my_last = 4 * qb + (wave >> 1);
    const int srow = tid >> 3, sch = tid & 7, sto = (srow * 72 + 8 * sch) * 2;
    const bf16_t* kg = Kb + ((size_t)b * SEQ + srow) * 512 + head * 64 + 8 * sch;
    const bf16_t* vg = VT + ((size_t)(b * 8 + head) * 64 + srow) * 4096 + 8 * sch;
    const u64* Mrow = MASK + (size_t)b * 64 * SEQ + tq;
    { const u32x4 kr = *(const u32x4*)kg, vr = *(const u32x4*)vg; *(LAS u32x4*)(lds + AT_K0 + sto) = kr; *(LAS u32x4*)(lds + AT_V0 + sto) = vr; }
    u64 mw = Mrow[0];
    __syncthreads();
    int ks_near = (tq0 - 175 + 63) >> 6; ks_near = ks_near < 0 ? 0 : ks_near;
#define AT_ITER(BODY) do { const bool more = (kt + 1 < nt); u32x4 kr, vr; u64 mwn = 0ull; \
        if (more) { kr = *(const u32x4*)(kg + (size_t)(kt + 1) * 64 * 512); vr = *(const u32x4*)(vg + (kt + 1) * 64); if (kt + 1 <= my_last) mwn = Mrow[(size_t)(kt + 1) * SEQ]; } \
        { const LAS bf16_t* Kt = (const LAS bf16_t*)(lds + (kt & 1) * AT_STAGE + AT_K0); const LAS bf16_t* Vt = (const LAS bf16_t*)(lds + (kt & 1) * AT_STAGE + AT_V0); BODY; } \
        if (more) { *(LAS u32x4*)(lds + ((kt + 1) & 1) * AT_STAGE + AT_K0 + sto) = kr; *(LAS u32x4*)(lds + ((kt + 1) & 1) * AT_STAGE + AT_V0 + sto) = vr; } \
        mw = mwn; __syncthreads(); } while (0)
    int kt = 0;
    for (; kt < ks_near; ++kt) AT_ITER(attn_tile<false>(Kt, Vt, btl, qf, qx, kx, O0, O1, m_ref, Lt, mw, tq, 64 * kt, g, c));
    for (; kt <= my_last; ++kt) AT_ITER(attn_tile<true>(Kt, Vt, btl, qf, qx, kx, O0, O1, m_ref, Lt, mw, tq, 64 * kt, g, c));
    for (; kt < nt; ++kt) AT_ITER((void)Kt; (void)Vt);
#undef AT_ITER
    const float inv = 1.0f / Lt[0];
#pragma unroll
    for (int mt = 0; mt < 2; ++mt)
#pragma unroll
        for (int rq = 0; rq < 4; ++rq) { const int d0 = 32 * mt + 8 * rq + 4 * g;
            const u32x2 gw = *(const u32x2*)(AG + tokq * 512 + head * 64 + d0);
            const float o0 = (mt ? O1[4 * rq + 0] : O0[4 * rq + 0]) * inv * bflo(gw.x), o1 = (mt ? O1[4 * rq + 1] : O0[4 * rq + 1]) * inv * bfhi(gw.x);
            const float o2 = (mt ? O1[4 * rq + 2] : O0[4 * rq + 2]) * inv * bflo(gw.y), o3 = (mt ? O1[4 * rq + 3] : O0[4 * rq + 3]) * inv * bfhi(gw.y);
            u32x2 ow; ow.x = cvt_pk_bf16(o0, o1); ow.y = cvt_pk_bf16(o2, o3);
            *(u32x2*)(MIXIN + tokq * 1024 + head * 64 + d0) = ow; }
}

constexpr int LDS_BYTES = 147456;
constexpr int MISC_OFF = 131072 + 8192;
constexpr int NPH = 26;

__global__ void __launch_bounds__(NTHREADS, 2) fwd_kernel(Args a) {
    extern __shared__ __attribute__((aligned(16))) unsigned char lds_raw[];
    LAS unsigned char* lds = (LAS unsigned char*)lds_raw;
    const int G = gridDim.x, wg = blockIdx.x;
    volatile LAS unsigned* misc = (volatile LAS unsigned*)(lds + MISC_OFF);
    if (threadIdx.x < 4) misc[threadIdx.x] = 0u;
    __syncthreads();
    XcdBarrier bar; bar.bar = nullptr; bar.x = 0; bar.st = misc;
    if (N_LAUNCHES == 1) bar = xcd_barrier_post((unsigned*)(get_args()->ws + WS_CTL), misc);
    int lo, hi; { ArgsP ap = get_args(); lo = ap->ph_lo; hi = ap->ph_hi; }
#define WSP(type, off) ((type*)(wsl + (off)))
#define IN(k) (lo <= (k) && (k) < hi)
#define SEAM(k) do { if (N_LAUNCHES == 1 && IN(k) && IN((k) + 1)) { XcdBarrier b_ = bar; asm volatile("" : "+s"(b_.bar), "+s"(b_.x)); xcd_barrier(b_); } } while (0)

    if (IN(0)) {
        ArgsP ap = get_args(); unsigned char* wsl = ap->ws;
        weight_phase((LAS float*)lds, ap, wsl);
        if (wg == 0) for (int i = opaque_tid(); i < 1024; i += NTHREADS) { const int rel = i >> 3, h = i & 7; WSP(float, WS_TAB)[i] = ap->rel_bias[t5_bucket(rel) * 8 + h]; }
    }
    SEAM(0);

#define LAYER_BODY(LAYER_) { constexpr int layer = (LAYER_); \
        const int pb = 1 + 6 * layer, e = layer >> 1; \
        constexpr bool even = (layer & 1) == 0; \
        if (IN(pb + 0)) { \
            ArgsP ap = get_args(); unsigned char* wsl = ap->ws; \
            const bf16_t* Wm = WSP(bf16_t, WS_WEIN) + ((size_t)e * NE + 4096) * 1024; \
            if (layer == 0) norm_misc_phase(lds, ap->x, nullptr, nullptr, nullptr, nullptr, WSP(bf16_t, WS_H), WSP(float, WS_XS), Wm, WSP(bf16_t, WS_IK), WSP(float, WS_IW), WSP(float, WS_BLR)); \
            else if (even) norm_misc_phase(lds, nullptr, WSP(bf16_t, WS_H), WSP(float, WS_XS), WSP(bf16_t, WS_MIX), ap->post_norm + (layer - 1) * DM, WSP(bf16_t, WS_H), WSP(float, WS_XS), Wm, WSP(bf16_t, WS_IK), WSP(float, WS_IW), WSP(float, WS_BLR)); \
            else norm_phase(nullptr, WSP(bf16_t, WS_H), WSP(float, WS_XS), WSP(bf16_t, WS_MIX), ap->post_norm + (layer - 1) * DM, WSP(bf16_t, WS_H), WSP(float, WS_XS), nullptr); \
        } \
        SEAM(pb + 0); \
        if (even) { \
            if (IN(pb + 1)) { \
                ArgsP ap = get_args(); unsigned char* wsl = ap->ws; \
                pg8::Gemm gm{WSP(bf16_t, WS_H), WSP(bf16_t, WS_WEIN) + (size_t)e * NE * 1024, T, 4096, 1024, 1024, 1 << 30, 0}; pg8::StaticOrder S; S.init(T, 4096, G, wg); \
                EpiEvenIn E{WSP(bf16_t, WS_Q), WSP(bf16_t, WS_K), WSP(bf16_t, WS_VT), WSP(bf16_t, WS_AG), WSP(bf16_t, WS_IQ), WSP(bf16_t, WS_BQ), WSP(bf16_t, WS_BK), WSP(bf16_t, WS_BV), WSP(bf16_t, WS_BG), \
                            WSP(bf16_t, WS_IK), WSP(float, WS_IW), WSP(float, WS_BLR)}; \
                pg8::gemm_phase(lds, gm, S, E); \
            } \
            SEAM(pb + 1); \
            if (IN(pb + 2)) { \
                ArgsP ap = get_args(); unsigned char* wsl = ap->ws; \
                { const int tid = opaque_tid(), lane = tid & 63, wave = __builtin_amdgcn_readfirstlane(tid >> 6); \
                  indexer_phase((LAS float*)lds, WSP(bf16_t, WS_IQ), WSP(bf16_t, WS_IK), WSP(float, WS_IW), WSP(u64, WS_MASK), wave, lane); } \
                { const float* gw2 = ap->even_gate_w2 + (size_t)e * 16 * 256; const float* gb2 = ap->even_gate_b2 + (size_t)e * 256; \
                  for (int it = wg; it < 1024; it += G) gla_state_item(lds, gw2, gb2, it, WSP(bf16_t, WS_BQ), WSP(bf16_t, WS_BK), WSP(bf16_t, WS_BV), WSP(float, WS_BLR), WSP(float, WS_DECAY), WSP(float, WS_MIXIN)); } \
            } \
            SEAM(pb + 2); \
            if (IN(pb + 3)) { \
                ArgsP ap = get_args(); unsigned char* wsl = ap->ws; \
                const float* GSTATE = WSP(float, WS_MIXIN); const float* DECAY = WSP(float, WS_DECAY); bf16_t* SPREV = WSP(bf16_t, WS_SPREV); \
                for (int el = wg * NTHREADS + opaque_tid(); el < 16 * 8192; el += G * NTHREADS) { \
                    const int bh = el >> 13, rem = el & 8191, dk = rem & 63; float Sv = 0.f; \
                    for (int n = 0; n < 64; ++n) { const size_t o = ((size_t)bh * 64 + n) * 8192 + rem; SPREV[o] = f2bf(Sv); Sv = DECAY[((size_t)bh * 64 + n) * 64 + dk] * Sv + GSTATE[o]; } \
                } \
            } \
            SEAM(pb + 3); \
            if (IN(pb + 4)) { \
                ArgsP ap = get_args(); unsigned char* wsl = ap->ws; \
                { const int tid = opaque_tid(); \
                  for (int it = wg; it < 512; it += G) { const int idx = it & 255, b = idx & 3, head = (idx >> 2) & 7, qbp = idx >> 5, qb = (it < 256) ? 15 - qbp : qbp; \
                      attn_item(lds, WSP(bf16_t, WS_Q), WSP(bf16_t, WS_K), WSP(bf16_t, WS_VT), WSP(bf16_t, WS_AG), WSP(u64, WS_MASK), WSP(float, WS_TAB), WSP(bf16_t, WS_MIXIN), b, head, qb, tid); } } \
                __syncthreads(); \
                { const float* gw2 = ap->even_gate_w2 + (size_t)e * 16 * 256; const float* gb2 = ap->even_gate_b2 + (size_t)e * 256; \
                  for (int it = wg; it < 1024; it += G) gla_out_item(lds, gw2, gb2, it, WSP(bf16_t, WS_BQ), WSP(bf16_t, WS_BK), WSP(bf16_t, WS_BV), WSP(float, WS_BLR), WSP(bf16_t, WS_BG), WSP(bf16_t, WS_SPREV), WSP(bf16_t, WS_MIXIN)); } \
            } \
            SEAM(pb + 4); \
        } else { \
            if (IN(pb + 1)) { \
                ArgsP ap = get_args(); unsigned char* wsl = ap->ws; \
                pg8::Gemm gm{WSP(bf16_t, WS_H), WSP(bf16_t, WS_WOIN) + (size_t)e * 2048 * 1024, T, 2048, 1024, 1024, 1 << 30, 0}; pg8::StaticOrder S; S.init(T, 2048, G, wg); \
                EpiOddIn E{WSP(bf16_t, WS_XR), WSP(bf16_t, WS_GS)}; \
                pg8::gemm_phase(lds, gm, S, E); \
            } \
            SEAM(pb + 1); \
            if (IN(pb + 2)) { \
                ArgsP ap = get_args(); unsigned char* wsl = ap->ws; \
                const bf16_t* XR = WSP(bf16_t, WS_XR); bf16_t* XC = WSP(bf16_t, WS_XC); \
                const float* cw = ap->odd_conv_w + (size_t)e * 4 * 1024; const float* cb = ap->odd_conv_b + (size_t)e * 1024; \
                { const int tid = opaque_tid(), c8 = (tid & 127) * 8; float wq[4][8], bq[8];   \
_Pragma("unroll") \
                  for (int k = 0; k < 8; ++k) { bq[k] = cb[c8 + k]; _Pragma("unroll") for (int j = 0; j < 4; ++j) wq[j][k] = cw[j * 1024 + c8 + k]; } \
                  for (int run = wg * 4 + (tid >> 7); run < T / 8; run += G * 4) { \
                    const int tok0 = run * 8, s0 = tok0 & 4095; float xw[11][8]; \
_Pragma("unroll") \
                    for (int i = 0; i < 11; ++i) { u32x4 w = (u32x4){0u, 0u, 0u, 0u}; if (s0 - 3 + i >= 0) w = *(const u32x4*)(XR + (size_t)(tok0 - 3 + i) * 1024 + c8); \
                        xw[i][0] = bflo(w.x); xw[i][1] = bfhi(w.x); xw[i][2] = bflo(w.y); xw[i][3] = bfhi(w.y); xw[i][4] = bflo(w.z); xw[i][5] = bfhi(w.z); xw[i][6] = bflo(w.w); xw[i][7] = bfhi(w.w); } \
_Pragma("unroll") \
                    for (int o = 0; o < 8; ++o) { float acc[8]; \
_Pragma("unroll") \
                        for (int k = 0; k < 8; ++k) acc[k] = bq[k] + wq[0][k] * xw[o][k] + wq[1][k] * xw[o + 1][k] + wq[2][k] * xw[o + 2][k] + wq[3][k] * xw[o + 3][k]; \
                        u32x4 ow; ow.x = cvt_pk_bf16(acc[0], acc[1]); ow.y = cvt_pk_bf16(acc[2], acc[3]); ow.z = cvt_pk_bf16(acc[4], acc[5]); ow.w = cvt_pk_bf16(acc[6], acc[7]); \
                        *(u32x4*)(XC + (size_t)(tok0 + o) * 1024 + c8) = ow; } \
                  } } \
            } \
            SEAM(pb + 2); \
            if (IN(pb + 3)) { \
                ArgsP ap = get_args(); unsigned char* wsl = ap->ws; \
                pg8::Gemm gm{WSP(bf16_t, WS_XC), WSP(bf16_t, WS_WOG) + (size_t)e * 2048 * 256, T, 2048, 256, 1024, 2, 512}; pg8::StaticOrder S; S.init(T, 2048, G, wg); \
                EpiGates E{ap->odd_b_a + (size_t)e * 1024, ap->odd_b_x + (size_t)e * 1024, ap->odd_lambda + (size_t)e * 1024, WSP(bf16_t, WS_XC), WSP(bf16_t, WS_LOGA), WSP(bf16_t, WS_U)}; \
                pg8::gemm_phase(lds, gm, S, E); \
            } \
            SEAM(pb + 3); \
            if (IN(pb + 4)) { \
                ArgsP ap = get_args(); unsigned char* wsl = ap->ws; \
                const bf16_t* LOGA = WSP(bf16_t, WS_LOGA); const bf16_t* U = WSP(bf16_t, WS_U); const bf16_t* GS = WSP(bf16_t, WS_GS); bf16_t* MIXIN = WSP(bf16_t, WS_MIXIN); \
                LAS float* sl = (LAS float*)lds; LAS float* hl = sl + 512; \
                const int tid = opaque_tid(); \
                for (int it = wg; it < 256; it += G) { \
                      \
                    const int xq = (it & 7) * 8 + ((it >> 3) >> 2), b = xq >> 4, ch = ((xq & 15) * 4 + ((it >> 3) & 3)) * 16 + (tid & 15), jc = tid >> 4; \
                    const size_t base = ((size_t)b * SEQ + jc * 128) * 1024 + ch, sbase = slab_idx(b * SEQ + jc * 128, ch); \
                    float hsum = 0.f, lsum = 0.f; \
                    for (int s0 = 0; s0 < 128; s0 += 16) { float la[16], uu[16]; \
                        _Pragma("unroll") for (int k = 0; k < 16; ++k) { la[k] = bf2f(LOGA[sbase + (size_t)(s0 + k) * 16]); uu[k] = bf2f(U[sbase + (size_t)(s0 + k) * 16]); } \
                        _Pragma("unroll") for (int k = 0; k < 16; ++k) { hsum = __builtin_amdgcn_exp2f(la[k]) * hsum + uu[k]; lsum += la[k]; } } \
                    sl[tid] = lsum; hl[tid] = hsum; \
                    __syncthreads(); \
                    float hin = 0.f; \
                    for (int cj = 0; cj < jc; ++cj) hin = __builtin_amdgcn_exp2f(sl[cj * 16 + (tid & 15)]) * hin + hl[cj * 16 + (tid & 15)]; \
                    float hv = hin; \
                    for (int s0 = 0; s0 < 128; s0 += 16) { float la[16], uu[16], gg[16]; \
                        _Pragma("unroll") for (int k = 0; k < 16; ++k) { la[k] = bf2f(LOGA[sbase + (size_t)(s0 + k) * 16]); uu[k] = bf2f(U[sbase + (size_t)(s0 + k) * 16]); gg[k] = bf2f(GS[sbase + (size_t)(s0 + k) * 16]); } \
                        _Pragma("unroll") for (int k = 0; k < 16; ++k) { hv = __builtin_amdgcn_exp2f(la[k]) * hv + uu[k]; MIXIN[base + (size_t)(s0 + k) * 1024] = f2bf(hv * gg[k]); } } \
                    __syncthreads(); \
                } \
            } \
            SEAM(pb + 4); \
        } \
        if (IN(pb + 5)) { \
            ArgsP ap = get_args(); unsigned char* wsl = ap->ws; \
            const bf16_t* W = (even ? WSP(bf16_t, WS_WEOUT) : WSP(bf16_t, WS_WOOUT)) + (size_t)e * 1024 * 1024; \
            pg8::Gemm gm{WSP(bf16_t, WS_MIXIN), W, T, 1024, 1024, 1024, 1 << 30, 0}; pg8::StaticOrder S; S.init(T, 1024, G, wg); \
            EpiMix E{WSP(bf16_t, WS_MIX)}; \
            pg8::gemm_phase(lds, gm, S, E); \
        } \
        SEAM(pb + 5); \
    }
    LAYER_BODY(0)
    LAYER_BODY(1)
    LAYER_BODY(2)
    LAYER_BODY(3)
#undef LAYER_BODY
    if (IN(25)) { ArgsP ap = get_args(); unsigned char* wsl = ap->ws; norm_phase(nullptr, WSP(bf16_t, WS_H), WSP(float, WS_XS), WSP(bf16_t, WS_MIX), ap->post_norm + 3 * DM, nullptr, nullptr, ap->out); }
#undef IN
#undef SEAM
#undef WSP
}

extern "C" void kernel_launch(void* const* d_in, const int* in_sizes, int n_in, void* d_out, int out_size, void* d_ws, size_t ws_size, hipStream_t stream) {
    static int grid = 0;
    if (grid == 0) {
        if (n_in != 17 || out_size != T * DM || ws_size < WS_END) { fprintf(stderr, "kernel_launch: unexpected sizes (n_in %d, out %d, ws %zu, need %zu)\n", n_in, out_size, ws_size, (size_t)WS_END); grid = -1; return; }
        int dev = 0, cus = 0, per_cu = 0;
        if (hipGetDevice(&dev) != hipSuccess || hipDeviceGetAttribute(&cus, hipDeviceAttributeMultiprocessorCount, dev) != hipSuccess) { grid = -1; return; }
        if (hipFuncSetAttribute((const void*)fwd_kernel, hipFuncAttributeMaxDynamicSharedMemorySize, LDS_BYTES) != hipSuccess) { fprintf(stderr, "kernel_launch: hipFuncSetAttribute failed\n"); grid = -1; return; }
        if (hipOccupancyMaxActiveBlocksPerMultiprocessor(&per_cu, (const void*)fwd_kernel, NTHREADS, LDS_BYTES) != hipSuccess || per_cu < 1) { fprintf(stderr, "kernel_launch: occupancy query says %d\n", per_cu); }
        (void)hipGetLastError();
        grid = cus;
    }
    if (grid < 0) return;
    (void)hipMemsetAsync((char*)d_ws + WS_CTL, 0, CTL_BYTES, stream);
    Args a{};
    a.x = (const float*)d_in[0]; a.rel_bias = (const float*)d_in[1]; a.pre_norm = (const float*)d_in[2]; a.post_norm = (const float*)d_in[3];
    a.even_w_in = (const float*)d_in[4]; a.even_gate_w2 = (const float*)d_in[5]; a.even_gate_b2 = (const float*)d_in[6]; a.even_w_out = (const float*)d_in[7];
    a.odd_w_in = (const float*)d_in[8]; a.odd_conv_w = (const float*)d_in[9]; a.odd_conv_b = (const float*)d_in[10]; a.odd_w_a = (const float*)d_in[11]; a.odd_b_a = (const float*)d_in[12];
    a.odd_w_x = (const float*)d_in[13]; a.odd_b_x = (const float*)d_in[14]; a.odd_lambda = (const float*)d_in[15]; a.odd_w_out = (const float*)d_in[16];
    a.out = (float*)d_out; a.ws = (unsigned char*)d_ws;
    if (N_LAUNCHES == 1) {
        a.ph_lo = 0; a.ph_hi = NPH;
        hipLaunchKernelGGL(fwd_kernel, dim3(grid), dim3(NTHREADS), LDS_BYTES, stream, a);
    } else {
        for (int ph = 0; ph < NPH; ++ph) { a.ph_lo = ph; a.ph_hi = ph + 1; hipLaunchKernelGGL(fwd_kernel, dim3(grid), dim3(NTHREADS), LDS_BYTES, stream, a); }
    }
}
```

```cpp
#include <hip/hip_runtime.h>
#include <stdint.h>
#include <stdio.h>

#ifndef N_LAUNCHES
#define N_LAUNCHES 1
#endif

#define LAS __attribute__((address_space(3)))
typedef unsigned short bf16_t;
typedef short bf16x8 __attribute__((ext_vector_type(8)));
typedef float f32x4 __attribute__((ext_vector_type(4)));
typedef float f32x2 __attribute__((ext_vector_type(2)));
typedef float f32x16 __attribute__((ext_vector_type(16)));
typedef unsigned u32x4 __attribute__((ext_vector_type(4)));
typedef unsigned u32x2 __attribute__((ext_vector_type(2)));
typedef unsigned long long u64;

constexpr int NB = 4, SEQ = 4096, T = NB * SEQ, DM = 1024;
constexpr int EVEN_IN = 4184, NE = 4352;
constexpr int NTHREADS = 512;
constexpr float EPS = 1e-6f;
constexpr float NEG_INF = -__builtin_inff();

constexpr size_t MB = 1024 * 1024;
constexpr size_t WS_CTL   = 0;
constexpr size_t CTL_BYTES = 65536;
constexpr size_t WS_WEIN  = WS_CTL + CTL_BYTES;
constexpr size_t WS_WEOUT = WS_WEIN + (size_t)2 * NE * 1024 * 2;
constexpr size_t WS_WOIN  = WS_WEOUT + 4 * MB;
constexpr size_t WS_WOG   = WS_WOIN + 8 * MB;
constexpr size_t WS_WOOUT = WS_WOG + 2 * MB;
constexpr size_t WS_TAB   = WS_WOOUT + 4 * MB;
constexpr size_t WS_XS    = WS_TAB + 4096;
constexpr size_t WS_H     = WS_XS + 65536;
constexpr size_t WS_MIXIN = WS_H + 32 * MB;
constexpr size_t WS_ACT   = WS_MIXIN + 32 * MB;
constexpr size_t WS_Q     = WS_ACT;
constexpr size_t WS_K     = WS_Q + 16 * MB;
constexpr size_t WS_VT    = WS_K + 16 * MB;
constexpr size_t WS_AG    = WS_VT + 16 * MB;
constexpr size_t WS_MIX   = WS_ACT;
constexpr size_t WS_IQ    = WS_AG + 16 * MB;
constexpr size_t WS_BQ    = WS_IQ + 16 * MB;
constexpr size_t WS_BK    = WS_BQ + 8 * MB;
constexpr size_t WS_BV    = WS_BK + 8 * MB;
constexpr size_t WS_BG    = WS_BV + 16 * MB;
constexpr size_t WS_IK    = WS_BG + 16 * MB;
constexpr size_t WS_IW    = WS_IK + 2 * MB;
constexpr size_t WS_BLR   = WS_IW + MB / 2;
constexpr size_t WS_MASK  = WS_BLR + MB;
constexpr size_t WS_SPREV = WS_MASK + 8 * MB;
constexpr size_t WS_DECAY = WS_SPREV + 16 * MB;
constexpr size_t WS_EVEN_END = WS_DECAY + MB / 4;
constexpr size_t WS_XR    = WS_ACT;
constexpr size_t WS_U     = WS_XR;
constexpr size_t WS_GS    = WS_XR + 32 * MB;
constexpr size_t WS_XC    = WS_GS + 32 * MB;
constexpr size_t WS_LOGA  = WS_XC + 32 * MB;
constexpr size_t WS_ODD_END = WS_LOGA + 32 * MB;
constexpr size_t WS_END   = WS_EVEN_END > WS_ODD_END ? WS_EVEN_END : WS_ODD_END;
static_assert(WS_END <= (size_t)256 * MB, "workspace map exceeds 256 MiB");

__device__ __forceinline__ float bf2f(unsigned v) { return __uint_as_float(v << 16); }
typedef __bf16 bf16pair_t __attribute__((ext_vector_type(2)));
typedef float f32pair_t __attribute__((ext_vector_type(2)));
__device__ __forceinline__ unsigned cvt_pk_bf16(float lo, float hi) { const f32pair_t v = {lo, hi}; const bf16pair_t b = __builtin_convertvector(v, bf16pair_t); return __builtin_bit_cast(unsigned, b); }
__device__ __forceinline__ bf16_t f2bf(float f) { return (bf16_t)cvt_pk_bf16(f, f); }
__device__ __forceinline__ float silu_f(float x) { return x / (1.0f + __expf(-x)); }
__device__ __forceinline__ float sigmoid_f(float x) { return 1.0f / (1.0f + __expf(-x)); }
__device__ __forceinline__ size_t slab_idx(int row, int ch) { return ((size_t)((row >> 12) * 64 + (ch >> 4)) * SEQ + (row & 4095)) * 16 + (ch & 15); }
__device__ __forceinline__ float log1p_01(float y) { const float ser = y * (1.0f - y * (0.5f - y * (0.33333334f - y * 0.25f))); return y < 0.03125f ? ser : __logf(1.0f + y); }
__device__ __forceinline__ float bflo(unsigned w) { return __uint_as_float(w << 16); }
__device__ __forceinline__ float bfhi(unsigned w) { return __uint_as_float(w & 0xFFFF0000u); }

__device__ __forceinline__ int opaque_tid() { int t = threadIdx.x; asm volatile("" : "+v"(t)); return t; }

__device__ __forceinline__ int wave_sum_i32(int v) {
    v += __builtin_amdgcn_update_dpp(0, v, 0xB1, 0xF, 0xF, true);
    v += __builtin_amdgcn_update_dpp(0, v, 0x4E, 0xF, 0xF, true);
    v += __builtin_amdgcn_update_dpp(0, v, 0x141, 0xF, 0xF, true);
    v += __builtin_amdgcn_update_dpp(0, v, 0x140, 0xF, 0xF, true);
    return __builtin_amdgcn_readlane(v, 0) + __builtin_amdgcn_readlane(v, 16) + __builtin_amdgcn_readlane(v, 32) + __builtin_amdgcn_readlane(v, 48);
}

__device__ __forceinline__ float wave_max_f32(float v) {
    v = fmaxf(v, __uint_as_float((unsigned)__builtin_amdgcn_update_dpp(0, (int)__float_as_uint(v), 0xB1, 0xF, 0xF, true)));
    v = fmaxf(v, __uint_as_float((unsigned)__builtin_amdgcn_update_dpp(0, (int)__float_as_uint(v), 0x4E, 0xF, 0xF, true)));
    v = fmaxf(v, __uint_as_float((unsigned)__builtin_amdgcn_update_dpp(0, (int)__float_as_uint(v), 0x141, 0xF, 0xF, true)));
    v = fmaxf(v, __uint_as_float((unsigned)__builtin_amdgcn_update_dpp(0, (int)__float_as_uint(v), 0x140, 0xF, 0xF, true)));
    const float a = __uint_as_float((unsigned)__builtin_amdgcn_readlane((int)__float_as_uint(v), 0)), b = __uint_as_float((unsigned)__builtin_amdgcn_readlane((int)__float_as_uint(v), 16));
    const float c = __uint_as_float((unsigned)__builtin_amdgcn_readlane((int)__float_as_uint(v), 32)), d = __uint_as_float((unsigned)__builtin_amdgcn_readlane((int)__float_as_uint(v), 48));
    return fmaxf(fmaxf(a, b), fmaxf(c, d));
}
__device__ __forceinline__ int wave_prefix_sum_i32(int v) {
    v += __builtin_amdgcn_update_dpp(0, v, 0x111, 0xF, 0xF, true);
    v += __builtin_amdgcn_update_dpp(0, v, 0x112, 0xF, 0xF, true);
    v += __builtin_amdgcn_update_dpp(0, v, 0x114, 0xF, 0xF, true);
    v += __builtin_amdgcn_update_dpp(0, v, 0x118, 0xF, 0xF, true);
    v += __builtin_amdgcn_update_dpp(0, v, 0x142, 0xA, 0xF, false);
    v += __builtin_amdgcn_update_dpp(0, v, 0x143, 0xC, 0xF, false);
    return v;
}

#define XB_TMO      128
#define XB_XCNT(j)  (256  + 64 * (j))
#define XB_XSUB(j)  (1280 + 64 * (j))
#define XB_XGEN(j)  (2304 + 64 * (j))
#define XB_TOP      3328
#define XB_TOPGEN   3392
#define XCD_BAR_WORDS 3456
#define XB_SPIN_CAP (1u << 18)

__device__ __forceinline__ unsigned xb_ld(unsigned* p)              { return __hip_atomic_load(p, __ATOMIC_RELAXED, __HIP_MEMORY_SCOPE_AGENT); }
__device__ __forceinline__ unsigned xb_add(unsigned* p, unsigned v) { return __hip_atomic_fetch_add(p, v, __ATOMIC_RELAXED, __HIP_MEMORY_SCOPE_AGENT); }
__device__ __forceinline__ unsigned xb_xcc_id() { return (unsigned)__builtin_amdgcn_s_getreg((3 << 11) | 20) & 0xFu; }
#define XB_SPIN(cond, bar) do { unsigned _sp = 0; while (cond) { __builtin_amdgcn_s_sleep(1); \
    if ((++_sp & 255u) == 0u) { if (xb_ld(&(bar)[XB_TMO])) break; if (_sp > XB_SPIN_CAP) { atomicAdd(&(bar)[XB_TMO], 1u); break; } } } } while (0)

struct XcdBarrier { unsigned* bar; unsigned x; volatile LAS unsigned* st; };

__device__ __forceinline__ XcdBarrier xcd_barrier_post(unsigned* bar, volatile LAS unsigned* st) {
    XcdBarrier b; b.bar = bar; b.x = xb_xcc_id(); b.st = st;
    if (threadIdx.x == 0) (void)xb_add(&bar[XB_XCNT(b.x)], 1u);
    return b;
}
__device__ __forceinline__ void xcd_barrier_complete(unsigned* bar, unsigned x, unsigned& nloc, unsigned& nx) {
    const unsigned G = gridDim.x * gridDim.y * gridDim.z;
    unsigned sum, cnt, mine, sp = 0u;
    for (;;) {
        sum = 0u; cnt = 0u; mine = 0u;
#pragma unroll
        for (unsigned j = 0; j < 16; ++j) { const unsigned c = xb_ld(&bar[XB_XCNT(j)]); sum += c; cnt += (c > 0u) ? 1u : 0u; mine = (j == x) ? c : mine; }
        if (sum == G) break;
        __builtin_amdgcn_s_sleep(1);
        if ((++sp & 255u) == 0u) { if (xb_ld(&bar[XB_TMO])) break; if (sp > XB_SPIN_CAP) { atomicAdd(&bar[XB_TMO], 1u); break; } }
    }
    nloc = mine > 0u ? mine : 1u; nx = cnt > 0u ? cnt : 1u;
}
__device__ __forceinline__ void xcd_barrier(const XcdBarrier& b) {
    asm volatile("s_waitcnt vmcnt(0)" ::: "memory");
    __syncthreads();
    if (threadIdx.x == 0) {
        unsigned* bar = b.bar;
        __builtin_amdgcn_s_waitcnt(0);
        unsigned nloc = b.st[0], nx = b.st[1];
        if (nloc == 0u) { xcd_barrier_complete(bar, b.x, nloc, nx); b.st[0] = nloc; b.st[1] = nx; }
        const unsigned old = xb_add(&bar[XB_XSUB(b.x)], 1u);
        const unsigned gen = old / nloc;
        if (old + 1u == (gen + 1u) * nloc) {
            __builtin_amdgcn_fence(__ATOMIC_RELEASE, "agent");
            asm volatile("s_waitcnt vmcnt(0)" ::: "memory");
            const unsigned og = xb_add(&bar[XB_TOP], 1u);
            const unsigned tg = og / nx;
            if (og + 1u == (tg + 1u) * nx) xb_add(&bar[XB_TOPGEN], 1u);
            else XB_SPIN(xb_ld(&bar[XB_TOPGEN]) == tg, bar);
            __builtin_amdgcn_fence(__ATOMIC_ACQUIRE, "agent");
            xb_add(&bar[XB_XGEN(b.x)], 1u);
            asm volatile("s_waitcnt vmcnt(0)" ::: "memory");
        } else {
            XB_SPIN(xb_ld(&bar[XB_XGEN(b.x)]) == gen, bar);
            __builtin_amdgcn_fence(__ATOMIC_ACQUIRE, "agent");
            asm volatile("s_waitcnt vmcnt(0)" ::: "memory");
        }
    }
    __syncthreads();
}

namespace pg8 {
constexpr int BM = 256, BK = 64, HALF = 128, HTB = HALF * BK * 2, STAGE_BYTES = 8 * HTB, NXCD = 8, WGM = 8;
__host__ __device__ __forceinline__ int lds_byte(int r, int c) { const int st = (r >> 4) * 2 + (c >> 5), rr = r & 15, cc = c & 31, ob = rr * 64 + cc * 2; return st * 1024 + (ob ^ (((ob >> 9) & 1) << 5)); }
__host__ __device__ __forceinline__ void stage_rc(int b, int& R, int& C) { const int st = b / 1024, sb = b % 1024, swz = sb ^ (((sb >> 9) & 1) << 5); R = (st >> 1) * 16 + swz / 64; C = (st & 1) * 32 + (swz % 64) / 2; }
__host__ __device__ __forceinline__ int perm32(int rho) { const int n = rho >> 4, i = rho & 15; return 8 * (i >> 2) + 4 * n + (i & 3); }

struct Unit { int pm, pn; };
struct Gemm { const bf16_t* A; const bf16_t* Bt; int M, N, K, lda, a_div, a_step; };

struct StaticOrder {
    int nM, nN, nwg, G, c;
    __host__ __device__ void init(int M, int N, int G_, int c_) { nM = M / BM; nN = N / BM; nwg = nM * nN; G = G_; c = c_; }
    __host__ __device__ bool next(int i, Unit& u) const {
        const long L = (long)i * G + c; if (L >= nwg) return false;
        int wgid = (int)L; { const int q = nwg / NXCD, r = nwg % NXCD, xcd = wgid % NXCD, off = wgid / NXCD; wgid = (xcd < r ? xcd * (q + 1) : r * (q + 1) + (xcd - r) * q) + off; }
        const int nig = WGM * nN, gid = wgid / nig, fm = gid * WGM, gsz = (nM - fm) < WGM ? (nM - fm) : WGM;
        u.pm = fm + ((wgid % nig) % gsz); u.pn = (wgid % nig) / gsz; return true;
    }
};

template <class Epi>
__device__ __forceinline__ void gemm_phase(LAS unsigned char* lds, const Gemm g, const StaticOrder& S, const Epi& E) {
    const int tid = opaque_tid(), wid = __builtin_amdgcn_readfirstlane(tid >> 6), lane = tid & 63, wr = wid >> 2, wc = wid & 3, fr = lane & 15, fq = lane >> 4;
    const int K = g.K, nt = K / BK, lda = g.lda;
    unsigned voffA[2], voffB[2];
#pragma unroll
    for (int i = 0; i < 2; ++i) { int R, C; stage_rc(tid * 16 + i * 8192, R, C); const int Rb = Epi::PERM ? ((R & ~31) + perm32(R & 31)) : R;
        voffA[i] = (unsigned)(R * lda + C) * 2u; voffB[i] = (unsigned)(Rb * K + C) * 2u; }
    const size_t kstep = (size_t)(BK * 2);
    const size_t hstepA = (size_t)HALF * lda * 2, hstepB = (size_t)HALF * K * 2;
    const size_t tstepA = 2 * hstepA, tstepB = 2 * hstepB;
    const unsigned ldsw = (unsigned)wid * 1024u;
    const int aoff = lds_byte(wr * 64 + fr, fq * 8), boff = lds_byte(wc * 32 + fr, fq * 8);
#define PG8_SA(b, h) (((b) * 2 + (h)) * HTB)
#define PG8_SB(b, h) ((4 + (b) * 2 + (h)) * HTB)
#define PG8_STAGE(bufoff, gbase, voff) do { _Pragma("unroll") for (int _i = 0; _i < 2; ++_i) \
        __builtin_amdgcn_global_load_lds((const unsigned*)((const char*)(gbase) + (voff)[_i]), (LAS unsigned*)(lds + (bufoff) + ldsw + _i * 8192), 16, 0, 0); } while (0)
#define PG8_LDA(dst, b, h) do { _Pragma("unroll") for (int m = 0; m < 4; ++m) _Pragma("unroll") for (int k = 0; k < 2; ++k) dst[m][k] = *(const LAS bf16x8*)(lds + PG8_SA(b, h) + aoff + m * 2048 + k * 1024); } while (0)
#define PG8_LDB(dst, b, h) do { _Pragma("unroll") for (int n = 0; n < 2; ++n) _Pragma("unroll") for (int k = 0; k < 2; ++k) dst[n][k] = *(const LAS bf16x8*)(lds + PG8_SB(b, h) + boff + n * 2048 + k * 1024); } while (0)
#define PG8_MMA(ai, bj, At, Bt) do { __builtin_amdgcn_s_setprio(1); _Pragma("unroll") for (int m = 0; m < 4; ++m) _Pragma("unroll") for (int n = 0; n < 2; ++n) _Pragma("unroll") for (int k = 0; k < 2; ++k) \
        acc[ai][bj][m][n] = __builtin_amdgcn_mfma_f32_16x16x32_bf16(Bt[n][k], At[m][k], acc[ai][bj][m][n], 0, 0, 0); __builtin_amdgcn_s_setprio(0); } while (0)
#define PG8_WAIT_V(n) asm volatile("s_waitcnt vmcnt(" #n ")" ::: "memory")
#define PG8_WAIT_L(n) asm volatile("s_waitcnt lgkmcnt(" #n ")" ::: "memory")
#define PG8_BAR __builtin_amdgcn_s_barrier()
#define PG8_SCHED __builtin_amdgcn_sched_barrier(0)
    Unit cur, nxt; int ui = 0;
    if (!S.next(0, cur)) return;
    f32x4 acc[2][2][4][2];
#pragma unroll
    for (int a = 0; a < 2; ++a)
#pragma unroll
        for (int b = 0; b < 2; ++b)
#pragma unroll
            for (int m = 0; m < 4; ++m)
#pragma unroll
                for (int n = 0; n < 2; ++n) acc[a][b][m][n] = (f32x4){0.f, 0.f, 0.f, 0.f};
    bf16x8 At[4][2], B0[2][2], B1[2][2];
    const char* cA = (const char*)g.A + (size_t)cur.pm * tstepA + (size_t)(cur.pn / g.a_div) * g.a_step; const char* cB = (const char*)g.Bt + (size_t)cur.pn * tstepB;
    PG8_STAGE(PG8_SB(0, 0), cB, voffB); PG8_STAGE(PG8_SA(0, 0), cA, voffA); PG8_STAGE(PG8_SB(0, 1), cB + hstepB, voffB); PG8_STAGE(PG8_SA(0, 1), cA + hstepA, voffA);
    if (wr == 1) PG8_BAR;
    PG8_WAIT_V(4); PG8_BAR;
    PG8_STAGE(PG8_SB(1, 0), cB + kstep, voffB); PG8_STAGE(PG8_SA(1, 0), cA + kstep, voffA); PG8_STAGE(PG8_SB(1, 1), cB + hstepB + kstep, voffB);
    PG8_WAIT_V(6); PG8_BAR;
    for (;;) {
        const bool has_next = S.next(ui + 1, nxt);
        const char* nA = has_next ? (const char*)g.A + (size_t)nxt.pm * tstepA + (size_t)(nxt.pn / g.a_div) * g.a_step : cA; const char* nB = has_next ? (const char*)g.Bt + (size_t)nxt.pn * tstepB : cB;
        for (int t = 0; t < nt; t += 2) {
            const bool last = (t == nt - 2);
            const char* a1 = cA + (size_t)(t + 1) * kstep;
            const char* a2 = last ? nA : cA + (size_t)(t + 2) * kstep; const char* b2 = last ? nB : cB + (size_t)(t + 2) * kstep;
            const char* a3 = a2 + kstep; const char* b3 = b2 + kstep;
            PG8_LDB(B0, 0, 0); PG8_SCHED; PG8_LDA(At, 0, 0); PG8_STAGE(PG8_SA(1, 1), a1 + hstepA, voffA);
            PG8_WAIT_L(8); PG8_BAR; PG8_WAIT_L(0); PG8_MMA(0, 0, At, B0); PG8_BAR; PG8_SCHED;
            PG8_LDB(B1, 0, 1); PG8_STAGE(PG8_SB(0, 0), b2, voffB);
            PG8_BAR; PG8_WAIT_L(0); PG8_MMA(0, 1, At, B1); PG8_BAR;
            PG8_LDA(At, 0, 1); PG8_STAGE(PG8_SA(0, 0), a2, voffA);
            PG8_BAR; PG8_WAIT_L(0); PG8_MMA(1, 0, At, B0); PG8_BAR; PG8_SCHED;
            PG8_STAGE(PG8_SB(0, 1), b2 + hstepB, voffB);
            PG8_WAIT_V(6); PG8_BAR; PG8_MMA(1, 1, At, B1); PG8_BAR;
            PG8_LDB(B0, 1, 0); PG8_SCHED; PG8_LDA(At, 1, 0); PG8_STAGE(PG8_SA(0, 1), a2 + hstepA, voffA);
            PG8_WAIT_L(8); PG8_BAR; PG8_WAIT_L(0); PG8_MMA(0, 0, At, B0); PG8_BAR; PG8_SCHED;
            PG8_LDB(B1, 1, 1); PG8_STAGE(PG8_SB(1, 0), b3, voffB);
            PG8_BAR; PG8_WAIT_L(0); PG8_MMA(0, 1, At, B1); PG8_BAR;
            PG8_LDA(At, 1, 1); PG8_STAGE(PG8_SA(1, 0), a3, voffA);
            PG8_BAR; PG8_WAIT_L(0); PG8_MMA(1, 0, At, B0); PG8_BAR; PG8_SCHED;
            PG8_STAGE(PG8_SB(1, 1), b3 + hstepB, voffB);
            PG8_WAIT_V(6); PG8_BAR; PG8_MMA(1, 1, At, B1); PG8_BAR;
        }
        E(acc, cur, wr, wc, fr, fq);
        if (!has_next) break;
#pragma unroll
        for (int a = 0; a < 2; ++a)
#pragma unroll
            for (int b = 0; b < 2; ++b)
#pragma unroll
                for (int m = 0; m < 4; ++m)
#pragma unroll
                    for (int n = 0; n < 2; ++n) acc[a][b][m][n] = (f32x4){0.f, 0.f, 0.f, 0.f};
        cur = nxt; cA = nA; cB = nB; ++ui;
    }
    PG8_WAIT_V(0);
    if (wr == 0) PG8_BAR;
    PG8_BAR;
#undef PG8_SA
#undef PG8_SB
#undef PG8_STAGE
#undef PG8_LDA
#undef PG8_LDB
#undef PG8_MMA
#undef PG8_WAIT_V
#undef PG8_WAIT_L
#undef PG8_BAR
#undef PG8_SCHED
}
}

struct EpiMix {
    static constexpr bool PERM = true;
    bf16_t* C;
    __device__ __forceinline__ void operator()(const f32x4 (&acc)[2][2][4][2], const pg8::Unit& u, int wr, int wc, int fr, int fq) const {
#pragma unroll
        for (int ai = 0; ai < 2; ++ai)
#pragma unroll
            for (int m = 0; m < 4; ++m) { const int row = u.pm * 256 + ai * 128 + wr * 64 + m * 16 + fr;
#pragma unroll
                for (int bj = 0; bj < 2; ++bj) { const f32x4 v0 = acc[ai][bj][m][0], v1 = acc[ai][bj][m][1];
                    u32x4 w; w.x = cvt_pk_bf16(v0[0], v0[1]); w.y = cvt_pk_bf16(v0[2], v0[3]); w.z = cvt_pk_bf16(v1[0], v1[1]); w.w = cvt_pk_bf16(v1[2], v1[3]);
                    *(u32x4*)(C + (size_t)row * 1024 + u.pn * 256 + bj * 128 + wc * 32 + 8 * fq) = w; } }
    }
};

constexpr float LOG2E_F = 1.4426950408889634f;
constexpr float IW_SCALE = 0.35355339059327373f * 0.125f;

struct EpiEvenIn {
    static constexpr bool PERM = true;
    bf16_t *Q, *Kb, *VT, *AG, *IQ, *BQ, *BK, *BV, *BG, *IK; float *IW, *BLR;
    __device__ __forceinline__ void operator()(const f32x4 (&acc)[2][2][4][2], const pg8::Unit& u, int wr, int wc, int fr, int fq) const {
        const int pn = u.pn;
        bf16_t* dst = Q; int ld = 512, col0 = 0, mode = 0;
        if (pn < 2) { dst = Q; col0 = pn * 256; }
        else if (pn < 4) { dst = Kb; col0 = (pn - 2) * 256; }
        else if (pn < 6) { mode = 2; col0 = (pn - 4) * 256; }
        else if (pn < 8) { dst = AG; col0 = (pn - 6) * 256; mode = 1; }
        else if (pn < 10) { dst = IQ; col0 = (pn - 8) * 256; }
        else if (pn == 10) { dst = BQ; ld = 256; }
        else if (pn == 11) { dst = BK; ld = 256; }
        else if (pn < 14) { dst = BV; col0 = (pn - 12) * 256; }
        else if (pn < 16) { dst = BG; col0 = (pn - 14) * 256; mode = 1; }
        else mode = 3;
#pragma unroll
        for (int ai = 0; ai < 2; ++ai)
#pragma unroll
            for (int m = 0; m < 4; ++m) {
                const int row = u.pm * 256 + ai * 128 + wr * 64 + m * 16 + fr;
#pragma unroll
                for (int bj = 0; bj < 2; ++bj) {
                    const int cb = bj * 128 + wc * 32 + 8 * fq;
                    f32x4 v0 = acc[ai][bj][m][0], v1 = acc[ai][bj][m][1];
                    if (mode <= 1) {
                        if (mode == 1) {
#pragma unroll
                            for (int j = 0; j < 4; ++j) { v0[j] = silu_f(v0[j]); v1[j] = silu_f(v1[j]); }
                        }
                        u32x4 w; w.x = cvt_pk_bf16(v0[0], v0[1]); w.y = cvt_pk_bf16(v0[2], v0[3]); w.z = cvt_pk_bf16(v1[0], v1[1]); w.w = cvt_pk_bf16(v1[2], v1[3]);
                        *(u32x4*)(dst + (size_t)row * ld + col0 + cb) = w;
                    } else if (mode == 2) {
                        const int c = col0 + cb, head = c >> 6, d = c & 63, b = row >> 12, s = row & 4095;
                        bf16_t* p = VT + ((size_t)(b * 8 + head) * 64 + d) * 4096 + s;
#pragma unroll
                        for (int j = 0; j < 4; ++j) { p[(size_t)j * 4096] = f2bf(v0[j]); p[(size_t)(j + 4) * 4096] = f2bf(v1[j]); }
                    } else {
                        if (cb < 64) {
                            u32x4 w; w.x = cvt_pk_bf16(v0[0], v0[1]); w.y = cvt_pk_bf16(v0[2], v0[3]); w.z = cvt_pk_bf16(v1[0], v1[1]); w.w = cvt_pk_bf16(v1[2], v1[3]);
                            const int q = cb >> 3, bb = row >> 12, sq = row & 4095;
                            *(u32x4*)(IK + ((((size_t)(bb * 128 + (sq >> 5)) * 4 + (q >> 1)) * 2 + (q & 1)) * 32 + (sq & 31)) * 8) = w;
                        } else if (cb == 64) {
                            *(f32x4*)(IW + (size_t)row * 8) = v0 * IW_SCALE; *(f32x4*)(IW + (size_t)row * 8 + 4) = v1 * IW_SCALE;
                        } else if (cb == 72 || cb == 80) {
                            *(f32x4*)(BLR + (size_t)row * 16 + (cb - 72)) = v0; *(f32x4*)(BLR + (size_t)row * 16 + (cb - 72) + 4) = v1;
                        }
                    }
                }
            }
    }
};

struct EpiOddIn {
    static constexpr bool PERM = true;
    bf16_t *XR, *GS;
    __device__ __forceinline__ void operator()(const f32x4 (&acc)[2][2][4][2], const pg8::Unit& u, int wr, int wc, int fr, int fq) const {
        const int pn = u.pn; const bool gate = pn >= 4;
        bf16_t* dst = gate ? GS : XR; const int col0 = (pn & 3) * 256;
#pragma unroll
        for (int ai = 0; ai < 2; ++ai)
#pragma unroll
            for (int m = 0; m < 4; ++m) {
                const int row = u.pm * 256 + ai * 128 + wr * 64 + m * 16 + fr;
#pragma unroll
                for (int bj = 0; bj < 2; ++bj) {
                    const int cb = bj * 128 + wc * 32 + 8 * fq;
                    f32x4 v0 = acc[ai][bj][m][0], v1 = acc[ai][bj][m][1];
                    if (gate) {
#pragma unroll
                        for (int j = 0; j < 4; ++j) { v0[j] = silu_f(v0[j]); v1[j] = silu_f(v1[j]); }
                    }
                    u32x4 w; w.x = cvt_pk_bf16(v0[0], v0[1]); w.y = cvt_pk_bf16(v0[2], v0[3]); w.z = cvt_pk_bf16(v1[0], v1[1]); w.w = cvt_pk_bf16(v1[2], v1[3]);
                    if (gate) *(u32x4*)(GS + slab_idx(row, col0 + cb)) = w;
                    else *(u32x4*)(XR + (size_t)row * 1024 + col0 + cb) = w;
                }
            }
    }
};

struct EpiGates {
    static constexpr bool PERM = true;
    const float *b_a, *b_x, *lam; const bf16_t* XC; bf16_t* LOGA; bf16_t* U;
    __device__ __forceinline__ void operator()(const f32x4 (&acc)[2][2][4][2], const pg8::Unit& u, int wr, int wc, int fr, int fq) const {
        const int chb = (u.pn >> 1) * 256 + (u.pn & 1) * 128 + wc * 32 + 8 * fq;
#pragma unroll
        for (int nh = 0; nh < 2; ++nh) {
            const int ch0 = chb + 4 * nh;
            const f32x4 lm = *(const f32x4*)(lam + ch0);
            const f32x4 nba = *(const f32x4*)(b_a + ch0) * (-LOG2E_F), nbx = *(const f32x4*)(b_x + ch0) * (-LOG2E_F);
            f32x4 c8;
#pragma unroll
            for (int j = 0; j < 4; ++j) c8[j] = (-8.0f * LOG2E_F) * (fmaxf(-lm[j], 0.f) + log1p_01(__expf(-fabsf(lm[j]))));
#pragma unroll
            for (int ai = 0; ai < 2; ++ai)
#pragma unroll
                for (int m = 0; m < 4; ++m) {
                    const int row = u.pm * 256 + ai * 128 + wr * 64 + m * 16 + fr;
                    const u32x2 xw = *(const u32x2*)(XC + (size_t)row * 1024 + ch0);
                    const float xv[4] = {bflo(xw.x), bfhi(xw.x), bflo(xw.y), bfhi(xw.y)};
                    f32x4 la; float uu[4];
#pragma unroll
                    for (int j = 0; j < 4; ++j) {
                        const float r = __builtin_amdgcn_rcpf(1.0f + __builtin_amdgcn_exp2f(__builtin_fmaf(acc[ai][0][m][nh][j], -LOG2E_F, nba[j])));
                        const float ig = __builtin_amdgcn_rcpf(1.0f + __builtin_amdgcn_exp2f(__builtin_fmaf(acc[ai][1][m][nh][j], -LOG2E_F, nbx[j])));
                        const float l2 = c8[j] * r, av = __builtin_amdgcn_exp2f(l2);
                        la[j] = l2;
                        uu[j] = __builtin_amdgcn_sqrtf(fmaxf(__builtin_fmaf(-av, av, 1.0f), 0.f)) * ig * xv[j];
                    }
                    { u32x2 lw; lw.x = cvt_pk_bf16(la[0], la[1]); lw.y = cvt_pk_bf16(la[2], la[3]); *(u32x2*)(LOGA + slab_idx(row, ch0)) = lw; }
                    u32x2 w; w.x = cvt_pk_bf16(uu[0], uu[1]); w.y = cvt_pk_bf16(uu[2], uu[3]);
                    *(u32x2*)(U + slab_idx(row, ch0)) = w;
                }
        }
    }
};

struct Args {
    const float* x; const float* rel_bias; const float* pre_norm; const float* post_norm;
    const float* even_w_in; const float* even_gate_w2; const float* even_gate_b2; const float* even_w_out;
    const float* odd_w_in; const float* odd_conv_w; const float* odd_conv_b; const float* odd_w_a; const float* odd_b_a;
    const float* odd_w_x; const float* odd_b_x; const float* odd_lambda; const float* odd_w_out;
    float* out; unsigned char* ws; int ph_lo, ph_hi;
};

typedef const Args __attribute__((address_space(4)))* ArgsP;
__device__ __forceinline__ ArgsP get_args() { ArgsP p = (ArgsP)__builtin_amdgcn_kernarg_segment_ptr(); asm volatile("" : "+s"(p)); return p; }

constexpr int WT_EIN = 2 * 68 * 16, WT_EOUT = 2 * 256, WT_OIN = 2 * 512, WT_OOUT = 2 * 256, WT_GATE = 2 * 128, WT_ALL = WT_EIN + WT_EOUT + WT_OIN + WT_OOUT + WT_GATE;
__device__ __forceinline__ void wtile_decode(int T, ArgsP ap, unsigned char* ws, int nl, int wn, const float*& colp, int& ld, bf16_t*& drow, int& K, const float*& ksc) {
    ksc = nullptr;
    if (T < WT_EIN) { const int e = T / 1088, r = T % 1088, tn = r % 68, tk = r / 68; K = 1024; ld = EVEN_IN;
        const int n = tn * 64 + nl; int c; bool ok = true; if (n < 2560) c = n; else if (n < 4096) c = n + 72; else if (n < 4168) c = n - 1536; else if (n < 4184) c = n; else { c = 0; ok = false; }
        ksc = ap->pre_norm + (size_t)(2 * e) * DM + tk * 64;
        colp = ok ? ap->even_w_in + ((size_t)e * 1024 + tk * 64) * EVEN_IN + c : nullptr;
        drow = (bf16_t*)(ws + WS_WEIN) + ((size_t)e * NE + tn * 64 + wn) * 1024 + tk * 64; return; }
    T -= WT_EIN;
    if (T < WT_EOUT) { const int e = T / 256, r = T % 256, tn = r % 16, tk = r / 16; K = 1024; ld = 1024;
        colp = ap->even_w_out + ((size_t)e * 1024 + tk * 64) * 1024 + tn * 64 + nl; drow = (bf16_t*)(ws + WS_WEOUT) + ((size_t)e * 1024 + tn * 64 + wn) * 1024 + tk * 64; return; }
    T -= WT_EOUT;
    if (T < WT_OIN) { const int e = T / 512, r = T % 512, tn = r % 32, tk = r / 32; K = 1024; ld = 2048;
        ksc = ap->pre_norm + (size_t)(2 * e + 1) * DM + tk * 64;
        colp = ap->odd_w_in + ((size_t)e * 1024 + tk * 64) * 2048 + tn * 64 + nl; drow = (bf16_t*)(ws + WS_WOIN) + ((size_t)e * 2048 + tn * 64 + wn) * 1024 + tk * 64; return; }
    T -= WT_OIN;
    if (T < WT_OOUT) { const int e = T / 256, r = T % 256, tn = r % 16, tk = r / 16; K = 1024; ld = 1024;
        colp = ap->odd_w_out + ((size_t)e * 1024 + tk * 64) * 1024 + tn * 64 + nl; drow = (bf16_t*)(ws + WS_WOOUT) + ((size_t)e * 1024 + tn * 64 + wn) * 1024 + tk * 64; return; }
    T -= WT_OOUT;
    {
        const int o = T / 128, r = T % 128, tn = r % 32, tk = r / 32; K = 256; ld = 256;
        const int cp = tn * 64, nb = cp >> 9, j = (cp >> 8) & 1, gs = (cp >> 7) & 1, e0 = j * 128 + (cp & 127);
        const float* src = gs ? ap->odd_w_x : ap->odd_w_a;
        colp = src + (((size_t)(o * 4 + nb)) * 256 + tk * 64) * 256 + e0 + nl; drow = (bf16_t*)(ws + WS_WOG) + ((size_t)o * 2048 + cp + wn) * 256 + tk * 64; }
}
__device__ __forceinline__ void weight_phase(LAS float* tile, ArgsP ap, unsigned char* ws) {
    const int tid = opaque_tid(), G = gridDim.x, nl = tid & 63, k0 = tid >> 6, wn = tid >> 3, wk = (tid & 7) * 8;
    float r[8]; const float* colp; const float* ksc; bf16_t* drow; int ld, K;
#define WT_LOAD() do { _Pragma("unroll") for (int i = 0; i < 8; ++i) r[i] = colp ? colp[(size_t)(k0 + 8 * i) * ld] * (ksc ? ksc[k0 + 8 * i] : 1.0f) : 0.f; } while (0)
    int T = blockIdx.x;
    if (T < WT_ALL) { wtile_decode(T, ap, ws, nl, wn, colp, ld, drow, K, ksc); WT_LOAD(); }
    for (; T < WT_ALL; T += G) {
        bf16_t* dcur = drow;
#pragma unroll
        for (int i = 0; i < 8; ++i) tile[(k0 + 8 * i) * 65 + nl] = r[i];
        __syncthreads();
        if (T + G < WT_ALL) { wtile_decode(T + G, ap, ws, nl, wn, colp, ld, drow, K, ksc); WT_LOAD(); }
        float v[8];
#pragma unroll
        for (int j = 0; j < 8; ++j) v[j] = tile[(wk + j) * 65 + wn];
        u32x4 w; w.x = cvt_pk_bf16(v[0], v[1]); w.y = cvt_pk_bf16(v[2], v[3]); w.z = cvt_pk_bf16(v[4], v[5]); w.w = cvt_pk_bf16(v[6], v[7]);
        *(u32x4*)(dcur + wk) = w;
        __syncthreads();
    }
#undef WT_LOAD
}

__device__ __forceinline__ int t5_bucket(int n) {
    if (n < 16) return n;
    int v = 16 + (int)(__logf((float)n / 16.0f) / 2.0794415416798357f * 16.0f);
    return v < 31 ? v : 31;
}

__device__ __forceinline__ void norm_phase(const float* xin, const bf16_t* xh_in, const float* s_in, const bf16_t* mix, const float* postw, bf16_t* xh_out, float* s_out, float* outf) {
    const int tid0 = opaque_tid(), lane = tid0 & 63, wave = tid0 >> 6;
    for (int row = blockIdx.x * 8 + wave; row < T; row += gridDim.x * 8) {
        f32x4 xv[4];
        if (xin) {
#pragma unroll
            for (int i = 0; i < 4; ++i) xv[i] = *(const f32x4*)(xin + (size_t)row * DM + lane * 4 + 256 * i);
        } else {
            const float sc = s_in[row];
#pragma unroll
            for (int i = 0; i < 4; ++i) { const u32x2 xw = *(const u32x2*)(xh_in + (size_t)row * DM + lane * 4 + 256 * i); xv[i] = (f32x4){bflo(xw.x), bfhi(xw.x), bflo(xw.y), bfhi(xw.y)} * sc; }
        }
        if (mix) {
            f32x4 mv[4]; float ss = 0.f;
#pragma unroll
            for (int i = 0; i < 4; ++i) { const u32x2 mw = *(const u32x2*)(mix + (size_t)row * DM + lane * 4 + 256 * i); mv[i] = (f32x4){bflo(mw.x), bfhi(mw.x), bflo(mw.y), bfhi(mw.y)};
                ss += mv[i][0] * mv[i][0] + mv[i][1] * mv[i][1] + mv[i][2] * mv[i][2] + mv[i][3] * mv[i][3]; }
#pragma unroll
            for (int o = 32; o >= 1; o >>= 1) ss += __shfl_xor(ss, o);
            const float r = rsqrtf(ss * (1.0f / DM) + EPS);
#pragma unroll
            for (int i = 0; i < 4; ++i) { const f32x4 w = *(const f32x4*)(postw + lane * 4 + 256 * i); xv[i] += mv[i] * r * w; }
        }
        if (outf) {
#pragma unroll
            for (int i = 0; i < 4; ++i) *(f32x4*)(outf + (size_t)row * DM + lane * 4 + 256 * i) = xv[i];
        } else {
            float ss = 0.f;
#pragma unroll
            for (int i = 0; i < 4; ++i) ss += xv[i][0] * xv[i][0] + xv[i][1] * xv[i][1] + xv[i][2] * xv[i][2] + xv[i][3] * xv[i][3];
#pragma unroll
            for (int o = 32; o >= 1; o >>= 1) ss += __shfl_xor(ss, o);
            const float ms = ss * (1.0f / DM) + EPS, r = rsqrtf(ms);
            if (lane == 0) s_out[row] = ms * r;
#pragma unroll
            for (int i = 0; i < 4; ++i) { const f32x4 y = xv[i] * r;
                u32x2 o2; o2.x = cvt_pk_bf16(y[0], y[1]); o2.y = cvt_pk_bf16(y[2], y[3]); *(u32x2*)(xh_out + (size_t)row * DM + lane * 4 + 256 * i) = o2; }
        }
    }
}

constexpr int NM_LD = 1032;
__device__ __forceinline__ void norm_misc_phase(LAS unsigned char* lds, const float* xin, const bf16_t* xh_in, const float* s_in, const bf16_t* mix, const float* postw, bf16_t* xh_out, float* s_out,
                                                const bf16_t* Wm  , bf16_t* IK, float* IW, float* BLR) {
    const int tid0 = opaque_tid(), lane = tid0 & 63, wave = __builtin_amdgcn_readfirstlane(tid0 >> 6);
    LAS bf16_t* xs = (LAS bf16_t*)lds;
    for (int pq = blockIdx.x; pq < T / 64; pq += gridDim.x) {
        for (int i = 0; i < 8; ++i) {
            const int rl = wave * 8 + i, row = pq * 64 + rl;
            f32x4 xv[4];
            if (xin) {
#pragma unroll
                for (int k = 0; k < 4; ++k) xv[k] = *(const f32x4*)(xin + (size_t)row * DM + lane * 4 + 256 * k);
            } else {
                const float sc = s_in[row];
#pragma unroll
                for (int k = 0; k < 4; ++k) { const u32x2 xw = *(const u32x2*)(xh_in + (size_t)row * DM + lane * 4 + 256 * k); xv[k] = (f32x4){bflo(xw.x), bfhi(xw.x), bflo(xw.y), bfhi(xw.y)} * sc; }
            }
            if (mix) {
                f32x4 mv[4]; float ss = 0.f;
#pragma unroll
                for (int k = 0; k < 4; ++k) { const u32x2 mw = *(const u32x2*)(mix + (size_t)row * DM + lane * 4 + 256 * k); mv[k] = (f32x4){bflo(mw.x), bfhi(mw.x), bflo(mw.y), bfhi(mw.y)};
                    ss += mv[k][0] * mv[k][0] + mv[k][1] * mv[k][1] + mv[k][2] * mv[k][2] + mv[k][3] * mv[k][3]; }
#pragma unroll
                for (int o = 32; o >= 1; o >>= 1) ss += __shfl_xor(ss, o);
                const float r = rsqrtf(ss * (1.0f / DM) + EPS);
#pragma unroll
                for (int k = 0; k < 4; ++k) { const f32x4 w = *(const f32x4*)(postw + lane * 4 + 256 * k); xv[k] += mv[k] * r * w; }
            }
            float ss = 0.f;
#pragma unroll
            for (int k = 0; k < 4; ++k) ss += xv[k][0] * xv[k][0] + xv[k][1] * xv[k][1] + xv[k][2] * xv[k][2] + xv[k][3] * xv[k][3];
#pragma unroll
            for (int o = 32; o >= 1; o >>= 1) ss += __shfl_xor(ss, o);
            const float ms = ss * (1.0f / DM) + EPS, r = rsqrtf(ms);
            if (lane == 0) s_out[row] = ms * r;
#pragma unroll
            for (int k = 0; k < 4; ++k) { const f32x4 y = xv[k] * r;
                u32x2 o2; o2.x = cvt_pk_bf16(y[0], y[1]); o2.y = cvt_pk_bf16(y[2], y[3]);
                *(u32x2*)(xh_out + (size_t)row * DM + lane * 4 + 256 * k) = o2; *(LAS u32x2*)(xs + rl * NM_LD + lane * 4 + 256 * k) = o2; }
        }
        __syncthreads();
        if (wave < 6) {
            const int n = lane & 15, kq = lane >> 4;
            f32x4 acc[4];
#pragma unroll
            for (int mt = 0; mt < 4; ++mt) acc[mt] = (f32x4){0.f, 0.f, 0.f, 0.f};
            const bf16_t* wrow = Wm + (size_t)(16 * wave + n) * 1024 + 8 * kq;
            for (int ks = 0; ks < 32; ks += 4) {
                bf16x8 bf[4];
#pragma unroll
                for (int u = 0; u < 4; ++u) bf[u] = *(const bf16x8*)(wrow + (ks + u) * 32);
#pragma unroll
                for (int u = 0; u < 4; ++u)
#pragma unroll
                    for (int mt = 0; mt < 4; ++mt) { const bf16x8 af = *(const LAS bf16x8*)(xs + (16 * mt + n) * NM_LD + (ks + u) * 32 + 8 * kq);
                        acc[mt] = __builtin_amdgcn_mfma_f32_16x16x32_bf16(af, bf[u], acc[mt], 0, 0, 0); }
            }
#pragma unroll
            for (int mt = 0; mt < 4; ++mt)
#pragma unroll
                for (int j = 0; j < 4; ++j) { const int row = pq * 64 + 16 * mt + 4 * kq + j; const float v = acc[mt][j];
                    if (wave < 4) { const int cc = 16 * wave + n, q = cc >> 3, bb = row >> 12, sq = row & 4095;
                        IK[((((size_t)(bb * 128 + (sq >> 5)) * 4 + (q >> 1)) * 2 + (q & 1)) * 32 + (sq & 31)) * 8 + (cc & 7)] = f2bf(v); }
                    else if (wave == 4) { if (n < 8) IW[(size_t)row * 8 + n] = v * IW_SCALE; else BLR[(size_t)row * 16 + (n - 8)] = v; }
                    else { if (n < 8) BLR[(size_t)row * 16 + 8 + n] = v; } }
        }
        __syncthreads();
    }
}

#define IDX_AF(AF, b_, t0_) do { \
        const int qi_ = 2 * ((c >> 2) & 1) + (c >> 4), hh_ = (c & 3) + 4 * ((c >> 3) & 1);   \
        _Pragma("unroll") for (int mt = 0; mt < 2; ++mt) { const size_t tq_ = (size_t)(b_) * SEQ + (t0_) + 4 * mt + qi_; \
            _Pragma("unroll") for (int ks = 0; ks < 4; ++ks) AF[mt][ks] = *(const bf16x8*)(IQ + tq_ * 512 + hh_ * 64 + ks * 16 + 8 * g); } } while (0)
#define IDX_WV(WV, b_, t0_) do { \
        _Pragma("unroll") for (int mt = 0; mt < 2; ++mt) _Pragma("unroll") for (int qq = 0; qq < 2; ++qq) { const size_t tq_ = (size_t)(b_) * SEQ + (t0_) + 4 * mt + 2 * g + qq; \
            const f32x4 w0_ = *(const f32x4*)(IW + tq_ * 8), w1_ = *(const f32x4*)(IW + tq_ * 8 + 4); \
            WV[mt][qq][0] = w0_[0]; WV[mt][qq][1] = w0_[1]; WV[mt][qq][2] = w0_[2]; WV[mt][qq][3] = w0_[3]; WV[mt][qq][4] = w1_[0]; WV[mt][qq][5] = w1_[1]; WV[mt][qq][6] = w1_[2]; WV[mt][qq][7] = w1_[3]; } } while (0)

__device__ __forceinline__ void indexer_phase(LAS float* sc, const bf16_t* IQ, const bf16_t* IK, const float* IW, u64* MASK, int wave, int lane) {
    const int g = lane >> 5, c = lane & 31, G = gridDim.x;
    bf16x8 af[2][4];
#define IDX_ITEM(k_) ((k_) * G + (((k_) & 1) ? (G - 1 - (int)blockIdx.x) : (int)blockIdx.x))
    { const int it0 = IDX_ITEM(0); if (it0 < 2048) IDX_AF(af, it0 & 3, (511 - (it0 >> 2)) * 8); }
        for (int kk = 0; kk * G < 2048; ++kk) {
    const int it = IDX_ITEM(kk); if (it >= 2048) break;
    const int b = it & 3, t0 = (511 - (it >> 2)) * 8;
    float wv[2][2][8];
    IDX_WV(wv, b, t0);
    const int ntiles = (t0 + 8 + 31) >> 5;
    const bf16_t* ikb = IK + (size_t)b * 128 * 2048 + (size_t)(g * 32 + c) * 8;
#define IDX_LOAD(buf, kt_) do { if ((kt_) < ntiles) { _Pragma("unroll") for (int ks = 0; ks < 4; ++ks) buf[ks] = *(const bf16x8*)(ikb + (size_t)(kt_) * 2048 + ks * 512); } } while (0)
#define IDX_TILE(buf, kt_) do { if ((kt_) < ntiles) { const int key = (kt_) * 32 + c; f32x16 a0, a1; \
        _Pragma("unroll") for (int r = 0; r < 16; ++r) { a0[r] = 0.f; a1[r] = 0.f; } \
        _Pragma("unroll") for (int ks = 0; ks < 4; ++ks) { a0 = __builtin_amdgcn_mfma_f32_32x32x16_bf16(af[0][ks], buf[ks], a0, 0, 0, 0); a1 = __builtin_amdgcn_mfma_f32_32x32x16_bf16(af[1][ks], buf[ks], a1, 0, 0, 0); } \
        _Pragma("unroll") for (int qq = 0; qq < 2; ++qq) { float s0 = 0.f, s1 = 0.f; \
            _Pragma("unroll") for (int h = 0; h < 8; ++h) { s0 += wv[0][qq][h] * fmaxf(a0[8 * qq + h], 0.f); s1 += wv[1][qq][h] * fmaxf(a1[8 * qq + h], 0.f); } \
            sc[(0 + 2 * g + qq) * 4096 + key] = s0; sc[(4 + 2 * g + qq) * 4096 + key] = s1; } } } while (0)
    {
        bf16x8 b0[4], b1[4], b2[4];
        IDX_LOAD(b0, wave); IDX_LOAD(b1, wave + 8);
        for (int kt = wave; kt < ntiles; kt += 24) {
            IDX_LOAD(b2, kt + 16); IDX_TILE(b0, kt);
            IDX_LOAD(b0, kt + 24); IDX_TILE(b1, kt + 8);
            IDX_LOAD(b1, kt + 32); IDX_TILE(b2, kt + 16);
        }
    }
#undef IDX_LOAD
#undef IDX_TILE
    __syncthreads();
    bf16x8 afn[2][4];
    { const int itn = IDX_ITEM(kk + 1); if ((kk + 1) * G < 2048 && itn < 2048) IDX_AF(afn, itn & 3, (511 - (itn >> 2)) * 8); }
    {
        const int t = t0 + wave, nvalid = t + 1, nreg = (nvalid + 63) >> 6, ngrp = (nreg + 7) >> 3;
        const int gfull = nvalid >> 9;
        LAS float* myrow = sc + wave * 4096;
        float sf[64];
#pragma unroll
        for (int jj = 0; jj < 8; ++jj) {
            if (jj < gfull) {
#pragma unroll
                for (int j8 = 0; j8 < 8; ++j8) sf[jj * 8 + j8] = myrow[64 * (jj * 8 + j8) + lane];
            } else if (jj < ngrp) {
#pragma unroll
                for (int j8 = 0; j8 < 8; ++j8) { const int j = jj * 8 + j8, kk = 64 * j + lane; const float v = myrow[kk]; sf[j] = (kk < nvalid) ? v : NEG_INF; }
            } else {
#pragma unroll
                for (int j8 = 0; j8 < 8; ++j8) sf[jj * 8 + j8] = NEG_INF;
            }
        }
        float thr_f = NEG_INF; int need = 0; bool ties = false;
#define CNT_GEF(valf, out) do { int c_ = 0; _Pragma("unroll") for (int jj = 0; jj < 8; ++jj) if (jj < ngrp) { _Pragma("unroll") for (int j8 = 0; j8 < 8; ++j8) c_ += (sf[jj * 8 + j8] >= (valf)) ? 1 : 0; } \
            (out) = wave_sum_i32(c_); } while (0)
        if (nvalid > 256) {
            float mx = NEG_INF, mn = -NEG_INF;
#pragma unroll
            for (int jj = 0; jj < 8; ++jj) { if (jj < gfull) {
#pragma unroll
                for (int j8 = 0; j8 < 8; ++j8) { const float v = sf[jj * 8 + j8]; mx = fmaxf(mx, v); mn = fminf(mn, v); } }
              else if (jj < ngrp) {
#pragma unroll
                for (int j8 = 0; j8 < 8; ++j8) { const float v = sf[jj * 8 + j8]; mx = fmaxf(mx, v); mn = fminf(mn, v == NEG_INF ? -NEG_INF : v); } } }
            mx = wave_max_f32(mx); mn = -wave_max_f32(-mn);
            const float scale = (mx > mn) ? 3839.0f / (mx - mn) : 0.f;
            LAS unsigned* hist = (LAS unsigned*)myrow;
#pragma unroll
            for (int k = 0; k < 16; ++k) *(LAS u32x4*)(hist + 4 * lane + 256 * k) = (u32x4){0u, 0u, 0u, 0u};
            __builtin_amdgcn_fence(__ATOMIC_RELEASE, "wavefront");
#pragma unroll
            for (int jj = 0; jj < 8; ++jj) { if (jj < gfull) {
#pragma unroll
                for (int j8 = 0; j8 < 8; ++j8) { const float v = sf[jj * 8 + j8];
                    int bn = (int)((v - mn) * scale); bn = bn > 3839 ? 3839 : bn; __hip_atomic_fetch_add(hist + (bn >> 6) * 68 + (bn & 63), 1u, __ATOMIC_RELAXED, __HIP_MEMORY_SCOPE_WAVEFRONT); } }
              else if (jj < ngrp) {
#pragma unroll
                for (int j8 = 0; j8 < 8; ++j8) { const float v = sf[jj * 8 + j8];
                    if (v != NEG_INF) { int bn = (int)((v - mn) * scale); bn = bn > 3839 ? 3839 : bn; __hip_atomic_fetch_add(hist + (bn >> 6) * 68 + (bn & 63), 1u, __ATOMIC_RELAXED, __HIP_MEMORY_SCOPE_WAVEFRONT); } } } }
            __builtin_amdgcn_fence(__ATOMIC_ACQ_REL, "wavefront");
            int cs = 0;
            if (lane < 60) {
#pragma unroll
                for (int k = 0; k < 16; ++k) { const u32x4 h4 = *(const LAS u32x4*)(hist + lane * 68 + 4 * k); cs += (int)((h4.x + h4.y) + (h4.z + h4.w)); }
            }
            int C, Bl, cnt_above, nA;
            {
                const int pre = wave_prefix_sum_i32(cs), tot = __builtin_amdgcn_readlane(pre, 63), suf = tot - pre + cs;
                const u64 mk = __ballot(suf >= 256);
                C = 63 - __builtin_clzll(mk);
                const int above_c = __builtin_amdgcn_readlane(suf, C) - __builtin_amdgcn_readlane(cs, C);
                const int bs = (int)hist[C * 68 + lane];
                const int pre2 = wave_prefix_sum_i32(bs), tot2 = __builtin_amdgcn_readlane(pre2, 63), suf2 = tot2 - pre2 + bs;
                const u64 mk2 = __ballot(suf2 >= 256 - above_c);
                Bl = 63 - __builtin_clzll(mk2);
                nA = __builtin_amdgcn_readlane(bs, Bl);
                cnt_above = above_c + __builtin_amdgcn_readlane(suf2, Bl) - nA;
            }
            const int binA = C * 64 + Bl, need1 = 256 - cnt_above;
            if (nA <= 64) {
                unsigned cv = 0u; int pos = 0;
                const float invs = (mx - mn) * (1.0f / 3839.0f), lo_f = mn + ((float)binA - 0.5f) * invs, hi_f = mn + ((float)binA + 1.5f) * invs;
#pragma unroll
                for (int jj = 0; jj < 8; ++jj) if (jj < ngrp) {
#pragma unroll
                    for (int j8 = 0; j8 < 8; ++j8) { const float v = sf[jj * 8 + j8];
                        u64 m = __ballot(v >= lo_f && v < hi_f);
                        if (m) { int bn = (int)((v - mn) * scale); bn = bn > 3839 ? 3839 : bn; m = __ballot(v >= lo_f && v < hi_f && bn == binA); }
                        while (m) { const int l = __builtin_ctzll(m); m &= m - 1ull; const unsigned uu = (unsigned)__builtin_amdgcn_readlane((int)__float_as_uint(v), l);
                            const unsigned kv = (uu & 0x80000000u) ? ~uu : (uu | 0x80000000u); if (lane == pos) cv = kv; ++pos; } } }
                unsigned tc = 0u;
                for (int bit = 31; bit >= 0; --bit) { const unsigned cand = tc | (1u << bit); if (__popcll(__ballot(cv >= cand)) >= need1) tc = cand; }
                thr_f = __uint_as_float((tc & 0x80000000u) ? (tc ^ 0x80000000u) : ~tc);
                const int cgt = cnt_above + __popcll(__ballot(cv > tc)), ceq = __popcll(__ballot(cv == tc));
                need = 256 - cgt; ties = (ceq != need);
            } else {
                unsigned tc = 0u;
                for (int bit = 31; bit >= 0; --bit) { const unsigned cand = tc | (1u << bit); const float cf = __uint_as_float((cand & 0x80000000u) ? (cand ^ 0x80000000u) : ~cand);
                    int cnt; CNT_GEF(cf, cnt); if (cnt >= 256) tc = cand; }
                thr_f = __uint_as_float((tc & 0x80000000u) ? (tc ^ 0x80000000u) : ~tc);
                int cge, cg = 0;
                CNT_GEF(thr_f, cge);
#pragma unroll
                for (int jj = 0; jj < 8; ++jj) if (jj < ngrp) {
#pragma unroll
                    for (int j8 = 0; j8 < 8; ++j8) cg += (sf[jj * 8 + j8] > thr_f) ? 1 : 0; }
                const int cgt = wave_sum_i32(cg);
                need = 256 - cgt; ties = ((cge - cgt) != need);
            }
        }
#undef CNT_GEF
        u64 myword = 0ull;
        if (nvalid <= 256) {
#pragma unroll
            for (int j = 0; j < 4; ++j) { const u64 mm = __ballot(64 * j + lane < nvalid); if (lane == j) myword = mm; }
        } else if (!ties) {
#pragma unroll
            for (int jj = 0; jj < 8; ++jj) if (jj < ngrp) {
#pragma unroll
                for (int j8 = 0; j8 < 8; ++j8) { const int j = jj * 8 + j8; const u64 mm = __ballot(sf[j] >= thr_f); if (lane == j) myword = mm; if ((j & 3) == 3) __builtin_amdgcn_sched_barrier(0); } }
        } else {
            int base = 0;
#pragma unroll
            for (int j = 0; j < 64; ++j) { const bool eq = sf[j] == thr_f; const u64 em = __ballot(eq);
                const int rank = base + (int)__builtin_amdgcn_mbcnt_hi((unsigned)(em >> 32), __builtin_amdgcn_mbcnt_lo((unsigned)em, 0u));
                const u64 mm = __ballot(sf[j] > thr_f || (eq && rank < need)); base += __popcll(em);
                if (lane == j) myword = mm; __builtin_amdgcn_sched_barrier(0); }
        }
        LAS u64* mst = (LAS u64*)(sc + 32768);
        mst[lane * 8 + wave] = myword;
    }
    __syncthreads();
    { const int tid_ = wave * 64 + lane, kt_ = tid_ >> 3, q_ = tid_ & 7; const LAS u64* mst = (const LAS u64*)(sc + 32768);
      MASK[((size_t)b * 64 + kt_) * SEQ + t0 + q_] = mst[kt_ * 8 + q_]; }
#pragma unroll
    for (int mt = 0; mt < 2; ++mt) {
#pragma unroll
        for (int ks = 0; ks < 4; ++ks) af[mt][ks] = afn[mt][ks];
    }
    }
}
#undef IDX_AF
#undef IDX_WV
#undef IDX_ITEM

constexpr int GL_BLR = 0;
constexpr int GL_W2  = GL_BLR + 4096;
constexpr int GL_GP  = GL_W2 + 4096;
constexpr int GL_QD  = GL_GP + 2048;
constexpr int GL_KD  = GL_QD + 64 * 72 * 2;
constexpr int GL_KT  = GL_KD + 64 * 72 * 2;
constexpr int GL_VT  = GL_KT + 64 * 72 * 2;
constexpr int GL_P   = GL_VT + 128 * 72 * 2;
constexpr int GL_O   = GL_P + 64 * 72 * 2;
constexpr int GL_END = GL_O + 64 * 132 * 4;

__device__ __forceinline__ void gla_stage_vt(LAS bf16_t* vt, const u32x4 (&vraw)[2], int tid) {
#pragma unroll
    for (int rep = 0; rep < 2; ++rep) { const int idx = tid + 512 * rep, j = idx >> 4, dv8 = (idx & 15) * 8;
        const u32x4 w = vraw[rep];
        vt[(dv8 + 0) * 72 + j] = (bf16_t)(w.x & 0xFFFF); vt[(dv8 + 1) * 72 + j] = (bf16_t)(w.x >> 16);
        vt[(dv8 + 2) * 72 + j] = (bf16_t)(w.y & 0xFFFF); vt[(dv8 + 3) * 72 + j] = (bf16_t)(w.y >> 16);
        vt[(dv8 + 4) * 72 + j] = (bf16_t)(w.z & 0xFFFF); vt[(dv8 + 5) * 72 + j] = (bf16_t)(w.z >> 16);
        vt[(dv8 + 6) * 72 + j] = (bf16_t)(w.w & 0xFFFF); vt[(dv8 + 7) * 72 + j] = (bf16_t)(w.w >> 16); }
}
__device__ __forceinline__ void gla_prep_state(LAS unsigned char* lds, const float* gw2, const float* gb2, int b, int hh, int n,
                                               bf16_t* BQ, bf16_t* BK, const bf16_t* BV, const float* BLR, float* DECAY) {
    const int tid = opaque_tid(), d = tid & 63, jg = tid >> 6;
    const size_t tok0 = (size_t)b * SEQ + n * 64;
    LAS float* blr = (LAS float*)(lds + GL_BLR); LAS float* w2s = (LAS float*)(lds + GL_W2); LAS float* gp = (LAS float*)(lds + GL_GP);
    LAS bf16_t* kt = (LAS bf16_t*)(lds + GL_KT); LAS bf16_t* vt = (LAS bf16_t*)(lds + GL_VT);
    bf16_t kraw[8], qraw[8]; u32x4 vraw[2];
#pragma unroll
    for (int i = 0; i < 8; ++i) { kraw[i] = BK[(tok0 + 8 * jg + i) * 256 + hh * 64 + d]; qraw[i] = BQ[(tok0 + 8 * jg + i) * 256 + hh * 64 + d]; }
#pragma unroll
    for (int rep = 0; rep < 2; ++rep) { const int idx = tid + 512 * rep; vraw[rep] = *(const u32x4*)(BV + (tok0 + (idx >> 4)) * 512 + hh * 128 + (idx & 15) * 8); }
    if (tid < 256) { *(LAS f32x4*)(blr + tid * 4) = *(const f32x4*)(BLR + tok0 * 16 + tid * 4); }
    else { const int q = tid - 256, r = q >> 4, d4 = (q & 15) * 4; *(LAS f32x4*)(w2s + r * 64 + d4) = *(const f32x4*)(gw2 + (size_t)r * 256 + hh * 64 + d4); }
    __syncthreads();
    float cs[8];
    { const float b2 = gb2[hh * 64 + d]; float run = 0.f; float w2c[16];
#pragma unroll
      for (int r = 0; r < 16; ++r) w2c[r] = w2s[r * 64 + d];
#pragma unroll
      for (int i = 0; i < 8; ++i) { float z = b2;
#pragma unroll
          for (int q = 0; q < 4; ++q) { const f32x4 bl = *(const LAS f32x4*)(blr + (8 * jg + i) * 16 + 4 * q);
              z += bl[0] * w2c[4 * q + 0]; z += bl[1] * w2c[4 * q + 1]; z += bl[2] * w2c[4 * q + 2]; z += bl[3] * w2c[4 * q + 3]; }
          const float la = -(fmaxf(-z, 0.f) + __logf(1.0f + __expf(-fabsf(z)))) * (1.0f / 16.0f);
          run += la; cs[i] = run; }
      gp[jg * 64 + d] = run; }
    __syncthreads();
    float off = 0.f, glast = 0.f;
#pragma unroll
    for (int j = 0; j < 8; ++j) { const float v = gp[j * 64 + d]; if (j < jg) off += v; glast += v; }
    const float eglast = __expf(glast);
    if (jg == 0) DECAY[((size_t)(b * 4 + hh) * 64 + n) * 64 + d] = eglast;
    unsigned ktw[4];
#pragma unroll
    for (int i = 0; i < 8; i += 2) {
        float ktv[2];
#pragma unroll
        for (int ii = 0; ii < 2; ++ii) { const int j = 8 * jg + i + ii; const float G = off + cs[i + ii];
            const float kv = bf2f(kraw[i + ii]), qv = bf2f(qraw[i + ii]);
            const float eg = __expf(G), eng = __builtin_amdgcn_rcpf(eg), kdv = kv * eng;
            ktv[ii] = kdv * eglast;
            BQ[(tok0 + j) * 256 + hh * 64 + d] = (bf16_t)(cvt_pk_bf16(qv * 0.125f * eg, 0.f) & 0xFFFFu);
            BK[(tok0 + j) * 256 + hh * 64 + d] = (bf16_t)(cvt_pk_bf16(kdv, 0.f) & 0xFFFFu); }
        ktw[i >> 1] = cvt_pk_bf16(ktv[0], ktv[1]);
    }
    *(LAS u32x4*)(kt + d * 72 + 8 * jg) = (u32x4){ktw[0], ktw[1], ktw[2], ktw[3]};
    gla_stage_vt(vt, vraw, tid);
    __syncthreads();
}
__device__ __forceinline__ void gla_prep_out(LAS unsigned char* lds, int b, int hh, int n, const bf16_t* BQ, const bf16_t* BK, const bf16_t* BV) {
    const int tid = opaque_tid(), row = tid >> 3, ch = (tid & 7) * 8;
    const size_t tok0 = (size_t)b * SEQ + n * 64;
    LAS bf16_t* qd = (LAS bf16_t*)(lds + GL_QD); LAS bf16_t* kd = (LAS bf16_t*)(lds + GL_KD); LAS bf16_t* vt = (LAS bf16_t*)(lds + GL_VT);
    u32x4 vraw[2];
    const u32x4 qw = *(const u32x4*)(BQ + (tok0 + row) * 256 + hh * 64 + ch), kw = *(const u32x4*)(BK + (tok0 + row) * 256 + hh * 64 + ch);
#pragma unroll
    for (int rep = 0; rep < 2; ++rep) { const int idx = tid + 512 * rep; vraw[rep] = *(const u32x4*)(BV + (tok0 + (idx >> 4)) * 512 + hh * 128 + (idx & 15) * 8); }
    *(LAS u32x4*)(qd + row * 72 + ch) = qw; *(LAS u32x4*)(kd + row * 72 + ch) = kw;
    gla_stage_vt(vt, vraw, tid);
    __syncthreads();
}

__device__ __forceinline__ void gla_state_item(LAS unsigned char* lds, const float* gw2, const float* gb2, int item, bf16_t* BQ, bf16_t* BK, const bf16_t* BV, const float* BLR, float* DECAY, float* GSTATE) {
    const int b = item >> 8, hh = (item >> 6) & 3, n = item & 63;
    gla_prep_state(lds, gw2, gb2, b, hh, n, BQ, BK, BV, BLR, DECAY);
    const int tid1 = opaque_tid(), lane = tid1 & 63, wave = tid1 >> 6, g = lane >> 5, c = lane & 31, mt = wave >> 1, nt = wave & 1;
    LAS bf16_t* kt = (LAS bf16_t*)(lds + GL_KT); LAS bf16_t* vt = (LAS bf16_t*)(lds + GL_VT);
    f32x16 acc;
#pragma unroll
    for (int r = 0; r < 16; ++r) acc[r] = 0.f;
#pragma unroll
    for (int ks = 0; ks < 4; ++ks) { const bf16x8 af = *(const LAS bf16x8*)(vt + (32 * mt + c) * 72 + ks * 16 + 8 * g); const bf16x8 bf = *(const LAS bf16x8*)(kt + (32 * nt + c) * 72 + ks * 16 + 8 * g);
        acc = __builtin_amdgcn_mfma_f32_32x32x16_bf16(af, bf, acc, 0, 0, 0); }
    float* dst = GSTATE + ((size_t)(b * 4 + hh) * 64 + n) * 8192;
#pragma unroll
    for (int r = 0; r < 16; ++r) { const int dv = 32 * mt + (r & 3) + 8 * (r >> 2) + 4 * g; dst[dv * 64 + 32 * nt + c] = acc[r]; }
    __syncthreads();
}

__device__ __forceinline__ void gla_out_item(LAS unsigned char* lds, const float* gw2, const float* gb2, int item, const bf16_t* BQ, const bf16_t* BK, const bf16_t* BV, const float* BLR, const bf16_t* BG,
                                              const bf16_t* SPREV, bf16_t* MIXIN) {
    const int b = item >> 8, hh = (item >> 6) & 3, n = item & 63;
    const int tid = opaque_tid(), lane = tid & 63, wave = tid >> 6, g = lane >> 5, c = lane & 31;
    bf16x8 spf[4]; u32x4 g0, g1;
    { const bf16_t* sp = SPREV + ((size_t)(b * 4 + hh) * 64 + n) * 8192 + (size_t)(32 * (wave & 3) + c) * 64 + 8 * g;
#pragma unroll
      for (int ks = 0; ks < 4; ++ks) spf[ks] = *(const bf16x8*)(sp + ks * 16);
      const size_t tokg = (size_t)b * SEQ + n * 64 + (tid >> 3);
      g0 = *(const u32x4*)(BG + tokg * 512 + hh * 128 + (tid & 7) * 16); g1 = *(const u32x4*)(BG + tokg * 512 + hh * 128 + (tid & 7) * 16 + 8); }
    gla_prep_out(lds, b, hh, n, BQ, BK, BV);
    LAS bf16_t* qd = (LAS bf16_t*)(lds + GL_QD); LAS bf16_t* kd = (LAS bf16_t*)(lds + GL_KD); LAS bf16_t* vt = (LAS bf16_t*)(lds + GL_VT); LAS bf16_t* P = (LAS bf16_t*)(lds + GL_P);
    LAS float* o = (LAS float*)(lds + GL_O);
    if (wave < 4) {
        const int mt = wave >> 1, nt = wave & 1;
        f32x16 acc;
#pragma unroll
        for (int r = 0; r < 16; ++r) acc[r] = 0.f;
        if (!(mt == 0 && nt == 1)) {
#pragma unroll
            for (int ks = 0; ks < 4; ++ks) { const bf16x8 af = *(const LAS bf16x8*)(qd + (32 * mt + c) * 72 + ks * 16 + 8 * g); const bf16x8 bf = *(const LAS bf16x8*)(kd + (32 * nt + c) * 72 + ks * 16 + 8 * g);
                acc = __builtin_amdgcn_mfma_f32_32x32x16_bf16(af, bf, acc, 0, 0, 0); }
        }
#pragma unroll
        for (int r = 0; r < 16; ++r) { const int i = 32 * mt + (r & 3) + 8 * (r >> 2) + 4 * g, j = 32 * nt + c; P[i * 72 + j] = f2bf(j <= i ? acc[r] : 0.f); }
    }
    __syncthreads();
    {
        const int mt = wave >> 2, nt = wave & 3;
        f32x16 acc;
#pragma unroll
        for (int r = 0; r < 16; ++r) acc[r] = 0.f;
#pragma unroll
        for (int ks = 0; ks < 4; ++ks) { const bf16x8 af = *(const LAS bf16x8*)(P + (32 * mt + c) * 72 + ks * 16 + 8 * g); const bf16x8 bf = *(const LAS bf16x8*)(vt + (32 * nt + c) * 72 + ks * 16 + 8 * g);
            acc = __builtin_amdgcn_mfma_f32_32x32x16_bf16(af, bf, acc, 0, 0, 0); }
#pragma unroll
        for (int ks = 0; ks < 4; ++ks) { const bf16x8 af = *(const LAS bf16x8*)(qd + (32 * mt + c) * 72 + ks * 16 + 8 * g); acc = __builtin_amdgcn_mfma_f32_32x32x16_bf16(af, spf[ks], acc, 0, 0, 0); }
#pragma unroll
        for (int r = 0; r < 16; ++r) { const int i = 32 * mt + (r & 3) + 8 * (r >> 2) + 4 * g; o[i * 132 + 32 * nt + c] = acc[r]; }
    }
    __syncthreads();
    {
        const int row = tid >> 3, part = tid & 7; float v[16]; float ss = 0.f;
#pragma unroll
        for (int k = 0; k < 16; ++k) { v[k] = o[row * 132 + part * 16 + k]; ss += v[k] * v[k]; }
        ss += __shfl_xor(ss, 1); ss += __shfl_xor(ss, 2); ss += __shfl_xor(ss, 4);
        const float r = rsqrtf(ss * (1.0f / 128.0f) + EPS);
        const size_t tok = (size_t)b * SEQ + n * 64 + row;
        const float gv[16] = {bflo(g0.x), bfhi(g0.x), bflo(g0.y), bfhi(g0.y), bflo(g0.z), bfhi(g0.z), bflo(g0.w), bfhi(g0.w),
                              bflo(g1.x), bfhi(g1.x), bflo(g1.y), bfhi(g1.y), bflo(g1.z), bfhi(g1.z), bflo(g1.w), bfhi(g1.w)};
        unsigned w[8];
#pragma unroll
        for (int k = 0; k < 8; ++k) w[k] = cvt_pk_bf16(v[2 * k] * r * gv[2 * k], v[2 * k + 1] * r * gv[2 * k + 1]);
        bf16_t* dp = MIXIN + tok * 1024 + 512 + hh * 128 + part * 16;
        *(u32x4*)dp = (u32x4){w[0], w[1], w[2], w[3]}; *(u32x4*)(dp + 8) = (u32x4){w[4], w[5], w[6], w[7]};
    }
    __syncthreads();
}

constexpr int AT_K0 = 0, AT_V0 = 9216, AT_STAGE = 18432, AT_BT = 2 * AT_STAGE;
constexpr float LOG2E = 1.4426950408889634f, AT_C1 = 0.125f * LOG2E, AT_THR = 8.0f;

template <bool NEAR>
__device__ __forceinline__ void attn_tile(const LAS bf16_t* Kt, const LAS bf16_t* Vt, const LAS float* btl, const bf16x8 (&qf)[4], bf16x8& qx, const bf16x8 kx, f32x16& O0, f32x16& O1, float& m_ref, f32x16& Lt,
                                          u64 mw, int tq, int key0, int g, int c) {
    const int pc = (c & 0x13) | ((c & 4) << 1) | ((c & 8) >> 1);
    f32x16 s0, s1;
#pragma unroll
    for (int r = 0; r < 16; ++r) { s0[r] = 0.f; s1[r] = 0.f; }
#pragma unroll
    for (int ks = 0; ks < 4; ++ks) {
        const bf16x8 k0 = *(const LAS bf16x8*)(Kt + pc * 72 + ks * 16 + 8 * g), k1 = *(const LAS bf16x8*)(Kt + (32 + pc) * 72 + ks * 16 + 8 * g);
        s0 = __builtin_amdgcn_mfma_f32_32x32x16_bf16(k0, qf[ks], s0, 0, 0, 0); s1 = __builtin_amdgcn_mfma_f32_32x32x16_bf16(k1, qf[ks], s1, 0, 0, 0);
    }
    s0 = __builtin_amdgcn_mfma_f32_32x32x16_bf16(kx, qx, s0, 0, 0, 0); s1 = __builtin_amdgcn_mfma_f32_32x32x16_bf16(kx, qx, s1, 0, 0, 0);
    const unsigned w0 = (unsigned)mw >> (8 * g), w1 = (unsigned)(mw >> 32) >> (8 * g);
    float x0[16], x1[16];
#pragma unroll
    for (int r = 0; r < 16; ++r) {
        if (NEAR) { const LAS float* pb = btl + (tq - key0 - 8 * g + 96 - 63);
            x0[r] = s0[r] + pb[63 - (16 * (r >> 3) + (r & 7))]; x1[r] = s1[r] + pb[63 - (16 * (r >> 3) + (r & 7) + 32)]; }
        else { x0[r] = s0[r]; x1[r] = s1[r]; }
    }
    float mx = fmaxf(fmaxf(x0[15], x0[14]), fmaxf(x1[15], x1[14]));
#pragma unroll
    for (int r = 0; r < 14; r += 1) asm("v_max3_f32 %0, %1, %2, %3" : "=v"(mx) : "v"(mx), "v"(x0[r]), "v"(x1[r]));
    if (__any(mx > AT_THR || mx < -64.0f)) {
        float ms = NEG_INF;
#pragma unroll
        for (int r = 0; r < 16; ++r) { const int bp = 16 * (r >> 3) + (r & 7);
            const float a0 = ((w0 >> bp) & 1u) ? x0[r] : NEG_INF, a1 = ((w1 >> bp) & 1u) ? x1[r] : NEG_INF; ms = fmaxf(ms, fmaxf(a0, a1)); }
        { const auto sw = __builtin_amdgcn_permlane32_swap(__float_as_uint(ms), __float_as_uint(ms), false, false); ms = fmaxf(__uint_as_float(sw[0]), __uint_as_float(sw[1])); }
        const bool empty = (Lt[0] == 0.f);
        float rel = (ms == NEG_INF) ? 0.f : (empty ? ms : fmaxf(ms, 0.f));
        const unsigned mb = cvt_pk_bf16(m_ref + rel, 0.f) << 16;
        const float m_new = __uint_as_float(mb), delta = m_new - m_ref;
        const float alpha = empty ? 1.0f : __builtin_amdgcn_exp2f(-delta);
#pragma unroll
        for (int r = 0; r < 16; ++r) { O0[r] *= alpha; O1[r] *= alpha; Lt[r] *= alpha; x0[r] -= delta; x1[r] -= delta; }
        m_ref = m_new;
        { u32x4 qw = (u32x4){0u, 0u, 0u, 0u}; if (g == 0) qw.x = (mb >> 16) ^ 0x8000u; qx = *(bf16x8*)&qw; }
    }
#pragma unroll
    for (int r = 0; r < 16; ++r) { const int bp = 16 * (r >> 3) + (r & 7);
        const float e0 = __builtin_amdgcn_exp2f(x0[r]), e1 = __builtin_amdgcn_exp2f(x1[r]);
        unsigned b0, b1;
        asm("v_bfe_i32 %0, %1, %2, 1" : "=v"(b0) : "v"(w0), "n"(bp)); asm("v_bfe_i32 %0, %1, %2, 1" : "=v"(b1) : "v"(w1), "n"(bp));
        x0[r] = __uint_as_float(__float_as_uint(e0) & b0); x1[r] = __uint_as_float(__float_as_uint(e1) & b1); }
#pragma unroll
    for (int s = 0; s < 4; ++s) {
        const float* xp = (s < 2) ? x0 : x1; const int o = 8 * (s & 1);
        u32x4 w; w.x = cvt_pk_bf16(xp[o + 0], xp[o + 1]); w.y = cvt_pk_bf16(xp[o + 2], xp[o + 3]); w.z = cvt_pk_bf16(xp[o + 4], xp[o + 5]); w.w = cvt_pk_bf16(xp[o + 6], xp[o + 7]);
        const bf16x8 pb = *(bf16x8*)&w;
        const bf16x8 v0 = *(const LAS bf16x8*)(Vt + c * 72 + s * 16 + 8 * g), v1 = *(const LAS bf16x8*)(Vt + (32 + c) * 72 + s * 16 + 8 * g);
        O0 = __builtin_amdgcn_mfma_f32_32x32x16_bf16(v0, pb, O0, 0, 0, 0); O1 = __builtin_amdgcn_mfma_f32_32x32x16_bf16(v1, pb, O1, 0, 0, 0);
        const u32x4 onew = (u32x4){0x3F803F80u, 0x3F803F80u, 0x3F803F80u, 0x3F803F80u};
        Lt = __builtin_amdgcn_mfma_f32_32x32x16_bf16(*(const bf16x8*)&onew, pb, Lt, 0, 0, 0);
    }
}

__device__ __forceinline__ void attn_item(LAS unsigned char* lds, const bf16_t* Q, const bf16_t* Kb, const bf16_t* VT, const bf16_t* AG, const u64* MASK, const float* btab, bf16_t* MIXIN,
                                          int b, int head, int qb, int tid) {
    const int lane = tid & 63, wave = __builtin_amdgcn_readfirstlane(tid >> 6), g = lane >> 5, c = lane & 31;
    const int tq0 = qb * 256 + wave * 32, tq = tq0 + c;
    const size_t tokq = (size_t)b * SEQ + tq;
    LAS float* btl = (LAS float*)(lds + AT_BT);
    if (tid < 320) { const int rel = tid - 96; btl[tid] = (rel >= 0 && rel < 128) ? (btab[rel * 8 + head] - btab[127 * 8 + head]) * LOG2E : 0.f; }
    bf16x8 qf[4];
#pragma unroll
    for (int ks = 0; ks < 4; ++ks) { const u32x4 qw = *(const u32x4*)(Q + tokq * 512 + head * 64 + ks * 16 + 8 * g);
        u32x4 sw; sw.x = cvt_pk_bf16(bflo(qw.x) * AT_C1, bfhi(qw.x) * AT_C1); sw.y = cvt_pk_bf16(bflo(qw.y) * AT_C1, bfhi(qw.y) * AT_C1);
        sw.z = cvt_pk_bf16(bflo(qw.z) * AT_C1, bfhi(qw.z) * AT_C1); sw.w = cvt_pk_bf16(bflo(qw.w) * AT_C1, bfhi(qw.w) * AT_C1); qf[ks] = *(bf16x8*)&sw; }
    bf16x8 qx, kx;
    { u32x4 z = (u32x4){0u, 0u, 0u, 0u}; qx = *(bf16x8*)&z; if (g == 0) z.x = 0x3F80u; kx = *(bf16x8*)&z; }
    f32x16 O0, O1;
#pragma unroll
    for (int r = 0; r < 16; ++r) { O0[r] = 0.f; O1[r] = 0.f; }
    float m_ref = 0.f; f32x16 Lt;
#pragma unroll
    for (int r = 0; r < 16; ++r) Lt[r] = 0.f;
    const int nt = 4 * qb + 4, my_last = 4 * qb + (wave >> 1);
    const int srow = tid >> 3, sch = tid & 7, sto = (srow * 72 + 8 * sch) * 2;
    const bf16_t* kg = Kb + ((size_t)b * SEQ + srow) * 512 + head * 64 + 8 * sch;
    const bf16_t* vg = VT + ((size_t)(b * 8 + head) * 64 + srow) * 4096 + 8 * sch;
    const u64* Mrow = MASK + (size_t)b * 64 * SEQ + tq;
    { const u32x4 kr = *(const u32x4*)kg, vr = *(const u32x4*)vg; *(LAS u32x4*)(lds + AT_K0 + sto) = kr; *(LAS u32x4*)(lds + AT_V0 + sto) = vr; }
    u64 mw = Mrow[0];
    __syncthreads();
    int ks_near = (tq0 - 175 + 63) >> 6; ks_near = ks_near < 0 ? 0 : ks_near;
#define AT_ITER(BODY) do { const bool more = (kt + 1 < nt); u32x4 kr, vr; u64 mwn = 0ull; \
        if (more) { kr = *(const u32x4*)(kg + (size_t)(kt + 1) * 64 * 512); vr = *(const u32x4*)(vg + (kt + 1) * 64); if (kt + 1 <= my_last) mwn = Mrow[(size_t)(kt + 1) * SEQ]; } \
        { const LAS bf16_t* Kt = (const LAS bf16_t*)(lds + (kt & 1) * AT_STAGE + AT_K0); const LAS bf16_t* Vt = (const LAS bf16_t*)(lds + (kt & 1) * AT_STAGE + AT_V0); BODY; } \
        if (more) { *(LAS u32x4*)(lds + ((kt + 1) & 1) * AT_STAGE + AT_K0 + sto) = kr; *(LAS u32x4*)(lds + ((kt + 1) & 1) * AT_STAGE + AT_V0 + sto) = vr; } \
        mw = mwn; __syncthreads(); } while (0)
    int kt = 0;
    if (wave >= 4) __builtin_amdgcn_s_setprio(1);
    for (; kt < ks_near; ++kt) AT_ITER(attn_tile<false>(Kt, Vt, btl, qf, qx, kx, O0, O1, m_ref, Lt, mw, tq, 64 * kt, g, c));
    for (; kt <= my_last; ++kt) AT_ITER(attn_tile<true>(Kt, Vt, btl, qf, qx, kx, O0, O1, m_ref, Lt, mw, tq, 64 * kt, g, c));
    for (; kt < nt; ++kt) AT_ITER((void)Kt; (void)Vt);
#undef AT_ITER
    __builtin_amdgcn_s_setprio(0);
    const float inv = 1.0f / Lt[0];
#pragma unroll
    for (int mt = 0; mt < 2; ++mt)
#pragma unroll
        for (int rq = 0; rq < 4; ++rq) { const int d0 = 32 * mt + 8 * rq + 4 * g;
            const u32x2 gw = *(const u32x2*)(AG + tokq * 512 + head * 64 + d0);
            const float o0 = (mt ? O1[4 * rq + 0] : O0[4 * rq + 0]) * inv * bflo(gw.x), o1 = (mt ? O1[4 * rq + 1] : O0[4 * rq + 1]) * inv * bfhi(gw.x);
            const float o2 = (mt ? O1[4 * rq + 2] : O0[4 * rq + 2]) * inv * bflo(gw.y), o3 = (mt ? O1[4 * rq + 3] : O0[4 * rq + 3]) * inv * bfhi(gw.y);
            u32x2 ow; ow.x = cvt_pk_bf16(o0, o1); ow.y = cvt_pk_bf16(o2, o3);
            *(u32x2*)(MIXIN + tokq * 1024 + head * 64 + d0) = ow; }
}

constexpr int LDS_BYTES = 147456;
constexpr int MISC_OFF = 131072 + 8192;
constexpr int NPH = 26;

__global__ void __launch_bounds__(NTHREADS, 2) fwd_kernel(Args a) {
    extern __shared__ __attribute__((aligned(16))) unsigned char lds_raw[];
    LAS unsigned char* lds = (LAS unsigned char*)lds_raw;
    const int G = gridDim.x, wg = blockIdx.x;
    volatile LAS unsigned* misc = (volatile LAS unsigned*)(lds + MISC_OFF);
    if (threadIdx.x < 4) misc[threadIdx.x] = 0u;
    __syncthreads();
    XcdBarrier bar; bar.bar = nullptr; bar.x = 0; bar.st = misc;
    if (N_LAUNCHES == 1) bar = xcd_barrier_post((unsigned*)(get_args()->ws + WS_CTL), misc);
    int lo, hi; { ArgsP ap = get_args(); lo = ap->ph_lo; hi = ap->ph_hi; }
#define WSP(type, off) ((type*)(wsl + (off)))
#define IN(k) (lo <= (k) && (k) < hi)
#define SEAM(k) do { if (N_LAUNCHES == 1 && IN(k) && IN((k) + 1)) { XcdBarrier b_ = bar; asm volatile("" : "+s"(b_.bar), "+s"(b_.x)); xcd_barrier(b_); } } while (0)

    if (IN(0)) {
        ArgsP ap = get_args(); unsigned char* wsl = ap->ws;
        weight_phase((LAS float*)lds, ap, wsl);
        if (wg == 0) for (int i = opaque_tid(); i < 1024; i += NTHREADS) { const int rel = i >> 3, h = i & 7; WSP(float, WS_TAB)[i] = ap->rel_bias[t5_bucket(rel) * 8 + h]; }
    }
    SEAM(0);

#define LAYER_BODY(LAYER_) { constexpr int layer = (LAYER_); \
        const int pb = 1 + 6 * layer, e = layer >> 1; \
        constexpr bool even = (layer & 1) == 0; \
        if (IN(pb + 0)) { \
            ArgsP ap = get_args(); unsigned char* wsl = ap->ws; \
            const bf16_t* Wm = WSP(bf16_t, WS_WEIN) + ((size_t)e * NE + 4096) * 1024; \
            if (layer == 0) norm_misc_phase(lds, ap->x, nullptr, nullptr, nullptr, nullptr, WSP(bf16_t, WS_H), WSP(float, WS_XS), Wm, WSP(bf16_t, WS_IK), WSP(float, WS_IW), WSP(float, WS_BLR)); \
            else if (even) norm_misc_phase(lds, nullptr, WSP(bf16_t, WS_H), WSP(float, WS_XS), WSP(bf16_t, WS_MIX), ap->post_norm + (layer - 1) * DM, WSP(bf16_t, WS_H), WSP(float, WS_XS), Wm, WSP(bf16_t, WS_IK), WSP(float, WS_IW), WSP(float, WS_BLR)); \
            else norm_phase(nullptr, WSP(bf16_t, WS_H), WSP(float, WS_XS), WSP(bf16_t, WS_MIX), ap->post_norm + (layer - 1) * DM, WSP(bf16_t, WS_H), WSP(float, WS_XS), nullptr); \
        } \
        SEAM(pb + 0); \
        if (even) { \
            if (IN(pb + 1)) { \
                ArgsP ap = get_args(); unsigned char* wsl = ap->ws; \
                pg8::Gemm gm{WSP(bf16_t, WS_H), WSP(bf16_t, WS_WEIN) + (size_t)e * NE * 1024, T, 4096, 1024, 1024, 1 << 30, 0}; pg8::StaticOrder S; S.init(T, 4096, G, wg); \
                EpiEvenIn E{WSP(bf16_t, WS_Q), WSP(bf16_t, WS_K), WSP(bf16_t, WS_VT), WSP(bf16_t, WS_AG), WSP(bf16_t, WS_IQ), WSP(bf16_t, WS_BQ), WSP(bf16_t, WS_BK), WSP(bf16_t, WS_BV), WSP(bf16_t, WS_BG), \
                            WSP(bf16_t, WS_IK), WSP(float, WS_IW), WSP(float, WS_BLR)}; \
                pg8::gemm_phase(lds, gm, S, E); \
            } \
            SEAM(pb + 1); \
            if (IN(pb + 2)) { \
                ArgsP ap = get_args(); unsigned char* wsl = ap->ws; \
                { const int tid = opaque_tid(), lane = tid & 63, wave = __builtin_amdgcn_readfirstlane(tid >> 6); \
                  indexer_phase((LAS float*)lds, WSP(bf16_t, WS_IQ), WSP(bf16_t, WS_IK), WSP(float, WS_IW), WSP(u64, WS_MASK), wave, lane); } \
                { const float* gw2 = ap->even_gate_w2 + (size_t)e * 16 * 256; const float* gb2 = ap->even_gate_b2 + (size_t)e * 256; \
                  for (int it = wg; it < 1024; it += G) gla_state_item(lds, gw2, gb2, it, WSP(bf16_t, WS_BQ), WSP(bf16_t, WS_BK), WSP(bf16_t, WS_BV), WSP(float, WS_BLR), WSP(float, WS_DECAY), WSP(float, WS_MIXIN)); } \
            } \
            SEAM(pb + 2); \
            if (IN(pb + 3)) { \
                ArgsP ap = get_args(); unsigned char* wsl = ap->ws; \
                const float* GSTATE = WSP(float, WS_MIXIN); const float* DECAY = WSP(float, WS_DECAY); bf16_t* SPREV = WSP(bf16_t, WS_SPREV); \
                for (int el = wg * NTHREADS + opaque_tid(); el < 16 * 8192; el += G * NTHREADS) { \
                    const int bh = el >> 13, rem = el & 8191, dk = rem & 63; float Sv = 0.f; \
                    for (int n = 0; n < 64; ++n) { const size_t o = ((size_t)bh * 64 + n) * 8192 + rem; SPREV[o] = f2bf(Sv); Sv = DECAY[((size_t)bh * 64 + n) * 64 + dk] * Sv + GSTATE[o]; } \
                } \
            } \
            SEAM(pb + 3); \
            if (IN(pb + 4)) { \
                ArgsP ap = get_args(); unsigned char* wsl = ap->ws; \
                { const int tid = opaque_tid(); \
                  for (int it = wg; it < 512; it += G) { const int idx = it & 255, b = idx & 3, head = (idx >> 2) & 7, qbp = idx >> 5, qb = (it < 256) ? 15 - qbp : qbp; \
                      attn_item(lds, WSP(bf16_t, WS_Q), WSP(bf16_t, WS_K), WSP(bf16_t, WS_VT), WSP(bf16_t, WS_AG), WSP(u64, WS_MASK), WSP(float, WS_TAB), WSP(bf16_t, WS_MIXIN), b, head, qb, tid); } } \
                __syncthreads(); \
                { const float* gw2 = ap->even_gate_w2 + (size_t)e * 16 * 256; const float* gb2 = ap->even_gate_b2 + (size_t)e * 256; \
                  for (int it = wg; it < 1024; it += G) gla_out_item(lds, gw2, gb2, it, WSP(bf16_t, WS_BQ), WSP(bf16_t, WS_BK), WSP(bf16_t, WS_BV), WSP(float, WS_BLR), WSP(bf16_t, WS_BG), WSP(bf16_t, WS_SPREV), WSP(bf16_t, WS_MIXIN)); } \
            } \
            SEAM(pb + 4); \
        } else { \
            if (IN(pb + 1)) { \
                ArgsP ap = get_args(); unsigned char* wsl = ap->ws; \
                pg8::Gemm gm{WSP(bf16_t, WS_H), WSP(bf16_t, WS_WOIN) + (size_t)e * 2048 * 1024, T, 2048, 1024, 1024, 1 << 30, 0}; pg8::StaticOrder S; S.init(T, 2048, G, wg); \
                EpiOddIn E{WSP(bf16_t, WS_XR), WSP(bf16_t, WS_GS)}; \
                pg8::gemm_phase(lds, gm, S, E); \
            } \
            SEAM(pb + 1); \
            if (IN(pb + 2)) { \
                ArgsP ap = get_args(); unsigned char* wsl = ap->ws; \
                const bf16_t* XR = WSP(bf16_t, WS_XR); bf16_t* XC = WSP(bf16_t, WS_XC); \
                const float* cw = ap->odd_conv_w + (size_t)e * 4 * 1024; const float* cb = ap->odd_conv_b + (size_t)e * 1024; \
                { const int tid = opaque_tid(), c8 = (tid & 127) * 8; float wq[4][8], bq[8];   \
_Pragma("unroll") \
                  for (int k = 0; k < 8; ++k) { bq[k] = cb[c8 + k]; _Pragma("unroll") for (int j = 0; j < 4; ++j) wq[j][k] = cw[j * 1024 + c8 + k]; } \
                  for (int run = wg * 4 + (tid >> 7); run < T / 8; run += G * 4) { \
                    const int tok0 = run * 8, s0 = tok0 & 4095; float xw[11][8]; \
_Pragma("unroll") \
                    for (int i = 0; i < 11; ++i) { u32x4 w = (u32x4){0u, 0u, 0u, 0u}; if (s0 - 3 + i >= 0) w = *(const u32x4*)(XR + (size_t)(tok0 - 3 + i) * 1024 + c8); \
                        xw[i][0] = bflo(w.x); xw[i][1] = bfhi(w.x); xw[i][2] = bflo(w.y); xw[i][3] = bfhi(w.y); xw[i][4] = bflo(w.z); xw[i][5] = bfhi(w.z); xw[i][6] = bflo(w.w); xw[i][7] = bfhi(w.w); } \
_Pragma("unroll") \
                    for (int o = 0; o < 8; ++o) { float acc[8]; \
_Pragma("unroll") \
                        for (int k = 0; k < 8; ++k) acc[k] = bq[k] + wq[0][k] * xw[o][k] + wq[1][k] * xw[o + 1][k] + wq[2][k] * xw[o + 2][k] + wq[3][k] * xw[o + 3][k]; \
                        u32x4 ow; ow.x = cvt_pk_bf16(acc[0], acc[1]); ow.y = cvt_pk_bf16(acc[2], acc[3]); ow.z = cvt_pk_bf16(acc[4], acc[5]); ow.w = cvt_pk_bf16(acc[6], acc[7]); \
                        *(u32x4*)(XC + (size_t)(tok0 + o) * 1024 + c8) = ow; } \
                  } } \
            } \
            SEAM(pb + 2); \
            if (IN(pb + 3)) { \
                ArgsP ap = get_args(); unsigned char* wsl = ap->ws; \
                pg8::Gemm gm{WSP(bf16_t, WS_XC), WSP(bf16_t, WS_WOG) + (size_t)e * 2048 * 256, T, 2048, 256, 1024, 2, 512}; pg8::StaticOrder S; S.init(T, 2048, G, wg); \
                EpiGates E{ap->odd_b_a + (size_t)e * 1024, ap->odd_b_x + (size_t)e * 1024, ap->odd_lambda + (size_t)e * 1024, WSP(bf16_t, WS_XC), WSP(bf16_t, WS_LOGA), WSP(bf16_t, WS_U)}; \
                pg8::gemm_phase(lds, gm, S, E); \
            } \
            SEAM(pb + 3); \
            if (IN(pb + 4)) { \
                ArgsP ap = get_args(); unsigned char* wsl = ap->ws; \
                const bf16_t* LOGA = WSP(bf16_t, WS_LOGA); const bf16_t* U = WSP(bf16_t, WS_U); const bf16_t* GS = WSP(bf16_t, WS_GS); bf16_t* MIXIN = WSP(bf16_t, WS_MIXIN); \
                LAS float* sl = (LAS float*)lds; LAS float* hl = sl + 512; \
                const int tid = opaque_tid(); \
                for (int it = wg; it < 256; it += G) { \
                      \
                    const int xq = (it & 7) * 8 + ((it >> 3) >> 2), b = xq >> 4, ch = ((xq & 15) * 4 + ((it >> 3) & 3)) * 16 + (tid & 15), jc = tid >> 4; \
                    const size_t base = ((size_t)b * SEQ + jc * 128) * 1024 + ch, sbase = slab_idx(b * SEQ + jc * 128, ch); \
                    float hsum = 0.f, lsum = 0.f; \
                    for (int s0 = 0; s0 < 128; s0 += 16) { float la[16], uu[16]; \
                        _Pragma("unroll") for (int k = 0; k < 16; ++k) { la[k] = bf2f(LOGA[sbase + (size_t)(s0 + k) * 16]); uu[k] = bf2f(U[sbase + (size_t)(s0 + k) * 16]); } \
                        _Pragma("unroll") for (int k = 0; k < 16; ++k) { hsum = __builtin_amdgcn_exp2f(la[k]) * hsum + uu[k]; lsum += la[k]; } } \
                    sl[tid] = lsum; hl[tid] = hsum; \
                    __syncthreads(); \
                    float hin = 0.f; \
                    for (int cj = 0; cj < jc; ++cj) hin = __builtin_amdgcn_exp2f(sl[cj * 16 + (tid & 15)]) * hin + hl[cj * 16 + (tid & 15)]; \
                    float hv = hin; \
                    for (int s0 = 0; s0 < 128; s0 += 16) { float la[16], uu[16], gg[16]; \
                        _Pragma("unroll") for (int k = 0; k < 16; ++k) { la[k] = bf2f(LOGA[sbase + (size_t)(s0 + k) * 16]); uu[k] = bf2f(U[sbase + (size_t)(s0 + k) * 16]); gg[k] = bf2f(GS[sbase + (size_t)(s0 + k) * 16]); } \
                        _Pragma("unroll") for (int k = 0; k < 16; ++k) { hv = __builtin_amdgcn_exp2f(la[k]) * hv + uu[k]; MIXIN[base + (size_t)(s0 + k) * 1024] = f2bf(hv * gg[k]); } } \
                    __syncthreads(); \
                } \
            } \
            SEAM(pb + 4); \
        } \
        if (IN(pb + 5)) { \
            ArgsP ap = get_args(); unsigned char* wsl = ap->ws; \
            const bf16_t* W = (even ? WSP(bf16_t, WS_WEOUT) : WSP(bf16_t, WS_WOOUT)) + (size_t)e * 1024 * 1024; \
            pg8::Gemm gm{WSP(bf16_t, WS_MIXIN), W, T, 1024, 1024, 1024, 1 << 30, 0}; pg8::StaticOrder S; S.init(T, 1024, G, wg); \
            EpiMix E{WSP(bf16_t, WS_MIX)}; \
            pg8::gemm_phase(lds, gm, S, E); \
        } \
        SEAM(pb + 5); \
    }
    LAYER_BODY(0)
    LAYER_BODY(1)
    LAYER_BODY(2)
    LAYER_BODY(3)
#undef LAYER_BODY
    if (IN(25)) { ArgsP ap = get_args(); unsigned char* wsl = ap->ws; norm_phase(nullptr, WSP(bf16_t, WS_H), WSP(float, WS_XS), WSP(bf16_t, WS_MIX), ap->post_norm + 3 * DM, nullptr, nullptr, ap->out); }
#undef IN
#undef SEAM
#undef WSP
}

extern "C" void kernel_launch(void* const* d_in, const int* in_sizes, int n_in, void* d_out, int out_size, void* d_ws, size_t ws_size, hipStream_t stream) {
    static int grid = 0;
    if (grid == 0) {
        if (n_in != 17 || out_size != T * DM || ws_size < WS_END) { fprintf(stderr, "kernel_launch: unexpected sizes (n_in %d, out %d, ws %zu, need %zu)\n", n_in, out_size, ws_size, (size_t)WS_END); grid = -1; return; }
        int dev = 0, cus = 0, per_cu = 0;
        if (hipGetDevice(&dev) != hipSuccess || hipDeviceGetAttribute(&cus, hipDeviceAttributeMultiprocessorCount, dev) != hipSuccess) { grid = -1; return; }
        if (hipFuncSetAttribute((const void*)fwd_kernel, hipFuncAttributeMaxDynamicSharedMemorySize, LDS_BYTES) != hipSuccess) { fprintf(stderr, "kernel_launch: hipFuncSetAttribute failed\n"); grid = -1; return; }
        if (hipOccupancyMaxActiveBlocksPerMultiprocessor(&per_cu, (const void*)fwd_kernel, NTHREADS, LDS_BYTES) != hipSuccess || per_cu < 1) { fprintf(stderr, "kernel_launch: occupancy query says %d\n", per_cu); }
        (void)hipGetLastError();
        grid = cus;
    }
    if (grid < 0) return;
    (void)hipMemsetAsync((char*)d_ws + WS_CTL, 0, CTL_BYTES, stream);
    Args a{};
    a.x = (const float*)d_in[0]; a.rel_bias = (const float*)d_in[1]; a.pre_norm = (const float*)d_in[2]; a.post_norm = (const float*)d_in[3];
    a.even_w_in = (const float*)d_in[4]; a.even_gate_w2 = (const float*)d_in[5]; a.even_gate_b2 = (const float*)d_in[6]; a.even_w_out = (const float*)d_in[7];
    a.odd_w_in = (const float*)d_in[8]; a.odd_conv_w = (const float*)d_in[9]; a.odd_conv_b = (const float*)d_in[10]; a.odd_w_a = (const float*)d_in[11]; a.odd_b_a = (const float*)d_in[12];
    a.odd_w_x = (const float*)d_in[13]; a.odd_b_x = (const float*)d_in[14]; a.odd_lambda = (const float*)d_in[15]; a.odd_w_out = (const float*)d_in[16];
    a.out = (float*)d_out; a.ws = (unsigned char*)d_ws;
    if (N_LAUNCHES == 1) {
        a.ph_lo = 0; a.ph_hi = NPH;
        hipLaunchKernelGGL(fwd_kernel, dim3(grid), dim3(NTHREADS), LDS_BYTES, stream, a);
    } else {
        for (int ph = 0; ph < NPH; ++ph) { a.ph_lo = ph; a.ph_hi = ph + 1; hipLaunchKernelGGL(fwd_kernel, dim3(grid), dim3(NTHREADS), LDS_BYTES, stream, a); }
    }
}
```

```cpp
#include <hip/hip_runtime.h>
#include <stdint.h>
#include <stdio.h>

#ifndef N_LAUNCHES
#define N_LAUNCHES 1
#endif

#define LAS __attribute__((address_space(3)))
typedef unsigned short bf16_t;
typedef short bf16x8 __attribute__((ext_vector_type(8)));
typedef float f32x4 __attribute__((ext_vector_type(4)));
typedef float f32x2 __attribute__((ext_vector_type(2)));
typedef float f32x16 __attribute__((ext_vector_type(16)));
typedef unsigned u32x4 __attribute__((ext_vector_type(4)));
typedef unsigned u32x2 __attribute__((ext_vector_type(2)));
typedef unsigned long long u64;

constexpr int NB = 4, SEQ = 4096, T = NB * SEQ, DM = 1024;
constexpr int EVEN_IN = 4184, NE = 4352;
constexpr int NTHREADS = 512;
constexpr float EPS = 1e-6f;
constexpr float NEG_INF = -__builtin_inff();

constexpr size_t MB = 1024 * 1024;
constexpr size_t WS_CTL   = 0;
constexpr size_t CTL_BYTES = 65536;
constexpr size_t WS_WEIN  = WS_CTL + CTL_BYTES;
constexpr size_t WS_WEOUT = WS_WEIN + (size_t)2 * NE * 1024 * 2;
constexpr size_t WS_WOIN  = WS_WEOUT + 4 * MB;
constexpr size_t WS_WOG   = WS_WOIN + 8 * MB;
constexpr size_t WS_WOOUT = WS_WOG + 2 * MB;
constexpr size_t WS_TAB   = WS_WOOUT + 4 * MB;
constexpr size_t WS_XS    = WS_TAB + 4096;
constexpr size_t WS_H     = WS_XS + 65536;
constexpr size_t WS_MIXIN = WS_H + 32 * MB;
constexpr size_t WS_ACT   = WS_MIXIN + 32 * MB;
constexpr size_t WS_Q     = WS_ACT;
constexpr size_t WS_K     = WS_Q + 16 * MB;
constexpr size_t WS_VT    = WS_K + 16 * MB;
constexpr size_t WS_AG    = WS_VT + 16 * MB;
constexpr size_t WS_MIX   = WS_ACT;
constexpr size_t WS_IQ    = WS_AG + 16 * MB;
constexpr size_t WS_BQ    = WS_IQ + 16 * MB;
constexpr size_t WS_BK    = WS_BQ + 8 * MB;
constexpr size_t WS_BV    = WS_BK + 8 * MB;
constexpr size_t WS_BG    = WS_BV + 16 * MB;
constexpr size_t WS_IK    = WS_BG + 16 * MB;
constexpr size_t WS_IW    = WS_IK + 2 * MB;
constexpr size_t WS_BLR   = WS_IW + MB / 2;
constexpr size_t WS_MASK  = WS_BLR + MB;
constexpr size_t WS_SPREV = WS_MASK + 8 * MB;
constexpr size_t WS_DECAY = WS_SPREV + 16 * MB;
constexpr size_t WS_EVEN_END = WS_DECAY + MB / 4;
constexpr size_t WS_XR    = WS_ACT;
constexpr size_t WS_U     = WS_XR;
constexpr size_t WS_GS    = WS_XR + 32 * MB;
constexpr size_t WS_XC    = WS_GS + 32 * MB;
constexpr size_t WS_LOGA  = WS_XC + 32 * MB;
constexpr size_t WS_ODD_END = WS_LOGA + 32 * MB;
constexpr size_t WS_END   = WS_EVEN_END > WS_ODD_END ? WS_EVEN_END : WS_ODD_END;
static_assert(WS_END <= (size_t)256 * MB, "workspace map exceeds 256 MiB");

__device__ __forceinline__ float bf2f(unsigned v) { return __uint_as_float(v << 16); }
typedef __bf16 bf16pair_t __attribute__((ext_vector_type(2)));
typedef float f32pair_t __attribute__((ext_vector_type(2)));
__device__ __forceinline__ unsigned cvt_pk_bf16(float lo, float hi) { const f32pair_t v = {lo, hi}; const bf16pair_t b = __builtin_convertvector(v, bf16pair_t); return __builtin_bit_cast(unsigned, b); }
__device__ __forceinline__ bf16_t f2bf(float f) { return (bf16_t)cvt_pk_bf16(f, f); }
__device__ __forceinline__ float silu_f(float x) { return x / (1.0f + __expf(-x)); }
__device__ __forceinline__ float sigmoid_f(float x) { return 1.0f / (1.0f + __expf(-x)); }
__device__ __forceinline__ size_t slab_idx(int row, int ch) { return ((size_t)((row >> 12) * 64 + (ch >> 4)) * SEQ + (row & 4095)) * 16 + (ch & 15); }
__device__ __forceinline__ float log1p_01(float y) { const float ser = y * (1.0f - y * (0.5f - y * (0.33333334f - y * 0.25f))); return y < 0.03125f ? ser : __logf(1.0f + y); }
__device__ __forceinline__ float bflo(unsigned w) { return __uint_as_float(w << 16); }
__device__ __forceinline__ float bfhi(unsigned w) { return __uint_as_float(w & 0xFFFF0000u); }

__device__ __forceinline__ int opaque_tid() { int t = threadIdx.x; asm volatile("" : "+v"(t)); return t; }

__device__ __forceinline__ int wave_sum_i32(int v) {
    v += __builtin_amdgcn_update_dpp(0, v, 0xB1, 0xF, 0xF, true);
    v += __builtin_amdgcn_update_dpp(0, v, 0x4E, 0xF, 0xF, true);
    v += __builtin_amdgcn_update_dpp(0, v, 0x141, 0xF, 0xF, true);
    v += __builtin_amdgcn_update_dpp(0, v, 0x140, 0xF, 0xF, true);
    return __builtin_amdgcn_readlane(v, 0) + __builtin_amdgcn_readlane(v, 16) + __builtin_amdgcn_readlane(v, 32) + __builtin_amdgcn_readlane(v, 48);
}

__device__ __forceinline__ float wave_max_f32(float v) {
    v = fmaxf(v, __uint_as_float((unsigned)__builtin_amdgcn_update_dpp(0, (int)__float_as_uint(v), 0xB1, 0xF, 0xF, true)));
    v = fmaxf(v, __uint_as_float((unsigned)__builtin_amdgcn_update_dpp(0, (int)__float_as_uint(v), 0x4E, 0xF, 0xF, true)));
    v = fmaxf(v, __uint_as_float((unsigned)__builtin_amdgcn_update_dpp(0, (int)__float_as_uint(v), 0x141, 0xF, 0xF, true)));
    v = fmaxf(v, __uint_as_float((unsigned)__builtin_amdgcn_update_dpp(0, (int)__float_as_uint(v), 0x140, 0xF, 0xF, true)));
    const float a = __uint_as_float((unsigned)__builtin_amdgcn_readlane((int)__float_as_uint(v), 0)), b = __uint_as_float((unsigned)__builtin_amdgcn_readlane((int)__float_as_uint(v), 16));
    const float c = __uint_as_float((unsigned)__builtin_amdgcn_readlane((int)__float_as_uint(v), 32)), d = __uint_as_float((unsigned)__builtin_amdgcn_readlane((int)__float_as_uint(v), 48));
    return fmaxf(fmaxf(a, b), fmaxf(c, d));
}
__device__ __forceinline__ int wave_prefix_sum_i32(int v) {
    v += __builtin_amdgcn_update_dpp(0, v, 0x111, 0xF, 0xF, true);
    v += __builtin_amdgcn_update_dpp(0, v, 0x112, 0xF, 0xF, true);
    v += __builtin_amdgcn_update_dpp(0, v, 0x114, 0xF, 0xF, true);
    v += __builtin_amdgcn_update_dpp(0, v, 0x118, 0xF, 0xF, true);
    v += __builtin_amdgcn_update_dpp(0, v, 0x142, 0xA, 0xF, false);
    v += __builtin_amdgcn_update_dpp(0, v, 0x143, 0xC, 0xF, false);
    return v;
}

#define XB_TMO      128
#define XB_XCNT(j)  (256  + 64 * (j))
#define XB_XSUB(j)  (1280 + 64 * (j))
#define XB_XGEN(j)  (2304 + 64 * (j))
#define XB_TOP      3328
#define XB_TOPGEN   3392
#define XCD_BAR_WORDS 3456
#define XB_SPIN_CAP (1u << 18)

__device__ __forceinline__ unsigned xb_ld(unsigned* p)              { return __hip_atomic_load(p, __ATOMIC_RELAXED, __HIP_MEMORY_SCOPE_AGENT); }
__device__ __forceinline__ unsigned xb_add(unsigned* p, unsigned v) { return __hip_atomic_fetch_add(p, v, __ATOMIC_RELAXED, __HIP_MEMORY_SCOPE_AGENT); }
__device__ __forceinline__ unsigned xb_xcc_id() { return (unsigned)__builtin_amdgcn_s_getreg((3 << 11) | 20) & 0xFu; }
#define XB_SPIN(cond, bar) do { unsigned _sp = 0; while (cond) { __builtin_amdgcn_s_sleep(1); \
    if ((++_sp & 255u) == 0u) { if (xb_ld(&(bar)[XB_TMO])) break; if (_sp > XB_SPIN_CAP) { atomicAdd(&(bar)[XB_TMO], 1u); break; } } } } while (0)

struct XcdBarrier { unsigned* bar; unsigned x; volatile LAS unsigned* st; };

__device__ __forceinline__ XcdBarrier xcd_barrier_post(unsigned* bar, volatile LAS unsigned* st) {
    XcdBarrier b; b.bar = bar; b.x = xb_xcc_id(); b.st = st;
    if (threadIdx.x == 0) (void)xb_add(&bar[XB_XCNT(b.x)], 1u);
    return b;
}
__device__ __forceinline__ void xcd_barrier_complete(unsigned* bar, unsigned x, unsigned& nloc, unsigned& nx) {
    const unsigned G = gridDim.x * gridDim.y * gridDim.z;
    unsigned sum, cnt, mine, sp = 0u;
    for (;;) {
        sum = 0u; cnt = 0u; mine = 0u;
#pragma unroll
        for (unsigned j = 0; j < 16; ++j) { const unsigned c = xb_ld(&bar[XB_XCNT(j)]); sum += c; cnt += (c > 0u) ? 1u : 0u; mine = (j == x) ? c : mine; }
        if (sum == G) break;
        __builtin_amdgcn_s_sleep(1);
        if ((++sp & 255u) == 0u) { if (xb_ld(&bar[XB_TMO])) break; if (sp > XB_SPIN_CAP) { atomicAdd(&bar[XB_TMO], 1u); break; } }
    }
    nloc = mine > 0u ? mine : 1u; nx = cnt > 0u ? cnt : 1u;
}
__device__ __forceinline__ void xcd_barrier(const XcdBarrier& b) {
    asm volatile("s_waitcnt vmcnt(0)" ::: "memory");
    __syncthreads();
    if (threadIdx.x == 0) {
        unsigned* bar = b.bar;
        __builtin_amdgcn_s_waitcnt(0);
        unsigned nloc = b.st[0], nx = b.st[1];
        if (nloc == 0u) { xcd_barrier_complete(bar, b.x, nloc, nx); b.st[0] = nloc; b.st[1] = nx; }
        const unsigned old = xb_add(&bar[XB_XSUB(b.x)], 1u);
        const unsigned gen = old / nloc;
        if (old + 1u == (gen + 1u) * nloc) {
            __builtin_amdgcn_fence(__ATOMIC_RELEASE, "agent");
            asm volatile("s_waitcnt vmcnt(0)" ::: "memory");
            const unsigned og = xb_add(&bar[XB_TOP], 1u);
            const unsigned tg = og / nx;
            if (og + 1u == (tg + 1u) * nx) xb_add(&bar[XB_TOPGEN], 1u);
            else XB_SPIN(xb_ld(&bar[XB_TOPGEN]) == tg, bar);
            __builtin_amdgcn_fence(__ATOMIC_ACQUIRE, "agent");
            xb_add(&bar[XB_XGEN(b.x)], 1u);
            asm volatile("s_waitcnt vmcnt(0)" ::: "memory");
        } else {
            XB_SPIN(xb_ld(&bar[XB_XGEN(b.x)]) == gen, bar);
            __builtin_amdgcn_fence(__ATOMIC_ACQUIRE, "agent");
            asm volatile("s_waitcnt vmcnt(0)" ::: "memory");
        }
    }
    __syncthreads();
}

namespace pg8 {
constexpr int BM = 256, BK = 64, HALF = 128, HTB = HALF * BK * 2, STAGE_BYTES = 8 * HTB, NXCD = 8, WGM = 8;
__host__ __device__ __forceinline__ int lds_byte(int r, int c) { const int st = (r >> 4) * 2 + (c >> 5), rr = r & 15, cc = c & 31, ob = rr * 64 + cc * 2; return st * 1024 + (ob ^ (((ob >> 9) & 1) << 5)); }
__host__ __device__ __forceinline__ void stage_rc(int b, int& R, int& C) { const int st = b / 1024, sb = b % 1024, swz = sb ^ (((sb >> 9) & 1) << 5); R = (st >> 1) * 16 + swz / 64; C = (st & 1) * 32 + (swz % 64) / 2; }
__host__ __device__ __forceinline__ int perm32(int rho) { const int n = rho >> 4, i = rho & 15; return 8 * (i >> 2) + 4 * n + (i & 3); }

struct Unit { int pm, pn; };
struct Gemm { const bf16_t* A; const bf16_t* Bt; int M, N, K, lda, a_div, a_step; };

struct StaticOrder {
    int nM, nN, nwg, G, c;
    __host__ __device__ void init(int M, int N, int G_, int c_) { nM = M / BM; nN = N / BM; nwg = nM * nN; G = G_; c = c_; }
    __host__ __device__ bool next(int i, Unit& u) const {
        const long L = (long)i * G + c; if (L >= nwg) return false;
        int wgid = (int)L; { const int q = nwg / NXCD, r = nwg % NXCD, xcd = wgid % NXCD, off = wgid / NXCD; wgid = (xcd < r ? xcd * (q + 1) : r * (q + 1) + (xcd - r) * q) + off; }
        const int nig = WGM * nN, gid = wgid / nig, fm = gid * WGM, gsz = (nM - fm) < WGM ? (nM - fm) : WGM;
        u.pm = fm + ((wgid % nig) % gsz); u.pn = (wgid % nig) / gsz; return true;
    }
};

template <class Epi>
__device__ __forceinline__ void gemm_phase(LAS unsigned char* lds, const Gemm g, const StaticOrder& S, const Epi& E) {
    const int tid = opaque_tid(), wid = __builtin_amdgcn_readfirstlane(tid >> 6), lane = tid & 63, wr = wid >> 2, wc = wid & 3, fr = lane & 15, fq = lane >> 4;
    const int K = g.K, nt = K / BK, lda = g.lda;
    unsigned voffA[2], voffB[2];
#pragma unroll
    for (int i = 0; i < 2; ++i) { int R, C; stage_rc(tid * 16 + i * 8192, R, C); const int Rb = Epi::PERM ? ((R & ~31) + perm32(R & 31)) : R;
        voffA[i] = (unsigned)(R * lda + C) * 2u; voffB[i] = (unsigned)(Rb * K + C) * 2u; }
    const size_t kstep = (size_t)(BK * 2);
    const size_t hstepA = (size_t)HALF * lda * 2, hstepB = (size_t)HALF * K * 2;
    const size_t tstepA = 2 * hstepA, tstepB = 2 * hstepB;
    const unsigned ldsw = (unsigned)wid * 1024u;
    const int aoff = lds_byte(wr * 64 + fr, fq * 8), boff = lds_byte(wc * 32 + fr, fq * 8);
#define PG8_SA(b, h) (((b) * 2 + (h)) * HTB)
#define PG8_SB(b, h) ((4 + (b) * 2 + (h)) * HTB)
#define PG8_STAGE(bufoff, gbase, voff) do { _Pragma("unroll") for (int _i = 0; _i < 2; ++_i) \
        __builtin_amdgcn_global_load_lds((const unsigned*)((const char*)(gbase) + (voff)[_i]), (LAS unsigned*)(lds + (bufoff) + ldsw + _i * 8192), 16, 0, 0); } while (0)
#define PG8_LDA(dst, b, h) do { _Pragma("unroll") for (int m = 0; m < 4; ++m) _Pragma("unroll") for (int k = 0; k < 2; ++k) dst[m][k] = *(const LAS bf16x8*)(lds + PG8_SA(b, h) + aoff + m * 2048 + k * 1024); } while (0)
#define PG8_LDB(dst, b, h) do { _Pragma("unroll") for (int n = 0; n < 2; ++n) _Pragma("unroll") for (int k = 0; k < 2; ++k) dst[n][k] = *(const LAS bf16x8*)(lds + PG8_SB(b, h) + boff + n * 2048 + k * 1024); } while (0)
#define PG8_MMA(ai, bj, At, Bt) do { __builtin_amdgcn_s_setprio(1); _Pragma("unroll") for (int m = 0; m < 4; ++m) _Pragma("unroll") for (int n = 0; n < 2; ++n) _Pragma("unroll") for (int k = 0; k < 2; ++k) \
        acc[ai][bj][m][n] = __builtin_amdgcn_mfma_f32_16x16x32_bf16(Bt[n][k], At[m][k], acc[ai][bj][m][n], 0, 0, 0); __builtin_amdgcn_s_setprio(0); } while (0)
#define PG8_WAIT_V(n) asm volatile("s_waitcnt vmcnt(" #n ")" ::: "memory")
#define PG8_WAIT_L(n) asm volatile("s_waitcnt lgkmcnt(" #n ")" ::: "memory")
#define PG8_BAR __builtin_amdgcn_s_barrier()
#define PG8_SCHED __builtin_amdgcn_sched_barrier(0)
    Unit cur, nxt; int ui = 0;
    if (!S.next(0, cur)) return;
    f32x4 acc[2][2][4][2];
#pragma unroll
    for (int a = 0; a < 2; ++a)
#pragma unroll
        for (int b = 0; b < 2; ++b)
#pragma unroll
            for (int m = 0; m < 4; ++m)
#pragma unroll
                for (int n = 0; n < 2; ++n) acc[a][b][m][n] = (f32x4){0.f, 0.f, 0.f, 0.f};
    bf16x8 At[4][2], B0[2][2], B1[2][2];
    const char* cA = (const char*)g.A + (size_t)cur.pm * tstepA + (size_t)(cur.pn / g.a_div) * g.a_step; const char* cB = (const char*)g.Bt + (size_t)cur.pn * tstepB;
    PG8_STAGE(PG8_SB(0, 0), cB, voffB); PG8_STAGE(PG8_SA(0, 0), cA, voffA); PG8_STAGE(PG8_SB(0, 1), cB + hstepB, voffB); PG8_STAGE(PG8_SA(0, 1), cA + hstepA, voffA);
    if (wr == 1) PG8_BAR;
    PG8_WAIT_V(4); PG8_BAR;
    PG8_STAGE(PG8_SB(1, 0), cB + kstep, voffB); PG8_STAGE(PG8_SA(1, 0), cA + kstep, voffA); PG8_STAGE(PG8_SB(1, 1), cB + hstepB + kstep, voffB);
    PG8_WAIT_V(6); PG8_BAR;
    for (;;) {
        const bool has_next = S.next(ui + 1, nxt);
        const char* nA = has_next ? (const char*)g.A + (size_t)nxt.pm * tstepA + (size_t)(nxt.pn / g.a_div) * g.a_step : cA; const char* nB = has_next ? (const char*)g.Bt + (size_t)nxt.pn * tstepB : cB;
        for (int t = 0; t < nt; t += 2) {
            const bool last = (t == nt - 2);
            const char* a1 = cA + (size_t)(t + 1) * kstep;
            const char* a2 = last ? nA : cA + (size_t)(t + 2) * kstep; const char* b2 = last ? nB : cB + (size_t)(t + 2) * kstep;
            const char* a3 = a2 + kstep; const char* b3 = b2 + kstep;
            PG8_LDB(B0, 0, 0); PG8_SCHED; PG8_LDA(At, 0, 0); PG8_STAGE(PG8_SA(1, 1), a1 + hstepA, voffA);
            PG8_WAIT_L(8); PG8_BAR; PG8_WAIT_L(0); PG8_MMA(0, 0, At, B0); PG8_BAR; PG8_SCHED;
            PG8_LDB(B1, 0, 1); PG8_STAGE(PG8_SB(0, 0), b2, voffB);
            PG8_BAR; PG8_WAIT_L(0); PG8_MMA(0, 1, At, B1); PG8_BAR;
            PG8_LDA(At, 0, 1); PG8_STAGE(PG8_SA(0, 0), a2, voffA);
            PG8_BAR; PG8_WAIT_L(0); PG8_MMA(1, 0, At, B0); PG8_BAR; PG8_SCHED;
            PG8_STAGE(PG8_SB(0, 1), b2 + hstepB, voffB);
            PG8_WAIT_V(6); PG8_BAR; PG8_MMA(1, 1, At, B1); PG8_BAR;
            PG8_LDB(B0, 1, 0); PG8_SCHED; PG8_LDA(At, 1, 0); PG8_STAGE(PG8_SA(0, 1), a2 + hstepA, voffA);
            PG8_WAIT_L(8); PG8_BAR; PG8_WAIT_L(0); PG8_MMA(0, 0, At, B0); PG8_BAR; PG8_SCHED;
            PG8_LDB(B1, 1, 1); PG8_STAGE(PG8_SB(1, 0), b3, voffB);
            PG8_BAR; PG8_WAIT_L(0); PG8_MMA(0, 1, At, B1); PG8_BAR;
            PG8_LDA(At, 1, 1); PG8_STAGE(PG8_SA(1, 0), a3, voffA);
            PG8_BAR; PG8_WAIT_L(0); PG8_MMA(1, 0, At, B0); PG8_BAR; PG8_SCHED;
            PG8_STAGE(PG8_SB(1, 1), b3 + hstepB, voffB);
            PG8_WAIT_V(6); PG8_BAR; PG8_MMA(1, 1, At, B1); PG8_BAR;
        }
        E(acc, cur, wr, wc, fr, fq);
        if (!has_next) break;
#pragma unroll
        for (int a = 0; a < 2; ++a)
#pragma unroll
            for (int b = 0; b < 2; ++b)
#pragma unroll
                for (int m = 0; m < 4; ++m)
#pragma unroll
                    for (int n = 0; n < 2; ++n) acc[a][b][m][n] = (f32x4){0.f, 0.f, 0.f, 0.f};
        cur = nxt; cA = nA; cB = nB; ++ui;
    }
    PG8_WAIT_V(0);
    if (wr == 0) PG8_BAR;
    PG8_BAR;
#undef PG8_SA
#undef PG8_SB
#undef PG8_STAGE
#undef PG8_LDA
#undef PG8_LDB
#undef PG8_MMA
#undef PG8_WAIT_V
#undef PG8_WAIT_L
#undef PG8_BAR
#undef PG8_SCHED
}
}

struct EpiMix {
    static constexpr bool PERM = true;
    bf16_t* C;
    __device__ __forceinline__ void operator()(const f32x4 (&acc)[2][2][4][2], const pg8::Unit& u, int wr, int wc, int fr, int fq) const {
#pragma unroll
        for (int ai = 0; ai < 2; ++ai)
#pragma unroll
            for (int m = 0; m < 4; ++m) { const int row = u.pm * 256 + ai * 128 + wr * 64 + m * 16 + fr;
#pragma unroll
                for (int bj = 0; bj < 2; ++bj) { const f32x4 v0 = acc[ai][bj][m][0], v1 = acc[ai][bj][m][1];
                    u32x4 w; w.x = cvt_pk_bf16(v0[0], v0[1]); w.y = cvt_pk_bf16(v0[2], v0[3]); w.z = cvt_pk_bf16(v1[0], v1[1]); w.w = cvt_pk_bf16(v1[2], v1[3]);
                    *(u32x4*)(C + (size_t)row * 1024 + u.pn * 256 + bj * 128 + wc * 32 + 8 * fq) = w; } }
    }
};

constexpr float LOG2E_F = 1.4426950408889634f;
constexpr float IW_SCALE = 0.35355339059327373f * 0.125f;

struct EpiEvenIn {
    static constexpr bool PERM = true;
    bf16_t *Q, *Kb, *VT, *AG, *IQ, *BQ, *BK, *BV, *BG, *IK; float *IW, *BLR;
    __device__ __forceinline__ void operator()(const f32x4 (&acc)[2][2][4][2], const pg8::Unit& u, int wr, int wc, int fr, int fq) const {
        const int pn = u.pn;
        bf16_t* dst = Q; int ld = 512, col0 = 0, mode = 0;
        if (pn < 2) { dst = Q; col0 = pn * 256; }
        else if (pn < 4) { dst = Kb; col0 = (pn - 2) * 256; }
        else if (pn < 6) { mode = 2; col0 = (pn - 4) * 256; }
        else if (pn < 8) { dst = AG; col0 = (pn - 6) * 256; mode = 1; }
        else if (pn < 10) { dst = IQ; col0 = (pn - 8) * 256; }
        else if (pn == 10) { dst = BQ; ld = 256; }
        else if (pn == 11) { dst = BK; ld = 256; }
        else if (pn < 14) { dst = BV; col0 = (pn - 12) * 256; }
        else if (pn < 16) { dst = BG; col0 = (pn - 14) * 256; mode = 1; }
        else mode = 3;
#pragma unroll
        for (int ai = 0; ai < 2; ++ai)
#pragma unroll
            for (int m = 0; m < 4; ++m) {
                const int row = u.pm * 256 + ai * 128 + wr * 64 + m * 16 + fr;
#pragma unroll
                for (int bj = 0; bj < 2; ++bj) {
                    const int cb = bj * 128 + wc * 32 + 8 * fq;
                    f32x4 v0 = acc[ai][bj][m][0], v1 = acc[ai][bj][m][1];
                    if (mode <= 1) {
                        if (mode == 1) {
#pragma unroll
                            for (int j = 0; j < 4; ++j) { v0[j] = silu_f(v0[j]); v1[j] = silu_f(v1[j]); }
                        }
                        u32x4 w; w.x = cvt_pk_bf16(v0[0], v0[1]); w.y = cvt_pk_bf16(v0[2], v0[3]); w.z = cvt_pk_bf16(v1[0], v1[1]); w.w = cvt_pk_bf16(v1[2], v1[3]);
                        *(u32x4*)(dst + (size_t)row * ld + col0 + cb) = w;
                    } else if (mode == 2) {
                        const int c = col0 + cb, head = c >> 6, d = c & 63, b = row >> 12, s = row & 4095;
                        bf16_t* p = VT + ((size_t)(b * 8 + head) * 64 + d) * 4096 + s;
#pragma unroll
                        for (int j = 0; j < 4; ++j) { p[(size_t)j * 4096] = f2bf(v0[j]); p[(size_t)(j + 4) * 4096] = f2bf(v1[j]); }
                    } else {
                        if (cb < 64) {
                            u32x4 w; w.x = cvt_pk_bf16(v0[0], v0[1]); w.y = cvt_pk_bf16(v0[2], v0[3]); w.z = cvt_pk_bf16(v1[0], v1[1]); w.w = cvt_pk_bf16(v1[2], v1[3]);
                            const int q = cb >> 3, bb = row >> 12, sq = row & 4095;
                            *(u32x4*)(IK + ((((size_t)(bb * 128 + (sq >> 5)) * 4 + (q >> 1)) * 2 + (q & 1)) * 32 + (sq & 31)) * 8) = w;
                        } else if (cb == 64) {
                            *(f32x4*)(IW + (size_t)row * 8) = v0 * IW_SCALE; *(f32x4*)(IW + (size_t)row * 8 + 4) = v1 * IW_SCALE;
                        } else if (cb == 72 || cb == 80) {
                            *(f32x4*)(BLR + (size_t)row * 16 + (cb - 72)) = v0; *(f32x4*)(BLR + (size_t)row * 16 + (cb - 72) + 4) = v1;
                        }
                    }
                }
            }
    }
};

struct EpiOddIn {
    static constexpr bool PERM = true;
    bf16_t *XR, *GS;
    __device__ __forceinline__ void operator()(const f32x4 (&acc)[2][2][4][2], const pg8::Unit& u, int wr, int wc, int fr, int fq) const {
        const int pn = u.pn; const bool gate = pn >= 4;
        bf16_t* dst = gate ? GS : XR; const int col0 = (pn & 3) * 256;
#pragma unroll
        for (int ai = 0; ai < 2; ++ai)
#pragma unroll
            for (int m = 0; m < 4; ++m) {
                const int row = u.pm * 256 + ai * 128 + wr * 64 + m * 16 + fr;
#pragma unroll
                for (int bj = 0; bj < 2; ++bj) {
                    const int cb = bj * 128 + wc * 32 + 8 * fq;
                    f32x4 v0 = acc[ai][bj][m][0], v1 = acc[ai][bj][m][1];
                    if (gate) {
#pragma unroll
                        for (int j = 0; j < 4; ++j) { v0[j] = silu_f(v0[j]); v1[j] = silu_f(v1[j]); }
                    }
                    u32x4 w; w.x = cvt_pk_bf16(v0[0], v0[1]); w.y = cvt_pk_bf16(v0[2], v0[3]); w.z = cvt_pk_bf16(v1[0], v1[1]); w.w = cvt_pk_bf16(v1[2], v1[3]);
                    if (gate) *(u32x4*)(GS + slab_idx(row, col0 + cb)) = w;
                    else *(u32x4*)(XR + (size_t)row * 1024 + col0 + cb) = w;
                }
            }
    }
};

struct EpiGates {
    static constexpr bool PERM = true;
    const float *b_a, *b_x, *lam; const bf16_t* XC; bf16_t* LOGA; bf16_t* U;
    __device__ __forceinline__ void operator()(const f32x4 (&acc)[2][2][4][2], const pg8::Unit& u, int wr, int wc, int fr, int fq) const {
        const int chb = (u.pn >> 1) * 256 + (u.pn & 1) * 128 + wc * 32 + 8 * fq;
#pragma unroll
        for (int nh = 0; nh < 2; ++nh) {
            const int ch0 = chb + 4 * nh;
            const f32x4 lm = *(const f32x4*)(lam + ch0);
            const f32x4 nba = *(const f32x4*)(b_a + ch0) * (-LOG2E_F), nbx = *(const f32x4*)(b_x + ch0) * (-LOG2E_F);
            f32x4 c8;
#pragma unroll
            for (int j = 0; j < 4; ++j) c8[j] = (-8.0f * LOG2E_F) * (fmaxf(-lm[j], 0.f) + log1p_01(__expf(-fabsf(lm[j]))));
#pragma unroll
            for (int ai = 0; ai < 2; ++ai)
#pragma unroll
                for (int m = 0; m < 4; ++m) {
                    const int row = u.pm * 256 + ai * 128 + wr * 64 + m * 16 + fr;
                    const u32x2 xw = *(const u32x2*)(XC + (size_t)row * 1024 + ch0);
                    const float xv[4] = {bflo(xw.x), bfhi(xw.x), bflo(xw.y), bfhi(xw.y)};
                    f32x4 la; float uu[4];
#pragma unroll
                    for (int j = 0; j < 4; ++j) {
                        const float r = __builtin_amdgcn_rcpf(1.0f + __builtin_amdgcn_exp2f(__builtin_fmaf(acc[ai][0][m][nh][j], -LOG2E_F, nba[j])));
                        const float ig = __builtin_amdgcn_rcpf(1.0f + __builtin_amdgcn_exp2f(__builtin_fmaf(acc[ai][1][m][nh][j], -LOG2E_F, nbx[j])));
                        const float l2 = c8[j] * r, av = __builtin_amdgcn_exp2f(l2);
                        la[j] = l2;
                        uu[j] = __builtin_amdgcn_sqrtf(fmaxf(__builtin_fmaf(-av, av, 1.0f), 0.f)) * ig * xv[j];
                    }
                    { u32x2 lw; lw.x = cvt_pk_bf16(la[0], la[1]); lw.y = cvt_pk_bf16(la[2], la[3]); *(u32x2*)(LOGA + slab_idx(row, ch0)) = lw; }
                    u32x2 w; w.x = cvt_pk_bf16(uu[0], uu[1]); w.y = cvt_pk_bf16(uu[2], uu[3]);
                    *(u32x2*)(U + slab_idx(row, ch0)) = w;
                }
        }
    }
};

struct Args {
    const float* x; const float* rel_bias; const float* pre_norm; const float* post_norm;
    const float* even_w_in; const float* even_gate_w2; const float* even_gate_b2; const float* even_w_out;
    const float* odd_w_in; const float* odd_conv_w; const float* odd_conv_b; const float* odd_w_a; const float* odd_b_a;
    const float* odd_w_x; const float* odd_b_x; const float* odd_lambda; const float* odd_w_out;
    float* out; unsigned char* ws; int ph_lo, ph_hi;
};

typedef const Args __attribute__((address_space(4)))* ArgsP;
__device__ __forceinline__ ArgsP get_args() { ArgsP p = (ArgsP)__builtin_amdgcn_kernarg_segment_ptr(); asm volatile("" : "+s"(p)); return p; }

constexpr int WT_EIN = 2 * 68 * 16, WT_EOUT = 2 * 256, WT_OIN = 2 * 512, WT_OOUT = 2 * 256, WT_GATE = 2 * 128, WT_ALL = WT_EIN + WT_EOUT + WT_OIN + WT_OOUT + WT_GATE;
__device__ __forceinline__ void wtile_decode(int T, ArgsP ap, unsigned char* ws, int nl, int wn, const float*& colp, int& ld, bf16_t*& drow, int& K, const float*& ksc) {
    ksc = nullptr;
    if (T < WT_EIN) { const int e = T / 1088, r = T % 1088, tn = r % 68, tk = r / 68; K = 1024; ld = EVEN_IN;
        const int n = tn * 64 + nl; int c; bool ok = true; if (n < 2560) c = n; else if (n < 4096) c = n + 72; else if (n < 4168) c = n - 1536; else if (n < 4184) c = n; else { c = 0; ok = false; }
        ksc = ap->pre_norm + (size_t)(2 * e) * DM + tk * 64;
        colp = ok ? ap->even_w_in + ((size_t)e * 1024 + tk * 64) * EVEN_IN + c : nullptr;
        drow = (bf16_t*)(ws + WS_WEIN) + ((size_t)e * NE + tn * 64 + wn) * 1024 + tk * 64; return; }
    T -= WT_EIN;
    if (T < WT_EOUT) { const int e = T / 256, r = T % 256, tn = r % 16, tk = r / 16; K = 1024; ld = 1024;
        colp = ap->even_w_out + ((size_t)e * 1024 + tk * 64) * 1024 + tn * 64 + nl; drow = (bf16_t*)(ws + WS_WEOUT) + ((size_t)e * 1024 + tn * 64 + wn) * 1024 + tk * 64; return; }
    T -= WT_EOUT;
    if (T < WT_OIN) { const int e = T / 512, r = T % 512, tn = r % 32, tk = r / 32; K = 1024; ld = 2048;
        ksc = ap->pre_norm + (size_t)(2 * e + 1) * DM + tk * 64;
        colp = ap->odd_w_in + ((size_t)e * 1024 + tk * 64) * 2048 + tn * 64 + nl; drow = (bf16_t*)(ws + WS_WOIN) + ((size_t)e * 2048 + tn * 64 + wn) * 1024 + tk * 64; return; }
    T -= WT_OIN;
    if (T < WT_OOUT) { const int e = T / 256, r = T % 256, tn = r % 16, tk = r / 16; K = 1024; ld = 1024;
        colp = ap->odd_w_out + ((size_t)e * 1024 + tk * 64) * 1024 + tn * 64 + nl; drow = (bf16_t*)(ws + WS_WOOUT) + ((size_t)e * 1024 + tn * 64 + wn) * 1024 + tk * 64; return; }
    T -= WT_OOUT;
    {
        const int o = T / 128, r = T % 128, tn = r % 32, tk = r / 32; K = 256; ld = 256;
        const int cp = tn * 64, nb = cp >> 9, j = (cp >> 8) & 1, gs = (cp >> 7) & 1, e0 = j * 128 + (cp & 127);
        const float* src = gs ? ap->odd_w_x : ap->odd_w_a;
        colp = src + (((size_t)(o * 4 + nb)) * 256 + tk * 64) * 256 + e0 + nl; drow = (bf16_t*)(ws + WS_WOG) + ((size_t)o * 2048 + cp + wn) * 256 + tk * 64; }
}
__device__ __forceinline__ void weight_phase(LAS float* tile, ArgsP ap, unsigned char* ws) {
    const int tid = opaque_tid(), G = gridDim.x, nl = tid & 63, k0 = tid >> 6, wn = tid >> 3, wk = (tid & 7) * 8;
    float r[8]; const float* colp; const float* ksc; bf16_t* drow; int ld, K;
#define WT_LOAD() do { _Pragma("unroll") for (int i = 0; i < 8; ++i) r[i] = colp ? colp[(size_t)(k0 + 8 * i) * ld] * (ksc ? ksc[k0 + 8 * i] : 1.0f) : 0.f; } while (0)
    int T = blockIdx.x;
    if (T < WT_ALL) { wtile_decode(T, ap, ws, nl, wn, colp, ld, drow, K, ksc); WT_LOAD(); }
    for (; T < WT_ALL; T += G) {
        bf16_t* dcur = drow;
#pragma unroll
        for (int i = 0; i < 8; ++i) tile[(k0 + 8 * i) * 65 + nl] = r[i];
        __syncthreads();
        if (T + G < WT_ALL) { wtile_decode(T + G, ap, ws, nl, wn, colp, ld, drow, K, ksc); WT_LOAD(); }
        float v[8];
#pragma unroll
        for (int j = 0; j < 8; ++j) v[j] = tile[(wk + j) * 65 + wn];
        u32x4 w; w.x = cvt_pk_bf16(v[0], v[1]); w.y = cvt_pk_bf16(v[2], v[3]); w.z = cvt_pk_bf16(v[4], v[5]); w.w = cvt_pk_bf16(v[6], v[7]);
        *(u32x4*)(dcur + wk) = w;
        __syncthreads();
    }
#undef WT_LOAD
}

__device__ __forceinline__ int t5_bucket(int n) {
    if (n < 16) return n;
    int v = 16 + (int)(__logf((float)n / 16.0f) / 2.0794415416798357f * 16.0f);
    return v < 31 ? v : 31;
}

__device__ __forceinline__ void norm_phase(const float* xin, const bf16_t* xh_in, const float* s_in, const bf16_t* mix, const float* postw, bf16_t* xh_out, float* s_out, float* outf) {
    const int tid0 = opaque_tid(), lane = tid0 & 63, wave = tid0 >> 6;
    for (int row = blockIdx.x * 8 + wave; row < T; row += gridDim.x * 8) {
        f32x4 xv[4];
        if (xin) {
#pragma unroll
            for (int i = 0; i < 4; ++i) xv[i] = *(const f32x4*)(xin + (size_t)row * DM + lane * 4 + 256 * i);
        } else {
            const float sc = s_in[row];
#pragma unroll
            for (int i = 0; i < 4; ++i) { const u32x2 xw = *(const u32x2*)(xh_in + (size_t)row * DM + lane * 4 + 256 * i); xv[i] = (f32x4){bflo(xw.x), bfhi(xw.x), bflo(xw.y), bfhi(xw.y)} * sc; }
        }
        if (mix) {
            f32x4 mv[4]; float ss = 0.f;
#pragma unroll
            for (int i = 0; i < 4; ++i) { const u32x2 mw = *(const u32x2*)(mix + (size_t)row * DM + lane * 4 + 256 * i); mv[i] = (f32x4){bflo(mw.x), bfhi(mw.x), bflo(mw.y), bfhi(mw.y)};
                ss += mv[i][0] * mv[i][0] + mv[i][1] * mv[i][1] + mv[i][2] * mv[i][2] + mv[i][3] * mv[i][3]; }
#pragma unroll
            for (int o = 32; o >= 1; o >>= 1) ss += __shfl_xor(ss, o);
            const float r = rsqrtf(ss * (1.0f / DM) + EPS);
#pragma unroll
            for (int i = 0; i < 4; ++i) { const f32x4 w = *(const f32x4*)(postw + lane * 4 + 256 * i); xv[i] += mv[i] * r * w; }
        }
        if (outf) {
#pragma unroll
            for (int i = 0; i < 4; ++i) *(f32x4*)(outf + (size_t)row * DM + lane * 4 + 256 * i) = xv[i];
        } else {
            float ss = 0.f;
#pragma unroll
            for (int i = 0; i < 4; ++i) ss += xv[i][0] * xv[i][0] + xv[i][1] * xv[i][1] + xv[i][2] * xv[i][2] + xv[i][3] * xv[i][3];
#pragma unroll
            for (int o = 32; o >= 1; o >>= 1) ss += __shfl_xor(ss, o);
            const float ms = ss * (1.0f / DM) + EPS, r = rsqrtf(ms);
            if (lane == 0) s_out[row] = ms * r;
#pragma unroll
            for (int i = 0; i < 4; ++i) { const f32x4 y = xv[i] * r;
                u32x2 o2; o2.x = cvt_pk_bf16(y[0], y[1]); o2.y = cvt_pk_bf16(y[2], y[3]); *(u32x2*)(xh_out + (size_t)row * DM + lane * 4 + 256 * i) = o2; }
        }
    }
}

constexpr int NM_LD = 1032;
__device__ __forceinline__ void norm_misc_phase(LAS unsigned char* lds, const float* xin, const bf16_t* xh_in, const float* s_in, const bf16_t* mix, const float* postw, bf16_t* xh_out, float* s_out,
                                                const bf16_t* Wm  , bf16_t* IK, float* IW, float* BLR) {
    const int tid0 = opaque_tid(), lane = tid0 & 63, wave = __builtin_amdgcn_readfirstlane(tid0 >> 6);
    LAS bf16_t* xs = (LAS bf16_t*)lds;
    for (int pq = blockIdx.x; pq < T / 64; pq += gridDim.x) {
        for (int i = 0; i < 8; ++i) {
            const int rl = wave * 8 + i, row = pq * 64 + rl;
            f32x4 xv[4];
            if (xin) {
#pragma unroll
                for (int k = 0; k < 4; ++k) xv[k] = *(const f32x4*)(xin + (size_t)row * DM + lane * 4 + 256 * k);
            } else {
                const float sc = s_in[row];
#pragma unroll
                for (int k = 0; k < 4; ++k) { const u32x2 xw = *(const u32x2*)(xh_in + (size_t)row * DM + lane * 4 + 256 * k); xv[k] = (f32x4){bflo(xw.x), bfhi(xw.x), bflo(xw.y), bfhi(xw.y)} * sc; }
            }
            if (mix) {
                f32x4 mv[4]; float ss = 0.f;
#pragma unroll
                for (int k = 0; k < 4; ++k) { const u32x2 mw = *(const u32x2*)(mix + (size_t)row * DM + lane * 4 + 256 * k); mv[k] = (f32x4){bflo(mw.x), bfhi(mw.x), bflo(mw.y), bfhi(mw.y)};
                    ss += mv[k][0] * mv[k][0] + mv[k][1] * mv[k][1] + mv[k][2] * mv[k][2] + mv[k][3] * mv[k][3]; }
#pragma unroll
                for (int o = 32; o >= 1; o >>= 1) ss += __shfl_xor(ss, o);
                const float r = rsqrtf(ss * (1.0f / DM) + EPS);
#pragma unroll
                for (int k = 0; k < 4; ++k) { const f32x4 w = *(const f32x4*)(postw + lane * 4 + 256 * k); xv[k] += mv[k] * r * w; }
            }
            float ss = 0.f;
#pragma unroll
            for (int k = 0; k < 4; ++k) ss += xv[k][0] * xv[k][0] + xv[k][1] * xv[k][1] + xv[k][2] * xv[k][2] + xv[k][3] * xv[k][3];
#pragma unroll
            for (int o = 32; o >= 1; o >>= 1) ss += __shfl_xor(ss, o);
            const float ms = ss * (1.0f / DM) + EPS, r = rsqrtf(ms);
            if (lane == 0) s_out[row] = ms * r;
#pragma unroll
            for (int k = 0; k < 4; ++k) { const f32x4 y = xv[k] * r;
                u32x2 o2; o2.x = cvt_pk_bf16(y[0], y[1]); o2.y = cvt_pk_bf16(y[2], y[3]);
                *(u32x2*)(xh_out + (size_t)row * DM + lane * 4 + 256 * k) = o2; *(LAS u32x2*)(xs + rl * NM_LD + lane * 4 + 256 * k) = o2; }
        }
        __syncthreads();
        if (wave < 6) {
            const int n = lane & 15, kq = lane >> 4;
            f32x4 acc[4];
#pragma unroll
            for (int mt = 0; mt < 4; ++mt) acc[mt] = (f32x4){0.f, 0.f, 0.f, 0.f};
            const bf16_t* wrow = Wm + (size_t)(16 * wave + n) * 1024 + 8 * kq;
            for (int ks = 0; ks < 32; ks += 4) {
                bf16x8 bf[4];
#pragma unroll
                for (int u = 0; u < 4; ++u) bf[u] = *(const bf16x8*)(wrow + (ks + u) * 32);
#pragma unroll
                for (int u = 0; u < 4; ++u)
#pragma unroll
                    for (int mt = 0; mt < 4; ++mt) { const bf16x8 af = *(const LAS bf16x8*)(xs + (16 * mt + n) * NM_LD + (ks + u) * 32 + 8 * kq);
                        acc[mt] = __builtin_amdgcn_mfma_f32_16x16x32_bf16(af, bf[u], acc[mt], 0, 0, 0); }
            }
#pragma unroll
            for (int mt = 0; mt < 4; ++mt)
#pragma unroll
                for (int j = 0; j < 4; ++j) { const int row = pq * 64 + 16 * mt + 4 * kq + j; const float v = acc[mt][j];
                    if (wave < 4) { const int cc = 16 * wave + n, q = cc >> 3, bb = row >> 12, sq = row & 4095;
                        IK[((((size_t)(bb * 128 + (sq >> 5)) * 4 + (q >> 1)) * 2 + (q & 1)) * 32 + (sq & 31)) * 8 + (cc & 7)] = f2bf(v); }
                    else if (wave == 4) { if (n < 8) IW[(size_t)row * 8 + n] = v * IW_SCALE; else BLR[(size_t)row * 16 + (n - 8)] = v; }
                    else { if (n < 8) BLR[(size_t)row * 16 + 8 + n] = v; } }
        }
        __syncthreads();
    }
}

#define IDX_AF(AF, b_, t0_) do { \
        const int qi_ = 2 * ((c >> 2) & 1) + (c >> 4), hh_ = (c & 3) + 4 * ((c >> 3) & 1);   \
        _Pragma("unroll") for (int mt = 0; mt < 2; ++mt) { const size_t tq_ = (size_t)(b_) * SEQ + (t0_) + 4 * mt + qi_; \
            _Pragma("unroll") for (int ks = 0; ks < 4; ++ks) AF[mt][ks] = *(const bf16x8*)(IQ + tq_ * 512 + hh_ * 64 + ks * 16 + 8 * g); } } while (0)
#define IDX_WV(WV, b_, t0_) do { \
        _Pragma("unroll") for (int mt = 0; mt < 2; ++mt) _Pragma("unroll") for (int qq = 0; qq < 2; ++qq) { const size_t tq_ = (size_t)(b_) * SEQ + (t0_) + 4 * mt + 2 * g + qq; \
            const f32x4 w0_ = *(const f32x4*)(IW + tq_ * 8), w1_ = *(const f32x4*)(IW + tq_ * 8 + 4); \
            WV[mt][qq][0] = w0_[0]; WV[mt][qq][1] = w0_[1]; WV[mt][qq][2] = w0_[2]; WV[mt][qq][3] = w0_[3]; WV[mt][qq][4] = w1_[0]; WV[mt][qq][5] = w1_[1]; WV[mt][qq][6] = w1_[2]; WV[mt][qq][7] = w1_[3]; } } while (0)

__device__ __forceinline__ void indexer_phase(LAS float* sc, const bf16_t* IQ, const bf16_t* IK, const float* IW, u64* MASK, int wave, int lane) {
    const int g = lane >> 5, c = lane & 31, G = gridDim.x;
    bf16x8 af[2][4];
#define IDX_ITEM(k_) ((k_) * G + (((k_) & 1) ? (G - 1 - (int)blockIdx.x) : (int)blockIdx.x))
    { const int it0 = IDX_ITEM(0); if (it0 < 2048) IDX_AF(af, it0 & 3, (511 - (it0 >> 2)) * 8); }
        for (int kk = 0; kk * G < 2048; ++kk) {
    const int it = IDX_ITEM(kk); if (it >= 2048) break;
    const int b = it & 3, t0 = (511 - (it >> 2)) * 8;
    float wv[2][2][8];
    IDX_WV(wv, b, t0);
    const int ntiles = (t0 + 8 + 31) >> 5;
    const bf16_t* ikb = IK + (size_t)b * 128 * 2048 + (size_t)(g * 32 + c) * 8;
#define IDX_LOAD(buf, kt_) do { if ((kt_) < ntiles) { _Pragma("unroll") for (int ks = 0; ks < 4; ++ks) buf[ks] = *(const bf16x8*)(ikb + (size_t)(kt_) * 2048 + ks * 512); } } while (0)
#define IDX_TILE(buf, kt_) do { if ((kt_) < ntiles) { const int key = (kt_) * 32 + c; f32x16 a0, a1; \
        _Pragma("unroll") for (int r = 0; r < 16; ++r) { a0[r] = 0.f; a1[r] = 0.f; } \
        _Pragma("unroll") for (int ks = 0; ks < 4; ++ks) { a0 = __builtin_amdgcn_mfma_f32_32x32x16_bf16(af[0][ks], buf[ks], a0, 0, 0, 0); a1 = __builtin_amdgcn_mfma_f32_32x32x16_bf16(af[1][ks], buf[ks], a1, 0, 0, 0); } \
        _Pragma("unroll") for (int qq = 0; qq < 2; ++qq) { float s0 = 0.f, s1 = 0.f; \
            _Pragma("unroll") for (int h = 0; h < 8; ++h) { s0 += wv[0][qq][h] * fmaxf(a0[8 * qq + h], 0.f); s1 += wv[1][qq][h] * fmaxf(a1[8 * qq + h], 0.f); } \
            sc[(0 + 2 * g + qq) * 4096 + key] = s0; sc[(4 + 2 * g + qq) * 4096 + key] = s1; } } } while (0)
    {
        bf16x8 b0[4], b1[4], b2[4];
        IDX_LOAD(b0, wave); IDX_LOAD(b1, wave + 8);
        for (int kt = wave; kt < ntiles; kt += 24) {
            IDX_LOAD(b2, kt + 16); IDX_TILE(b0, kt);
            IDX_LOAD(b0, kt + 24); IDX_TILE(b1, kt + 8);
            IDX_LOAD(b1, kt + 32); IDX_TILE(b2, kt + 16);
        }
    }
#undef IDX_LOAD
#undef IDX_TILE
    __syncthreads();
    bf16x8 afn[2][4];
    { const int itn = IDX_ITEM(kk + 1); if ((kk + 1) * G < 2048 && itn < 2048) IDX_AF(afn, itn & 3, (511 - (itn >> 2)) * 8); }
    {
        const int t = t0 + wave, nvalid = t + 1, nreg = (nvalid + 63) >> 6, ngrp = (nreg + 7) >> 3;
        const int gfull = nvalid >> 9;
        LAS float* myrow = sc + wave * 4096;
        float sf[64];
#pragma unroll
        for (int jj = 0; jj < 8; ++jj) {
            if (jj < gfull) {
#pragma unroll
                for (int j8 = 0; j8 < 8; ++j8) sf[jj * 8 + j8] = myrow[64 * (jj * 8 + j8) + lane];
            } else if (jj < ngrp) {
#pragma unroll
                for (int j8 = 0; j8 < 8; ++j8) { const int j = jj * 8 + j8, kk = 64 * j + lane; const float v = myrow[kk]; sf[j] = (kk < nvalid) ? v : NEG_INF; }
            } else {
#pragma unroll
                for (int j8 = 0; j8 < 8; ++j8) sf[jj * 8 + j8] = NEG_INF;
            }
        }
        float thr_f = NEG_INF; int need = 0; bool ties = false;
#define CNT_GEF(valf, out) do { int c_ = 0; _Pragma("unroll") for (int jj = 0; jj < 8; ++jj) if (jj < ngrp) { _Pragma("unroll") for (int j8 = 0; j8 < 8; ++j8) c_ += (sf[jj * 8 + j8] >= (valf)) ? 1 : 0; } \
            (out) = wave_sum_i32(c_); } while (0)
        if (nvalid > 256) {
            float mx = NEG_INF, mn = -NEG_INF;
#pragma unroll
            for (int jj = 0; jj < 8; ++jj) { if (jj < gfull) {
#pragma unroll
                for (int j8 = 0; j8 < 8; ++j8) { const float v = sf[jj * 8 + j8]; mx = fmaxf(mx, v); mn = fminf(mn, v); } }
              else if (jj < ngrp) {
#pragma unroll
                for (int j8 = 0; j8 < 8; ++j8) { const float v = sf[jj * 8 + j8]; mx = fmaxf(mx, v); mn = fminf(mn, v == NEG_INF ? -NEG_INF : v); } } }
            mx = wave_max_f32(mx); mn = -wave_max_f32(-mn);
            const float scale = (mx > mn) ? 3839.0f / (mx - mn) : 0.f;
            LAS unsigned* hist = (LAS unsigned*)myrow;
#pragma unroll
            for (int k = 0; k < 16; ++k) *(LAS u32x4*)(hist + 4 * lane + 256 * k) = (u32x4){0u, 0u, 0u, 0u};
            __builtin_amdgcn_fence(__ATOMIC_RELEASE, "wavefront");
#pragma unroll
            for (int jj = 0; jj < 8; ++jj) { if (jj < gfull) {
#pragma unroll
                for (int j8 = 0; j8 < 8; ++j8) { const float v = sf[jj * 8 + j8];
                    int bn = (int)((v - mn) * scale); bn = bn > 3839 ? 3839 : bn; __hip_atomic_fetch_add(hist + (bn >> 6) * 68 + (bn & 63), 1u, __ATOMIC_RELAXED, __HIP_MEMORY_SCOPE_WAVEFRONT); } }
              else if (jj < ngrp) {
#pragma unroll
                for (int j8 = 0; j8 < 8; ++j8) { const float v = sf[jj * 8 + j8];
                    if (v != NEG_INF) { int bn = (int)((v - mn) * scale); bn = bn > 3839 ? 3839 : bn; __hip_atomic_fetch_add(hist + (bn >> 6) * 68 + (bn & 63), 1u, __ATOMIC_RELAXED, __HIP_MEMORY_SCOPE_WAVEFRONT); } } } }
            __builtin_amdgcn_fence(__ATOMIC_ACQ_REL, "wavefront");
            int cs = 0;
            if (lane < 60) {
#pragma unroll
                for (int k = 0; k < 16; ++k) { const u32x4 h4 = *(const LAS u32x4*)(hist + lane * 68 + 4 * k); cs += (int)((h4.x + h4.y) + (h4.z + h4.w)); }
            }
            int C, Bl, cnt_above, nA;
            {
                const int pre = wave_prefix_sum_i32(cs), tot = __builtin_amdgcn_readlane(pre, 63), suf = tot - pre + cs;
                const u64 mk = __ballot(suf >= 256);
                C = 63 - __builtin_clzll(mk);
                const int above_c = __builtin_amdgcn_readlane(suf, C) - __builtin_amdgcn_readlane(cs, C);
                const int bs = (int)hist[C * 68 + lane];
                const int pre2 = wave_prefix_sum_i32(bs), tot2 = __builtin_amdgcn_readlane(pre2, 63), suf2 = tot2 - pre2 + bs;
                const u64 mk2 = __ballot(suf2 >= 256 - above_c);
                Bl = 63 - __builtin_clzll(mk2);
                nA = __builtin_amdgcn_readlane(bs, Bl);
                cnt_above = above_c + __builtin_amdgcn_readlane(suf2, Bl) - nA;
            }
            const int binA = C * 64 + Bl, need1 = 256 - cnt_above;
            if (nA <= 64) {
                unsigned cv = 0u; int pos = 0;
                const float invs = (mx - mn) * (1.0f / 3839.0f), lo_f = mn + ((float)binA - 0.5f) * invs, hi_f = mn + ((float)binA + 1.5f) * invs;
#pragma unroll
                for (int jj = 0; jj < 8; ++jj) if (jj < ngrp) {
#pragma unroll
                    for (int j8 = 0; j8 < 8; ++j8) { const float v = sf[jj * 8 + j8];
                        u64 m = __ballot(v >= lo_f && v < hi_f);
                        if (m) { int bn = (int)((v - mn) * scale); bn = bn > 3839 ? 3839 : bn; m = __ballot(v >= lo_f && v < hi_f && bn == binA); }
                        while (m) { const int l = __builtin_ctzll(m); m &= m - 1ull; const unsigned uu = (unsigned)__builtin_amdgcn_readlane((int)__float_as_uint(v), l);
                            const unsigned kv = (uu & 0x80000000u) ? ~uu : (uu | 0x80000000u); if (lane == pos) cv = kv; ++pos; } } }
                unsigned tc = 0u;
                for (int bit = 31; bit >= 0; --bit) { const unsigned cand = tc | (1u << bit); if (__popcll(__ballot(cv >= cand)) >= need1) tc = cand; }
                thr_f = __uint_as_float((tc & 0x80000000u) ? (tc ^ 0x80000000u) : ~tc);
                const int cgt = cnt_above + __popcll(__ballot(cv > tc)), ceq = __popcll(__ballot(cv == tc));
                need = 256 - cgt; ties = (ceq != need);
            } else {
                unsigned tc = 0u;
                for (int bit = 31; bit >= 0; --bit) { const unsigned cand = tc | (1u << bit); const float cf = __uint_as_float((cand & 0x80000000u) ? (cand ^ 0x80000000u) : ~cand);
                    int cnt; CNT_GEF(cf, cnt); if (cnt >= 256) tc = cand; }
                thr_f = __uint_as_float((tc & 0x80000000u) ? (tc ^ 0x80000000u) : ~tc);
                int cge, cg = 0;
                CNT_GEF(thr_f, cge);
#pragma unroll
                for (int jj = 0; jj < 8; ++jj) if (jj < ngrp) {
#pragma unroll
                    for (int j8 = 0; j8 < 8; ++j8) cg += (sf[jj * 8 + j8] > thr_f) ? 1 : 0; }
                const int cgt = wave_sum_i32(cg);
                need = 256 - cgt; ties = ((cge - cgt) != need);
            }
        }
#undef CNT_GEF
        u64 myword = 0ull;
        if (nvalid <= 256) {
#pragma unroll
            for (int j = 0; j < 4; ++j) { const u64 mm = __ballot(64 * j + lane < nvalid); if (lane == j) myword = mm; }
        } else if (!ties) {
#pragma unroll
            for (int jj = 0; jj < 8; ++jj) if (jj < ngrp) {
#pragma unroll
                for (int j8 = 0; j8 < 8; ++j8) { const int j = jj * 8 + j8; const u64 mm = __ballot(sf[j] >= thr_f); if (lane == j) myword = mm; if ((j & 3) == 3) __builtin_amdgcn_sched_barrier(0); } }
        } else {
            int base = 0;
#pragma unroll
            for (int j = 0; j < 64; ++j) { const bool eq = sf[j] == thr_f; const u64 em = __ballot(eq);
                const int rank = base + (int)__builtin_amdgcn_mbcnt_hi((unsigned)(em >> 32), __builtin_amdgcn_mbcnt_lo((unsigned)em, 0u));
                const u64 mm = __ballot(sf[j] > thr_f || (eq && rank < need)); base += __popcll(em);
                if (lane == j) myword = mm; __builtin_amdgcn_sched_barrier(0); }
        }
        LAS u64* mst = (LAS u64*)(sc + 32768);
        mst[lane * 8 + wave] = myword;
    }
    __syncthreads();
    { const int tid_ = wave * 64 + lane, kt_ = tid_ >> 3, q_ = tid_ & 7; const LAS u64* mst = (const LAS u64*)(sc + 32768);
      MASK[((size_t)b * 64 + kt_) * SEQ + t0 + q_] = mst[kt_ * 8 + q_]; }
#pragma unroll
    for (int mt = 0; mt < 2; ++mt) {
#pragma unroll
        for (int ks = 0; ks < 4; ++ks) af[mt][ks] = afn[mt][ks];
    }
    }
}
#undef IDX_AF
#undef IDX_WV
#undef IDX_ITEM

constexpr int GL_BLR = 0;
constexpr int GL_W2  = GL_BLR + 4096;
constexpr int GL_GP  = GL_W2 + 4096;
constexpr int GL_QD  = GL_GP + 2048;
constexpr int GL_KD  = GL_QD + 64 * 72 * 2;
constexpr int GL_KT  = GL_KD + 64 * 72 * 2;
constexpr int GL_VT  = GL_KT + 64 * 72 * 2;
constexpr int GL_P   = GL_VT + 128 * 72 * 2;
constexpr int GL_O   = GL_P + 64 * 72 * 2;
constexpr int GL_END = GL_O + 64 * 132 * 4;

__device__ __forceinline__ void gla_stage_vt(LAS bf16_t* vt, const u32x4 (&vraw)[2], int tid) {
#pragma unroll
    for (int rep = 0; rep < 2; ++rep) { const int idx = tid + 512 * rep, j = idx >> 4, dv8 = (idx & 15) * 8;
        const u32x4 w = vraw[rep];
        vt[(dv8 + 0) * 72 + j] = (bf16_t)(w.x & 0xFFFF); vt[(dv8 + 1) * 72 + j] = (bf16_t)(w.x >> 16);
        vt[(dv8 + 2) * 72 + j] = (bf16_t)(w.y & 0xFFFF); vt[(dv8 + 3) * 72 + j] = (bf16_t)(w.y >> 16);
        vt[(dv8 + 4) * 72 + j] = (bf16_t)(w.z & 0xFFFF); vt[(dv8 + 5) * 72 + j] = (bf16_t)(w.z >> 16);
        vt[(dv8 + 6) * 72 + j] = (bf16_t)(w.w & 0xFFFF); vt[(dv8 + 7) * 72 + j] = (bf16_t)(w.w >> 16); }
}
__device__ __forceinline__ void gla_prep_state(LAS unsigned char* lds, const float* gw2, const float* gb2, int b, int hh, int n,
                                               bf16_t* BQ, bf16_t* BK, const bf16_t* BV, const float* BLR, float* DECAY) {
    const int tid = opaque_tid(), d = tid & 63, jg = tid >> 6;
    const size_t tok0 = (size_t)b * SEQ + n * 64;
    LAS float* blr = (LAS float*)(lds + GL_BLR); LAS float* w2s = (LAS float*)(lds + GL_W2); LAS float* gp = (LAS float*)(lds + GL_GP);
    LAS bf16_t* kt = (LAS bf16_t*)(lds + GL_KT); LAS bf16_t* vt = (LAS bf16_t*)(lds + GL_VT);
    bf16_t kraw[8], qraw[8]; u32x4 vraw[2];
#pragma unroll
    for (int i = 0; i < 8; ++i) { kraw[i] = BK[(tok0 + 8 * jg + i) * 256 + hh * 64 + d]; qraw[i] = BQ[(tok0 + 8 * jg + i) * 256 + hh * 64 + d]; }
#pragma unroll
    for (int rep = 0; rep < 2; ++rep) { const int idx = tid + 512 * rep; vraw[rep] = *(const u32x4*)(BV + (tok0 + (idx >> 4)) * 512 + hh * 128 + (idx & 15) * 8); }
    if (tid < 256) { *(LAS f32x4*)(blr + tid * 4) = *(const f32x4*)(BLR + tok0 * 16 + tid * 4); }
    else { const int q = tid - 256, r = q >> 4, d4 = (q & 15) * 4; *(LAS f32x4*)(w2s + r * 64 + d4) = *(const f32x4*)(gw2 + (size_t)r * 256 + hh * 64 + d4); }
    __syncthreads();
    float cs[8];
    { const float b2 = gb2[hh * 64 + d]; float run = 0.f; float w2c[16];
#pragma unroll
      for (int r = 0; r < 16; ++r) w2c[r] = w2s[r * 64 + d];
#pragma unroll
      for (int i = 0; i < 8; ++i) { float z = b2;
#pragma unroll
          for (int q = 0; q < 4; ++q) { const f32x4 bl = *(const LAS f32x4*)(blr + (8 * jg + i) * 16 + 4 * q);
              z += bl[0] * w2c[4 * q + 0]; z += bl[1] * w2c[4 * q + 1]; z += bl[2] * w2c[4 * q + 2]; z += bl[3] * w2c[4 * q + 3]; }
          const float la = -(fmaxf(-z, 0.f) + __logf(1.0f + __expf(-fabsf(z)))) * (1.0f / 16.0f);
          run += la; cs[i] = run; }
      gp[jg * 64 + d] = run; }
    __syncthreads();
    float off = 0.f, glast = 0.f;
#pragma unroll
    for (int j = 0; j < 8; ++j) { const float v = gp[j * 64 + d]; if (j < jg) off += v; glast += v; }
    const float eglast = __expf(glast);
    if (jg == 0) DECAY[((size_t)(b * 4 + hh) * 64 + n) * 64 + d] = eglast;
    unsigned ktw[4];
#pragma unroll
    for (int i = 0; i < 8; i += 2) {
        float ktv[2];
#pragma unroll
        for (int ii = 0; ii < 2; ++ii) { const int j = 8 * jg + i + ii; const float G = off + cs[i + ii];
            const float kv = bf2f(kraw[i + ii]), qv = bf2f(qraw[i + ii]);
            const float eg = __expf(G), eng = __builtin_amdgcn_rcpf(eg), kdv = kv * eng;
            ktv[ii] = kdv * eglast;
            BQ[(tok0 + j) * 256 + hh * 64 + d] = (bf16_t)(cvt_pk_bf16(qv * 0.125f * eg, 0.f) & 0xFFFFu);
            BK[(tok0 + j) * 256 + hh * 64 + d] = (bf16_t)(cvt_pk_bf16(kdv, 0.f) & 0xFFFFu); }
        ktw[i >> 1] = cvt_pk_bf16(ktv[0], ktv[1]);
    }
    *(LAS u32x4*)(kt + d * 72 + 8 * jg) = (u32x4){ktw[0], ktw[1], ktw[2], ktw[3]};
    gla_stage_vt(vt, vraw, tid);
    __syncthreads();
}
__device__ __forceinline__ void gla_prep_out(LAS unsigned char* lds, int b, int hh, int n, const bf16_t* BQ, const bf16_t* BK, const bf16_t* BV) {
    const int tid = opaque_tid(), row = tid >> 3, ch = (tid & 7) * 8;
    const size_t tok0 = (size_t)b * SEQ + n * 64;
    LAS bf16_t* qd = (LAS bf16_t*)(lds + GL_QD); LAS bf16_t* kd = (LAS bf16_t*)(lds + GL_KD); LAS bf16_t* vt = (LAS bf16_t*)(lds + GL_VT);
    u32x4 vraw[2];
    const u32x4 qw = *(const u32x4*)(BQ + (tok0 + row) * 256 + hh * 64 + ch), kw = *(const u32x4*)(BK + (tok0 + row) * 256 + hh * 64 + ch);
#pragma unroll
    for (int rep = 0; rep < 2; ++rep) { const int idx = tid + 512 * rep; vraw[rep] = *(const u32x4*)(BV + (tok0 + (idx >> 4)) * 512 + hh * 128 + (idx & 15) * 8); }
    *(LAS u32x4*)(qd + row * 72 + ch) = qw; *(LAS u32x4*)(kd + row * 72 + ch) = kw;
    gla_stage_vt(vt, vraw, tid);
    __syncthreads();
}

__device__ __forceinline__ void gla_state_item(LAS unsigned char* lds, const float* gw2, const float* gb2, int item, bf16_t* BQ, bf16_t* BK, const bf16_t* BV, const float* BLR, float* DECAY, float* GSTATE) {
    const int b = item >> 8, hh = (item >> 6) & 3, n = item & 63;
    gla_prep_state(lds, gw2, gb2, b, hh, n, BQ, BK, BV, BLR, DECAY);
    const int tid1 = opaque_tid(), lane = tid1 & 63, wave = tid1 >> 6, g = lane >> 5, c = lane & 31, mt = wave >> 1, nt = wave & 1;
    LAS bf16_t* kt = (LAS bf16_t*)(lds + GL_KT); LAS bf16_t* vt = (LAS bf16_t*)(lds + GL_VT);
    f32x16 acc;
#pragma unroll
    for (int r = 0; r < 16; ++r) acc[r] = 0.f;
#pragma unroll
    for (int ks = 0; ks < 4; ++ks) { const bf16x8 af = *(const LAS bf16x8*)(vt + (32 * mt + c) * 72 + ks * 16 + 8 * g); const bf16x8 bf = *(const LAS bf16x8*)(kt + (32 * nt + c) * 72 + ks * 16 + 8 * g);
        acc = __builtin_amdgcn_mfma_f32_32x32x16_bf16(af, bf, acc, 0, 0, 0); }
    float* dst = GSTATE + ((size_t)(b * 4 + hh) * 64 + n) * 8192;
#pragma unroll
    for (int r = 0; r < 16; ++r) { const int dv = 32 * mt + (r & 3) + 8 * (r >> 2) + 4 * g; dst[dv * 64 + 32 * nt + c] = acc[r]; }
    __syncthreads();
}

__device__ __forceinline__ void gla_out_item(LAS unsigned char* lds, const float* gw2, const float* gb2, int item, const bf16_t* BQ, const bf16_t* BK, const bf16_t* BV, const float* BLR, const bf16_t* BG,
                                              const bf16_t* SPREV, bf16_t* MIXIN) {
    const int b = item >> 8, hh = (item >> 6) & 3, n = item & 63;
    const int tid = opaque_tid(), lane = tid & 63, wave = tid >> 6, g = lane >> 5, c = lane & 31;
    bf16x8 spf[4]; u32x4 g0, g1;
    { const bf16_t* sp = SPREV + ((size_t)(b * 4 + hh) * 64 + n) * 8192 + (size_t)(32 * (wave & 3) + c) * 64 + 8 * g;
#pragma unroll
      for (int ks = 0; ks < 4; ++ks) spf[ks] = *(const bf16x8*)(sp + ks * 16);
      const size_t tokg = (size_t)b * SEQ + n * 64 + (tid >> 3);
      g0 = *(const u32x4*)(BG + tokg * 512 + hh * 128 + (tid & 7) * 16); g1 = *(const u32x4*)(BG + tokg * 512 + hh * 128 + (tid & 7) * 16 + 8); }
    gla_prep_out(lds, b, hh, n, BQ, BK, BV);
    LAS bf16_t* qd = (LAS bf16_t*)(lds + GL_QD); LAS bf16_t* kd = (LAS bf16_t*)(lds + GL_KD); LAS bf16_t* vt = (LAS bf16_t*)(lds + GL_VT); LAS bf16_t* P = (LAS bf16_t*)(lds + GL_P);
    LAS float* o = (LAS float*)(lds + GL_O);
    if (wave < 4) {
        const int mt = wave >> 1, nt = wave & 1;
        f32x16 acc;
#pragma unroll
        for (int r = 0; r < 16; ++r) acc[r] = 0.f;
        if (!(mt == 0 && nt == 1)) {
#pragma unroll
            for (int ks = 0; ks < 4; ++ks) { const bf16x8 af = *(const LAS bf16x8*)(qd + (32 * mt + c) * 72 + ks * 16 + 8 * g); const bf16x8 bf = *(const LAS bf16x8*)(kd + (32 * nt + c) * 72 + ks * 16 + 8 * g);
                acc = __builtin_amdgcn_mfma_f32_32x32x16_bf16(af, bf, acc, 0, 0, 0); }
        }
#pragma unroll
        for (int r = 0; r < 16; ++r) { const int i = 32 * mt + (r & 3) + 8 * (r >> 2) + 4 * g, j = 32 * nt + c; P[i * 72 + j] = f2bf(j <= i ? acc[r] : 0.f); }
    }
    __syncthreads();
    {
        const int mt = wave >> 2, nt = wave & 3;
        f32x16 acc;
#pragma unroll
        for (int r = 0; r < 16; ++r) acc[r] = 0.f;
#pragma unroll
        for (int ks = 0; ks < 4; ++ks) { const bf16x8 af = *(const LAS bf16x8*)(P + (32 * mt + c) * 72 + ks * 16 + 8 * g); const bf16x8 bf = *(const LAS bf16x8*)(vt + (32 * nt + c) * 72 + ks * 16 + 8 * g);
            acc = __builtin_amdgcn_mfma_f32_32x32x16_bf16(af, bf, acc, 0, 0, 0); }
#pragma unroll
        for (int ks = 0; ks < 4; ++ks) { const bf16x8 af = *(const LAS bf16x8*)(qd + (32 * mt + c) * 72 + ks * 16 + 8 * g); acc = __builtin_amdgcn_mfma_f32_32x32x16_bf16(af, spf[ks], acc, 0, 0, 0); }
#pragma unroll
        for (int r = 0; r < 16; ++r) { const int i = 32 * mt + (r & 3) + 8 * (r >> 2) + 4 * g; o[i * 132 + 32 * nt + c] = acc[r]; }
    }
    __syncthreads();
    {
        const int row = tid >> 3, part = tid & 7; float v[16]; float ss = 0.f;
#pragma unroll
        for (int k = 0; k < 16; ++k) { v[k] = o[row * 132 + part * 16 + k]; ss += v[k] * v[k]; }
        ss += __shfl_xor(ss, 1); ss += __shfl_xor(ss, 2); ss += __shfl_xor(ss, 4);
        const float r = rsqrtf(ss * (1.0f / 128.0f) + EPS);
        const size_t tok = (size_t)b * SEQ + n * 64 + row;
        const float gv[16] = {bflo(g0.x), bfhi(g0.x), bflo(g0.y), bfhi(g0.y), bflo(g0.z), bfhi(g0.z), bflo(g0.w), bfhi(g0.w),
                              bflo(g1.x), bfhi(g1.x), bflo(g1.y), bfhi(g1.y), bflo(g1.z), bfhi(g1.z), bflo(g1.w), bfhi(g1.w)};
        unsigned w[8];
#pragma unroll
        for (int k = 0; k < 8; ++k) w[k] = cvt_pk_bf16(v[2 * k] * r * gv[2 * k], v[2 * k + 1] * r * gv[2 * k + 1]);
        bf16_t* dp = MIXIN + tok * 1024 + 512 + hh * 128 + part * 16;
        *(u32x4*)dp = (u32x4){w[0], w[1], w[2], w[3]}; *(u32x4*)(dp + 8) = (u32x4){w[4], w[5], w[6], w[7]};
    }
    __syncthreads();
}

constexpr int AT_K0 = 0, AT_V0 = 9216, AT_STAGE = 18432, AT_BT = 2 * AT_STAGE;
constexpr float LOG2E = 1.4426950408889634f, AT_C1 = 0.125f * LOG2E, AT_THR = 8.0f;

template <bool NEAR>
__device__ __forceinline__ void attn_tile(const LAS bf16_t* Kt, const LAS bf16_t* Vt, const LAS float* btl, const bf16x8 (&qf)[4], bf16x8& qx, const bf16x8 kx, f32x16& O0, f32x16& O1, float& m_ref, f32x16& Lt,
                                          u64 mw, int tq, int key0, int g, int c) {
    const int pc = (c & 0x13) | ((c & 4) << 1) | ((c & 8) >> 1);
    f32x16 s0, s1;
#pragma unroll
    for (int r = 0; r < 16; ++r) { s0[r] = 0.f; s1[r] = 0.f; }
#pragma unroll
    for (int ks = 0; ks < 4; ++ks) {
        const bf16x8 k0 = *(const LAS bf16x8*)(Kt + pc * 72 + ks * 16 + 8 * g), k1 = *(const LAS bf16x8*)(Kt + (32 + pc) * 72 + ks * 16 + 8 * g);
        s0 = __builtin_amdgcn_mfma_f32_32x32x16_bf16(k0, qf[ks], s0, 0, 0, 0); s1 = __builtin_amdgcn_mfma_f32_32x32x16_bf16(k1, qf[ks], s1, 0, 0, 0);
    }
    s0 = __builtin_amdgcn_mfma_f32_32x32x16_bf16(kx, qx, s0, 0, 0, 0); s1 = __builtin_amdgcn_mfma_f32_32x32x16_bf16(kx, qx, s1, 0, 0, 0);
    const unsigned w0 = (unsigned)mw >> (8 * g), w1 = (unsigned)(mw >> 32) >> (8 * g);
    float x0[16], x1[16];
#pragma unroll
    for (int r = 0; r < 16; ++r) {
        if (NEAR) { const LAS float* pb = btl + (tq - key0 - 8 * g + 96 - 63);
            x0[r] = s0[r] + pb[63 - (16 * (r >> 3) + (r & 7))]; x1[r] = s1[r] + pb[63 - (16 * (r >> 3) + (r & 7) + 32)]; }
        else { x0[r] = s0[r]; x1[r] = s1[r]; }
    }
    float mx = fmaxf(fmaxf(x0[15], x0[14]), fmaxf(x1[15], x1[14]));
    asm("v_max3_f32 %0, %0, %1, %2\n\tv_max3_f32 %0, %0, %3, %4\n\tv_max3_f32 %0, %0, %5, %6\n\tv_max3_f32 %0, %0, %7, %8\n\tv_max3_f32 %0, %0, %9, %10\n\tv_max3_f32 %0, %0, %11, %12\n\tv_max3_f32 %0, %0, %13, %14"
        : "+v"(mx) : "v"(x0[0]), "v"(x1[0]), "v"(x0[1]), "v"(x1[1]), "v"(x0[2]), "v"(x1[2]), "v"(x0[3]), "v"(x1[3]), "v"(x0[4]), "v"(x1[4]), "v"(x0[5]), "v"(x1[5]), "v"(x0[6]), "v"(x1[6]));
    asm("v_max3_f32 %0, %0, %1, %2\n\tv_max3_f32 %0, %0, %3, %4\n\tv_max3_f32 %0, %0, %5, %6\n\tv_max3_f32 %0, %0, %7, %8\n\tv_max3_f32 %0, %0, %9, %10\n\tv_max3_f32 %0, %0, %11, %12\n\tv_max3_f32 %0, %0, %13, %14"
        : "+v"(mx) : "v"(x0[7]), "v"(x1[7]), "v"(x0[8]), "v"(x1[8]), "v"(x0[9]), "v"(x1[9]), "v"(x0[10]), "v"(x1[10]), "v"(x0[11]), "v"(x1[11]), "v"(x0[12]), "v"(x1[12]), "v"(x0[13]), "v"(x1[13]));
    if (__any(mx > AT_THR || mx < -64.0f)) {
        float ms = NEG_INF;
#pragma unroll
        for (int r = 0; r < 16; ++r) { const int bp = 16 * (r >> 3) + (r & 7);
            const float a0 = ((w0 >> bp) & 1u) ? x0[r] : NEG_INF, a1 = ((w1 >> bp) & 1u) ? x1[r] : NEG_INF; ms = fmaxf(ms, fmaxf(a0, a1)); }
        { const auto sw = __builtin_amdgcn_permlane32_swap(__float_as_uint(ms), __float_as_uint(ms), false, false); ms = fmaxf(__uint_as_float(sw[0]), __uint_as_float(sw[1])); }
        const bool empty = (Lt[0] == 0.f);
        float rel = (ms == NEG_INF) ? 0.f : (empty ? ms : fmaxf(ms, 0.f));
        const unsigned mb = cvt_pk_bf16(m_ref + rel, 0.f) << 16;
        const float m_new = __uint_as_float(mb), delta = m_new - m_ref;
        const float alpha = empty ? 1.0f : __builtin_amdgcn_exp2f(-delta);
#pragma unroll
        for (int r = 0; r < 16; ++r) { O0[r] *= alpha; O1[r] *= alpha; Lt[r] *= alpha; x0[r] -= delta; x1[r] -= delta; }
        m_ref = m_new;
        { u32x4 qw = (u32x4){0u, 0u, 0u, 0u}; if (g == 0) qw.x = (mb >> 16) ^ 0x8000u; qx = *(bf16x8*)&qw; }
    }
#pragma unroll
    for (int r = 0; r < 16; ++r) { const int bp = 16 * (r >> 3) + (r & 7);
        const float e0 = __builtin_amdgcn_exp2f(x0[r]), e1 = __builtin_amdgcn_exp2f(x1[r]);
        unsigned b0, b1;
        asm("v_bfe_i32 %0, %1, %2, 1" : "=v"(b0) : "v"(w0), "n"(bp)); asm("v_bfe_i32 %0, %1, %2, 1" : "=v"(b1) : "v"(w1), "n"(bp));
        x0[r] = __uint_as_float(__float_as_uint(e0) & b0); x1[r] = __uint_as_float(__float_as_uint(e1) & b1); }
#pragma unroll
    for (int s = 0; s < 4; ++s) {
        const float* xp = (s < 2) ? x0 : x1; const int o = 8 * (s & 1);
        u32x4 w; w.x = cvt_pk_bf16(xp[o + 0], xp[o + 1]); w.y = cvt_pk_bf16(xp[o + 2], xp[o + 3]); w.z = cvt_pk_bf16(xp[o + 4], xp[o + 5]); w.w = cvt_pk_bf16(xp[o + 6], xp[o + 7]);
        const bf16x8 pb = *(bf16x8*)&w;
        const bf16x8 v0 = *(const LAS bf16x8*)(Vt + c * 72 + s * 16 + 8 * g), v1 = *(const LAS bf16x8*)(Vt + (32 + c) * 72 + s * 16 + 8 * g);
        O0 = __builtin_amdgcn_mfma_f32_32x32x16_bf16(v0, pb, O0, 0, 0, 0); O1 = __builtin_amdgcn_mfma_f32_32x32x16_bf16(v1, pb, O1, 0, 0, 0);
        const u32x4 onew = (u32x4){0x3F803F80u, 0x3F803F80u, 0x3F803F80u, 0x3F803F80u};
        Lt = __builtin_amdgcn_mfma_f32_32x32x16_bf16(*(const bf16x8*)&onew, pb, Lt, 0, 0, 0);
    }
}

__device__ __forceinline__ void attn_item(LAS unsigned char* lds, const bf16_t* Q, const bf16_t* Kb, const bf16_t* VT, const bf16_t* AG, const u64* MASK, const float* btab, bf16_t* MIXIN,
                                          int b, int head, int qb, int tid) {
    const int lane = tid & 63, wave = __builtin_amdgcn_readfirstlane(tid >> 6), g = lane >> 5, c = lane & 31;
    const int tq0 = qb * 256 + wave * 32, tq = tq0 + c;
    const size_t tokq = (size_t)b * SEQ + tq;
    LAS float* btl = (LAS float*)(lds + AT_BT);
    if (tid < 320) { const int rel = tid - 96; btl[tid] = (rel >= 0 && rel < 128) ? (btab[rel * 8 + head] - btab[127 * 8 + head]) * LOG2E : 0.f; }
    bf16x8 qf[4];
#pragma unroll
    for (int ks = 0; ks < 4; ++ks) { const u32x4 qw = *(const u32x4*)(Q + tokq * 512 + head * 64 + ks * 16 + 8 * g);
        u32x4 sw; sw.x = cvt_pk_bf16(bflo(qw.x) * AT_C1, bfhi(qw.x) * AT_C1); sw.y = cvt_pk_bf16(bflo(qw.y) * AT_C1, bfhi(qw.y) * AT_C1);
        sw.z = cvt_pk_bf16(bflo(qw.z) * AT_C1, bfhi(qw.z) * AT_C1); sw.w = cvt_pk_bf16(bflo(qw.w) * AT_C1, bfhi(qw.w) * AT_C1); qf[ks] = *(bf16x8*)&sw; }
    bf16x8 qx, kx;
    { u32x4 z = (u32x4){0u, 0u, 0u, 0u}; qx = *(bf16x8*)&z; if (g == 0) z.x = 0x3F80u; kx = *(bf16x8*)&z; }
    f32x16 O0, O1;
#pragma unroll
    for (int r = 0; r < 16; ++r) { O0[r] = 0.f; O1[r] = 0.f; }
    float m_ref = 0.f; f32x16 Lt;
#pragma unroll
    for (int r = 0; r < 16; ++r) Lt[r] = 0.f;
    const int nt = 4 * qb + 4, my_last = 4 * qb + (wave >> 1);
    const int srow = tid >> 3, sch = tid & 7, sto = (srow * 72 + 8 * sch) * 2;
    const bf16_t* kg = Kb + ((size_t)b * SEQ + srow) * 512 + head * 64 + 8 * sch;
    const bf16_t* vg = VT + ((size_t)(b * 8 + head) * 64 + srow) * 4096 + 8 * sch;
    const u64* Mrow = MASK + (size_t)b * 64 * SEQ + tq;
    { const u32x4 kr = *(const u32x4*)kg, vr = *(const u32x4*)vg; *(LAS u32x4*)(lds + AT_K0 + sto) = kr; *(LAS u32x4*)(lds + AT_V0 + sto) = vr; }
    u64 mw = Mrow[0];
    __syncthreads();
    int ks_near = (tq0 - 175 + 63) >> 6; ks_near = ks_near < 0 ? 0 : ks_near;
#define AT_ITER(BODY) do { const bool more = (kt + 1 < nt); u32x4 kr, vr; u64 mwn = 0ull; \
        if (more) { kr = *(const u32x4*)(kg + (size_t)(kt + 1) * 64 * 512); vr = *(const u32x4*)(vg + (kt + 1) * 64); if (kt + 1 <= my_last) mwn = Mrow[(size_t)(kt + 1) * SEQ]; } \
        { const LAS bf16_t* Kt = (const LAS bf16_t*)(lds + (kt & 1) * AT_STAGE + AT_K0); const LAS bf16_t* Vt = (const LAS bf16_t*)(lds + (kt & 1) * AT_STAGE + AT_V0); BODY; } \
        if (more) { *(LAS u32x4*)(lds + ((kt + 1) & 1) * AT_STAGE + AT_K0 + sto) = kr; *(LAS u32x4*)(lds + ((kt + 1) & 1) * AT_STAGE + AT_V0 + sto) = vr; } \
        mw = mwn; __syncthreads(); } while (0)
    int kt = 0;
    if (wave >= 4) __builtin_amdgcn_s_setprio(1);
    for (; kt < ks_near; ++kt) AT_ITER(attn_tile<false>(Kt, Vt, btl, qf, qx, kx, O0, O1, m_ref, Lt, mw, tq, 64 * kt, g, c));
    for (; kt <= my_last; ++kt) AT_ITER(attn_tile<true>(Kt, Vt, btl, qf, qx, kx, O0, O1, m_ref, Lt, mw, tq, 64 * kt, g, c));
    for (; kt < nt; ++kt) AT_ITER((void)Kt; (void)Vt);
#undef AT_ITER
    __builtin_amdgcn_s_setprio(0);
    const float inv = 1.0f / Lt[0];
#pragma unroll
    for (int mt = 0; mt < 2; ++mt)
#pragma unroll
        for (int rq = 0; rq < 4; ++rq) { const int d0 = 32 * mt + 8 * rq + 4 * g;
            const u32x2 gw = *(const u32x2*)(AG + tokq * 512 + head * 64 + d0);
            const float o0 = (mt ? O1[4 * rq + 0] : O0[4 * rq + 0]) * inv * bflo(gw.x), o1 = (mt ? O1[4 * rq + 1] : O0[4 * rq + 1]) * inv * bfhi(gw.x);
            const float o2 = (mt ? O1[4 * rq + 2] : O0[4 * rq + 2]) * inv * bflo(gw.y), o3 = (mt ? O1[4 * rq + 3] : O0[4 * rq + 3]) * inv * bfhi(gw.y);
            u32x2 ow; ow.x = cvt_pk_bf16(o0, o1); ow.y = cvt_pk_bf16(o2, o3);
            *(u32x2*)(MIXIN + tokq * 1024 + head * 64 + d0) = ow; }
}

constexpr int LDS_BYTES = 147456;
constexpr int MISC_OFF = 131072 + 8192;
constexpr int NPH = 26;

__global__ void __launch_bounds__(NTHREADS, 2) fwd_kernel(Args a) {
    extern __shared__ __attribute__((aligned(16))) unsigned char lds_raw[];
    LAS unsigned char* lds = (LAS unsigned char*)lds_raw;
    const int G = gridDim.x, wg = blockIdx.x;
    volatile LAS unsigned* misc = (volatile LAS unsigned*)(lds + MISC_OFF);
    if (threadIdx.x < 4) misc[threadIdx.x] = 0u;
    __syncthreads();
    XcdBarrier bar; bar.bar = nullptr; bar.x = 0; bar.st = misc;
    if (N_LAUNCHES == 1) bar = xcd_barrier_post((unsigned*)(get_args()->ws + WS_CTL), misc);
    int lo, hi; { ArgsP ap = get_args(); lo = ap->ph_lo; hi = ap->ph_hi; }
#define WSP(type, off) ((type*)(wsl + (off)))
#define IN(k) (lo <= (k) && (k) < hi)
#define SEAM(k) do { if (N_LAUNCHES == 1 && IN(k) && IN((k) + 1)) { XcdBarrier b_ = bar; asm volatile("" : "+s"(b_.bar), "+s"(b_.x)); xcd_barrier(b_); } } while (0)

    if (IN(0)) {
        ArgsP ap = get_args(); unsigned char* wsl = ap->ws;
        weight_phase((LAS float*)lds, ap, wsl);
        if (wg == 0) for (int i = opaque_tid(); i < 1024; i += NTHREADS) { const int rel = i >> 3, h = i & 7; WSP(float, WS_TAB)[i] = ap->rel_bias[t5_bucket(rel) * 8 + h]; }
    }
    SEAM(0);

#define LAYER_BODY(LAYER_) { constexpr int layer = (LAYER_); \
        const int pb = 1 + 6 * layer, e = layer >> 1; \
        constexpr bool even = (layer & 1) == 0; \
        if (IN(pb + 0)) { \
            ArgsP ap = get_args(); unsigned char* wsl = ap->ws; \
            const bf16_t* Wm = WSP(bf16_t, WS_WEIN) + ((size_t)e * NE + 4096) * 1024; \
            if (layer == 0) norm_misc_phase(lds, ap->x, nullptr, nullptr, nullptr, nullptr, WSP(bf16_t, WS_H), WSP(float, WS_XS), Wm, WSP(bf16_t, WS_IK), WSP(float, WS_IW), WSP(float, WS_BLR)); \
            else if (even) norm_misc_phase(lds, nullptr, WSP(bf16_t, WS_H), WSP(float, WS_XS), WSP(bf16_t, WS_MIX), ap->post_norm + (layer - 1) * DM, WSP(bf16_t, WS_H), WSP(float, WS_XS), Wm, WSP(bf16_t, WS_IK), WSP(float, WS_IW), WSP(float, WS_BLR)); \
            else norm_phase(nullptr, WSP(bf16_t, WS_H), WSP(float, WS_XS), WSP(bf16_t, WS_MIX), ap->post_norm + (layer - 1) * DM, WSP(bf16_t, WS_H), WSP(float, WS_XS), nullptr); \
        } \
        SEAM(pb + 0); \
        if (even) { \
            if (IN(pb + 1)) { \
                ArgsP ap = get_args(); unsigned char* wsl = ap->ws; \
                pg8::Gemm gm{WSP(bf16_t, WS_H), WSP(bf16_t, WS_WEIN) + (size_t)e * NE * 1024, T, 4096, 1024, 1024, 1 << 30, 0}; pg8::StaticOrder S; S.init(T, 4096, G, wg); \
                EpiEvenIn E{WSP(bf16_t, WS_Q), WSP(bf16_t, WS_K), WSP(bf16_t, WS_VT), WSP(bf16_t, WS_AG), WSP(bf16_t, WS_IQ), WSP(bf16_t, WS_BQ), WSP(bf16_t, WS_BK), WSP(bf16_t, WS_BV), WSP(bf16_t, WS_BG), \
                            WSP(bf16_t, WS_IK), WSP(float, WS_IW), WSP(float, WS_BLR)}; \
                pg8::gemm_phase(lds, gm, S, E); \
            } \
            SEAM(pb + 1); \
            if (IN(pb + 2)) { \
                ArgsP ap = get_args(); unsigned char* wsl = ap->ws; \
                { const int tid = opaque_tid(), lane = tid & 63, wave = __builtin_amdgcn_readfirstlane(tid >> 6); \
                  indexer_phase((LAS float*)lds, WSP(bf16_t, WS_IQ), WSP(bf16_t, WS_IK), WSP(float, WS_IW), WSP(u64, WS_MASK), wave, lane); } \
                { const float* gw2 = ap->even_gate_w2 + (size_t)e * 16 * 256; const float* gb2 = ap->even_gate_b2 + (size_t)e * 256; \
                  for (int it = wg; it < 1024; it += G) gla_state_item(lds, gw2, gb2, it, WSP(bf16_t, WS_BQ), WSP(bf16_t, WS_BK), WSP(bf16_t, WS_BV), WSP(float, WS_BLR), WSP(float, WS_DECAY), WSP(float, WS_MIXIN)); } \
            } \
            SEAM(pb + 2); \
            if (IN(pb + 3)) { \
                ArgsP ap = get_args(); unsigned char* wsl = ap->ws; \
                const float* GSTATE = WSP(float, WS_MIXIN); const float* DECAY = WSP(float, WS_DECAY); bf16_t* SPREV = WSP(bf16_t, WS_SPREV); \
                for (int el = wg * NTHREADS + opaque_tid(); el < 16 * 8192; el += G * NTHREADS) { \
                    const int bh = el >> 13, rem = el & 8191, dk = rem & 63; float Sv = 0.f; \
                    for (int n = 0; n < 64; ++n) { const size_t o = ((size_t)bh * 64 + n) * 8192 + rem; SPREV[o] = f2bf(Sv); Sv = DECAY[((size_t)bh * 64 + n) * 64 + dk] * Sv + GSTATE[o]; } \
                } \
            } \
            SEAM(pb + 3); \
            if (IN(pb + 4)) { \
                ArgsP ap = get_args(); unsigned char* wsl = ap->ws; \
                { const int tid = opaque_tid(); \
                  for (int it = wg; it < 512; it += G) { const int idx = it & 255, b = idx & 3, head = (idx >> 2) & 7, qbp = idx >> 5, qb = (it < 256) ? 15 - qbp : qbp; \
                      attn_item(lds, WSP(bf16_t, WS_Q), WSP(bf16_t, WS_K), WSP(bf16_t, WS_VT), WSP(bf16_t, WS_AG), WSP(u64, WS_MASK), WSP(float, WS_TAB), WSP(bf16_t, WS_MIXIN), b, head, qb, tid); } } \
                __syncthreads(); \
                { const float* gw2 = ap->even_gate_w2 + (size_t)e * 16 * 256; const float* gb2 = ap->even_gate_b2 + (size_t)e * 256; \
                  for (int it = wg; it < 1024; it += G) gla_out_item(lds, gw2, gb2, it, WSP(bf16_t, WS_BQ), WSP(bf16_t, WS_BK), WSP(bf16_t, WS_BV), WSP(float, WS_BLR), WSP(bf16_t, WS_BG), WSP(bf16_t, WS_SPREV), WSP(bf16_t, WS_MIXIN)); } \
            } \
            SEAM(pb + 4); \
        } else { \
            if (IN(pb + 1)) { \
                ArgsP ap = get_args(); unsigned char* wsl = ap->ws; \
                pg8::Gemm gm{WSP(bf16_t, WS_H), WSP(bf16_t, WS_WOIN) + (size_t)e * 2048 * 1024, T, 2048, 1024, 1024, 1 << 30, 0}; pg8::StaticOrder S; S.init(T, 2048, G, wg); \
                EpiOddIn E{WSP(bf16_t, WS_XR), WSP(bf16_t, WS_GS)}; \
                pg8::gemm_phase(lds, gm, S, E); \
            } \
            SEAM(pb + 1); \
            if (IN(pb + 2)) { \
                ArgsP ap = get_args(); unsigned char* wsl = ap->ws; \
                const bf16_t* XR = WSP(bf16_t, WS_XR); bf16_t* XC = WSP(bf16_t, WS_XC); \
                const float* cw = ap->odd_conv_w + (size_t)e * 4 * 1024; const float* cb = ap->odd_conv_b + (size_t)e * 1024; \
                { const int tid = opaque_tid(), c8 = (tid & 127) * 8; float wq[4][8], bq[8];   \
_Pragma("unroll") \
                  for (int k = 0; k < 8; ++k) { bq[k] = cb[c8 + k]; _Pragma("unroll") for (int j = 0; j < 4; ++j) wq[j][k] = cw[j * 1024 + c8 + k]; } \
                  for (int run = wg * 4 + (tid >> 7); run < T / 8; run += G * 4) { \
                    const int tok0 = run * 8, s0 = tok0 & 4095; float xw[11][8]; \
_Pragma("unroll") \
                    for (int i = 0; i < 11; ++i) { u32x4 w = (u32x4){0u, 0u, 0u, 0u}; if (s0 - 3 + i >= 0) w = *(const u32x4*)(XR + (size_t)(tok0 - 3 + i) * 1024 + c8); \
                        xw[i][0] = bflo(w.x); xw[i][1] = bfhi(w.x); xw[i][2] = bflo(w.y); xw[i][3] = bfhi(w.y); xw[i][4] = bflo(w.z); xw[i][5] = bfhi(w.z); xw[i][6] = bflo(w.w); xw[i][7] = bfhi(w.w); } \
_Pragma("unroll") \
                    for (int o = 0; o < 8; ++o) { float acc[8]; \
_Pragma("unroll") \
                        for (int k = 0; k < 8; ++k) acc[k] = bq[k] + wq[0][k] * xw[o][k] + wq[1][k] * xw[o + 1][k] + wq[2][k] * xw[o + 2][k] + wq[3][k] * xw[o + 3][k]; \
                        u32x4 ow; ow.x = cvt_pk_bf16(acc[0], acc[1]); ow.y = cvt_pk_bf16(acc[2], acc[3]); ow.z = cvt_pk_bf16(acc[4], acc[5]); ow.w = cvt_pk_bf16(acc[6], acc[7]); \
                        *(u32x4*)(XC + (size_t)(tok0 + o) * 1024 + c8) = ow; } \
                  } } \
            } \
            SEAM(pb + 2); \
            if (IN(pb + 3)) { \
                ArgsP ap = get_args(); unsigned char* wsl = ap->ws; \
                pg8::Gemm gm{WSP(bf16_t, WS_XC), WSP(bf16_t, WS_WOG) + (size_t)e * 2048 * 256, T, 2048, 256, 1024, 2, 512}; pg8::StaticOrder S; S.init(T, 2048, G, wg); \
                EpiGates E{ap->odd_b_a + (size_t)e * 1024, ap->odd_b_x + (size_t)e * 1024, ap->odd_lambda + (size_t)e * 1024, WSP(bf16_t, WS_XC), WSP(bf16_t, WS_LOGA), WSP(bf16_t, WS_U)}; \
                pg8::gemm_phase(lds, gm, S, E); \
            } \
            SEAM(pb + 3); \
            if (IN(pb + 4)) { \
                ArgsP ap = get_args(); unsigned char* wsl = ap->ws; \
                const bf16_t* LOGA = WSP(bf16_t, WS_LOGA); const bf16_t* U = WSP(bf16_t, WS_U); const bf16_t* GS = WSP(bf16_t, WS_GS); bf16_t* MIXIN = WSP(bf16_t, WS_MIXIN); \
                LAS float* sl = (LAS float*)lds; LAS float* hl = sl + 512; \
                const int tid = opaque_tid(); \
                for (int it = wg; it < 256; it += G) { \
                      \
                    const int xq = (it & 7) * 8 + ((it >> 3) >> 2), b = xq >> 4, ch = ((xq & 15) * 4 + ((it >> 3) & 3)) * 16 + (tid & 15), jc = tid >> 4; \
                    const size_t base = ((size_t)b * SEQ + jc * 128) * 1024 + ch, sbase = slab_idx(b * SEQ + jc * 128, ch); \
                    float hsum = 0.f, lsum = 0.f; \
                    for (int s0 = 0; s0 < 128; s0 += 16) { float la[16], uu[16]; \
                        _Pragma("unroll") for (int k = 0; k < 16; ++k) { la[k] = bf2f(LOGA[sbase + (size_t)(s0 + k) * 16]); uu[k] = bf2f(U[sbase + (size_t)(s0 + k) * 16]); } \
                        _Pragma("unroll") for (int k = 0; k < 16; ++k) { hsum = __builtin_amdgcn_exp2f(la[k]) * hsum + uu[k]; lsum += la[k]; } } \
                    sl[tid] = lsum; hl[tid] = hsum; \
                    __syncthreads(); \
                    float hin = 0.f; \
                    for (int cj = 0; cj < jc; ++cj) hin = __builtin_amdgcn_exp2f(sl[cj * 16 + (tid & 15)]) * hin + hl[cj * 16 + (tid & 15)]; \
                    float hv = hin; \
                    for (int s0 = 0; s0 < 128; s0 += 16) { float la[16], uu[16], gg[16]; \
                        _Pragma("unroll") for (int k = 0; k < 16; ++k) { la[k] = bf2f(LOGA[sbase + (size_t)(s0 + k) * 16]); uu[k] = bf2f(U[sbase + (size_t)(s0 + k) * 16]); gg[k] = bf2f(GS[sbase + (size_t)(s0 + k) * 16]); } \
                        _Pragma("unroll") for (int k = 0; k < 16; ++k) { hv = __builtin_amdgcn_exp2f(la[k]) * hv + uu[k]; MIXIN[base + (size_t)(s0 + k) * 1024] = f2bf(hv * gg[k]); } } \
                    __syncthreads(); \
                } \
            } \
            SEAM(pb + 4); \
        } \
        if (IN(pb + 5)) { \
            ArgsP ap = get_args(); unsigned char* wsl = ap->ws; \
            const bf16_t* W = (even ? WSP(bf16_t, WS_WEOUT) : WSP(bf16_t, WS_WOOUT)) + (size_t)e * 1024 * 1024; \
            pg8::Gemm gm{WSP(bf16_t, WS_MIXIN), W, T, 1024, 1024, 1024, 1 << 30, 0}; pg8::StaticOrder S; S.init(T, 1024, G, wg); \
            EpiMix E{WSP(bf16_t, WS_MIX)}; \
            pg8::gemm_phase(lds, gm, S, E); \
        } \
        SEAM(pb + 5); \
    }
    LAYER_BODY(0)
    LAYER_BODY(1)
    LAYER_BODY(2)
    LAYER_BODY(3)
#undef LAYER_BODY
    if (IN(25)) { ArgsP ap = get_args(); unsigned char* wsl = ap->ws; norm_phase(nullptr, WSP(bf16_t, WS_H), WSP(float, WS_XS), WSP(bf16_t, WS_MIX), ap->post_norm + 3 * DM, nullptr, nullptr, ap->out); }
#undef IN
#undef SEAM
#undef WSP
}

extern "C" void kernel_launch(void* const* d_in, const int* in_sizes, int n_in, void* d_out, int out_size, void* d_ws, size_t ws_size, hipStream_t stream) {
    static int grid = 0;
    if (grid == 0) {
        if (n_in != 17 || out_size != T * DM || ws_size < WS_END) { fprintf(stderr, "kernel_launch: unexpected sizes (n_in %d, out %d, ws %zu, need %zu)\n", n_in, out_size, ws_size, (size_t)WS_END); grid = -1; return; }
        int dev = 0, cus = 0, per_cu = 0;
        if (hipGetDevice(&dev) != hipSuccess || hipDeviceGetAttribute(&cus, hipDeviceAttributeMultiprocessorCount, dev) != hipSuccess) { grid = -1; return; }
        if (hipFuncSetAttribute((const void*)fwd_kernel, hipFuncAttributeMaxDynamicSharedMemorySize, LDS_BYTES) != hipSuccess) { fprintf(stderr, "kernel_launch: hipFuncSetAttribute failed\n"); grid = -1; return; }
        if (hipOccupancyMaxActiveBlocksPerMultiprocessor(&per_cu, (const void*)fwd_kernel, NTHREADS, LDS_BYTES) != hipSuccess || per_cu < 1) { fprintf(stderr, "kernel_launch: occupancy query says %d\n", per_cu); }
        (void)hipGetLastError();
        grid = cus;
    }
    if (grid < 0) return;
    (void)hipMemsetAsync((char*)d_ws + WS_CTL, 0, CTL_BYTES, stream);
    Args a{};
    a.x = (const float*)d_in[0]; a.rel_bias = (const float*)d_in[1]; a.pre_norm = (const float*)d_in[2]; a.post_norm = (const float*)d_in[3];
    a.even_w_in = (const float*)d_in[4]; a.even_gate_w2 = (const float*)d_in[5]; a.even_gate_b2 = (const float*)d_in[6]; a.even_w_out = (const float*)d_in[7];
    a.odd_w_in = (const float*)d_in[8]; a.odd_conv_w = (const float*)d_in[9]; a.odd_conv_b = (const float*)d_in[10]; a.odd_w_a = (const float*)d_in[11]; a.odd_b_a = (const float*)d_in[12];
    a.odd_w_x = (const float*)d_in[13]; a.odd_b_x = (const float*)d_in[14]; a.odd_lambda = (const float*)d_in[15]; a.odd_w_out = (const float*)d_in[16];
    a.out = (float*)d_out; a.ws = (unsigned char*)d_ws;
    if (N_LAUNCHES == 1) {
        a.ph_lo = 0; a.ph_hi = NPH;
        hipLaunchKernelGGL(fwd_kernel, dim3(grid), dim3(NTHREADS), LDS_BYTES, stream, a);
    } else {
        for (int ph = 0; ph < NPH; ++ph) { a.ph_lo = ph; a.ph_hi = ph + 1; hipLaunchKernelGGL(fwd_kernel, dim3(grid), dim3(NTHREADS), LDS_BYTES, stream, a); }
    }
}
```

```cpp
#include <hip/hip_runtime.h>
#include <stdint.h>
#include <stdio.h>

#ifndef N_LAUNCHES
#define N_LAUNCHES 1
#endif

#define LAS __attribute__((address_space(3)))
typedef unsigned short bf16_t;
typedef short bf16x8 __attribute__((ext_vector_type(8)));
typedef float f32x4 __attribute__((ext_vector_type(4)));
typedef float f32x2 __attribute__((ext_vector_type(2)));
typedef float f32x16 __attribute__((ext_vector_type(16)));
typedef unsigned u32x4 __attribute__((ext_vector_type(4)));
typedef unsigned u32x2 __attribute__((ext_vector_type(2)));
typedef unsigned long long u64;

constexpr int NB = 4, SEQ = 4096, T = NB * SEQ, DM = 1024;
constexpr int EVEN_IN = 4184, NE = 4352;
constexpr int NTHREADS = 512;
constexpr float EPS = 1e-6f;
constexpr float NEG_INF = -__builtin_inff();

constexpr size_t MB = 1024 * 1024;
constexpr size_t WS_CTL   = 0;
constexpr size_t CTL_BYTES = 65536;
constexpr size_t WS_WEIN  = WS_CTL + CTL_BYTES;
constexpr size_t WS_WEOUT = WS_WEIN + (size_t)2 * NE * 1024 * 2;
constexpr size_t WS_WOIN  = WS_WEOUT + 4 * MB;
constexpr size_t WS_WOG   = WS_WOIN + 8 * MB;
constexpr size_t WS_WOOUT = WS_WOG + 2 * MB;
constexpr size_t WS_TAB   = WS_WOOUT + 4 * MB;
constexpr size_t WS_XS    = WS_TAB + 4096;
constexpr size_t WS_H     = WS_XS + 65536;
constexpr size_t WS_MIXIN = WS_H + 32 * MB;
constexpr size_t WS_ACT   = WS_MIXIN + 32 * MB;
constexpr size_t WS_Q     = WS_ACT;
constexpr size_t WS_K     = WS_Q + 16 * MB;
constexpr size_t WS_VT    = WS_K + 16 * MB;
constexpr size_t WS_AG    = WS_VT + 16 * MB;
constexpr size_t WS_MIX   = WS_ACT;
constexpr size_t WS_IQ    = WS_AG + 16 * MB;
constexpr size_t WS_BQ    = WS_IQ + 16 * MB;
constexpr size_t WS_BK    = WS_BQ + 8 * MB;
constexpr size_t WS_BV    = WS_BK + 8 * MB;
constexpr size_t WS_BG    = WS_BV + 16 * MB;
constexpr size_t WS_IK    = WS_BG + 16 * MB;
constexpr size_t WS_IW    = WS_IK + 2 * MB;
constexpr size_t WS_BLR   = WS_IW + MB / 2;
constexpr size_t WS_MASK  = WS_BLR + MB;
constexpr size_t WS_SPREV = WS_MASK + 8 * MB;
constexpr size_t WS_DECAY = WS_SPREV + 16 * MB;
constexpr size_t WS_EVEN_END = WS_DECAY + MB / 4;
constexpr size_t WS_XR    = WS_ACT;
constexpr size_t WS_U     = WS_XR;
constexpr size_t WS_GS    = WS_XR + 32 * MB;
constexpr size_t WS_XC    = WS_GS + 32 * MB;
constexpr size_t WS_LOGA  = WS_XC + 32 * MB;
constexpr size_t WS_ODD_END = WS_LOGA + 32 * MB;
constexpr size_t WS_END   = WS_EVEN_END > WS_ODD_END ? WS_EVEN_END : WS_ODD_END;
static_assert(WS_END <= (size_t)256 * MB, "workspace map exceeds 256 MiB");

__device__ __forceinline__ float bf2f(unsigned v) { return __uint_as_float(v << 16); }
typedef __bf16 bf16pair_t __attribute__((ext_vector_type(2)));
typedef float f32pair_t __attribute__((ext_vector_type(2)));
__device__ __forceinline__ unsigned cvt_pk_bf16(float lo, float hi) { const f32pair_t v = {lo, hi}; const bf16pair_t b = __builtin_convertvector(v, bf16pair_t); return __builtin_bit_cast(unsigned, b); }
__device__ __forceinline__ bf16_t f2bf(float f) { return (bf16_t)cvt_pk_bf16(f, f); }
__device__ __forceinline__ float silu_f(float x) { return x / (1.0f + __expf(-x)); }
__device__ __forceinline__ float sigmoid_f(float x) { return 1.0f / (1.0f + __expf(-x)); }
__device__ __forceinline__ size_t slab_idx(int row, int ch) { return ((size_t)((row >> 12) * 64 + (ch >> 4)) * SEQ + (row & 4095)) * 16 + (ch & 15); }
__device__ __forceinline__ float log1p_01(float y) { const float ser = y * (1.0f - y * (0.5f - y * (0.33333334f - y * 0.25f))); return y < 0.03125f ? ser : __logf(1.0f + y); }
__device__ __forceinline__ float bflo(unsigned w) { return __uint_as_float(w << 16); }
__device__ __forceinline__ float bfhi(unsigned w) { return __uint_as_float(w & 0xFFFF0000u); }

__device__ __forceinline__ int opaque_tid() { int t = threadIdx.x; asm volatile("" : "+v"(t)); return t; }

__device__ __forceinline__ int wave_sum_i32(int v) {
    v += __builtin_amdgcn_update_dpp(0, v, 0xB1, 0xF, 0xF, true);
    v += __builtin_amdgcn_update_dpp(0, v, 0x4E, 0xF, 0xF, true);
    v += __builtin_amdgcn_update_dpp(0, v, 0x141, 0xF, 0xF, true);
    v += __builtin_amdgcn_update_dpp(0, v, 0x140, 0xF, 0xF, true);
    return __builtin_amdgcn_readlane(v, 0) + __builtin_amdgcn_readlane(v, 16) + __builtin_amdgcn_readlane(v, 32) + __builtin_amdgcn_readlane(v, 48);
}

__device__ __forceinline__ float wave_max_f32(float v) {
    v = fmaxf(v, __uint_as_float((unsigned)__builtin_amdgcn_update_dpp(0, (int)__float_as_uint(v), 0xB1, 0xF, 0xF, true)));
    v = fmaxf(v, __uint_as_float((unsigned)__builtin_amdgcn_update_dpp(0, (int)__float_as_uint(v), 0x4E, 0xF, 0xF, true)));
    v = fmaxf(v, __uint_as_float((unsigned)__builtin_amdgcn_update_dpp(0, (int)__float_as_uint(v), 0x141, 0xF, 0xF, true)));
    v = fmaxf(v, __uint_as_float((unsigned)__builtin_amdgcn_update_dpp(0, (int)__float_as_uint(v), 0x140, 0xF, 0xF, true)));
    const float a = __uint_as_float((unsigned)__builtin_amdgcn_readlane((int)__float_as_uint(v), 0)), b = __uint_as_float((unsigned)__builtin_amdgcn_readlane((int)__float_as_uint(v), 16));
    const float c = __uint_as_float((unsigned)__builtin_amdgcn_readlane((int)__float_as_uint(v), 32)), d = __uint_as_float((unsigned)__builtin_amdgcn_readlane((int)__float_as_uint(v), 48));
    return fmaxf(fmaxf(a, b), fmaxf(c, d));
}
__device__ __forceinline__ int wave_prefix_sum_i32(int v) {
    v += __builtin_amdgcn_update_dpp(0, v, 0x111, 0xF, 0xF, true);
    v += __builtin_amdgcn_update_dpp(0, v, 0x112, 0xF, 0xF, true);
    v += __builtin_amdgcn_update_dpp(0, v, 0x114, 0xF, 0xF, true);
    v += __builtin_amdgcn_update_dpp(0, v, 0x118, 0xF, 0xF, true);
    v += __builtin_amdgcn_update_dpp(0, v, 0x142, 0xA, 0xF, false);
    v += __builtin_amdgcn_update_dpp(0, v, 0x143, 0xC, 0xF, false);
    return v;
}

#define XB_TMO      128
#define XB_XCNT(j)  (256  + 64 * (j))
#define XB_XSUB(j)  (1280 + 64 * (j))
#define XB_XGEN(j)  (2304 + 64 * (j))
#define XB_TOP      3328
#define XB_TOPGEN   3392
#define XCD_BAR_WORDS 3456
#define XB_SPIN_CAP (1u << 18)

__device__ __forceinline__ unsigned xb_ld(unsigned* p)              { return __hip_atomic_load(p, __ATOMIC_RELAXED, __HIP_MEMORY_SCOPE_AGENT); }
__device__ __forceinline__ unsigned xb_add(unsigned* p, unsigned v) { return __hip_atomic_fetch_add(p, v, __ATOMIC_RELAXED, __HIP_MEMORY_SCOPE_AGENT); }
__device__ __forceinline__ unsigned xb_xcc_id() { return (unsigned)__builtin_amdgcn_s_getreg((3 << 11) | 20) & 0xFu; }
#define XB_SPIN(cond, bar) do { unsigned _sp = 0; while (cond) { __builtin_amdgcn_s_sleep(1); \
    if ((++_sp & 255u) == 0u) { if (xb_ld(&(bar)[XB_TMO])) break; if (_sp > XB_SPIN_CAP) { atomicAdd(&(bar)[XB_TMO], 1u); break; } } } } while (0)

struct XcdBarrier { unsigned* bar; unsigned x; volatile LAS unsigned* st; };

__device__ __forceinline__ XcdBarrier xcd_barrier_post(unsigned* bar, volatile LAS unsigned* st) {
    XcdBarrier b; b.bar = bar; b.x = xb_xcc_id(); b.st = st;
    if (threadIdx.x == 0) (void)xb_add(&bar[XB_XCNT(b.x)], 1u);
    return b;
}
__device__ __forceinline__ void xcd_barrier_complete(unsigned* bar, unsigned x, unsigned& nloc, unsigned& nx) {
    const unsigned G = gridDim.x * gridDim.y * gridDim.z;
    unsigned sum, cnt, mine, sp = 0u;
    for (;;) {
        sum = 0u; cnt = 0u; mine = 0u;
#pragma unroll
        for (unsigned j = 0; j < 16; ++j) { const unsigned c = xb_ld(&bar[XB_XCNT(j)]); sum += c; cnt += (c > 0u) ? 1u : 0u; mine = (j == x) ? c : mine; }
        if (sum == G) break;
        __builtin_amdgcn_s_sleep(1);
        if ((++sp & 255u) == 0u) { if (xb_ld(&bar[XB_TMO])) break; if (sp > XB_SPIN_CAP) { atomicAdd(&bar[XB_TMO], 1u); break; } }
    }
    nloc = mine > 0u ? mine : 1u; nx = cnt > 0u ? cnt : 1u;
}
__device__ __forceinline__ void xcd_barrier(const XcdBarrier& b) {
    asm volatile("s_waitcnt vmcnt(0)" ::: "memory");
    __syncthreads();
    if (threadIdx.x == 0) {
        unsigned* bar = b.bar;
        __builtin_amdgcn_s_waitcnt(0);
        unsigned nloc = b.st[0], nx = b.st[1];
        if (nloc == 0u) { xcd_barrier_complete(bar, b.x, nloc, nx); b.st[0] = nloc; b.st[1] = nx; }
        const unsigned old = xb_add(&bar[XB_XSUB(b.x)], 1u);
        const unsigned gen = old / nloc;
        if (old + 1u == (gen + 1u) * nloc) {
            __builtin_amdgcn_fence(__ATOMIC_RELEASE, "agent");
            asm volatile("s_waitcnt vmcnt(0)" ::: "memory");
            const unsigned og = xb_add(&bar[XB_TOP], 1u);
            const unsigned tg = og / nx;
            if (og + 1u == (tg + 1u) * nx) xb_add(&bar[XB_TOPGEN], 1u);
            else XB_SPIN(xb_ld(&bar[XB_TOPGEN]) == tg, bar);
            __builtin_amdgcn_fence(__ATOMIC_ACQUIRE, "agent");
            xb_add(&bar[XB_XGEN(b.x)], 1u);
            asm volatile("s_waitcnt vmcnt(0)" ::: "memory");
        } else {
            XB_SPIN(xb_ld(&bar[XB_XGEN(b.x)]) == gen, bar);
            __builtin_amdgcn_fence(__ATOMIC_ACQUIRE, "agent");
            asm volatile("s_waitcnt vmcnt(0)" ::: "memory");
        }
    }
    __syncthreads();
}

namespace pg8 {
constexpr int BM = 256, BK = 64, HALF = 128, HTB = HALF * BK * 2, STAGE_BYTES = 8 * HTB, NXCD = 8, WGM = 8;
__host__ __device__ __forceinline__ int lds_byte(int r, int c) { const int st = (r >> 4) * 2 + (c >> 5), rr = r & 15, cc = c & 31, ob = rr * 64 + cc * 2; return st * 1024 + (ob ^ (((ob >> 9) & 1) << 5)); }
__host__ __device__ __forceinline__ void stage_rc(int b, int& R, int& C) { const int st = b / 1024, sb = b % 1024, swz = sb ^ (((sb >> 9) & 1) << 5); R = (st >> 1) * 16 + swz / 64; C = (st & 1) * 32 + (swz % 64) / 2; }
__host__ __device__ __forceinline__ int perm32(int rho) { const int n = rho >> 4, i = rho & 15; return 8 * (i >> 2) + 4 * n + (i & 3); }

struct Unit { int pm, pn; };
struct Gemm { const bf16_t* A; const bf16_t* Bt; int M, N, K, lda, a_div, a_step; };

struct StaticOrder {
    int nM, nN, nwg, G, c;
    __host__ __device__ void init(int M, int N, int G_, int c_) { nM = M / BM; nN = N / BM; nwg = nM * nN; G = G_; c = c_; }
    __host__ __device__ bool next(int i, Unit& u) const {
        const long L = (long)i * G + c; if (L >= nwg) return false;
        int wgid = (int)L; { const int q = nwg / NXCD, r = nwg % NXCD, xcd = wgid % NXCD, off = wgid / NXCD; wgid = (xcd < r ? xcd * (q + 1) : r * (q + 1) + (xcd - r) * q) + off; }
        const int nig = WGM * nN, gid = wgid / nig, fm = gid * WGM, gsz = (nM - fm) < WGM ? (nM - fm) : WGM;
        u.pm = fm + ((wgid % nig) % gsz); u.pn = (wgid % nig) / gsz; return true;
    }
};

template <class Epi>
__device__ __forceinline__ void gemm_phase(LAS unsigned char* lds, const Gemm g, const StaticOrder& S, const Epi& E) {
    const int tid = opaque_tid(), wid = __builtin_amdgcn_readfirstlane(tid >> 6), lane = tid & 63, wr = wid >> 2, wc = wid & 3, fr = lane & 15, fq = lane >> 4;
    const int K = g.K, nt = K / BK, lda = g.lda;
    unsigned voffA[2], voffB[2];
#pragma unroll
    for (int i = 0; i < 2; ++i) { int R, C; stage_rc(tid * 16 + i * 8192, R, C); const int Rb = Epi::PERM ? ((R & ~31) + perm32(R & 31)) : R;
        voffA[i] = (unsigned)(R * lda + C) * 2u; voffB[i] = (unsigned)(Rb * K + C) * 2u; }
    const size_t kstep = (size_t)(BK * 2);
    const size_t hstepA = (size_t)HALF * lda * 2, hstepB = (size_t)HALF * K * 2;
    const size_t tstepA = 2 * hstepA, tstepB = 2 * hstepB;
    const unsigned ldsw = (unsigned)wid * 1024u;
    const int aoff = lds_byte(wr * 64 + fr, fq * 8), boff = lds_byte(wc * 32 + fr, fq * 8);
#define PG8_SA(b, h) (((b) * 2 + (h)) * HTB)
#define PG8_SB(b, h) ((4 + (b) * 2 + (h)) * HTB)
#define PG8_STAGE(bufoff, gbase, voff) do { _Pragma("unroll") for (int _i = 0; _i < 2; ++_i) \
        __builtin_amdgcn_global_load_lds((const unsigned*)((const char*)(gbase) + (voff)[_i]), (LAS unsigned*)(lds + (bufoff) + ldsw + _i * 8192), 16, 0, 0); } while (0)
#define PG8_LDA(dst, b, h) do { _Pragma("unroll") for (int m = 0; m < 4; ++m) _Pragma("unroll") for (int k = 0; k < 2; ++k) dst[m][k] = *(const LAS bf16x8*)(lds + PG8_SA(b, h) + aoff + m * 2048 + k * 1024); } while (0)
#define PG8_LDB(dst, b, h) do { _Pragma("unroll") for (int n = 0; n < 2; ++n) _Pragma("unroll") for (int k = 0; k < 2; ++k) dst[n][k] = *(const LAS bf16x8*)(lds + PG8_SB(b, h) + boff + n * 2048 + k * 1024); } while (0)
#define PG8_MMA(ai, bj, At, Bt) do { __builtin_amdgcn_s_setprio(1); _Pragma("unroll") for (int m = 0; m < 4; ++m) _Pragma("unroll") for (int n = 0; n < 2; ++n) _Pragma("unroll") for (int k = 0; k < 2; ++k) \
        acc[ai][bj][m][n] = __builtin_amdgcn_mfma_f32_16x16x32_bf16(Bt[n][k], At[m][k], acc[ai][bj][m][n], 0, 0, 0); __builtin_amdgcn_s_setprio(0); } while (0)
#define PG8_WAIT_V(n) asm volatile("s_waitcnt vmcnt(" #n ")" ::: "memory")
#define PG8_WAIT_L(n) asm volatile("s_waitcnt lgkmcnt(" #n ")" ::: "memory")
#define PG8_BAR __builtin_amdgcn_s_barrier()
#define PG8_SCHED __builtin_amdgcn_sched_barrier(0)
    Unit cur, nxt; int ui = 0;
    if (!S.next(0, cur)) return;
    f32x4 acc[2][2][4][2];
#pragma unroll
    for (int a = 0; a < 2; ++a)
#pragma unroll
        for (int b = 0; b < 2; ++b)
#pragma unroll
            for (int m = 0; m < 4; ++m)
#pragma unroll
                for (int n = 0; n < 2; ++n) acc[a][b][m][n] = (f32x4){0.f, 0.f, 0.f, 0.f};
    bf16x8 At[4][2], B0[2][2], B1[2][2];
    const char* cA = (const char*)g.A + (size_t)cur.pm * tstepA + (size_t)(cur.pn / g.a_div) * g.a_step; const char* cB = (const char*)g.Bt + (size_t)cur.pn * tstepB;
    PG8_STAGE(PG8_SB(0, 0), cB, voffB); PG8_STAGE(PG8_SA(0, 0), cA, voffA); PG8_STAGE(PG8_SB(0, 1), cB + hstepB, voffB); PG8_STAGE(PG8_SA(0, 1), cA + hstepA, voffA);
    if (wr == 1) PG8_BAR;
    PG8_WAIT_V(4); PG8_BAR;
    PG8_STAGE(PG8_SB(1, 0), cB + kstep, voffB); PG8_STAGE(PG8_SA(1, 0), cA + kstep, voffA); PG8_STAGE(PG8_SB(1, 1), cB + hstepB + kstep, voffB);
    PG8_WAIT_V(6); PG8_BAR;
    for (;;) {
        const bool has_next = S.next(ui + 1, nxt);
        const char* nA = has_next ? (const char*)g.A + (size_t)nxt.pm * tstepA + (size_t)(nxt.pn / g.a_div) * g.a_step : cA; const char* nB = has_next ? (const char*)g.Bt + (size_t)nxt.pn * tstepB : cB;
        for (int t = 0; t < nt; t += 2) {
            const bool last = (t == nt - 2);
            const char* a1 = cA + (size_t)(t + 1) * kstep;
            const char* a2 = last ? nA : cA + (size_t)(t + 2) * kstep; const char* b2 = last ? nB : cB + (size_t)(t + 2) * kstep;
            const char* a3 = a2 + kstep; const char* b3 = b2 + kstep;
            PG8_LDB(B0, 0, 0); PG8_SCHED; PG8_LDA(At, 0, 0); PG8_STAGE(PG8_SA(1, 1), a1 + hstepA, voffA);
            PG8_WAIT_L(8); PG8_BAR; PG8_WAIT_L(0); PG8_MMA(0, 0, At, B0); PG8_BAR; PG8_SCHED;
            PG8_LDB(B1, 0, 1); PG8_STAGE(PG8_SB(0, 0), b2, voffB);
            PG8_BAR; PG8_WAIT_L(0); PG8_MMA(0, 1, At, B1); PG8_BAR;
            PG8_LDA(At, 0, 1); PG8_STAGE(PG8_SA(0, 0), a2, voffA);
            PG8_BAR; PG8_WAIT_L(0); PG8_MMA(1, 0, At, B0); PG8_BAR; PG8_SCHED;
            PG8_STAGE(PG8_SB(0, 1), b2 + hstepB, voffB);
            PG8_WAIT_V(6); PG8_BAR; PG8_MMA(1, 1, At, B1); PG8_BAR;
            PG8_LDB(B0, 1, 0); PG8_SCHED; PG8_LDA(At, 1, 0); PG8_STAGE(PG8_SA(0, 1), a2 + hstepA, voffA);
            PG8_WAIT_L(8); PG8_BAR; PG8_WAIT_L(0); PG8_MMA(0, 0, At, B0); PG8_BAR; PG8_SCHED;
            PG8_LDB(B1, 1, 1); PG8_STAGE(PG8_SB(1, 0), b3, voffB);
            PG8_BAR; PG8_WAIT_L(0); PG8_MMA(0, 1, At, B1); PG8_BAR;
            PG8_LDA(At, 1, 1); PG8_STAGE(PG8_SA(1, 0), a3, voffA);
            PG8_BAR; PG8_WAIT_L(0); PG8_MMA(1, 0, At, B0); PG8_BAR; PG8_SCHED;
            PG8_STAGE(PG8_SB(1, 1), b3 + hstepB, voffB);
            PG8_WAIT_V(6); PG8_BAR; PG8_MMA(1, 1, At, B1); PG8_BAR;
        }
        E(acc, cur, wr, wc, fr, fq);
        if (!has_next) break;
#pragma unroll
        for (int a = 0; a < 2; ++a)
#pragma unroll
            for (int b = 0; b < 2; ++b)
#pragma unroll
                for (int m = 0; m < 4; ++m)
#pragma unroll
                    for (int n = 0; n < 2; ++n) acc[a][b][m][n] = (f32x4){0.f, 0.f, 0.f, 0.f};
        cur = nxt; cA = nA; cB = nB; ++ui;
    }
    PG8_WAIT_V(0);
    if (wr == 0) PG8_BAR;
    PG8_BAR;
#undef PG8_SA
#undef PG8_SB
#undef PG8_STAGE
#undef PG8_LDA
#undef PG8_LDB
#undef PG8_MMA
#undef PG8_WAIT_V
#undef PG8_WAIT_L
#undef PG8_BAR
#undef PG8_SCHED
}
}

struct EpiMix {
    static constexpr bool PERM = true;
    bf16_t* C;
    __device__ __forceinline__ void operator()(const f32x4 (&acc)[2][2][4][2], const pg8::Unit& u, int wr, int wc, int fr, int fq) const {
#pragma unroll
        for (int ai = 0; ai < 2; ++ai)
#pragma unroll
            for (int m = 0; m < 4; ++m) { const int row = u.pm * 256 + ai * 128 + wr * 64 + m * 16 + fr;
#pragma unroll
                for (int bj = 0; bj < 2; ++bj) { const f32x4 v0 = acc[ai][bj][m][0], v1 = acc[ai][bj][m][1];
                    u32x4 w; w.x = cvt_pk_bf16(v0[0], v0[1]); w.y = cvt_pk_bf16(v0[2], v0[3]); w.z = cvt_pk_bf16(v1[0], v1[1]); w.w = cvt_pk_bf16(v1[2], v1[3]);
                    *(u32x4*)(C + (size_t)row * 1024 + u.pn * 256 + bj * 128 + wc * 32 + 8 * fq) = w; } }
    }
};

constexpr float LOG2E_F = 1.4426950408889634f;
constexpr float IW_SCALE = 0.35355339059327373f * 0.125f;

struct EpiEvenIn {
    static constexpr bool PERM = true;
    bf16_t *Q, *Kb, *VT, *AG, *IQ, *BQ, *BK, *BV, *BG, *IK; float *IW, *BLR;
    __device__ __forceinline__ void operator()(const f32x4 (&acc)[2][2][4][2], const pg8::Unit& u, int wr, int wc, int fr, int fq) const {
        const int pn = u.pn;
        bf16_t* dst = Q; int ld = 512, col0 = 0, mode = 0;
        if (pn < 2) { dst = Q; col0 = pn * 256; }
        else if (pn < 4) { dst = Kb; col0 = (pn - 2) * 256; }
        else if (pn < 6) { mode = 2; col0 = (pn - 4) * 256; }
        else if (pn < 8) { dst = AG; col0 = (pn - 6) * 256; mode = 1; }
        else if (pn < 10) { dst = IQ; col0 = (pn - 8) * 256; }
        else if (pn == 10) { dst = BQ; ld = 256; }
        else if (pn == 11) { dst = BK; ld = 256; }
        else if (pn < 14) { dst = BV; col0 = (pn - 12) * 256; }
        else if (pn < 16) { dst = BG; col0 = (pn - 14) * 256; mode = 1; }
        else mode = 3;
#pragma unroll
        for (int ai = 0; ai < 2; ++ai)
#pragma unroll
            for (int m = 0; m < 4; ++m) {
                const int row = u.pm * 256 + ai * 128 + wr * 64 + m * 16 + fr;
#pragma unroll
                for (int bj = 0; bj < 2; ++bj) {
                    const int cb = bj * 128 + wc * 32 + 8 * fq;
                    f32x4 v0 = acc[ai][bj][m][0], v1 = acc[ai][bj][m][1];
                    if (mode <= 1) {
                        if (mode == 1) {
#pragma unroll
                            for (int j = 0; j < 4; ++j) { v0[j] = silu_f(v0[j]); v1[j] = silu_f(v1[j]); }
                        }
                        u32x4 w; w.x = cvt_pk_bf16(v0[0], v0[1]); w.y = cvt_pk_bf16(v0[2], v0[3]); w.z = cvt_pk_bf16(v1[0], v1[1]); w.w = cvt_pk_bf16(v1[2], v1[3]);
                        *(u32x4*)(dst + (size_t)row * ld + col0 + cb) = w;
                    } else if (mode == 2) {
                        const int c = col0 + cb, head = c >> 6, d = c & 63, b = row >> 12, s = row & 4095;
                        bf16_t* p = VT + ((size_t)(b * 8 + head) * 64 + d) * 4096 + s;
#pragma unroll
                        for (int j = 0; j < 4; ++j) { p[(size_t)j * 4096] = f2bf(v0[j]); p[(size_t)(j + 4) * 4096] = f2bf(v1[j]); }
                    } else {
                        if (cb < 64) {
                            u32x4 w; w.x = cvt_pk_bf16(v0[0], v0[1]); w.y = cvt_pk_bf16(v0[2], v0[3]); w.z = cvt_pk_bf16(v1[0], v1[1]); w.w = cvt_pk_bf16(v1[2], v1[3]);
                            const int q = cb >> 3, bb = row >> 12, sq = row & 4095;
                            *(u32x4*)(IK + ((((size_t)(bb * 128 + (sq >> 5)) * 4 + (q >> 1)) * 2 + (q & 1)) * 32 + (sq & 31)) * 8) = w;
                        } else if (cb == 64) {
                            *(f32x4*)(IW + (size_t)row * 8) = v0 * IW_SCALE; *(f32x4*)(IW + (size_t)row * 8 + 4) = v1 * IW_SCALE;
                        } else if (cb == 72 || cb == 80) {
                            *(f32x4*)(BLR + (size_t)row * 16 + (cb - 72)) = v0; *(f32x4*)(BLR + (size_t)row * 16 + (cb - 72) + 4) = v1;
                        }
                    }
                }
            }
    }
};

struct EpiOddIn {
    static constexpr bool PERM = true;
    bf16_t *XR, *GS;
    __device__ __forceinline__ void operator()(const f32x4 (&acc)[2][2][4][2], const pg8::Unit& u, int wr, int wc, int fr, int fq) const {
        const int pn = u.pn; const bool gate = pn >= 4;
        bf16_t* dst = gate ? GS : XR; const int col0 = (pn & 3) * 256;
#pragma unroll
        for (int ai = 0; ai < 2; ++ai)
#pragma unroll
            for (int m = 0; m < 4; ++m) {
                const int row = u.pm * 256 + ai * 128 + wr * 64 + m * 16 + fr;
#pragma unroll
                for (int bj = 0; bj < 2; ++bj) {
                    const int cb = bj * 128 + wc * 32 + 8 * fq;
                    f32x4 v0 = acc[ai][bj][m][0], v1 = acc[ai][bj][m][1];
                    if (gate) {
#pragma unroll
                        for (int j = 0; j < 4; ++j) { v0[j] = silu_f(v0[j]); v1[j] = silu_f(v1[j]); }
                    }
                    u32x4 w; w.x = cvt_pk_bf16(v0[0], v0[1]); w.y = cvt_pk_bf16(v0[2], v0[3]); w.z = cvt_pk_bf16(v1[0], v1[1]); w.w = cvt_pk_bf16(v1[2], v1[3]);
                    if (gate) *(u32x4*)(GS + slab_idx(row, col0 + cb)) = w;
                    else *(u32x4*)(XR + (size_t)row * 1024 + col0 + cb) = w;
                }
            }
    }
};

struct EpiGates {
    static constexpr bool PERM = true;
    const float *b_a, *b_x, *lam; const bf16_t* XC; bf16_t* LOGA; bf16_t* U;
    __device__ __forceinline__ void operator()(const f32x4 (&acc)[2][2][4][2], const pg8::Unit& u, int wr, int wc, int fr, int fq) const {
        const int chb = (u.pn >> 1) * 256 + (u.pn & 1) * 128 + wc * 32 + 8 * fq;
#pragma unroll
        for (int nh = 0; nh < 2; ++nh) {
            const int ch0 = chb + 4 * nh;
            const f32x4 lm = *(const f32x4*)(lam + ch0);
            const f32x4 nba = *(const f32x4*)(b_a + ch0) * (-LOG2E_F), nbx = *(const f32x4*)(b_x + ch0) * (-LOG2E_F);
            f32x4 c8;
#pragma unroll
            for (int j = 0; j < 4; ++j) c8[j] = (-8.0f * LOG2E_F) * (fmaxf(-lm[j], 0.f) + log1p_01(__expf(-fabsf(lm[j]))));
#pragma unroll
            for (int ai = 0; ai < 2; ++ai)
#pragma unroll
                for (int m = 0; m < 4; ++m) {
                    const int row = u.pm * 256 + ai * 128 + wr * 64 + m * 16 + fr;
                    const u32x2 xw = *(const u32x2*)(XC + (size_t)row * 1024 + ch0);
                    const float xv[4] = {bflo(xw.x), bfhi(xw.x), bflo(xw.y), bfhi(xw.y)};
                    f32x4 la; float uu[4];
#pragma unroll
                    for (int j = 0; j < 4; ++j) {
                        const float r = __builtin_amdgcn_rcpf(1.0f + __builtin_amdgcn_exp2f(__builtin_fmaf(acc[ai][0][m][nh][j], -LOG2E_F, nba[j])));
                        const float ig = __builtin_amdgcn_rcpf(1.0f + __builtin_amdgcn_exp2f(__builtin_fmaf(acc[ai][1][m][nh][j], -LOG2E_F, nbx[j])));
                        const float l2 = c8[j] * r, av = __builtin_amdgcn_exp2f(l2);
                        la[j] = l2;
                        uu[j] = __builtin_amdgcn_sqrtf(fmaxf(__builtin_fmaf(-av, av, 1.0f), 0.f)) * ig * xv[j];
                    }
                    { u32x2 lw; lw.x = cvt_pk_bf16(la[0], la[1]); lw.y = cvt_pk_bf16(la[2], la[3]); *(u32x2*)(LOGA + slab_idx(row, ch0)) = lw; }
                    u32x2 w; w.x = cvt_pk_bf16(uu[0], uu[1]); w.y = cvt_pk_bf16(uu[2], uu[3]);
                    *(u32x2*)(U + slab_idx(row, ch0)) = w;
                }
        }
    }
};

struct Args {
    const float* x; const float* rel_bias; const float* pre_norm; const float* post_norm;
    const float* even_w_in; const float* even_gate_w2; const float* even_gate_b2; const float* even_w_out;
    const float* odd_w_in; const float* odd_conv_w; const float* odd_conv_b; const float* odd_w_a; const float* odd_b_a;
    const float* odd_w_x; const float* odd_b_x; const float* odd_lambda; const float* odd_w_out;
    float* out; unsigned char* ws; int ph_lo, ph_hi;
};

typedef const Args __attribute__((address_space(4)))* ArgsP;
__device__ __forceinline__ ArgsP get_args() { ArgsP p = (ArgsP)__builtin_amdgcn_kernarg_segment_ptr(); asm volatile("" : "+s"(p)); return p; }

constexpr int WT_EIN = 2 * 68 * 16, WT_EOUT = 2 * 256, WT_OIN = 2 * 512, WT_OOUT = 2 * 256, WT_GATE = 2 * 128, WT_ALL = WT_EIN + WT_EOUT + WT_OIN + WT_OOUT + WT_GATE;
__device__ __forceinline__ void wtile_decode(int T, ArgsP ap, unsigned char* ws, int nl, int wn, const float*& colp, int& ld, bf16_t*& drow, int& K, const float*& ksc) {
    ksc = nullptr;
    if (T < WT_EIN) { const int e = T / 1088, r = T % 1088, tn = r % 68, tk = r / 68; K = 1024; ld = EVEN_IN;
        const int n = tn * 64 + nl; int c; bool ok = true; if (n < 2560) c = n; else if (n < 4096) c = n + 72; else if (n < 4168) c = n - 1536; else if (n < 4184) c = n; else { c = 0; ok = false; }
        ksc = ap->pre_norm + (size_t)(2 * e) * DM + tk * 64;
        colp = ok ? ap->even_w_in + ((size_t)e * 1024 + tk * 64) * EVEN_IN + c : nullptr;
        drow = (bf16_t*)(ws + WS_WEIN) + ((size_t)e * NE + tn * 64 + wn) * 1024 + tk * 64; return; }
    T -= WT_EIN;
    if (T < WT_EOUT) { const int e = T / 256, r = T % 256, tn = r % 16, tk = r / 16; K = 1024; ld = 1024;
        colp = ap->even_w_out + ((size_t)e * 1024 + tk * 64) * 1024 + tn * 64 + nl; drow = (bf16_t*)(ws + WS_WEOUT) + ((size_t)e * 1024 + tn * 64 + wn) * 1024 + tk * 64; return; }
    T -= WT_EOUT;
    if (T < WT_OIN) { const int e = T / 512, r = T % 512, tn = r % 32, tk = r / 32; K = 1024; ld = 2048;
        ksc = ap->pre_norm + (size_t)(2 * e + 1) * DM + tk * 64;
        colp = ap->odd_w_in + ((size_t)e * 1024 + tk * 64) * 2048 + tn * 64 + nl; drow = (bf16_t*)(ws + WS_WOIN) + ((size_t)e * 2048 + tn * 64 + wn) * 1024 + tk * 64; return; }
    T -= WT_OIN;
    if (T < WT_OOUT) { const int e = T / 256, r = T % 256, tn = r % 16, tk = r / 16; K = 1024; ld = 1024;
        colp = ap->odd_w_out + ((size_t)e * 1024 + tk * 64) * 1024 + tn * 64 + nl; drow = (bf16_t*)(ws + WS_WOOUT) + ((size_t)e * 1024 + tn * 64 + wn) * 1024 + tk * 64; return; }
    T -= WT_OOUT;
    {
        const int o = T / 128, r = T % 128, tn = r % 32, tk = r / 32; K = 256; ld = 256;
        const int cp = tn * 64, nb = cp >> 9, j = (cp >> 8) & 1, gs = (cp >> 7) & 1, e0 = j * 128 + (cp & 127);
        const float* src = gs ? ap->odd_w_x : ap->odd_w_a;
        colp = src + (((size_t)(o * 4 + nb)) * 256 + tk * 64) * 256 + e0 + nl; drow = (bf16_t*)(ws + WS_WOG) + ((size_t)o * 2048 + cp + wn) * 256 + tk * 64; }
}
__device__ __forceinline__ void weight_phase(LAS float* tile, ArgsP ap, unsigned char* ws) {
    const int tid = opaque_tid(), G = gridDim.x, nl = tid & 63, k0 = tid >> 6, wn = tid >> 3, wk = (tid & 7) * 8;
    float r[8]; const float* colp; const float* ksc; bf16_t* drow; int ld, K;
#define WT_LOAD() do { _Pragma("unroll") for (int i = 0; i < 8; ++i) r[i] = colp ? colp[(size_t)(k0 + 8 * i) * ld] * (ksc ? ksc[k0 + 8 * i] : 1.0f) : 0.f; } while (0)
    int T = blockIdx.x;
    if (T < WT_ALL) { wtile_decode(T, ap, ws, nl, wn, colp, ld, drow, K, ksc); WT_LOAD(); }
    for (; T < WT_ALL; T += G) {
        bf16_t* dcur = drow;
#pragma unroll
        for (int i = 0; i < 8; ++i) tile[(k0 + 8 * i) * 65 + nl] = r[i];
        __syncthreads();
        if (T + G < WT_ALL) { wtile_decode(T + G, ap, ws, nl, wn, colp, ld, drow, K, ksc); WT_LOAD(); }
        float v[8];
#pragma unroll
        for (int j = 0; j < 8; ++j) v[j] = tile[(wk + j) * 65 + wn];
        u32x4 w; w.x = cvt_pk_bf16(v[0], v[1]); w.y = cvt_pk_bf16(v[2], v[3]); w.z = cvt_pk_bf16(v[4], v[5]); w.w = cvt_pk_bf16(v[6], v[7]);
        *(u32x4*)(dcur + wk) = w;
        __syncthreads();
    }
#undef WT_LOAD
}

__device__ __forceinline__ int t5_bucket(int n) {
    if (n < 16) return n;
    int v = 16 + (int)(__logf((float)n / 16.0f) / 2.0794415416798357f * 16.0f);
    return v < 31 ? v : 31;
}

__device__ __forceinline__ void norm_phase(const float* xin, const bf16_t* xh_in, const float* s_in, const bf16_t* mix, const float* postw, bf16_t* xh_out, float* s_out, float* outf) {
    const int tid0 = opaque_tid(), lane = tid0 & 63, wave = tid0 >> 6;
    for (int row = blockIdx.x * 8 + wave; row < T; row += gridDim.x * 8) {
        f32x4 xv[4];
        if (xin) {
#pragma unroll
            for (int i = 0; i < 4; ++i) xv[i] = *(const f32x4*)(xin + (size_t)row * DM + lane * 4 + 256 * i);
        } else {
            const float sc = s_in[row];
#pragma unroll
            for (int i = 0; i < 4; ++i) { const u32x2 xw = *(const u32x2*)(xh_in + (size_t)row * DM + lane * 4 + 256 * i); xv[i] = (f32x4){bflo(xw.x), bfhi(xw.x), bflo(xw.y), bfhi(xw.y)} * sc; }
        }
        if (mix) {
            f32x4 mv[4]; float ss = 0.f;
#pragma unroll
            for (int i = 0; i < 4; ++i) { const u32x2 mw = *(const u32x2*)(mix + (size_t)row * DM + lane * 4 + 256 * i); mv[i] = (f32x4){bflo(mw.x), bfhi(mw.x), bflo(mw.y), bfhi(mw.y)};
                ss += mv[i][0] * mv[i][0] + mv[i][1] * mv[i][1] + mv[i][2] * mv[i][2] + mv[i][3] * mv[i][3]; }
#pragma unroll
            for (int o = 32; o >= 1; o >>= 1) ss += __shfl_xor(ss, o);
            const float r = rsqrtf(ss * (1.0f / DM) + EPS);
#pragma unroll
            for (int i = 0; i < 4; ++i) { const f32x4 w = *(const f32x4*)(postw + lane * 4 + 256 * i); xv[i] += mv[i] * r * w; }
        }
        if (outf) {
#pragma unroll
            for (int i = 0; i < 4; ++i) *(f32x4*)(outf + (size_t)row * DM + lane * 4 + 256 * i) = xv[i];
        } else {
            float ss = 0.f;
#pragma unroll
            for (int i = 0; i < 4; ++i) ss += xv[i][0] * xv[i][0] + xv[i][1] * xv[i][1] + xv[i][2] * xv[i][2] + xv[i][3] * xv[i][3];
#pragma unroll
            for (int o = 32; o >= 1; o >>= 1) ss += __shfl_xor(ss, o);
            const float ms = ss * (1.0f / DM) + EPS, r = rsqrtf(ms);
            if (lane == 0) s_out[row] = ms * r;
#pragma unroll
            for (int i = 0; i < 4; ++i) { const f32x4 y = xv[i] * r;
                u32x2 o2; o2.x = cvt_pk_bf16(y[0], y[1]); o2.y = cvt_pk_bf16(y[2], y[3]); *(u32x2*)(xh_out + (size_t)row * DM + lane * 4 + 256 * i) = o2; }
        }
    }
}

constexpr int NM_LD = 1032;
__device__ __forceinline__ void norm_misc_phase(LAS unsigned char* lds, const float* xin, const bf16_t* xh_in, const float* s_in, const bf16_t* mix, const float* postw, bf16_t* xh_out, float* s_out,
                                                const bf16_t* Wm  , bf16_t* IK, float* IW, float* BLR) {
    const int tid0 = opaque_tid(), lane = tid0 & 63, wave = __builtin_amdgcn_readfirstlane(tid0 >> 6);
    LAS bf16_t* xs = (LAS bf16_t*)lds;
    for (int pq = blockIdx.x; pq < T / 64; pq += gridDim.x) {
        for (int i = 0; i < 8; ++i) {
            const int rl = wave * 8 + i, row = pq * 64 + rl;
            f32x4 xv[4];
            if (xin) {
#pragma unroll
                for (int k = 0; k < 4; ++k) xv[k] = *(const f32x4*)(xin + (size_t)row * DM + lane * 4 + 256 * k);
            } else {
                const float sc = s_in[row];
#pragma unroll
                for (int k = 0; k < 4; ++k) { const u32x2 xw = *(const u32x2*)(xh_in + (size_t)row * DM + lane * 4 + 256 * k); xv[k] = (f32x4){bflo(xw.x), bfhi(xw.x), bflo(xw.y), bfhi(xw.y)} * sc; }
            }
            if (mix) {
                f32x4 mv[4]; float ss = 0.f;
#pragma unroll
                for (int k = 0; k < 4; ++k) { const u32x2 mw = *(const u32x2*)(mix + (size_t)row * DM + lane * 4 + 256 * k); mv[k] = (f32x4){bflo(mw.x), bfhi(mw.x), bflo(mw.y), bfhi(mw.y)};
                    ss += mv[k][0] * mv[k][0] + mv[k][1] * mv[k][1] + mv[k][2] * mv[k][2] + mv[k][3] * mv[k][3]; }
#pragma unroll
                for (int o = 32; o >= 1; o >>= 1) ss += __shfl_xor(ss, o);
                const float r = rsqrtf(ss * (1.0f / DM) + EPS);
#pragma unroll
                for (int k = 0; k < 4; ++k) { const f32x4 w = *(const f32x4*)(postw + lane * 4 + 256 * k); xv[k] += mv[k] * r * w; }
            }
            float ss = 0.f;
#pragma unroll
            for (int k = 0; k < 4; ++k) ss += xv[k][0] * xv[k][0] + xv[k][1] * xv[k][1] + xv[k][2] * xv[k][2] + xv[k][3] * xv[k][3];
#pragma unroll
            for (int o = 32; o >= 1; o >>= 1) ss += __shfl_xor(ss, o);
            const float ms = ss * (1.0f / DM) + EPS, r = rsqrtf(ms);
            if (lane == 0) s_out[row] = ms * r;
#pragma unroll
            for (int k = 0; k < 4; ++k) { const f32x4 y = xv[k] * r;
                u32x2 o2; o2.x = cvt_pk_bf16(y[0], y[1]); o2.y = cvt_pk_bf16(y[2], y[3]);
                *(u32x2*)(xh_out + (size_t)row * DM + lane * 4 + 256 * k) = o2; *(LAS u32x2*)(xs + rl * NM_LD + lane * 4 + 256 * k) = o2; }
        }
        __syncthreads();
        if (wave < 6) {
            const int n = lane & 15, kq = lane >> 4;
            f32x4 acc[4];
#pragma unroll
            for (int mt = 0; mt < 4; ++mt) acc[mt] = (f32x4){0.f, 0.f, 0.f, 0.f};
            const bf16_t* wrow = Wm + (size_t)(16 * wave + n) * 1024 + 8 * kq;
            for (int ks = 0; ks < 32; ks += 4) {
                bf16x8 bf[4];
#pragma unroll
                for (int u = 0; u < 4; ++u) bf[u] = *(const bf16x8*)(wrow + (ks + u) * 32);
#pragma unroll
                for (int u = 0; u < 4; ++u)
#pragma unroll
                    for (int mt = 0; mt < 4; ++mt) { const bf16x8 af = *(const LAS bf16x8*)(xs + (16 * mt + n) * NM_LD + (ks + u) * 32 + 8 * kq);
                        acc[mt] = __builtin_amdgcn_mfma_f32_16x16x32_bf16(af, bf[u], acc[mt], 0, 0, 0); }
            }
#pragma unroll
            for (int mt = 0; mt < 4; ++mt)
#pragma unroll
                for (int j = 0; j < 4; ++j) { const int row = pq * 64 + 16 * mt + 4 * kq + j; const float v = acc[mt][j];
                    if (wave < 4) { const int cc = 16 * wave + n, q = cc >> 3, bb = row >> 12, sq = row & 4095;
                        IK[((((size_t)(bb * 128 + (sq >> 5)) * 4 + (q >> 1)) * 2 + (q & 1)) * 32 + (sq & 31)) * 8 + (cc & 7)] = f2bf(v); }
                    else if (wave == 4) { if (n < 8) IW[(size_t)row * 8 + n] = v * IW_SCALE; else BLR[(size_t)row * 16 + (n - 8)] = v; }
                    else { if (n < 8) BLR[(size_t)row * 16 + 8 + n] = v; } }
        }
        __syncthreads();
    }
}

#define IDX_AF(AF, b_, t0_) do { \
        const int qi_ = 2 * ((c >> 2) & 1) + (c >> 4), hh_ = (c & 3) + 4 * ((c >> 3) & 1);   \
        _Pragma("unroll") for (int mt = 0; mt < 2; ++mt) { const size_t tq_ = (size_t)(b_) * SEQ + (t0_) + 4 * mt + qi_; \
            _Pragma("unroll") for (int ks = 0; ks < 4; ++ks) AF[mt][ks] = *(const bf16x8*)(IQ + tq_ * 512 + hh_ * 64 + ks * 16 + 8 * g); } } while (0)
#define IDX_WV(WV, b_, t0_) do { \
        _Pragma("unroll") for (int mt = 0; mt < 2; ++mt) _Pragma("unroll") for (int qq = 0; qq < 2; ++qq) { const size_t tq_ = (size_t)(b_) * SEQ + (t0_) + 4 * mt + 2 * g + qq; \
            const f32x4 w0_ = *(const f32x4*)(IW + tq_ * 8), w1_ = *(const f32x4*)(IW + tq_ * 8 + 4); \
            WV[mt][qq][0] = w0_[0]; WV[mt][qq][1] = w0_[1]; WV[mt][qq][2] = w0_[2]; WV[mt][qq][3] = w0_[3]; WV[mt][qq][4] = w1_[0]; WV[mt][qq][5] = w1_[1]; WV[mt][qq][6] = w1_[2]; WV[mt][qq][7] = w1_[3]; } } while (0)

__device__ __forceinline__ void indexer_phase(LAS float* sc, const bf16_t* IQ, const bf16_t* IK, const float* IW, u64* MASK, int wave, int lane) {
    const int g = lane >> 5, c = lane & 31, G = gridDim.x;
    bf16x8 af[2][4];
#define IDX_ITEM(k_) ((k_) * G + (((k_) & 1) ? (G - 1 - (int)blockIdx.x) : (int)blockIdx.x))
    { const int it0 = IDX_ITEM(0); if (it0 < 2048) IDX_AF(af, it0 & 3, (511 - (it0 >> 2)) * 8); }
        for (int kk = 0; kk * G < 2048; ++kk) {
    const int it = IDX_ITEM(kk); if (it >= 2048) break;
    const int b = it & 3, t0 = (511 - (it >> 2)) * 8;
    float wv[2][2][8];
    IDX_WV(wv, b, t0);
    const int ntiles = (t0 + 8 + 31) >> 5;
    const bf16_t* ikb = IK + (size_t)b * 128 * 2048 + (size_t)(g * 32 + c) * 8;
#define IDX_LOAD(buf, kt_) do { if ((kt_) < ntiles) { _Pragma("unroll") for (int ks = 0; ks < 4; ++ks) buf[ks] = *(const bf16x8*)(ikb + (size_t)(kt_) * 2048 + ks * 512); } } while (0)
#define IDX_TILE(buf, kt_) do { if ((kt_) < ntiles) { const int key = (kt_) * 32 + c; f32x16 a0, a1; \
        _Pragma("unroll") for (int r = 0; r < 16; ++r) { a0[r] = 0.f; a1[r] = 0.f; } \
        _Pragma("unroll") for (int ks = 0; ks < 4; ++ks) { a0 = __builtin_amdgcn_mfma_f32_32x32x16_bf16(af[0][ks], buf[ks], a0, 0, 0, 0); a1 = __builtin_amdgcn_mfma_f32_32x32x16_bf16(af[1][ks], buf[ks], a1, 0, 0, 0); } \
        _Pragma("unroll") for (int qq = 0; qq < 2; ++qq) { float s0 = 0.f, s1 = 0.f; \
            _Pragma("unroll") for (int h = 0; h < 8; ++h) { s0 += wv[0][qq][h] * fmaxf(a0[8 * qq + h], 0.f); s1 += wv[1][qq][h] * fmaxf(a1[8 * qq + h], 0.f); } \
            sc[(0 + 2 * g + qq) * 4096 + key] = s0; sc[(4 + 2 * g + qq) * 4096 + key] = s1; } } } while (0)
    {
        bf16x8 b0[4], b1[4], b2[4];
        IDX_LOAD(b0, wave); IDX_LOAD(b1, wave + 8);
        for (int kt = wave; kt < ntiles; kt += 24) {
            IDX_LOAD(b2, kt + 16); IDX_TILE(b0, kt);
            IDX_LOAD(b0, kt + 24); IDX_TILE(b1, kt + 8);
            IDX_LOAD(b1, kt + 32); IDX_TILE(b2, kt + 16);
        }
    }
#undef IDX_LOAD
#undef IDX_TILE
    __syncthreads();
    bf16x8 afn[2][4];
    { const int itn = IDX_ITEM(kk + 1); if ((kk + 1) * G < 2048 && itn < 2048) IDX_AF(afn, itn & 3, (511 - (itn >> 2)) * 8); }
    {
        const int t = t0 + wave, nvalid = t + 1, nreg = (nvalid + 63) >> 6, ngrp = (nreg + 7) >> 3;
        const int gfull = nvalid >> 9;
        LAS float* myrow = sc + wave * 4096;
        float sf[64];
#pragma unroll
        for (int jj = 0; jj < 8; ++jj) {
            if (jj < gfull) {
#pragma unroll
                for (int j8 = 0; j8 < 8; ++j8) sf[jj * 8 + j8] = myrow[64 * (jj * 8 + j8) + lane];
            } else if (jj < ngrp) {
#pragma unroll
                for (int j8 = 0; j8 < 8; ++j8) { const int j = jj * 8 + j8, kk = 64 * j + lane; const float v = myrow[kk]; sf[j] = (kk < nvalid) ? v : NEG_INF; }
            } else {
#pragma unroll
                for (int j8 = 0; j8 < 8; ++j8) sf[jj * 8 + j8] = NEG_INF;
            }
        }
        float thr_f = NEG_INF; int need = 0; bool ties = false;
#define CNT_GEF(valf, out) do { int c_ = 0; _Pragma("unroll") for (int jj = 0; jj < 8; ++jj) if (jj < ngrp) { _Pragma("unroll") for (int j8 = 0; j8 < 8; ++j8) c_ += (sf[jj * 8 + j8] >= (valf)) ? 1 : 0; } \
            (out) = wave_sum_i32(c_); } while (0)
        if (nvalid > 256) {
            float mx = NEG_INF, mn = -NEG_INF;
#pragma unroll
            for (int jj = 0; jj < 8; ++jj) { if (jj < gfull) {
#pragma unroll
                for (int j8 = 0; j8 < 8; ++j8) { const float v = sf[jj * 8 + j8]; mx = fmaxf(mx, v); mn = fminf(mn, v); } }
              else if (jj < ngrp) {
#pragma unroll
                for (int j8 = 0; j8 < 8; ++j8) { const float v = sf[jj * 8 + j8]; mx = fmaxf(mx, v); mn = fminf(mn, v == NEG_INF ? -NEG_INF : v); } } }
            mx = wave_max_f32(mx); mn = -wave_max_f32(-mn);
            const float scale = (mx > mn) ? 3839.0f / (mx - mn) : 0.f;
            LAS unsigned* hist = (LAS unsigned*)myrow;
#pragma unroll
            for (int k = 0; k < 16; ++k) *(LAS u32x4*)(hist + 4 * lane + 256 * k) = (u32x4){0u, 0u, 0u, 0u};
            __builtin_amdgcn_fence(__ATOMIC_RELEASE, "wavefront");
#pragma unroll
            for (int jj = 0; jj < 8; ++jj) { if (jj < gfull) {
#pragma unroll
                for (int j8 = 0; j8 < 8; ++j8) { const float v = sf[jj * 8 + j8];
                    int bn = (int)((v - mn) * scale); bn = bn > 3839 ? 3839 : bn; __hip_atomic_fetch_add(hist + (bn >> 6) * 68 + (bn & 63), 1u, __ATOMIC_RELAXED, __HIP_MEMORY_SCOPE_WAVEFRONT); } }
              else if (jj < ngrp) {
#pragma unroll
                for (int j8 = 0; j8 < 8; ++j8) { const float v = sf[jj * 8 + j8];
                    if (v != NEG_INF) { int bn = (int)((v - mn) * scale); bn = bn > 3839 ? 3839 : bn; __hip_atomic_fetch_add(hist + (bn >> 6) * 68 + (bn & 63), 1u, __ATOMIC_RELAXED, __HIP_MEMORY_SCOPE_WAVEFRONT); } } } }
            __builtin_amdgcn_fence(__ATOMIC_ACQ_REL, "wavefront");
            int cs = 0;
            if (lane < 60) {
#pragma unroll
                for (int k = 0; k < 16; ++k) { const u32x4 h4 = *(const LAS u32x4*)(hist + lane * 68 + 4 * k); cs += (int)((h4.x + h4.y) + (h4.z + h4.w)); }
            }
            int C, Bl, cnt_above, nA;
            {
                const int pre = wave_prefix_sum_i32(cs), tot = __builtin_amdgcn_readlane(pre, 63), suf = tot - pre + cs;
                const u64 mk = __ballot(suf >= 256);
                C = 63 - __builtin_clzll(mk);
                const int above_c = __builtin_amdgcn_readlane(suf, C) - __builtin_amdgcn_readlane(cs, C);
                const int bs = (int)hist[C * 68 + lane];
                const int pre2 = wave_prefix_sum_i32(bs), tot2 = __builtin_amdgcn_readlane(pre2, 63), suf2 = tot2 - pre2 + bs;
                const u64 mk2 = __ballot(suf2 >= 256 - above_c);
                Bl = 63 - __builtin_clzll(mk2);
                nA = __builtin_amdgcn_readlane(bs, Bl);
                cnt_above = above_c + __builtin_amdgcn_readlane(suf2, Bl) - nA;
            }
            const int binA = C * 64 + Bl, need1 = 256 - cnt_above;
            if (nA <= 64) {
                unsigned cv = 0u; int pos = 0;
                const float invs = (mx - mn) * (1.0f / 3839.0f), lo_f = mn + ((float)binA - 0.5f) * invs, hi_f = mn + ((float)binA + 1.5f) * invs;
#pragma unroll
                for (int jj = 0; jj < 8; ++jj) if (jj < ngrp) {
#pragma unroll
                    for (int j8 = 0; j8 < 8; ++j8) { const float v = sf[jj * 8 + j8];
                        u64 m = __ballot(v >= lo_f && v < hi_f);
                        if (m) { int bn = (int)((v - mn) * scale); bn = bn > 3839 ? 3839 : bn; m = __ballot(v >= lo_f && v < hi_f && bn == binA); }
                        while (m) { const int l = __builtin_ctzll(m); m &= m - 1ull; const unsigned uu = (unsigned)__builtin_amdgcn_readlane((int)__float_as_uint(v), l);
                            const unsigned kv = (uu & 0x80000000u) ? ~uu : (uu | 0x80000000u); if (lane == pos) cv = kv; ++pos; } } }
                unsigned tc = 0u;
                for (int bit = 31; bit >= 0; --bit) { const unsigned cand = tc | (1u << bit); if (__popcll(__ballot(cv >= cand)) >= need1) tc = cand; }
                thr_f = __uint_as_float((tc & 0x80000000u) ? (tc ^ 0x80000000u) : ~tc);
                const int cgt = cnt_above + __popcll(__ballot(cv > tc)), ceq = __popcll(__ballot(cv == tc));
                need = 256 - cgt; ties = (ceq != need);
            } else {
                unsigned tc = 0u;
                for (int bit = 31; bit >= 0; --bit) { const unsigned cand = tc | (1u << bit); const float cf = __uint_as_float((cand & 0x80000000u) ? (cand ^ 0x80000000u) : ~cand);
                    int cnt; CNT_GEF(cf, cnt); if (cnt >= 256) tc = cand; }
                thr_f = __uint_as_float((tc & 0x80000000u) ? (tc ^ 0x80000000u) : ~tc);
                int cge, cg = 0;
                CNT_GEF(thr_f, cge);
#pragma unroll
                for (int jj = 0; jj < 8; ++jj) if (jj < ngrp) {
#pragma unroll
                    for (int j8 = 0; j8 < 8; ++j8) cg += (sf[jj * 8 + j8] > thr_f) ? 1 : 0; }
                const int cgt = wave_sum_i32(cg);
                need = 256 - cgt; ties = ((cge - cgt) != need);
            }
        }
#undef CNT_GEF
        u64 myword = 0ull;
        if (nvalid <= 256) {
#pragma unroll
            for (int j = 0; j < 4; ++j) { const u64 mm = __ballot(64 * j + lane < nvalid); if (lane == j) myword = mm; }
        } else if (!ties) {
#pragma unroll
            for (int jj = 0; jj < 8; ++jj) if (jj < ngrp) {
#pragma unroll
                for (int j8 = 0; j8 < 8; ++j8) { const int j = jj * 8 + j8; const u64 mm = __ballot(sf[j] >= thr_f); if (lane == j) myword = mm; if ((j & 3) == 3) __builtin_amdgcn_sched_barrier(0); } }
        } else {
            int base = 0;
#pragma unroll
            for (int j = 0; j < 64; ++j) { const bool eq = sf[j] == thr_f; const u64 em = __ballot(eq);
                const int rank = base + (int)__builtin_amdgcn_mbcnt_hi((unsigned)(em >> 32), __builtin_amdgcn_mbcnt_lo((unsigned)em, 0u));
                const u64 mm = __ballot(sf[j] > thr_f || (eq && rank < need)); base += __popcll(em);
                if (lane == j) myword = mm; __builtin_amdgcn_sched_barrier(0); }
        }
        LAS u64* mst = (LAS u64*)(sc + 32768);
        mst[lane * 8 + wave] = myword;
    }
    __syncthreads();
    { const int tid_ = wave * 64 + lane, kt_ = tid_ >> 3, q_ = tid_ & 7; const LAS u64* mst = (const LAS u64*)(sc + 32768);
      MASK[((size_t)b * 64 + kt_) * SEQ + t0 + q_] = mst[kt_ * 8 + q_]; }
#pragma unroll
    for (int mt = 0; mt < 2; ++mt) {
#pragma unroll
        for (int ks = 0; ks < 4; ++ks) af[mt][ks] = afn[mt][ks];
    }
    }
}
#undef IDX_AF
#undef IDX_WV
#undef IDX_ITEM

constexpr int GL_BLR = 0;
constexpr int GL_W2  = GL_BLR + 4096;
constexpr int GL_GP  = GL_W2 + 4096;
constexpr int GL_QD  = GL_GP + 2048;
constexpr int GL_KD  = GL_QD + 64 * 72 * 2;
constexpr int GL_KT  = GL_KD + 64 * 72 * 2;
constexpr int GL_VT  = GL_KT + 64 * 72 * 2;
constexpr int GL_P   = GL_VT + 128 * 72 * 2;
constexpr int GL_O   = GL_P + 64 * 72 * 2;
constexpr int GL_END = GL_O + 64 * 132 * 4;

__device__ __forceinline__ void gla_stage_vt(LAS bf16_t* vt, const u32x4 (&vraw)[2], int tid) {
#pragma unroll
    for (int rep = 0; rep < 2; ++rep) { const int idx = tid + 512 * rep, j = idx >> 4, dv8 = (idx & 15) * 8;
        const u32x4 w = vraw[rep];
        vt[(dv8 + 0) * 72 + j] = (bf16_t)(w.x & 0xFFFF); vt[(dv8 + 1) * 72 + j] = (bf16_t)(w.x >> 16);
        vt[(dv8 + 2) * 72 + j] = (bf16_t)(w.y & 0xFFFF); vt[(dv8 + 3) * 72 + j] = (bf16_t)(w.y >> 16);
        vt[(dv8 + 4) * 72 + j] = (bf16_t)(w.z & 0xFFFF); vt[(dv8 + 5) * 72 + j] = (bf16_t)(w.z >> 16);
        vt[(dv8 + 6) * 72 + j] = (bf16_t)(w.w & 0xFFFF); vt[(dv8 + 7) * 72 + j] = (bf16_t)(w.w >> 16); }
}
__device__ __forceinline__ void gla_prep_state(LAS unsigned char* lds, const float* gw2, const float* gb2, int b, int hh, int n,
                                               bf16_t* BQ, bf16_t* BK, const bf16_t* BV, const float* BLR, float* DECAY) {
    const int tid = opaque_tid(), d = tid & 63, jg = tid >> 6;
    const size_t tok0 = (size_t)b * SEQ + n * 64;
    LAS float* blr = (LAS float*)(lds + GL_BLR); LAS float* w2s = (LAS float*)(lds + GL_W2); LAS float* gp = (LAS float*)(lds + GL_GP);
    LAS bf16_t* kt = (LAS bf16_t*)(lds + GL_KT); LAS bf16_t* vt = (LAS bf16_t*)(lds + GL_VT);
    bf16_t kraw[8], qraw[8]; u32x4 vraw[2];
#pragma unroll
    for (int i = 0; i < 8; ++i) { kraw[i] = BK[(tok0 + 8 * jg + i) * 256 + hh * 64 + d]; qraw[i] = BQ[(tok0 + 8 * jg + i) * 256 + hh * 64 + d]; }
#pragma unroll
    for (int rep = 0; rep < 2; ++rep) { const int idx = tid + 512 * rep; vraw[rep] = *(const u32x4*)(BV + (tok0 + (idx >> 4)) * 512 + hh * 128 + (idx & 15) * 8); }
    if (tid < 256) { *(LAS f32x4*)(blr + tid * 4) = *(const f32x4*)(BLR + tok0 * 16 + tid * 4); }
    else { const int q = tid - 256, r = q >> 4, d4 = (q & 15) * 4; *(LAS f32x4*)(w2s + r * 64 + d4) = *(const f32x4*)(gw2 + (size_t)r * 256 + hh * 64 + d4); }
    __syncthreads();
    float cs[8];
    { const float b2 = gb2[hh * 64 + d]; float run = 0.f; float w2c[16];
#pragma unroll
      for (int r = 0; r < 16; ++r) w2c[r] = w2s[r * 64 + d];
#pragma unroll
      for (int i = 0; i < 8; ++i) { float z = b2;
#pragma unroll
          for (int q = 0; q < 4; ++q) { const f32x4 bl = *(const LAS f32x4*)(blr + (8 * jg + i) * 16 + 4 * q);
              z += bl[0] * w2c[4 * q + 0]; z += bl[1] * w2c[4 * q + 1]; z += bl[2] * w2c[4 * q + 2]; z += bl[3] * w2c[4 * q + 3]; }
          const float la = -(fmaxf(-z, 0.f) + __logf(1.0f + __expf(-fabsf(z)))) * (1.0f / 16.0f);
          run += la; cs[i] = run; }
      gp[jg * 64 + d] = run; }
    __syncthreads();
    float off = 0.f, glast = 0.f;
#pragma unroll
    for (int j = 0; j < 8; ++j) { const float v = gp[j * 64 + d]; if (j < jg) off += v; glast += v; }
    const float eglast = __expf(glast);
    if (jg == 0) DECAY[((size_t)(b * 4 + hh) * 64 + n) * 64 + d] = eglast;
    unsigned ktw[4];
#pragma unroll
    for (int i = 0; i < 8; i += 2) {
        float ktv[2];
#pragma unroll
        for (int ii = 0; ii < 2; ++ii) { const int j = 8 * jg + i + ii; const float G = off + cs[i + ii];
            const float kv = bf2f(kraw[i + ii]), qv = bf2f(qraw[i + ii]);
            const float eg = __expf(G), eng = __builtin_amdgcn_rcpf(eg), kdv = kv * eng;
            ktv[ii] = kdv * eglast;
            BQ[(tok0 + j) * 256 + hh * 64 + d] = (bf16_t)(cvt_pk_bf16(qv * 0.125f * eg, 0.f) & 0xFFFFu);
            BK[(tok0 + j) * 256 + hh * 64 + d] = (bf16_t)(cvt_pk_bf16(kdv, 0.f) & 0xFFFFu); }
        ktw[i >> 1] = cvt_pk_bf16(ktv[0], ktv[1]);
    }
    *(LAS u32x4*)(kt + d * 72 + 8 * jg) = (u32x4){ktw[0], ktw[1], ktw[2], ktw[3]};
    gla_stage_vt(vt, vraw, tid);
    __syncthreads();
}
__device__ __forceinline__ void gla_prep_out(LAS unsigned char* lds, int b, int hh, int n, const bf16_t* BQ, const bf16_t* BK, const bf16_t* BV) {
    const int tid = opaque_tid(), row = tid >> 3, ch = (tid & 7) * 8;
    const size_t tok0 = (size_t)b * SEQ + n * 64;
    LAS bf16_t* qd = (LAS bf16_t*)(lds + GL_QD); LAS bf16_t* kd = (LAS bf16_t*)(lds + GL_KD); LAS bf16_t* vt = (LAS bf16_t*)(lds + GL_VT);
    u32x4 vraw[2];
    const u32x4 qw = *(const u32x4*)(BQ + (tok0 + row) * 256 + hh * 64 + ch), kw = *(const u32x4*)(BK + (tok0 + row) * 256 + hh * 64 + ch);
#pragma unroll
    for (int rep = 0; rep < 2; ++rep) { const int idx = tid + 512 * rep; vraw[rep] = *(const u32x4*)(BV + (tok0 + (idx >> 4)) * 512 + hh * 128 + (idx & 15) * 8); }
    *(LAS u32x4*)(qd + row * 72 + ch) = qw; *(LAS u32x4*)(kd + row * 72 + ch) = kw;
    gla_stage_vt(vt, vraw, tid);
    __syncthreads();
}

__device__ __forceinline__ void gla_state_item(LAS unsigned char* lds, const float* gw2, const float* gb2, int item, bf16_t* BQ, bf16_t* BK, const bf16_t* BV, const float* BLR, float* DECAY, float* GSTATE) {
    const int b = item >> 8, hh = (item >> 6) & 3, n = item & 63;
    gla_prep_state(lds, gw2, gb2, b, hh, n, BQ, BK, BV, BLR, DECAY);
    const int tid1 = opaque_tid(), lane = tid1 & 63, wave = tid1 >> 6, g = lane >> 5, c = lane & 31, mt = wave >> 1, nt = wave & 1;
    LAS bf16_t* kt = (LAS bf16_t*)(lds + GL_KT); LAS bf16_t* vt = (LAS bf16_t*)(lds + GL_VT);
    f32x16 acc;
#pragma unroll
    for (int r = 0; r < 16; ++r) acc[r] = 0.f;
#pragma unroll
    for (int ks = 0; ks < 4; ++ks) { const bf16x8 af = *(const LAS bf16x8*)(vt + (32 * mt + c) * 72 + ks * 16 + 8 * g); const bf16x8 bf = *(const LAS bf16x8*)(kt + (32 * nt + c) * 72 + ks * 16 + 8 * g);
        acc = __builtin_amdgcn_mfma_f32_32x32x16_bf16(af, bf, acc, 0, 0, 0); }
    float* dst = GSTATE + ((size_t)(b * 4 + hh) * 64 + n) * 8192;
#pragma unroll
    for (int r = 0; r < 16; ++r) { const int dv = 32 * mt + (r & 3) + 8 * (r >> 2) + 4 * g; dst[dv * 64 + 32 * nt + c] = acc[r]; }
    __syncthreads();
}

__device__ __forceinline__ void gla_out_item(LAS unsigned char* lds, const float* gw2, const float* gb2, int item, const bf16_t* BQ, const bf16_t* BK, const bf16_t* BV, const float* BLR, const bf16_t* BG,
                                              const bf16_t* SPREV, bf16_t* MIXIN) {
    const int b = item >> 8, hh = (item >> 6) & 3, n = item & 63;
    const int tid = opaque_tid(), lane = tid & 63, wave = tid >> 6, g = lane >> 5, c = lane & 31;
    bf16x8 spf[4]; u32x4 g0, g1;
    { const bf16_t* sp = SPREV + ((size_t)(b * 4 + hh) * 64 + n) * 8192 + (size_t)(32 * (wave & 3) + c) * 64 + 8 * g;
#pragma unroll
      for (int ks = 0; ks < 4; ++ks) spf[ks] = *(const bf16x8*)(sp + ks * 16);
      const size_t tokg = (size_t)b * SEQ + n * 64 + (tid >> 3);
      g0 = *(const u32x4*)(BG + tokg * 512 + hh * 128 + (tid & 7) * 16); g1 = *(const u32x4*)(BG + tokg * 512 + hh * 128 + (tid & 7) * 16 + 8); }
    gla_prep_out(lds, b, hh, n, BQ, BK, BV);
    LAS bf16_t* qd = (LAS bf16_t*)(lds + GL_QD); LAS bf16_t* kd = (LAS bf16_t*)(lds + GL_KD); LAS bf16_t* vt = (LAS bf16_t*)(lds + GL_VT); LAS bf16_t* P = (LAS bf16_t*)(lds + GL_P);
    LAS float* o = (LAS float*)(lds + GL_O);
    if (wave < 4) {
        const int mt = wave >> 1, nt = wave & 1;
        f32x16 acc;
#pragma unroll
        for (int r = 0; r < 16; ++r) acc[r] = 0.f;
        if (!(mt == 0 && nt == 1)) {
#pragma unroll
            for (int ks = 0; ks < 4; ++ks) { const bf16x8 af = *(const LAS bf16x8*)(qd + (32 * mt + c) * 72 + ks * 16 + 8 * g); const bf16x8 bf = *(const LAS bf16x8*)(kd + (32 * nt + c) * 72 + ks * 16 + 8 * g);
                acc = __builtin_amdgcn_mfma_f32_32x32x16_bf16(af, bf, acc, 0, 0, 0); }
        }
#pragma unroll
        for (int r = 0; r < 16; ++r) { const int i = 32 * mt + (r & 3) + 8 * (r >> 2) + 4 * g, j = 32 * nt + c; P[i * 72 + j] = f2bf(j <= i ? acc[r] : 0.f); }
    }
    __syncthreads();
    {
        const int mt = wave >> 2, nt = wave & 3;
        f32x16 acc;
#pragma unroll
        for (int r = 0; r < 16; ++r) acc[r] = 0.f;
#pragma unroll
        for (int ks = 0; ks < 4; ++ks) { const bf16x8 af = *(const LAS bf16x8*)(P + (32 * mt + c) * 72 + ks * 16 + 8 * g); const bf16x8 bf = *(const LAS bf16x8*)(vt + (32 * nt + c) * 72 + ks * 16 + 8 * g);
            acc = __builtin_amdgcn_mfma_f32_32x32x16_bf16(af, bf, acc, 0, 0, 0); }
#pragma unroll
        for (int ks = 0; ks < 4; ++ks) { const bf16x8 af = *(const LAS bf16x8*)(qd + (32 * mt + c) * 72 + ks * 16 + 8 * g); acc = __builtin_amdgcn_mfma_f32_32x32x16_bf16(af, spf[ks], acc, 0, 0, 0); }
#pragma unroll
        for (int r = 0; r < 16; ++r) { const int i = 32 * mt + (r & 3) + 8 * (r >> 2) + 4 * g; o[i * 132 + 32 * nt + c] = acc[r]; }
    }
    __syncthreads();
    {
        const int row = tid >> 3, part = tid & 7; float v[16]; float ss = 0.f;
#pragma unroll
        for (int k = 0; k < 16; ++k) { v[k] = o[row * 132 + part * 16 + k]; ss += v[k] * v[k]; }
        ss += __shfl_xor(ss, 1); ss += __shfl_xor(ss, 2); ss += __shfl_xor(ss, 4);
        const float r = rsqrtf(ss * (1.0f / 128.0f) + EPS);
        const size_t tok = (size_t)b * SEQ + n * 64 + row;
        const float gv[16] = {bflo(g0.x), bfhi(g0.x), bflo(g0.y), bfhi(g0.y), bflo(g0.z), bfhi(g0.z), bflo(g0.w), bfhi(g0.w),
                              bflo(g1.x), bfhi(g1.x), bflo(g1.y), bfhi(g1.y), bflo(g1.z), bfhi(g1.z), bflo(g1.w), bfhi(g1.w)};
        unsigned w[8];
#pragma unroll
        for (int k = 0; k < 8; ++k) w[k] = cvt_pk_bf16(v[2 * k] * r * gv[2 * k], v[2 * k + 1] * r * gv[2 * k + 1]);
        bf16_t* dp = MIXIN + tok * 1024 + 512 + hh * 128 + part * 16;
        *(u32x4*)dp = (u32x4){w[0], w[1], w[2], w[3]}; *(u32x4*)(dp + 8) = (u32x4){w[4], w[5], w[6], w[7]};
    }
    __syncthreads();
}

constexpr int AT_K0 = 0, AT_V0 = 9216, AT_STAGE = 18432, AT_BT = 2 * AT_STAGE;
constexpr float LOG2E = 1.4426950408889634f, AT_C1 = 0.125f * LOG2E, AT_THR = 8.0f;

template <bool NEAR>
__device__ __forceinline__ void attn_tile(const LAS bf16_t* Kt, const LAS bf16_t* Vt, const LAS float* btl, const bf16x8 (&qf)[4], f32x16& negm, f32x16& O0, f32x16& O1, float& m_ref, float& thr, f32pair_t& lsum,
                                          u64 mw, int tq, int key0, int g, int c) {
    const int pc = (c & 0x13) | ((c & 4) << 1) | ((c & 8) >> 1);
    f32x16 s0, s1;
#pragma unroll
    for (int ks = 0; ks < 4; ++ks) {
        const bf16x8 k0 = *(const LAS bf16x8*)(Kt + pc * 72 + ks * 16 + 8 * g), k1 = *(const LAS bf16x8*)(Kt + (32 + pc) * 72 + ks * 16 + 8 * g);
        if (ks == 0) { s0 = __builtin_amdgcn_mfma_f32_32x32x16_bf16(k0, qf[0], negm, 0, 0, 0); s1 = __builtin_amdgcn_mfma_f32_32x32x16_bf16(k1, qf[0], negm, 0, 0, 0); }
        else { s0 = __builtin_amdgcn_mfma_f32_32x32x16_bf16(k0, qf[ks], s0, 0, 0, 0); s1 = __builtin_amdgcn_mfma_f32_32x32x16_bf16(k1, qf[ks], s1, 0, 0, 0); }
    }
    const unsigned w0 = (unsigned)mw >> (8 * g), w1 = (unsigned)(mw >> 32) >> (8 * g);
    float x0[16], x1[16];
#pragma unroll
    for (int r = 0; r < 16; ++r) {
        if (NEAR) { const LAS float* pb = btl + (tq - key0 - 8 * g + 96 - 63);
            x0[r] = s0[r] + pb[63 - (16 * (r >> 3) + (r & 7))]; x1[r] = s1[r] + pb[63 - (16 * (r >> 3) + (r & 7) + 32)]; }
        else { x0[r] = s0[r]; x1[r] = s1[r]; }
    }
    float mx = fmaxf(fmaxf(x0[15], x0[14]), fmaxf(x1[15], x1[14]));
    asm("v_max3_f32 %0, %0, %1, %2\n\tv_max3_f32 %0, %0, %3, %4\n\tv_max3_f32 %0, %0, %5, %6\n\tv_max3_f32 %0, %0, %7, %8\n\tv_max3_f32 %0, %0, %9, %10\n\tv_max3_f32 %0, %0, %11, %12\n\tv_max3_f32 %0, %0, %13, %14"
        : "+v"(mx) : "v"(x0[0]), "v"(x1[0]), "v"(x0[1]), "v"(x1[1]), "v"(x0[2]), "v"(x1[2]), "v"(x0[3]), "v"(x1[3]), "v"(x0[4]), "v"(x1[4]), "v"(x0[5]), "v"(x1[5]), "v"(x0[6]), "v"(x1[6]));
    asm("v_max3_f32 %0, %0, %1, %2\n\tv_max3_f32 %0, %0, %3, %4\n\tv_max3_f32 %0, %0, %5, %6\n\tv_max3_f32 %0, %0, %7, %8\n\tv_max3_f32 %0, %0, %9, %10\n\tv_max3_f32 %0, %0, %11, %12\n\tv_max3_f32 %0, %0, %13, %14"
        : "+v"(mx) : "v"(x0[7]), "v"(x1[7]), "v"(x0[8]), "v"(x1[8]), "v"(x0[9]), "v"(x1[9]), "v"(x0[10]), "v"(x1[10]), "v"(x0[11]), "v"(x1[11]), "v"(x0[12]), "v"(x1[12]), "v"(x0[13]), "v"(x1[13]));
    if (__any(mx > thr)) {
        float ms = NEG_INF;
#pragma unroll
        for (int r = 0; r < 16; ++r) { const int bp = 16 * (r >> 3) + (r & 7);
            const float a0 = ((w0 >> bp) & 1u) ? x0[r] : NEG_INF, a1 = ((w1 >> bp) & 1u) ? x1[r] : NEG_INF; ms = fmaxf(ms, fmaxf(a0, a1)); }
        { const auto sw = __builtin_amdgcn_permlane32_swap(__float_as_uint(ms), __float_as_uint(ms), false, false); ms = fmaxf(__uint_as_float(sw[0]), __uint_as_float(sw[1])); }
        const bool unset = (thr == NEG_INF);
        const float delta = (ms == NEG_INF) ? 0.f : (unset ? ms : fmaxf(ms, 0.f));
        const float alpha = unset ? 1.0f : __builtin_amdgcn_exp2f(-delta);
#pragma unroll
        for (int r = 0; r < 16; ++r) { O0[r] *= alpha; O1[r] *= alpha; x0[r] -= delta; x1[r] -= delta; }
        lsum *= alpha; m_ref += delta; if (ms != NEG_INF) thr = AT_THR;
#pragma unroll
        for (int r = 0; r < 16; ++r) negm[r] = -m_ref;
    }
#pragma unroll
    for (int r = 0; r < 16; ++r) { const int bp = 16 * (r >> 3) + (r & 7);
        const float e0 = __builtin_amdgcn_exp2f(x0[r]), e1 = __builtin_amdgcn_exp2f(x1[r]);
        unsigned b0, b1;
        asm("v_bfe_i32 %0, %1, %2, 1" : "=v"(b0) : "v"(w0), "n"(bp)); asm("v_bfe_i32 %0, %1, %2, 1" : "=v"(b1) : "v"(w1), "n"(bp));
        x0[r] = __uint_as_float(__float_as_uint(e0) & b0); x1[r] = __uint_as_float(__float_as_uint(e1) & b1); }
#pragma unroll
    for (int s = 0; s < 4; ++s) {
        const float* xp = (s < 2) ? x0 : x1; const int o = 8 * (s & 1);
        u32x4 w; w.x = cvt_pk_bf16(xp[o + 0], xp[o + 1]); w.y = cvt_pk_bf16(xp[o + 2], xp[o + 3]); w.z = cvt_pk_bf16(xp[o + 4], xp[o + 5]); w.w = cvt_pk_bf16(xp[o + 6], xp[o + 7]);
        const bf16x8 pb = *(bf16x8*)&w;
        const bf16x8 v0 = *(const LAS bf16x8*)(Vt + c * 72 + s * 16 + 8 * g), v1 = *(const LAS bf16x8*)(Vt + (32 + c) * 72 + s * 16 + 8 * g);
        O0 = __builtin_amdgcn_mfma_f32_32x32x16_bf16(v0, pb, O0, 0, 0, 0); O1 = __builtin_amdgcn_mfma_f32_32x32x16_bf16(v1, pb, O1, 0, 0, 0);
#pragma unroll
        for (int i = 0; i < 8; i += 2) lsum += (f32pair_t){xp[o + i], xp[o + i + 1]};
    }
}

__device__ __forceinline__ void attn_item(LAS unsigned char* lds, const bf16_t* Q, const bf16_t* Kb, const bf16_t* VT, const bf16_t* AG, const u64* MASK, const float* btab, bf16_t* MIXIN,
                                          int b, int head, int qb, int tid) {
    const int lane = tid & 63, wave = __builtin_amdgcn_readfirstlane(tid >> 6), g = lane >> 5, c = lane & 31;
    const int tq0 = qb * 256 + wave * 32, tq = tq0 + c;
    const size_t tokq = (size_t)b * SEQ + tq;
    LAS float* btl = (LAS float*)(lds + AT_BT);
    if (tid < 320) { const int rel = tid - 96; btl[tid] = (rel >= 0 && rel < 128) ? (btab[rel * 8 + head] - btab[127 * 8 + head]) * LOG2E : 0.f; }
    bf16x8 qf[4];
#pragma unroll
    for (int ks = 0; ks < 4; ++ks) { const u32x4 qw = *(const u32x4*)(Q + tokq * 512 + head * 64 + ks * 16 + 8 * g);
        u32x4 sw; sw.x = cvt_pk_bf16(bflo(qw.x) * AT_C1, bfhi(qw.x) * AT_C1); sw.y = cvt_pk_bf16(bflo(qw.y) * AT_C1, bfhi(qw.y) * AT_C1);
        sw.z = cvt_pk_bf16(bflo(qw.z) * AT_C1, bfhi(qw.z) * AT_C1); sw.w = cvt_pk_bf16(bflo(qw.w) * AT_C1, bfhi(qw.w) * AT_C1); qf[ks] = *(bf16x8*)&sw; }
    f32x16 O0, O1, negm;
#pragma unroll
    for (int r = 0; r < 16; ++r) { O0[r] = 0.f; O1[r] = 0.f; negm[r] = 0.f; }
    float m_ref = 0.f, thr = NEG_INF; f32pair_t lsum = {0.f, 0.f};
    const int nt = 4 * qb + 4, my_last = 4 * qb + (wave >> 1);
    const int srow = tid >> 3, sch = tid & 7, sto = (srow * 72 + 8 * sch) * 2;
    const bf16_t* kg = Kb + ((size_t)b * SEQ + srow) * 512 + head * 64 + 8 * sch;
    const bf16_t* vg = VT + ((size_t)(b * 8 + head) * 64 + srow) * 4096 + 8 * sch;
    const u64* Mrow = MASK + (size_t)b * 64 * SEQ + tq;
    { const u32x4 kr = *(const u32x4*)kg, vr = *(const u32x4*)vg; *(LAS u32x4*)(lds + AT_K0 + sto) = kr; *(LAS u32x4*)(lds + AT_V0 + sto) = vr; }
    u64 mw = Mrow[0];
    __syncthreads();
    int ks_near = (tq0 - 175 + 63) >> 6; ks_near = ks_near < 0 ? 0 : ks_near;
#define AT_ITER(BODY) do { const bool more = (kt + 1 < nt); u32x4 kr, vr; u64 mwn = 0ull; \
        if (more) { kr = *(const u32x4*)(kg + (size_t)(kt + 1) * 64 * 512); vr = *(const u32x4*)(vg + (kt + 1) * 64); if (kt + 1 <= my_last) mwn = Mrow[(size_t)(kt + 1) * SEQ]; } \
        { const LAS bf16_t* Kt = (const LAS bf16_t*)(lds + (kt & 1) * AT_STAGE + AT_K0); const LAS bf16_t* Vt = (const LAS bf16_t*)(lds + (kt & 1) * AT_STAGE + AT_V0); BODY; } \
        if (more) { *(LAS u32x4*)(lds + ((kt + 1) & 1) * AT_STAGE + AT_K0 + sto) = kr; *(LAS u32x4*)(lds + ((kt + 1) & 1) * AT_STAGE + AT_V0 + sto) = vr; } \
        mw = mwn; __syncthreads(); } while (0)
    int kt = 0;
    if (wave >= 4) __builtin_amdgcn_s_setprio(1);
    for (; kt < ks_near; ++kt) AT_ITER(attn_tile<false>(Kt, Vt, btl, qf, negm, O0, O1, m_ref, thr, lsum, mw, tq, 64 * kt, g, c));
    for (; kt <= my_last; ++kt) AT_ITER(attn_tile<true>(Kt, Vt, btl, qf, negm, O0, O1, m_ref, thr, lsum, mw, tq, 64 * kt, g, c));
    for (; kt < nt; ++kt) AT_ITER((void)Kt; (void)Vt);
#undef AT_ITER
    __builtin_amdgcn_s_setprio(0);
    float inv;
    { const float l1 = lsum.x + lsum.y; const auto sw = __builtin_amdgcn_permlane32_swap(__float_as_uint(l1), __float_as_uint(l1), false, false); inv = 1.0f / (__uint_as_float(sw[0]) + __uint_as_float(sw[1])); }
#pragma unroll
    for (int mt = 0; mt < 2; ++mt)
#pragma unroll
        for (int rq = 0; rq < 4; ++rq) { const int d0 = 32 * mt + 8 * rq + 4 * g;
            const u32x2 gw = *(const u32x2*)(AG + tokq * 512 + head * 64 + d0);
            const float o0 = (mt ? O1[4 * rq + 0] : O0[4 * rq + 0]) * inv * bflo(gw.x), o1 = (mt ? O1[4 * rq + 1] : O0[4 * rq + 1]) * inv * bfhi(gw.x);
            const float o2 = (mt ? O1[4 * rq + 2] : O0[4 * rq + 2]) * inv * bflo(gw.y), o3 = (mt ? O1[4 * rq + 3] : O0[4 * rq + 3]) * inv * bfhi(gw.y);
            u32x2 ow; ow.x = cvt_pk_bf16(o0, o1); ow.y = cvt_pk_bf16(o2, o3);
            *(u32x2*)(MIXIN + tokq * 1024 + head * 64 + d0) = ow; }
}

constexpr int LDS_BYTES = 147456;
constexpr int MISC_OFF = 131072 + 8192;
constexpr int NPH = 26;

__global__ void __launch_bounds__(NTHREADS, 2) fwd_kernel(Args a) {
    extern __shared__ __attribute__((aligned(16))) unsigned char lds_raw[];
    LAS unsigned char* lds = (LAS unsigned char*)lds_raw;
    const int G = gridDim.x, wg = blockIdx.x;
    volatile LAS unsigned* misc = (volatile LAS unsigned*)(lds + MISC_OFF);
    if (threadIdx.x < 4) misc[threadIdx.x] = 0u;
    __syncthreads();
    XcdBarrier bar; bar.bar = nullptr; bar.x = 0; bar.st = misc;
    if (N_LAUNCHES == 1) bar = xcd_barrier_post((unsigned*)(get_args()->ws + WS_CTL), misc);
    int lo, hi; { ArgsP ap = get_args(); lo = ap->ph_lo; hi = ap->ph_hi; }
#define WSP(type, off) ((type*)(wsl + (off)))
#define IN(k) (lo <= (k) && (k) < hi)
#define SEAM(k) do { if (N_LAUNCHES == 1 && IN(k) && IN((k) + 1)) { XcdBarrier b_ = bar; asm volatile("" : "+s"(b_.bar), "+s"(b_.x)); xcd_barrier(b_); } } while (0)

    if (IN(0)) {
        ArgsP ap = get_args(); unsigned char* wsl = ap->ws;
        weight_phase((LAS float*)lds, ap, wsl);
        if (wg == 0) for (int i = opaque_tid(); i < 1024; i += NTHREADS) { const int rel = i >> 3, h = i & 7; WSP(float, WS_TAB)[i] = ap->rel_bias[t5_bucket(rel) * 8 + h]; }
    }
    SEAM(0);

#define LAYER_BODY(LAYER_) { constexpr int layer = (LAYER_); \
        const int pb = 1 + 6 * layer, e = layer >> 1; \
        constexpr bool even = (layer & 1) == 0; \
        if (IN(pb + 0)) { \
            ArgsP ap = get_args(); unsigned char* wsl = ap->ws; \
            const bf16_t* Wm = WSP(bf16_t, WS_WEIN) + ((size_t)e * NE + 4096) * 1024; \
            if (layer == 0) norm_misc_phase(lds, ap->x, nullptr, nullptr, nullptr, nullptr, WSP(bf16_t, WS_H), WSP(float, WS_XS), Wm, WSP(bf16_t, WS_IK), WSP(float, WS_IW), WSP(float, WS_BLR)); \
            else if (even) norm_misc_phase(lds, nullptr, WSP(bf16_t, WS_H), WSP(float, WS_XS), WSP(bf16_t, WS_MIX), ap->post_norm + (layer - 1) * DM, WSP(bf16_t, WS_H), WSP(float, WS_XS), Wm, WSP(bf16_t, WS_IK), WSP(float, WS_IW), WSP(float, WS_BLR)); \
            else norm_phase(nullptr, WSP(bf16_t, WS_H), WSP(float, WS_XS), WSP(bf16_t, WS_MIX), ap->post_norm + (layer - 1) * DM, WSP(bf16_t, WS_H), WSP(float, WS_XS), nullptr); \
        } \
        SEAM(pb + 0); \
        if (even) { \
            if (IN(pb + 1)) { \
                ArgsP ap = get_args(); unsigned char* wsl = ap->ws; \
                pg8::Gemm gm{WSP(bf16_t, WS_H), WSP(bf16_t, WS_WEIN) + (size_t)e * NE * 1024, T, 4096, 1024, 1024, 1 << 30, 0}; pg8::StaticOrder S; S.init(T, 4096, G, wg); \
                EpiEvenIn E{WSP(bf16_t, WS_Q), WSP(bf16_t, WS_K), WSP(bf16_t, WS_VT), WSP(bf16_t, WS_AG), WSP(bf16_t, WS_IQ), WSP(bf16_t, WS_BQ), WSP(bf16_t, WS_BK), WSP(bf16_t, WS_BV), WSP(bf16_t, WS_BG), \
                            WSP(bf16_t, WS_IK), WSP(float, WS_IW), WSP(float, WS_BLR)}; \
                pg8::gemm_phase(lds, gm, S, E); \
            } \
            SEAM(pb + 1); \
            if (IN(pb + 2)) { \
                ArgsP ap = get_args(); unsigned char* wsl = ap->ws; \
                { const int tid = opaque_tid(), lane = tid & 63, wave = __builtin_amdgcn_readfirstlane(tid >> 6); \
                  indexer_phase((LAS float*)lds, WSP(bf16_t, WS_IQ), WSP(bf16_t, WS_IK), WSP(float, WS_IW), WSP(u64, WS_MASK), wave, lane); } \
                { const float* gw2 = ap->even_gate_w2 + (size_t)e * 16 * 256; const float* gb2 = ap->even_gate_b2 + (size_t)e * 256; \
                  for (int it = wg; it < 1024; it += G) gla_state_item(lds, gw2, gb2, it, WSP(bf16_t, WS_BQ), WSP(bf16_t, WS_BK), WSP(bf16_t, WS_BV), WSP(float, WS_BLR), WSP(float, WS_DECAY), WSP(float, WS_MIXIN)); } \
            } \
            SEAM(pb + 2); \
            if (IN(pb + 3)) { \
                ArgsP ap = get_args(); unsigned char* wsl = ap->ws; \
                const float* GSTATE = WSP(float, WS_MIXIN); const float* DECAY = WSP(float, WS_DECAY); bf16_t* SPREV = WSP(bf16_t, WS_SPREV); \
                for (int el = wg * NTHREADS + opaque_tid(); el < 16 * 8192; el += G * NTHREADS) { \
                    const int bh = el >> 13, rem = el & 8191, dk = rem & 63; float Sv = 0.f; \
                    for (int n = 0; n < 64; ++n) { const size_t o = ((size_t)bh * 64 + n) * 8192 + rem; SPREV[o] = f2bf(Sv); Sv = DECAY[((size_t)bh * 64 + n) * 64 + dk] * Sv + GSTATE[o]; } \
                } \
            } \
            SEAM(pb + 3); \
            if (IN(pb + 4)) { \
                ArgsP ap = get_args(); unsigned char* wsl = ap->ws; \
                { const int tid = opaque_tid(); \
                  for (int it = wg; it < 512; it += G) { const int idx = it & 255, b = idx & 3, head = (idx >> 2) & 7, qbp = idx >> 5, qb = (it < 256) ? 15 - qbp : qbp; \
                      attn_item(lds, WSP(bf16_t, WS_Q), WSP(bf16_t, WS_K), WSP(bf16_t, WS_VT), WSP(bf16_t, WS_AG), WSP(u64, WS_MASK), WSP(float, WS_TAB), WSP(bf16_t, WS_MIXIN), b, head, qb, tid); } } \
                __syncthreads(); \
                { const float* gw2 = ap->even_gate_w2 + (size_t)e * 16 * 256; const float* gb2 = ap->even_gate_b2 + (size_t)e * 256; \
                  for (int it = wg; it < 1024; it += G) gla_out_item(lds, gw2, gb2, it, WSP(bf16_t, WS_BQ), WSP(bf16_t, WS_BK), WSP(bf16_t, WS_BV), WSP(float, WS_BLR), WSP(bf16_t, WS_BG), WSP(bf16_t, WS_SPREV), WSP(bf16_t, WS_MIXIN)); } \
            } \
            SEAM(pb + 4); \
        } else { \
            if (IN(pb + 1)) { \
                ArgsP ap = get_args(); unsigned char* wsl = ap->ws; \
                pg8::Gemm gm{WSP(bf16_t, WS_H), WSP(bf16_t, WS_WOIN) + (size_t)e * 2048 * 1024, T, 2048, 1024, 1024, 1 << 30, 0}; pg8::StaticOrder S; S.init(T, 2048, G, wg); \
                EpiOddIn E{WSP(bf16_t, WS_XR), WSP(bf16_t, WS_GS)}; \
                pg8::gemm_phase(lds, gm, S, E); \
            } \
            SEAM(pb + 1); \
            if (IN(pb + 2)) { \
                ArgsP ap = get_args(); unsigned char* wsl = ap->ws; \
                const bf16_t* XR = WSP(bf16_t, WS_XR); bf16_t* XC = WSP(bf16_t, WS_XC); \
                const float* cw = ap->odd_conv_w + (size_t)e * 4 * 1024; const float* cb = ap->odd_conv_b + (size_t)e * 1024; \
                { const int tid = opaque_tid(), c8 = (tid & 127) * 8; float wq[4][8], bq[8];   \
_Pragma("unroll") \
                  for (int k = 0; k < 8; ++k) { bq[k] = cb[c8 + k]; _Pragma("unroll") for (int j = 0; j < 4; ++j) wq[j][k] = cw[j * 1024 + c8 + k]; } \
                  for (int run = wg * 4 + (tid >> 7); run < T / 8; run += G * 4) { \
                    const int tok0 = run * 8, s0 = tok0 & 4095; float xw[11][8]; \
_Pragma("unroll") \
                    for (int i = 0; i < 11; ++i) { u32x4 w = (u32x4){0u, 0u, 0u, 0u}; if (s0 - 3 + i >= 0) w = *(const u32x4*)(XR + (size_t)(tok0 - 3 + i) * 1024 + c8); \
                        xw[i][0] = bflo(w.x); xw[i][1] = bfhi(w.x); xw[i][2] = bflo(w.y); xw[i][3] = bfhi(w.y); xw[i][4] = bflo(w.z); xw[i][5] = bfhi(w.z); xw[i][6] = bflo(w.w); xw[i][7] = bfhi(w.w); } \
_Pragma("unroll") \
                    for (int o = 0; o < 8; ++o) { float acc[8]; \
_Pragma("unroll") \
                        for (int k = 0; k < 8; ++k) acc[k] = bq[k] + wq[0][k] * xw[o][k] + wq[1][k] * xw[o + 1][k] + wq[2][k] * xw[o + 2][k] + wq[3][k] * xw[o + 3][k]; \
                        u32x4 ow; ow.x = cvt_pk_bf16(acc[0], acc[1]); ow.y = cvt_pk_bf16(acc[2], acc[3]); ow.z = cvt_pk_bf16(acc[4], acc[5]); ow.w = cvt_pk_bf16(acc[6], acc[7]); \
                        *(u32x4*)(XC + (size_t)(tok0 + o) * 1024 + c8) = ow; } \
                  } } \
            } \
            SEAM(pb + 2); \
            if (IN(pb + 3)) { \
                ArgsP ap = get_args(); unsigned char* wsl = ap->ws; \
                pg8::Gemm gm{WSP(bf16_t, WS_XC), WSP(bf16_t, WS_WOG) + (size_t)e * 2048 * 256, T, 2048, 256, 1024, 2, 512}; pg8::StaticOrder S; S.init(T, 2048, G, wg); \
                EpiGates E{ap->odd_b_a + (size_t)e * 1024, ap->odd_b_x + (size_t)e * 1024, ap->odd_lambda + (size_t)e * 1024, WSP(bf16_t, WS_XC), WSP(bf16_t, WS_LOGA), WSP(bf16_t, WS_U)}; \
                pg8::gemm_phase(lds, gm, S, E); \
            } \
            SEAM(pb + 3); \
            if (IN(pb + 4)) { \
                ArgsP ap = get_args(); unsigned char* wsl = ap->ws; \
                const bf16_t* LOGA = WSP(bf16_t, WS_LOGA); const bf16_t* U = WSP(bf16_t, WS_U); const bf16_t* GS = WSP(bf16_t, WS_GS); bf16_t* MIXIN = WSP(bf16_t, WS_MIXIN); \
                LAS float* sl = (LAS float*)lds; LAS float* hl = sl + 512; \
                const int tid = opaque_tid(); \
                for (int it = wg; it < 256; it += G) { \
                      \
                    const int xq = (it & 7) * 8 + ((it >> 3) >> 2), b = xq >> 4, ch = ((xq & 15) * 4 + ((it >> 3) & 3)) * 16 + (tid & 15), jc = tid >> 4; \
                    const size_t base = ((size_t)b * SEQ + jc * 128) * 1024 + ch, sbase = slab_idx(b * SEQ + jc * 128, ch); \
                    float hsum = 0.f, lsum = 0.f; \
                    for (int s0 = 0; s0 < 128; s0 += 16) { float la[16], uu[16]; \
                        _Pragma("unroll") for (int k = 0; k < 16; ++k) { la[k] = bf2f(LOGA[sbase + (size_t)(s0 + k) * 16]); uu[k] = bf2f(U[sbase + (size_t)(s0 + k) * 16]); } \
                        _Pragma("unroll") for (int k = 0; k < 16; ++k) { hsum = __builtin_amdgcn_exp2f(la[k]) * hsum + uu[k]; lsum += la[k]; } } \
                    sl[tid] = lsum; hl[tid] = hsum; \
                    __syncthreads(); \
                    float hin = 0.f; \
                    for (int cj = 0; cj < jc; ++cj) hin = __builtin_amdgcn_exp2f(sl[cj * 16 + (tid & 15)]) * hin + hl[cj * 16 + (tid & 15)]; \
                    float hv = hin; \
                    for (int s0 = 0; s0 < 128; s0 += 16) { float la[16], uu[16], gg[16]; \
                        _Pragma("unroll") for (int k = 0; k < 16; ++k) { la[k] = bf2f(LOGA[sbase + (size_t)(s0 + k) * 16]); uu[k] = bf2f(U[sbase + (size_t)(s0 + k) * 16]); gg[k] = bf2f(GS[sbase + (size_t)(s0 + k) * 16]); } \
                        _Pragma("unroll") for (int k = 0; k < 16; ++k) { hv = __builtin_amdgcn_exp2f(la[k]) * hv + uu[k]; MIXIN[base + (size_t)(s0 + k) * 1024] = f2bf(hv * gg[k]); } } \
                    __syncthreads(); \
                } \
            } \
            SEAM(pb + 4); \
        } \
        if (IN(pb + 5)) { \
            ArgsP ap = get_args(); unsigned char* wsl = ap->ws; \
            const bf16_t* W = (even ? WSP(bf16_t, WS_WEOUT) : WSP(bf16_t, WS_WOOUT)) + (size_t)e * 1024 * 1024; \
            pg8::Gemm gm{WSP(bf16_t, WS_MIXIN), W, T, 1024, 1024, 1024, 1 << 30, 0}; pg8::StaticOrder S; S.init(T, 1024, G, wg); \
            EpiMix E{WSP(bf16_t, WS_MIX)}; \
            pg8::gemm_phase(lds, gm, S, E); \
        } \
        SEAM(pb + 5); \
    }
    LAYER_BODY(0)
    LAYER_BODY(1)
    LAYER_BODY(2)
    LAYER_BODY(3)
#undef LAYER_BODY
    if (IN(25)) { ArgsP ap = get_args(); unsigned char* wsl = ap->ws; norm_phase(nullptr, WSP(bf16_t, WS_H), WSP(float, WS_XS), WSP(bf16_t, WS_MIX), ap->post_norm + 3 * DM, nullptr, nullptr, ap->out); }
#undef IN
#undef SEAM
#undef WSP
}

extern "C" void kernel_launch(void* const* d_in, const int* in_sizes, int n_in, void* d_out, int out_size, void* d_ws, size_t ws_size, hipStream_t stream) {
    static int grid = 0;
    if (grid == 0) {
        if (n_in != 17 || out_size != T * DM || ws_size < WS_END) { fprintf(stderr, "kernel_launch: unexpected sizes (n_in %d, out %d, ws %zu, need %zu)\n", n_in, out_size, ws_size, (size_t)WS_END); grid = -1; return; }
        int dev = 0, cus = 0, per_cu = 0;
        if (hipGetDevice(&dev) != hipSuccess || hipDeviceGetAttribute(&cus, hipDeviceAttributeMultiprocessorCount, dev) != hipSuccess) { grid = -1; return; }
        if (hipFuncSetAttribute((const void*)fwd_kernel, hipFuncAttributeMaxDynamicSharedMemorySize, LDS_BYTES) != hipSuccess) { fprintf(stderr, "kernel_launch: hipFuncSetAttribute failed\n"); grid = -1; return; }
        if (hipOccupancyMaxActiveBlocksPerMultiprocessor(&per_cu, (const void*)fwd_kernel, NTHREADS, LDS_BYTES) != hipSuccess || per_cu < 1) { fprintf(stderr, "kernel_launch: occupancy query says %d\n", per_cu); }
        (void)hipGetLastError();
        grid = cus;
    }
    if (grid < 0) return;
    (void)hipMemsetAsync((char*)d_ws + WS_CTL, 0, CTL_BYTES, stream);
    Args a{};
    a.x = (const float*)d_in[0]; a.rel_bias = (const float*)d_in[1]; a.pre_norm = (const float*)d_in[2]; a.post_norm = (const float*)d_in[3];
    a.even_w_in = (const float*)d_in[4]; a.even_gate_w2 = (const float*)d_in[5]; a.even_gate_b2 = (const float*)d_in[6]; a.even_w_out = (const float*)d_in[7];
    a.odd_w_in = (const float*)d_in[8]; a.odd_conv_w = (const float*)d_in[9]; a.odd_conv_b = (const float*)d_in[10]; a.odd_w_a = (const float*)d_in[11]; a.odd_b_a = (const float*)d_in[12];
    a.odd_w_x = (const float*)d_in[13]; a.odd_b_x = (const float*)d_in[14]; a.odd_lambda = (const float*)d_in[15]; a.odd_w_out = (const float*)d_in[16];
    a.out = (float*)d_out; a.ws = (unsigned char*)d_ws;
    if (N_LAUNCHES == 1) {
        a.ph_lo = 0; a.ph_hi = NPH;
        hipLaunchKernelGGL(fwd_kernel, dim3(grid), dim3(NTHREADS), LDS_BYTES, stream, a);
    } else {
        for (int ph = 0; ph < NPH; ++ph) { a.ph_lo = ph; a.ph_hi = ph + 1; hipLaunchKernelGGL(fwd_kernel, dim3(grid), dim3(NTHREADS), LDS_BYTES, stream, a); }
    }
}
```

```cpp
#include <hip/hip_runtime.h>
#include <stdint.h>
#include <stdio.h>

#ifndef N_LAUNCHES
#define N_LAUNCHES 1
#endif

#define LAS __attribute__((address_space(3)))
typedef unsigned short bf16_t;
typedef short bf16x8 __attribute__((ext_vector_type(8)));
typedef float f32x4 __attribute__((ext_vector_type(4)));
typedef float f32x2 __attribute__((ext_vector_type(2)));
typedef float f32x16 __attribute__((ext_vector_type(16)));
typedef unsigned u32x4 __attribute__((ext_vector_type(4)));
typedef unsigned u32x2 __attribute__((ext_vector_type(2)));
typedef unsigned long long u64;

constexpr int NB = 4, SEQ = 4096, T = NB * SEQ, DM = 1024;
constexpr int EVEN_IN = 4184, NE = 4352;
constexpr int NTHREADS = 512;
constexpr float EPS = 1e-6f;
constexpr float NEG_INF = -__builtin_inff();

constexpr size_t MB = 1024 * 1024;
constexpr size_t WS_CTL   = 0;
constexpr size_t CTL_BYTES = 65536;
constexpr size_t WS_WEIN  = WS_CTL + CTL_BYTES;
constexpr size_t WS_WEOUT = WS_WEIN + (size_t)2 * NE * 1024 * 2;
constexpr size_t WS_WOIN  = WS_WEOUT + 4 * MB;
constexpr size_t WS_WOG   = WS_WOIN + 8 * MB;
constexpr size_t WS_WOOUT = WS_WOG + 2 * MB;
constexpr size_t WS_TAB   = WS_WOOUT + 4 * MB;
constexpr size_t WS_XS    = WS_TAB + 4096;
constexpr size_t WS_H     = WS_XS + 65536;
constexpr size_t WS_MIXIN = WS_H + 32 * MB;
constexpr size_t WS_ACT   = WS_MIXIN + 32 * MB;
constexpr size_t WS_Q     = WS_ACT;
constexpr size_t WS_K     = WS_Q + 16 * MB;
constexpr size_t WS_VT    = WS_K + 16 * MB;
constexpr size_t WS_AG    = WS_VT + 16 * MB;
constexpr size_t WS_MIX   = WS_ACT;
constexpr size_t WS_IQ    = WS_AG + 16 * MB;
constexpr size_t WS_BQ    = WS_IQ + 16 * MB;
constexpr size_t WS_BK    = WS_BQ + 8 * MB;
constexpr size_t WS_BV    = WS_BK + 8 * MB;
constexpr size_t WS_BG    = WS_BV + 16 * MB;
constexpr size_t WS_IK    = WS_BG + 16 * MB;
constexpr size_t WS_IW    = WS_IK + 2 * MB;
constexpr size_t WS_BLR   = WS_IW + MB / 2;
constexpr size_t WS_MASK  = WS_BLR + MB;
constexpr size_t WS_SPREV = WS_MASK + 8 * MB;
constexpr size_t WS_DECAY = WS_SPREV + 16 * MB;
constexpr size_t WS_EVEN_END = WS_DECAY + MB / 4;
constexpr size_t WS_XR    = WS_ACT;
constexpr size_t WS_U     = WS_XR;
constexpr size_t WS_GS    = WS_XR + 32 * MB;
constexpr size_t WS_XC    = WS_GS + 32 * MB;
constexpr size_t WS_LOGA  = WS_XC + 32 * MB;
constexpr size_t WS_ODD_END = WS_LOGA + 32 * MB;
constexpr size_t WS_END   = WS_EVEN_END > WS_ODD_END ? WS_EVEN_END : WS_ODD_END;
static_assert(WS_END <= (size_t)256 * MB, "workspace map exceeds 256 MiB");

__device__ __forceinline__ float bf2f(unsigned v) { return __uint_as_float(v << 16); }
typedef __bf16 bf16pair_t __attribute__((ext_vector_type(2)));
typedef float f32pair_t __attribute__((ext_vector_type(2)));
__device__ __forceinline__ unsigned cvt_pk_bf16(float lo, float hi) { const f32pair_t v = {lo, hi}; const bf16pair_t b = __builtin_convertvector(v, bf16pair_t); return __builtin_bit_cast(unsigned, b); }
__device__ __forceinline__ bf16_t f2bf(float f) { return (bf16_t)cvt_pk_bf16(f, f); }
__device__ __forceinline__ float silu_f(float x) { return x / (1.0f + __expf(-x)); }
__device__ __forceinline__ float sigmoid_f(float x) { return 1.0f / (1.0f + __expf(-x)); }
__device__ __forceinline__ size_t slab_idx(int row, int ch) { return ((size_t)((row >> 12) * 64 + (ch >> 4)) * SEQ + (row & 4095)) * 16 + (ch & 15); }
__device__ __forceinline__ float log1p_01(float y) { const float ser = y * (1.0f - y * (0.5f - y * (0.33333334f - y * 0.25f))); return y < 0.03125f ? ser : __logf(1.0f + y); }
__device__ __forceinline__ float bflo(unsigned w) { return __uint_as_float(w << 16); }
__device__ __forceinline__ float bfhi(unsigned w) { return __uint_as_float(w & 0xFFFF0000u); }

__device__ __forceinline__ int opaque_tid() { int t = threadIdx.x; asm volatile("" : "+v"(t)); return t; }

__device__ __forceinline__ int wave_sum_i32(int v) {
    v += __builtin_amdgcn_update_dpp(0, v, 0xB1, 0xF, 0xF, true);
    v += __builtin_amdgcn_update_dpp(0, v, 0x4E, 0xF, 0xF, true);
    v += __builtin_amdgcn_update_dpp(0, v, 0x141, 0xF, 0xF, true);
    v += __builtin_amdgcn_update_dpp(0, v, 0x140, 0xF, 0xF, true);
    return __builtin_amdgcn_readlane(v, 0) + __builtin_amdgcn_readlane(v, 16) + __builtin_amdgcn_readlane(v, 32) + __builtin_amdgcn_readlane(v, 48);
}

__device__ __forceinline__ float wave_max_f32(float v) {
    v = fmaxf(v, __uint_as_float((unsigned)__builtin_amdgcn_update_dpp(0, (int)__float_as_uint(v), 0xB1, 0xF, 0xF, true)));
    v = fmaxf(v, __uint_as_float((unsigned)__builtin_amdgcn_update_dpp(0, (int)__float_as_uint(v), 0x4E, 0xF, 0xF, true)));
    v = fmaxf(v, __uint_as_float((unsigned)__builtin_amdgcn_update_dpp(0, (int)__float_as_uint(v), 0x141, 0xF, 0xF, true)));
    v = fmaxf(v, __uint_as_float((unsigned)__builtin_amdgcn_update_dpp(0, (int)__float_as_uint(v), 0x140, 0xF, 0xF, true)));
    const float a = __uint_as_float((unsigned)__builtin_amdgcn_readlane((int)__float_as_uint(v), 0)), b = __uint_as_float((unsigned)__builtin_amdgcn_readlane((int)__float_as_uint(v), 16));
    const float c = __uint_as_float((unsigned)__builtin_amdgcn_readlane((int)__float_as_uint(v), 32)), d = __uint_as_float((unsigned)__builtin_amdgcn_readlane((int)__float_as_uint(v), 48));
    return fmaxf(fmaxf(a, b), fmaxf(c, d));
}
__device__ __forceinline__ int wave_prefix_sum_i32(int v) {
    v += __builtin_amdgcn_update_dpp(0, v, 0x111, 0xF, 0xF, true);
    v += __builtin_amdgcn_update_dpp(0, v, 0x112, 0xF, 0xF, true);
    v += __builtin_amdgcn_update_dpp(0, v, 0x114, 0xF, 0xF, true);
    v += __builtin_amdgcn_update_dpp(0, v, 0x118, 0xF, 0xF, true);
    v += __builtin_amdgcn_update_dpp(0, v, 0x142, 0xA, 0xF, false);
    v += __builtin_amdgcn_update_dpp(0, v, 0x143, 0xC, 0xF, false);
    return v;
}

#define XB_TMO      128
#define XB_XCNT(j)  (256  + 64 * (j))
#define XB_XSUB(j)  (1280 + 64 * (j))
#define XB_XGEN(j)  (2304 + 64 * (j))
#define XB_TOP      3328
#define XB_TOPGEN   3392
#define XCD_BAR_WORDS 3456
#define XB_SPIN_CAP (1u << 18)

__device__ __forceinline__ unsigned xb_ld(unsigned* p)              { return __hip_atomic_load(p, __ATOMIC_RELAXED, __HIP_MEMORY_SCOPE_AGENT); }
__device__ __forceinline__ unsigned xb_add(unsigned* p, unsigned v) { return __hip_atomic_fetch_add(p, v, __ATOMIC_RELAXED, __HIP_MEMORY_SCOPE_AGENT); }
__device__ __forceinline__ unsigned xb_xcc_id() { return (unsigned)__builtin_amdgcn_s_getreg((3 << 11) | 20) & 0xFu; }
#define XB_SPIN(cond, bar) do { unsigned _sp = 0; while (cond) { __builtin_amdgcn_s_sleep(1); \
    if ((++_sp & 255u) == 0u) { if (xb_ld(&(bar)[XB_TMO])) break; if (_sp > XB_SPIN_CAP) { atomicAdd(&(bar)[XB_TMO], 1u); break; } } } } while (0)

struct XcdBarrier { unsigned* bar; unsigned x; volatile LAS unsigned* st; };

__device__ __forceinline__ XcdBarrier xcd_barrier_post(unsigned* bar, volatile LAS unsigned* st) {
    XcdBarrier b; b.bar = bar; b.x = xb_xcc_id(); b.st = st;
    if (threadIdx.x == 0) (void)xb_add(&bar[XB_XCNT(b.x)], 1u);
    return b;
}
__device__ __forceinline__ void xcd_barrier_complete(unsigned* bar, unsigned x, unsigned& nloc, unsigned& nx) {
    const unsigned G = gridDim.x * gridDim.y * gridDim.z;
    unsigned sum, cnt, mine, sp = 0u;
    for (;;) {
        sum = 0u; cnt = 0u; mine = 0u;
#pragma unroll
        for (unsigned j = 0; j < 16; ++j) { const unsigned c = xb_ld(&bar[XB_XCNT(j)]); sum += c; cnt += (c > 0u) ? 1u : 0u; mine = (j == x) ? c : mine; }
        if (sum == G) break;
        __builtin_amdgcn_s_sleep(1);
        if ((++sp & 255u) == 0u) { if (xb_ld(&bar[XB_TMO])) break; if (sp > XB_SPIN_CAP) { atomicAdd(&bar[XB_TMO], 1u); break; } }
    }
    nloc = mine > 0u ? mine : 1u; nx = cnt > 0u ? cnt : 1u;
}
__device__ __forceinline__ void xcd_barrier(const XcdBarrier& b) {
    asm volatile("s_waitcnt vmcnt(0)" ::: "memory");
    __syncthreads();
    if (threadIdx.x == 0) {
        unsigned* bar = b.bar;
        __builtin_amdgcn_s_waitcnt(0);
        unsigned nloc = b.st[0], nx = b.st[1];
        if (nloc == 0u) { xcd_barrier_complete(bar, b.x, nloc, nx); b.st[0] = nloc; b.st[1] = nx; }
        const unsigned old = xb_add(&bar[XB_XSUB(b.x)], 1u);
        const unsigned gen = old / nloc;
        if (old + 1u == (gen + 1u) * nloc) {
            __builtin_amdgcn_fence(__ATOMIC_RELEASE, "agent");
            asm volatile("s_waitcnt vmcnt(0)" ::: "memory");
            const unsigned og = xb_add(&bar[XB_TOP], 1u);
            const unsigned tg = og / nx;
            if (og + 1u == (tg + 1u) * nx) xb_add(&bar[XB_TOPGEN], 1u);
            else XB_SPIN(xb_ld(&bar[XB_TOPGEN]) == tg, bar);
            __builtin_amdgcn_fence(__ATOMIC_ACQUIRE, "agent");
            xb_add(&bar[XB_XGEN(b.x)], 1u);
            asm volatile("s_waitcnt vmcnt(0)" ::: "memory");
        } else {
            XB_SPIN(xb_ld(&bar[XB_XGEN(b.x)]) == gen, bar);
            __builtin_amdgcn_fence(__ATOMIC_ACQUIRE, "agent");
            asm volatile("s_waitcnt vmcnt(0)" ::: "memory");
        }
    }
    __syncthreads();
}

namespace pg8 {
constexpr int BM = 256, BK = 64, HALF = 128, HTB = HALF * BK * 2, STAGE_BYTES = 8 * HTB, NXCD = 8, WGM = 8;
__host__ __device__ __forceinline__ int lds_byte(int r, int c) { const int st = (r >> 4) * 2 + (c >> 5), rr = r & 15, cc = c & 31, ob = rr * 64 + cc * 2; return st * 1024 + (ob ^ (((ob >> 9) & 1) << 5)); }
__host__ __device__ __forceinline__ void stage_rc(int b, int& R, int& C) { const int st = b / 1024, sb = b % 1024, swz = sb ^ (((sb >> 9) & 1) << 5); R = (st >> 1) * 16 + swz / 64; C = (st & 1) * 32 + (swz % 64) / 2; }
__host__ __device__ __forceinline__ int perm32(int rho) { const int n = rho >> 4, i = rho & 15; return 8 * (i >> 2) + 4 * n + (i & 3); }

struct Unit { int pm, pn; };
struct Gemm { const bf16_t* A; const bf16_t* Bt; int M, N, K, lda, a_div, a_step; };

struct StaticOrder {
    int nM, nN, nwg, G, c;
    __host__ __device__ void init(int M, int N, int G_, int c_) { nM = M / BM; nN = N / BM; nwg = nM * nN; G = G_; c = c_; }
    __host__ __device__ bool next(int i, Unit& u) const {
        const long L = (long)i * G + c; if (L >= nwg) return false;
        int wgid = (int)L; { const int q = nwg / NXCD, r = nwg % NXCD, xcd = wgid % NXCD, off = wgid / NXCD; wgid = (xcd < r ? xcd * (q + 1) : r * (q + 1) + (xcd - r) * q) + off; }
        const int nig = WGM * nN, gid = wgid / nig, fm = gid * WGM, gsz = (nM - fm) < WGM ? (nM - fm) : WGM;
        u.pm = fm + ((wgid % nig) % gsz); u.pn = (wgid % nig) / gsz; return true;
    }
};

template <class Epi>
__device__ __forceinline__ void gemm_phase(LAS unsigned char* lds, const Gemm g, const StaticOrder& S, const Epi& E) {
    const int tid = opaque_tid(), wid = __builtin_amdgcn_readfirstlane(tid >> 6), lane = tid & 63, wr = wid >> 2, wc = wid & 3, fr = lane & 15, fq = lane >> 4;
    const int K = g.K, nt = K / BK, lda = g.lda;
    unsigned voffA[2], voffB[2];
#pragma unroll
    for (int i = 0; i < 2; ++i) { int R, C; stage_rc(tid * 16 + i * 8192, R, C); const int Rb = Epi::PERM ? ((R & ~31) + perm32(R & 31)) : R;
        voffA[i] = (unsigned)(R * lda + C) * 2u; voffB[i] = (unsigned)(Rb * K + C) * 2u; }
    const size_t kstep = (size_t)(BK * 2);
    const size_t hstepA = (size_t)HALF * lda * 2, hstepB = (size_t)HALF * K * 2;
    const size_t tstepA = 2 * hstepA, tstepB = 2 * hstepB;
    const unsigned ldsw = (unsigned)wid * 1024u;
    const int aoff = lds_byte(wr * 64 + fr, fq * 8), boff = lds_byte(wc * 32 + fr, fq * 8);
#define PG8_SA(b, h) (((b) * 2 + (h)) * HTB)
#define PG8_SB(b, h) ((4 + (b) * 2 + (h)) * HTB)
#define PG8_STAGE(bufoff, gbase, voff) do { _Pragma("unroll") for (int _i = 0; _i < 2; ++_i) \
        __builtin_amdgcn_global_load_lds((const unsigned*)((const char*)(gbase) + (voff)[_i]), (LAS unsigned*)(lds + (bufoff) + ldsw + _i * 8192), 16, 0, 0); } while (0)
#define PG8_LDA(dst, b, h) do { _Pragma("unroll") for (int m = 0; m < 4; ++m) _Pragma("unroll") for (int k = 0; k < 2; ++k) dst[m][k] = *(const LAS bf16x8*)(lds + PG8_SA(b, h) + aoff + m * 2048 + k * 1024); } while (0)
#define PG8_LDB(dst, b, h) do { _Pragma("unroll") for (int n = 0; n < 2; ++n) _Pragma("unroll") for (int k = 0; k < 2; ++k) dst[n][k] = *(const LAS bf16x8*)(lds + PG8_SB(b, h) + boff + n * 2048 + k * 1024); } while (0)
#define PG8_MMA(ai, bj, At, Bt) do { __builtin_amdgcn_s_setprio(1); _Pragma("unroll") for (int m = 0; m < 4; ++m) _Pragma("unroll") for (int n = 0; n < 2; ++n) _Pragma("unroll") for (int k = 0; k < 2; ++k) \
        acc[ai][bj][m][n] = __builtin_amdgcn_mfma_f32_16x16x32_bf16(Bt[n][k], At[m][k], acc[ai][bj][m][n], 0, 0, 0); __builtin_amdgcn_s_setprio(0); } while (0)
#define PG8_WAIT_V(n) asm volatile("s_waitcnt vmcnt(" #n ")" ::: "memory")
#define PG8_WAIT_L(n) asm volatile("s_waitcnt lgkmcnt(" #n ")" ::: "memory")
#define PG8_BAR __builtin_amdgcn_s_barrier()
#define PG8_SCHED __builtin_amdgcn_sched_barrier(0)
    Unit cur, nxt; int ui = 0;
    if (!S.next(0, cur)) return;
    f32x4 acc[2][2][4][2];
#pragma unroll
    for (int a = 0; a < 2; ++a)
#pragma unroll
        for (int b = 0; b < 2; ++b)
#pragma unroll
            for (int m = 0; m < 4; ++m)
#pragma unroll
                for (int n = 0; n < 2; ++n) acc[a][b][m][n] = (f32x4){0.f, 0.f, 0.f, 0.f};
    bf16x8 At[4][2], B0[2][2], B1[2][2];
    const char* cA = (const char*)g.A + (size_t)cur.pm * tstepA + (size_t)(cur.pn / g.a_div) * g.a_step; const char* cB = (const char*)g.Bt + (size_t)cur.pn * tstepB;
    PG8_STAGE(PG8_SB(0, 0), cB, voffB); PG8_STAGE(PG8_SA(0, 0), cA, voffA); PG8_STAGE(PG8_SB(0, 1), cB + hstepB, voffB); PG8_STAGE(PG8_SA(0, 1), cA + hstepA, voffA);
    if (wr == 1) PG8_BAR;
    PG8_WAIT_V(4); PG8_BAR;
    PG8_STAGE(PG8_SB(1, 0), cB + kstep, voffB); PG8_STAGE(PG8_SA(1, 0), cA + kstep, voffA); PG8_STAGE(PG8_SB(1, 1), cB + hstepB + kstep, voffB);
    PG8_WAIT_V(6); PG8_BAR;
    for (;;) {
        const bool has_next = S.next(ui + 1, nxt);
        const char* nA = has_next ? (const char*)g.A + (size_t)nxt.pm * tstepA + (size_t)(nxt.pn / g.a_div) * g.a_step : cA; const char* nB = has_next ? (const char*)g.Bt + (size_t)nxt.pn * tstepB : cB;
        for (int t = 0; t < nt; t += 2) {
            const bool last = (t == nt - 2);
            const char* a1 = cA + (size_t)(t + 1) * kstep;
            const char* a2 = last ? nA : cA + (size_t)(t + 2) * kstep; const char* b2 = last ? nB : cB + (size_t)(t + 2) * kstep;
            const char* a3 = a2 + kstep; const char* b3 = b2 + kstep;
            PG8_LDB(B0, 0, 0); PG8_SCHED; PG8_LDA(At, 0, 0); PG8_STAGE(PG8_SA(1, 1), a1 + hstepA, voffA);
            PG8_WAIT_L(8); PG8_BAR; PG8_WAIT_L(0); PG8_MMA(0, 0, At, B0); PG8_BAR; PG8_SCHED;
            PG8_LDB(B1, 0, 1); PG8_STAGE(PG8_SB(0, 0), b2, voffB);
            PG8_BAR; PG8_WAIT_L(0); PG8_MMA(0, 1, At, B1); PG8_BAR;
            PG8_LDA(At, 0, 1); PG8_STAGE(PG8_SA(0, 0), a2, voffA);
            PG8_BAR; PG8_WAIT_L(0); PG8_MMA(1, 0, At, B0); PG8_BAR; PG8_SCHED;
            PG8_STAGE(PG8_SB(0, 1), b2 + hstepB, voffB);
            PG8_WAIT_V(6); PG8_BAR; PG8_MMA(1, 1, At, B1); PG8_BAR;
            PG8_LDB(B0, 1, 0); PG8_SCHED; PG8_LDA(At, 1, 0); PG8_STAGE(PG8_SA(0, 1), a2 + hstepA, voffA);
            PG8_WAIT_L(8); PG8_BAR; PG8_WAIT_L(0); PG8_MMA(0, 0, At, B0); PG8_BAR; PG8_SCHED;
            PG8_LDB(B1, 1, 1); PG8_STAGE(PG8_SB(1, 0), b3, voffB);
            PG8_BAR; PG8_WAIT_L(0); PG8_MMA(0, 1, At, B1); PG8_BAR;
            PG8_LDA(At, 1, 1); PG8_STAGE(PG8_SA(1, 0), a3, voffA);
            PG8_BAR; PG8_WAIT_L(0); PG8_MMA(1, 0, At, B0); PG8_BAR; PG8_SCHED;
            PG8_STAGE(PG8_SB(1, 1), b3 + hstepB, voffB);
            PG8_WAIT_V(6); PG8_BAR; PG8_MMA(1, 1, At, B1); PG8_BAR;
        }
        E(acc, cur, wr, wc, fr, fq);
        if (!has_next) break;
#pragma unroll
        for (int a = 0; a < 2; ++a)
#pragma unroll
            for (int b = 0; b < 2; ++b)
#pragma unroll
                for (int m = 0; m < 4; ++m)
#pragma unroll
                    for (int n = 0; n < 2; ++n) acc[a][b][m][n] = (f32x4){0.f, 0.f, 0.f, 0.f};
        cur = nxt; cA = nA; cB = nB; ++ui;
    }
    PG8_WAIT_V(0);
    if (wr == 0) PG8_BAR;
    PG8_BAR;
#undef PG8_SA
#undef PG8_SB
#undef PG8_STAGE
#undef PG8_LDA
#undef PG8_LDB
#undef PG8_MMA
#undef PG8_WAIT_V
#undef PG8_WAIT_L
#undef PG8_BAR
#undef PG8_SCHED
}
}

struct EpiMix {
    static constexpr bool PERM = true;
    bf16_t* C;
    __device__ __forceinline__ void operator()(const f32x4 (&acc)[2][2][4][2], const pg8::Unit& u, int wr, int wc, int fr, int fq) const {
#pragma unroll
        for (int ai = 0; ai < 2; ++ai)
#pragma unroll
            for (int m = 0; m < 4; ++m) { const int row = u.pm * 256 + ai * 128 + wr * 64 + m * 16 + fr;
#pragma unroll
                for (int bj = 0; bj < 2; ++bj) { const f32x4 v0 = acc[ai][bj][m][0], v1 = acc[ai][bj][m][1];
                    u32x4 w; w.x = cvt_pk_bf16(v0[0], v0[1]); w.y = cvt_pk_bf16(v0[2], v0[3]); w.z = cvt_pk_bf16(v1[0], v1[1]); w.w = cvt_pk_bf16(v1[2], v1[3]);
                    *(u32x4*)(C + (size_t)row * 1024 + u.pn * 256 + bj * 128 + wc * 32 + 8 * fq) = w; } }
    }
};

constexpr float LOG2E_F = 1.4426950408889634f;
constexpr float IW_SCALE = 0.35355339059327373f * 0.125f;

struct EpiEvenIn {
    static constexpr bool PERM = true;
    bf16_t *Q, *Kb, *VT, *AG, *IQ, *BQ, *BK, *BV, *BG, *IK; float *IW, *BLR;
    __device__ __forceinline__ void operator()(const f32x4 (&acc)[2][2][4][2], const pg8::Unit& u, int wr, int wc, int fr, int fq) const {
        const int pn = u.pn;
        bf16_t* dst = Q; int ld = 512, col0 = 0, mode = 0;
        if (pn < 2) { dst = Q; col0 = pn * 256; }
        else if (pn < 4) { dst = Kb; col0 = (pn - 2) * 256; }
        else if (pn < 6) { mode = 2; col0 = (pn - 4) * 256; }
        else if (pn < 8) { dst = AG; col0 = (pn - 6) * 256; mode = 1; }
        else if (pn < 10) { dst = IQ; col0 = (pn - 8) * 256; }
        else if (pn == 10) { dst = BQ; ld = 256; }
        else if (pn == 11) { dst = BK; ld = 256; }
        else if (pn < 14) { dst = BV; col0 = (pn - 12) * 256; }
        else if (pn < 16) { dst = BG; col0 = (pn - 14) * 256; mode = 1; }
        else mode = 3;
#pragma unroll
        for (int ai = 0; ai < 2; ++ai)
#pragma unroll
            for (int m = 0; m < 4; ++m) {
                const int row = u.pm * 256 + ai * 128 + wr * 64 + m * 16 + fr;
#pragma unroll
                for (int bj = 0; bj < 2; ++bj) {
                    const int cb = bj * 128 + wc * 32 + 8 * fq;
                    f32x4 v0 = acc[ai][bj][m][0], v1 = acc[ai][bj][m][1];
                    if (mode <= 1) {
                        if (mode == 1) {
#pragma unroll
                            for (int j = 0; j < 4; ++j) { v0[j] = silu_f(v0[j]); v1[j] = silu_f(v1[j]); }
                        }
                        u32x4 w; w.x = cvt_pk_bf16(v0[0], v0[1]); w.y = cvt_pk_bf16(v0[2], v0[3]); w.z = cvt_pk_bf16(v1[0], v1[1]); w.w = cvt_pk_bf16(v1[2], v1[3]);
                        *(u32x4*)(dst + (size_t)row * ld + col0 + cb) = w;
                    } else if (mode == 2) {
                        const int c = col0 + cb, head = c >> 6, d = c & 63, b = row >> 12, s = row & 4095;
                        bf16_t* p = VT + ((size_t)(b * 8 + head) * 64 + d) * 4096 + s;
#pragma unroll
                        for (int j = 0; j < 4; ++j) { p[(size_t)j * 4096] = f2bf(v0[j]); p[(size_t)(j + 4) * 4096] = f2bf(v1[j]); }
                    } else {
                        if (cb < 64) {
                            u32x4 w; w.x = cvt_pk_bf16(v0[0], v0[1]); w.y = cvt_pk_bf16(v0[2], v0[3]); w.z = cvt_pk_bf16(v1[0], v1[1]); w.w = cvt_pk_bf16(v1[2], v1[3]);
                            const int q = cb >> 3, bb = row >> 12, sq = row & 4095;
                            *(u32x4*)(IK + ((((size_t)(bb * 128 + (sq >> 5)) * 4 + (q >> 1)) * 2 + (q & 1)) * 32 + (sq & 31)) * 8) = w;
                        } else if (cb == 64) {
                            *(f32x4*)(IW + (size_t)row * 8) = v0 * IW_SCALE; *(f32x4*)(IW + (size_t)row * 8 + 4) = v1 * IW_SCALE;
                        } else if (cb == 72 || cb == 80) {
                            *(f32x4*)(BLR + (size_t)row * 16 + (cb - 72)) = v0; *(f32x4*)(BLR + (size_t)row * 16 + (cb - 72) + 4) = v1;
                        }
                    }
                }
            }
    }
};

struct EpiOddIn {
    static constexpr bool PERM = true;
    bf16_t *XR, *GS;
    __device__ __forceinline__ void operator()(const f32x4 (&acc)[2][2][4][2], const pg8::Unit& u, int wr, int wc, int fr, int fq) const {
        const int pn = u.pn; const bool gate = pn >= 4;
        bf16_t* dst = gate ? GS : XR; const int col0 = (pn & 3) * 256;
#pragma unroll
        for (int ai = 0; ai < 2; ++ai)
#pragma unroll
            for (int m = 0; m < 4; ++m) {
                const int row = u.pm * 256 + ai * 128 + wr * 64 + m * 16 + fr;
#pragma unroll
                for (int bj = 0; bj < 2; ++bj) {
                    const int cb = bj * 128 + wc * 32 + 8 * fq;
                    f32x4 v0 = acc[ai][bj][m][0], v1 = acc[ai][bj][m][1];
                    if (gate) {
#pragma unroll
                        for (int j = 0; j < 4; ++j) { v0[j] = silu_f(v0[j]); v1[j] = silu_f(v1[j]); }
                    }
                    u32x4 w; w.x = cvt_pk_bf16(v0[0], v0[1]); w.y = cvt_pk_bf16(v0[2], v0[3]); w.z = cvt_pk_bf16(v1[0], v1[1]); w.w = cvt_pk_bf16(v1[2], v1[3]);
                    if (gate) *(u32x4*)(GS + slab_idx(row, col0 + cb)) = w;
                    else *(u32x4*)(XR + (size_t)row * 1024 + col0 + cb) = w;
                }
            }
    }
};

struct EpiGates {
    static constexpr bool PERM = true;
    const float *b_a, *b_x, *lam; const bf16_t* XC; bf16_t* LOGA; bf16_t* U;
    __device__ __forceinline__ void operator()(const f32x4 (&acc)[2][2][4][2], const pg8::Unit& u, int wr, int wc, int fr, int fq) const {
        const int chb = (u.pn >> 1) * 256 + (u.pn & 1) * 128 + wc * 32 + 8 * fq;
#pragma unroll
        for (int nh = 0; nh < 2; ++nh) {
            const int ch0 = chb + 4 * nh;
            const f32x4 lm = *(const f32x4*)(lam + ch0);
            const f32x4 nba = *(const f32x4*)(b_a + ch0) * (-LOG2E_F), nbx = *(const f32x4*)(b_x + ch0) * (-LOG2E_F);
            f32x4 c8;
#pragma unroll
            for (int j = 0; j < 4; ++j) c8[j] = (-8.0f * LOG2E_F) * (fmaxf(-lm[j], 0.f) + log1p_01(__expf(-fabsf(lm[j]))));
#pragma unroll
            for (int ai = 0; ai < 2; ++ai)
#pragma unroll
                for (int m = 0; m < 4; ++m) {
                    const int row = u.pm * 256 + ai * 128 + wr * 64 + m * 16 + fr;
                    const u32x2 xw = *(const u32x2*)(XC + (size_t)row * 1024 + ch0);
                    const float xv[4] = {bflo(xw.x), bfhi(xw.x), bflo(xw.y), bfhi(xw.y)};
                    f32x4 la; float uu[4];
#pragma unroll
                    for (int j = 0; j < 4; ++j) {
                        const float r = __builtin_amdgcn_rcpf(1.0f + __builtin_amdgcn_exp2f(__builtin_fmaf(acc[ai][0][m][nh][j], -LOG2E_F, nba[j])));
                        const float ig = __builtin_amdgcn_rcpf(1.0f + __builtin_amdgcn_exp2f(__builtin_fmaf(acc[ai][1][m][nh][j], -LOG2E_F, nbx[j])));
                        const float l2 = c8[j] * r, av = __builtin_amdgcn_exp2f(l2);
                        la[j] = l2;
                        uu[j] = __builtin_amdgcn_sqrtf(fmaxf(__builtin_fmaf(-av, av, 1.0f), 0.f)) * ig * xv[j];
                    }
                    { u32x2 lw; lw.x = cvt_pk_bf16(la[0], la[1]); lw.y = cvt_pk_bf16(la[2], la[3]); *(u32x2*)(LOGA + slab_idx(row, ch0)) = lw; }
                    u32x2 w; w.x = cvt_pk_bf16(uu[0], uu[1]); w.y = cvt_pk_bf16(uu[2], uu[3]);
                    *(u32x2*)(U + slab_idx(row, ch0)) = w;
                }
        }
    }
};

struct Args {
    const float* x; const float* rel_bias; const float* pre_norm; const float* post_norm;
    const float* even_w_in; const float* even_gate_w2; const float* even_gate_b2; const float* even_w_out;
    const float* odd_w_in; const float* odd_conv_w; const float* odd_conv_b; const float* odd_w_a; const float* odd_b_a;
    const float* odd_w_x; const float* odd_b_x; const float* odd_lambda; const float* odd_w_out;
    float* out; unsigned char* ws; int ph_lo, ph_hi;
};

typedef const Args __attribute__((address_space(4)))* ArgsP;
__device__ __forceinline__ ArgsP get_args() { ArgsP p = (ArgsP)__builtin_amdgcn_kernarg_segment_ptr(); asm volatile("" : "+s"(p)); return p; }

constexpr int WT_EIN = 2 * 68 * 16, WT_EOUT = 2 * 256, WT_OIN = 2 * 512, WT_OOUT = 2 * 256, WT_GATE = 2 * 128, WT_ALL = WT_EIN + WT_EOUT + WT_OIN + WT_OOUT + WT_GATE;
__device__ __forceinline__ void wtile_decode(int T, ArgsP ap, unsigned char* ws, int nl, int wn, const float*& colp, int& ld, bf16_t*& drow, int& K, const float*& ksc) {
    ksc = nullptr;
    if (T < WT_EIN) { const int e = T / 1088, r = T % 1088, tn = r % 68, tk = r / 68; K = 1024; ld = EVEN_IN;
        const int n = tn * 64 + nl; int c; bool ok = true; if (n < 2560) c = n; else if (n < 4096) c = n + 72; else if (n < 4168) c = n - 1536; else if (n < 4184) c = n; else { c = 0; ok = false; }
        ksc = ap->pre_norm + (size_t)(2 * e) * DM + tk * 64;
        colp = ok ? ap->even_w_in + ((size_t)e * 1024 + tk * 64) * EVEN_IN + c : nullptr;
        drow = (bf16_t*)(ws + WS_WEIN) + ((size_t)e * NE + tn * 64 + wn) * 1024 + tk * 64; return; }
    T -= WT_EIN;
    if (T < WT_EOUT) { const int e = T / 256, r = T % 256, tn = r % 16, tk = r / 16; K = 1024; ld = 1024;
        colp = ap->even_w_out + ((size_t)e * 1024 + tk * 64) * 1024 + tn * 64 + nl; drow = (bf16_t*)(ws + WS_WEOUT) + ((size_t)e * 1024 + tn * 64 + wn) * 1024 + tk * 64; return; }
    T -= WT_EOUT;
    if (T < WT_OIN) { const int e = T / 512, r = T % 512, tn = r % 32, tk = r / 32; K = 1024; ld = 2048;
        ksc = ap->pre_norm + (size_t)(2 * e + 1) * DM + tk * 64;
        colp = ap->odd_w_in + ((size_t)e * 1024 + tk * 64) * 2048 + tn * 64 + nl; drow = (bf16_t*)(ws + WS_WOIN) + ((size_t)e * 2048 + tn * 64 + wn) * 1024 + tk * 64; return; }
    T -= WT_OIN;
    if (T < WT_OOUT) { const int e = T / 256, r = T % 256, tn = r % 16, tk = r / 16; K = 1024; ld = 1024;
        colp = ap->odd_w_out + ((size_t)e * 1024 + tk * 64) * 1024 + tn * 64 + nl; drow = (bf16_t*)(ws + WS_WOOUT) + ((size_t)e * 1024 + tn * 64 + wn) * 1024 + tk * 64; return; }
    T -= WT_OOUT;
    {
        const int o = T / 128, r = T % 128, tn = r % 32, tk = r / 32; K = 256; ld = 256;
        const int cp = tn * 64, nb = cp >> 9, j = (cp >> 8) & 1, gs = (cp >> 7) & 1, e0 = j * 128 + (cp & 127);
        const float* src = gs ? ap->odd_w_x : ap->odd_w_a;
        colp = src + (((size_t)(o * 4 + nb)) * 256 + tk * 64) * 256 + e0 + nl; drow = (bf16_t*)(ws + WS_WOG) + ((size_t)o * 2048 + cp + wn) * 256 + tk * 64; }
}
__device__ __forceinline__ void weight_phase(LAS float* tile, ArgsP ap, unsigned char* ws) {
    const int tid = opaque_tid(), G = gridDim.x, nl = tid & 63, k0 = tid >> 6, wn = tid >> 3, wk = (tid & 7) * 8;
    float r[8]; const float* colp; const float* ksc; bf16_t* drow; int ld, K;
#define WT_LOAD() do { _Pragma("unroll") for (int i = 0; i < 8; ++i) r[i] = colp ? colp[(size_t)(k0 + 8 * i) * ld] * (ksc ? ksc[k0 + 8 * i] : 1.0f) : 0.f; } while (0)
    int T = blockIdx.x;
    if (T < WT_ALL) { wtile_decode(T, ap, ws, nl, wn, colp, ld, drow, K, ksc); WT_LOAD(); }
    for (; T < WT_ALL; T += G) {
        bf16_t* dcur = drow;
#pragma unroll
        for (int i = 0; i < 8; ++i) tile[(k0 + 8 * i) * 65 + nl] = r[i];
        __syncthreads();
        if (T + G < WT_ALL) { wtile_decode(T + G, ap, ws, nl, wn, colp, ld, drow, K, ksc); WT_LOAD(); }
        float v[8];
#pragma unroll
        for (int j = 0; j < 8; ++j) v[j] = tile[(wk + j) * 65 + wn];
        u32x4 w; w.x = cvt_pk_bf16(v[0], v[1]); w.y = cvt_pk_bf16(v[2], v[3]); w.z = cvt_pk_bf16(v[4], v[5]); w.w = cvt_pk_bf16(v[6], v[7]);
        *(u32x4*)(dcur + wk) = w;
        __syncthreads();
    }
#undef WT_LOAD
}

__device__ __forceinline__ int t5_bucket(int n) {
    if (n < 16) return n;
    int v = 16 + (int)(__logf((float)n / 16.0f) / 2.0794415416798357f * 16.0f);
    return v < 31 ? v : 31;
}

__device__ __forceinline__ void norm_phase(const float* xin, const bf16_t* xh_in, const float* s_in, const bf16_t* mix, const float* postw, bf16_t* xh_out, float* s_out, float* outf) {
    const int tid0 = opaque_tid(), lane = tid0 & 63, wave = tid0 >> 6;
    for (int row = blockIdx.x * 8 + wave; row < T; row += gridDim.x * 8) {
        f32x4 xv[4];
        if (xin) {
#pragma unroll
            for (int i = 0; i < 4; ++i) xv[i] = *(const f32x4*)(xin + (size_t)row * DM + lane * 4 + 256 * i);
        } else {
            const float sc = s_in[row];
#pragma unroll
            for (int i = 0; i < 4; ++i) { const u32x2 xw = *(const u32x2*)(xh_in + (size_t)row * DM + lane * 4 + 256 * i); xv[i] = (f32x4){bflo(xw.x), bfhi(xw.x), bflo(xw.y), bfhi(xw.y)} * sc; }
        }
        if (mix) {
            f32x4 mv[4]; float ss = 0.f;
#pragma unroll
            for (int i = 0; i < 4; ++i) { const u32x2 mw = *(const u32x2*)(mix + (size_t)row * DM + lane * 4 + 256 * i); mv[i] = (f32x4){bflo(mw.x), bfhi(mw.x), bflo(mw.y), bfhi(mw.y)};
                ss += mv[i][0] * mv[i][0] + mv[i][1] * mv[i][1] + mv[i][2] * mv[i][2] + mv[i][3] * mv[i][3]; }
#pragma unroll
            for (int o = 32; o >= 1; o >>= 1) ss += __shfl_xor(ss, o);
            const float r = rsqrtf(ss * (1.0f / DM) + EPS);
#pragma unroll
            for (int i = 0; i < 4; ++i) { const f32x4 w = *(const f32x4*)(postw + lane * 4 + 256 * i); xv[i] += mv[i] * r * w; }
        }
        if (outf) {
#pragma unroll
            for (int i = 0; i < 4; ++i) *(f32x4*)(outf + (size_t)row * DM + lane * 4 + 256 * i) = xv[i];
        } else {
            float ss = 0.f;
#pragma unroll
            for (int i = 0; i < 4; ++i) ss += xv[i][0] * xv[i][0] + xv[i][1] * xv[i][1] + xv[i][2] * xv[i][2] + xv[i][3] * xv[i][3];
#pragma unroll
            for (int o = 32; o >= 1; o >>= 1) ss += __shfl_xor(ss, o);
            const float ms = ss * (1.0f / DM) + EPS, r = rsqrtf(ms);
            if (lane == 0) s_out[row] = ms * r;
#pragma unroll
            for (int i = 0; i < 4; ++i) { const f32x4 y = xv[i] * r;
                u32x2 o2; o2.x = cvt_pk_bf16(y[0], y[1]); o2.y = cvt_pk_bf16(y[2], y[3]); *(u32x2*)(xh_out + (size_t)row * DM + lane * 4 + 256 * i) = o2; }
        }
    }
}

constexpr int NM_LD = 1032;
__device__ __forceinline__ void norm_misc_phase(LAS unsigned char* lds, const float* xin, const bf16_t* xh_in, const float* s_in, const bf16_t* mix, const float* postw, bf16_t* xh_out, float* s_out,
                                                const bf16_t* Wm  , bf16_t* IK, float* IW, float* BLR) {
    const int tid0 = opaque_tid(), lane = tid0 & 63, wave = __builtin_amdgcn_readfirstlane(tid0 >> 6);
    LAS bf16_t* xs = (LAS bf16_t*)lds;
    for (int pq = blockIdx.x; pq < T / 64; pq += gridDim.x) {
        for (int i = 0; i < 8; ++i) {
            const int rl = wave * 8 + i, row = pq * 64 + rl;
            f32x4 xv[4];
            if (xin) {
#pragma unroll
                for (int k = 0; k < 4; ++k) xv[k] = *(const f32x4*)(xin + (size_t)row * DM + lane * 4 + 256 * k);
            } else {
                const float sc = s_in[row];
#pragma unroll
                for (int k = 0; k < 4; ++k) { const u32x2 xw = *(const u32x2*)(xh_in + (size_t)row * DM + lane * 4 + 256 * k); xv[k] = (f32x4){bflo(xw.x), bfhi(xw.x), bflo(xw.y), bfhi(xw.y)} * sc; }
            }
            if (mix) {
                f32x4 mv[4]; float ss = 0.f;
#pragma unroll
                for (int k = 0; k < 4; ++k) { const u32x2 mw = *(const u32x2*)(mix + (size_t)row * DM + lane * 4 + 256 * k); mv[k] = (f32x4){bflo(mw.x), bfhi(mw.x), bflo(mw.y), bfhi(mw.y)};
                    ss += mv[k][0] * mv[k][0] + mv[k][1] * mv[k][1] + mv[k][2] * mv[k][2] + mv[k][3] * mv[k][3]; }
#pragma unroll
                for (int o = 32; o >= 1; o >>= 1) ss += __shfl_xor(ss, o);
                const float r = rsqrtf(ss * (1.0f / DM) + EPS);
#pragma unroll
                for (int k = 0; k < 4; ++k) { const f32x4 w = *(const f32x4*)(postw + lane * 4 + 256 * k); xv[k] += mv[k] * r * w; }
            }
            float ss = 0.f;
#pragma unroll
            for (int k = 0; k < 4; ++k) ss += xv[k][0] * xv[k][0] + xv[k][1] * xv[k][1] + xv[k][2] * xv[k][2] + xv[k][3] * xv[k][3];
#pragma unroll
            for (int o = 32; o >= 1; o >>= 1) ss += __shfl_xor(ss, o);
            const float ms = ss * (1.0f / DM) + EPS, r = rsqrtf(ms);
            if (lane == 0) s_out[row] = ms * r;
#pragma unroll
            for (int k = 0; k < 4; ++k) { const f32x4 y = xv[k] * r;
                u32x2 o2; o2.x = cvt_pk_bf16(y[0], y[1]); o2.y = cvt_pk_bf16(y[2], y[3]);
                *(u32x2*)(xh_out + (size_t)row * DM + lane * 4 + 256 * k) = o2; *(LAS u32x2*)(xs + rl * NM_LD + lane * 4 + 256 * k) = o2; }
        }
        __syncthreads();
        if (wave < 6) {
            const int n = lane & 15, kq = lane >> 4;
            f32x4 acc[4];
#pragma unroll
            for (int mt = 0; mt < 4; ++mt) acc[mt] = (f32x4){0.f, 0.f, 0.f, 0.f};
            const bf16_t* wrow = Wm + (size_t)(16 * wave + n) * 1024 + 8 * kq;
            for (int ks = 0; ks < 32; ks += 4) {
                bf16x8 bf[4];
#pragma unroll
                for (int u = 0; u < 4; ++u) bf[u] = *(const bf16x8*)(wrow + (ks + u) * 32);
#pragma unroll
                for (int u = 0; u < 4; ++u)
#pragma unroll
                    for (int mt = 0; mt < 4; ++mt) { const bf16x8 af = *(const LAS bf16x8*)(xs + (16 * mt + n) * NM_LD + (ks + u) * 32 + 8 * kq);
                        acc[mt] = __builtin_amdgcn_mfma_f32_16x16x32_bf16(af, bf[u], acc[mt], 0, 0, 0); }
            }
#pragma unroll
            for (int mt = 0; mt < 4; ++mt)
#pragma unroll
                for (int j = 0; j < 4; ++j) { const int row = pq * 64 + 16 * mt + 4 * kq + j; const float v = acc[mt][j];
                    if (wave < 4) { const int cc = 16 * wave + n, q = cc >> 3, bb = row >> 12, sq = row & 4095;
                        IK[((((size_t)(bb * 128 + (sq >> 5)) * 4 + (q >> 1)) * 2 + (q & 1)) * 32 + (sq & 31)) * 8 + (cc & 7)] = f2bf(v); }
                    else if (wave == 4) { if (n < 8) IW[(size_t)row * 8 + n] = v * IW_SCALE; else BLR[(size_t)row * 16 + (n - 8)] = v; }
                    else { if (n < 8) BLR[(size_t)row * 16 + 8 + n] = v; } }
        }
        __syncthreads();
    }
}

#define IDX_AF(AF, b_, t0_) do { \
        const int qi_ = 2 * ((c >> 2) & 1) + (c >> 4), hh_ = (c & 3) + 4 * ((c >> 3) & 1);   \
        _Pragma("unroll") for (int mt = 0; mt < 2; ++mt) { const size_t tq_ = (size_t)(b_) * SEQ + (t0_) + 4 * mt + qi_; \
            _Pragma("unroll") for (int ks = 0; ks < 4; ++ks) AF[mt][ks] = *(const bf16x8*)(IQ + tq_ * 512 + hh_ * 64 + ks * 16 + 8 * g); } } while (0)
#define IDX_WV(WV, b_, t0_) do { \
        _Pragma("unroll") for (int mt = 0; mt < 2; ++mt) _Pragma("unroll") for (int qq = 0; qq < 2; ++qq) { const size_t tq_ = (size_t)(b_) * SEQ + (t0_) + 4 * mt + 2 * g + qq; \
            const f32x4 w0_ = *(const f32x4*)(IW + tq_ * 8), w1_ = *(const f32x4*)(IW + tq_ * 8 + 4); \
            WV[mt][qq][0] = w0_[0]; WV[mt][qq][1] = w0_[1]; WV[mt][qq][2] = w0_[2]; WV[mt][qq][3] = w0_[3]; WV[mt][qq][4] = w1_[0]; WV[mt][qq][5] = w1_[1]; WV[mt][qq][6] = w1_[2]; WV[mt][qq][7] = w1_[3]; } } while (0)

__device__ __forceinline__ void indexer_phase(LAS float* sc, const bf16_t* IQ, const bf16_t* IK, const float* IW, u64* MASK, int wave, int lane) {
    const int g = lane >> 5, c = lane & 31, G = gridDim.x;
    bf16x8 af[2][4];
#define IDX_ITEM(k_) ((k_) * G + (((k_) & 1) ? (G - 1 - (int)blockIdx.x) : (int)blockIdx.x))
    { const int it0 = IDX_ITEM(0); if (it0 < 2048) IDX_AF(af, it0 & 3, (511 - (it0 >> 2)) * 8); }
        for (int kk = 0; kk * G < 2048; ++kk) {
    const int it = IDX_ITEM(kk); if (it >= 2048) break;
    const int b = it & 3, t0 = (511 - (it >> 2)) * 8;
    float wv[2][2][8];
    IDX_WV(wv, b, t0);
    const int ntiles = (t0 + 8 + 31) >> 5;
    const bf16_t* ikb = IK + (size_t)b * 128 * 2048 + (size_t)(g * 32 + c) * 8;
#define IDX_LOAD(buf, kt_) do { if ((kt_) < ntiles) { _Pragma("unroll") for (int ks = 0; ks < 4; ++ks) buf[ks] = *(const bf16x8*)(ikb + (size_t)(kt_) * 2048 + ks * 512); } } while (0)
#define IDX_TILE(buf, kt_) do { if ((kt_) < ntiles) { const int key = (kt_) * 32 + c; f32x16 a0, a1; \
        _Pragma("unroll") for (int r = 0; r < 16; ++r) { a0[r] = 0.f; a1[r] = 0.f; } \
        _Pragma("unroll") for (int ks = 0; ks < 4; ++ks) { a0 = __builtin_amdgcn_mfma_f32_32x32x16_bf16(af[0][ks], buf[ks], a0, 0, 0, 0); a1 = __builtin_amdgcn_mfma_f32_32x32x16_bf16(af[1][ks], buf[ks], a1, 0, 0, 0); } \
        _Pragma("unroll") for (int qq = 0; qq < 2; ++qq) { float s0 = 0.f, s1 = 0.f; \
            _Pragma("unroll") for (int h = 0; h < 8; ++h) { s0 += wv[0][qq][h] * fmaxf(a0[8 * qq + h], 0.f); s1 += wv[1][qq][h] * fmaxf(a1[8 * qq + h], 0.f); } \
            sc[(0 + 2 * g + qq) * 4096 + key] = s0; sc[(4 + 2 * g + qq) * 4096 + key] = s1; } } } while (0)
    {
        bf16x8 b0[4], b1[4], b2[4];
        IDX_LOAD(b0, wave); IDX_LOAD(b1, wave + 8);
        for (int kt = wave; kt < ntiles; kt += 24) {
            IDX_LOAD(b2, kt + 16); IDX_TILE(b0, kt);
            IDX_LOAD(b0, kt + 24); IDX_TILE(b1, kt + 8);
            IDX_LOAD(b1, kt + 32); IDX_TILE(b2, kt + 16);
        }
    }
#undef IDX_LOAD
#undef IDX_TILE
    __syncthreads();
    bf16x8 afn[2][4];
    { const int itn = IDX_ITEM(kk + 1); if ((kk + 1) * G < 2048 && itn < 2048) IDX_AF(afn, itn & 3, (511 - (itn >> 2)) * 8); }
    {
        const int t = t0 + wave, nvalid = t + 1, nreg = (nvalid + 63) >> 6, ngrp = (nreg + 7) >> 3;
        const int gfull = nvalid >> 9;
        LAS float* myrow = sc + wave * 4096;
        float sf[64];
#pragma unroll
        for (int jj = 0; jj < 8; ++jj) {
            if (jj < gfull) {
#pragma unroll
                for (int j8 = 0; j8 < 8; ++j8) sf[jj * 8 + j8] = myrow[64 * (jj * 8 + j8) + lane];
            } else if (jj < ngrp) {
#pragma unroll
                for (int j8 = 0; j8 < 8; ++j8) { const int j = jj * 8 + j8, kk = 64 * j + lane; const float v = myrow[kk]; sf[j] = (kk < nvalid) ? v : NEG_INF; }
            } else {
#pragma unroll
                for (int j8 = 0; j8 < 8; ++j8) sf[jj * 8 + j8] = NEG_INF;
            }
        }
        float thr_f = NEG_INF; int need = 0; bool ties = false;
#define CNT_GEF(valf, out) do { int c_ = 0; _Pragma("unroll") for (int jj = 0; jj < 8; ++jj) if (jj < ngrp) { _Pragma("unroll") for (int j8 = 0; j8 < 8; ++j8) c_ += (sf[jj * 8 + j8] >= (valf)) ? 1 : 0; } \
            (out) = wave_sum_i32(c_); } while (0)
        if (nvalid > 256) {
            float mx = NEG_INF, mn = -NEG_INF;
#pragma unroll
            for (int jj = 0; jj < 8; ++jj) { if (jj < gfull) {
#pragma unroll
                for (int j8 = 0; j8 < 8; ++j8) { const float v = sf[jj * 8 + j8]; mx = fmaxf(mx, v); mn = fminf(mn, v); } }
              else if (jj < ngrp) {
#pragma unroll
                for (int j8 = 0; j8 < 8; ++j8) { const float v = sf[jj * 8 + j8]; mx = fmaxf(mx, v); mn = fminf(mn, v == NEG_INF ? -NEG_INF : v); } } }
            mx = wave_max_f32(mx); mn = -wave_max_f32(-mn);
            const float scale = (mx > mn) ? 3839.0f / (mx - mn) : 0.f;
            LAS unsigned* hist = (LAS unsigned*)myrow;
#pragma unroll
            for (int k = 0; k < 16; ++k) *(LAS u32x4*)(hist + 4 * lane + 256 * k) = (u32x4){0u, 0u, 0u, 0u};
            __builtin_amdgcn_fence(__ATOMIC_RELEASE, "wavefront");
#pragma unroll
            for (int jj = 0; jj < 8; ++jj) { if (jj < gfull) {
#pragma unroll
                for (int j8 = 0; j8 < 8; ++j8) { const float v = sf[jj * 8 + j8];
                    int bn = (int)((v - mn) * scale); bn = bn > 3839 ? 3839 : bn; __hip_atomic_fetch_add(hist + (bn >> 6) * 68 + (bn & 63), 1u, __ATOMIC_RELAXED, __HIP_MEMORY_SCOPE_WAVEFRONT); } }
              else if (jj < ngrp) {
#pragma unroll
                for (int j8 = 0; j8 < 8; ++j8) { const float v = sf[jj * 8 + j8];
                    if (v != NEG_INF) { int bn = (int)((v - mn) * scale); bn = bn > 3839 ? 3839 : bn; __hip_atomic_fetch_add(hist + (bn >> 6) * 68 + (bn & 63), 1u, __ATOMIC_RELAXED, __HIP_MEMORY_SCOPE_WAVEFRONT); } } } }
            __builtin_amdgcn_fence(__ATOMIC_ACQ_REL, "wavefront");
            int cs = 0;
            if (lane < 60) {
#pragma unroll
                for (int k = 0; k < 16; ++k) { const u32x4 h4 = *(const LAS u32x4*)(hist + lane * 68 + 4 * k); cs += (int)((h4.x + h4.y) + (h4.z + h4.w)); }
            }
            int C, Bl, cnt_above, nA;
            {
                const int pre = wave_prefix_sum_i32(cs), tot = __builtin_amdgcn_readlane(pre, 63), suf = tot - pre + cs;
                const u64 mk = __ballot(suf >= 256);
                C = 63 - __builtin_clzll(mk);
                const int above_c = __builtin_amdgcn_readlane(suf, C) - __builtin_amdgcn_readlane(cs, C);
                const int bs = (int)hist[C * 68 + lane];
                const int pre2 = wave_prefix_sum_i32(bs), tot2 = __builtin_amdgcn_readlane(pre2, 63), suf2 = tot2 - pre2 + bs;
                const u64 mk2 = __ballot(suf2 >= 256 - above_c);
                Bl = 63 - __builtin_clzll(mk2);
                nA = __builtin_amdgcn_readlane(bs, Bl);
                cnt_above = above_c + __builtin_amdgcn_readlane(suf2, Bl) - nA;
            }
            const int binA = C * 64 + Bl, need1 = 256 - cnt_above;
            if (nA <= 64) {
                unsigned cv = 0u; int pos = 0;
                const float invs = (mx - mn) * (1.0f / 3839.0f), lo_f = mn + ((float)binA - 0.5f) * invs, hi_f = mn + ((float)binA + 1.5f) * invs;
#pragma unroll
                for (int jj = 0; jj < 8; ++jj) if (jj < ngrp) {
#pragma unroll
                    for (int j8 = 0; j8 < 8; ++j8) { const float v = sf[jj * 8 + j8];
                        u64 m = __ballot(v >= lo_f && v < hi_f);
                        if (m) { int bn = (int)((v - mn) * scale); bn = bn > 3839 ? 3839 : bn; m = __ballot(v >= lo_f && v < hi_f && bn == binA); }
                        while (m) { const int l = __builtin_ctzll(m); m &= m - 1ull; const unsigned uu = (unsigned)__builtin_amdgcn_readlane((int)__float_as_uint(v), l);
                            const unsigned kv = (uu & 0x80000000u) ? ~uu : (uu | 0x80000000u); if (lane == pos) cv = kv; ++pos; } } }
                unsigned tc = 0u;
                for (int bit = 31; bit >= 0; --bit) { const unsigned cand = tc | (1u << bit); if (__popcll(__ballot(cv >= cand)) >= need1) tc = cand; }
                thr_f = __uint_as_float((tc & 0x80000000u) ? (tc ^ 0x80000000u) : ~tc);
                const int cgt = cnt_above + __popcll(__ballot(cv > tc)), ceq = __popcll(__ballot(cv == tc));
                need = 256 - cgt; ties = (ceq != need);
            } else {
                unsigned tc = 0u;
                for (int bit = 31; bit >= 0; --bit) { const unsigned cand = tc | (1u << bit); const float cf = __uint_as_float((cand & 0x80000000u) ? (cand ^ 0x80000000u) : ~cand);
                    int cnt; CNT_GEF(cf, cnt); if (cnt >= 256) tc = cand; }
                thr_f = __uint_as_float((tc & 0x80000000u) ? (tc ^ 0x80000000u) : ~tc);
                int cge, cg = 0;
                CNT_GEF(thr_f, cge);
#pragma unroll
                for (int jj = 0; jj < 8; ++jj) if (jj < ngrp) {
#pragma unroll
                    for (int j8 = 0; j8 < 8; ++j8) cg += (sf[jj * 8 + j8] > thr_f) ? 1 : 0; }
                const int cgt = wave_sum_i32(cg);
                need = 256 - cgt; ties = ((cge - cgt) != need);
            }
        }
#undef CNT_GEF
        u64 myword = 0ull;
        if (nvalid <= 256) {
#pragma unroll
            for (int j = 0; j < 4; ++j) { const u64 mm = __ballot(64 * j + lane < nvalid); if (lane == j) myword = mm; }
        } else if (!ties) {
#pragma unroll
            for (int jj = 0; jj < 8; ++jj) if (jj < ngrp) {
#pragma unroll
                for (int j8 = 0; j8 < 8; ++j8) { const int j = jj * 8 + j8; const u64 mm = __ballot(sf[j] >= thr_f); if (lane == j) myword = mm; if ((j & 3) == 3) __builtin_amdgcn_sched_barrier(0); } }
        } else {
            int base = 0;
#pragma unroll
            for (int j = 0; j < 64; ++j) { const bool eq = sf[j] == thr_f; const u64 em = __ballot(eq);
                const int rank = base + (int)__builtin_amdgcn_mbcnt_hi((unsigned)(em >> 32), __builtin_amdgcn_mbcnt_lo((unsigned)em, 0u));
                const u64 mm = __ballot(sf[j] > thr_f || (eq && rank < need)); base += __popcll(em);
                if (lane == j) myword = mm; __builtin_amdgcn_sched_barrier(0); }
        }
        LAS u64* mst = (LAS u64*)(sc + 32768);
        mst[lane * 8 + wave] = myword;
    }
    __syncthreads();
    { const int tid_ = wave * 64 + lane, kt_ = tid_ >> 3, q_ = tid_ & 7; const LAS u64* mst = (const LAS u64*)(sc + 32768);
      MASK[((size_t)b * 64 + kt_) * SEQ + t0 + q_] = mst[kt_ * 8 + q_]; }
#pragma unroll
    for (int mt = 0; mt < 2; ++mt) {
#pragma unroll
        for (int ks = 0; ks < 4; ++ks) af[mt][ks] = afn[mt][ks];
    }
    }
}
#undef IDX_AF
#undef IDX_WV
#undef IDX_ITEM

constexpr int GL_BLR = 0;
constexpr int GL_W2  = GL_BLR + 4096;
constexpr int GL_GP  = GL_W2 + 4096;
constexpr int GL_QD  = GL_GP + 2048;
constexpr int GL_KD  = GL_QD + 64 * 72 * 2;
constexpr int GL_KT  = GL_KD + 64 * 72 * 2;
constexpr int GL_VT  = GL_KT + 64 * 72 * 2;
constexpr int GL_P   = GL_VT + 128 * 72 * 2;
constexpr int GL_O   = GL_P + 64 * 72 * 2;
constexpr int GL_END = GL_O + 64 * 132 * 4;

__device__ __forceinline__ void gla_stage_vt(LAS bf16_t* vt, const u32x4 (&vraw)[2], int tid) {
#pragma unroll
    for (int rep = 0; rep < 2; ++rep) { const int idx = tid + 512 * rep, j = idx >> 4, dv8 = (idx & 15) * 8;
        const u32x4 w = vraw[rep];
        vt[(dv8 + 0) * 72 + j] = (bf16_t)(w.x & 0xFFFF); vt[(dv8 + 1) * 72 + j] = (bf16_t)(w.x >> 16);
        vt[(dv8 + 2) * 72 + j] = (bf16_t)(w.y & 0xFFFF); vt[(dv8 + 3) * 72 + j] = (bf16_t)(w.y >> 16);
        vt[(dv8 + 4) * 72 + j] = (bf16_t)(w.z & 0xFFFF); vt[(dv8 + 5) * 72 + j] = (bf16_t)(w.z >> 16);
        vt[(dv8 + 6) * 72 + j] = (bf16_t)(w.w & 0xFFFF); vt[(dv8 + 7) * 72 + j] = (bf16_t)(w.w >> 16); }
}
__device__ __forceinline__ void gla_prep_state(LAS unsigned char* lds, const float* gw2, const float* gb2, int b, int hh, int n,
                                               bf16_t* BQ, bf16_t* BK, const bf16_t* BV, const float* BLR, float* DECAY) {
    const int tid = opaque_tid(), d = tid & 63, jg = tid >> 6;
    const size_t tok0 = (size_t)b * SEQ + n * 64;
    LAS float* blr = (LAS float*)(lds + GL_BLR); LAS float* w2s = (LAS float*)(lds + GL_W2); LAS float* gp = (LAS float*)(lds + GL_GP);
    LAS bf16_t* kt = (LAS bf16_t*)(lds + GL_KT); LAS bf16_t* vt = (LAS bf16_t*)(lds + GL_VT);
    bf16_t kraw[8], qraw[8]; u32x4 vraw[2];
#pragma unroll
    for (int i = 0; i < 8; ++i) { kraw[i] = BK[(tok0 + 8 * jg + i) * 256 + hh * 64 + d]; qraw[i] = BQ[(tok0 + 8 * jg + i) * 256 + hh * 64 + d]; }
#pragma unroll
    for (int rep = 0; rep < 2; ++rep) { const int idx = tid + 512 * rep; vraw[rep] = *(const u32x4*)(BV + (tok0 + (idx >> 4)) * 512 + hh * 128 + (idx & 15) * 8); }
    if (tid < 256) { *(LAS f32x4*)(blr + tid * 4) = *(const f32x4*)(BLR + tok0 * 16 + tid * 4); }
    else { const int q = tid - 256, r = q >> 4, d4 = (q & 15) * 4; *(LAS f32x4*)(w2s + r * 64 + d4) = *(const f32x4*)(gw2 + (size_t)r * 256 + hh * 64 + d4); }
    __syncthreads();
    float cs[8];
    { const float b2 = gb2[hh * 64 + d]; float run = 0.f; float w2c[16];
#pragma unroll
      for (int r = 0; r < 16; ++r) w2c[r] = w2s[r * 64 + d];
#pragma unroll
      for (int i = 0; i < 8; ++i) { float z = b2;
#pragma unroll
          for (int q = 0; q < 4; ++q) { const f32x4 bl = *(const LAS f32x4*)(blr + (8 * jg + i) * 16 + 4 * q);
              z += bl[0] * w2c[4 * q + 0]; z += bl[1] * w2c[4 * q + 1]; z += bl[2] * w2c[4 * q + 2]; z += bl[3] * w2c[4 * q + 3]; }
          const float la = -(fmaxf(-z, 0.f) + __logf(1.0f + __expf(-fabsf(z)))) * (1.0f / 16.0f);
          run += la; cs[i] = run; }
      gp[jg * 64 + d] = run; }
    __syncthreads();
    float off = 0.f, glast = 0.f;
#pragma unroll
    for (int j = 0; j < 8; ++j) { const float v = gp[j * 64 + d]; if (j < jg) off += v; glast += v; }
    const float eglast = __expf(glast);
    if (jg == 0) DECAY[((size_t)(b * 4 + hh) * 64 + n) * 64 + d] = eglast;
    unsigned ktw[4];
#pragma unroll
    for (int i = 0; i < 8; i += 2) {
        float ktv[2];
#pragma unroll
        for (int ii = 0; ii < 2; ++ii) { const int j = 8 * jg + i + ii; const float G = off + cs[i + ii];
            const float kv = bf2f(kraw[i + ii]), qv = bf2f(qraw[i + ii]);
            const float eg = __expf(G), eng = __builtin_amdgcn_rcpf(eg), kdv = kv * eng;
            ktv[ii] = kdv * eglast;
            BQ[(tok0 + j) * 256 + hh * 64 + d] = (bf16_t)(cvt_pk_bf16(qv * 0.125f * eg, 0.f) & 0xFFFFu);
            BK[(tok0 + j) * 256 + hh * 64 + d] = (bf16_t)(cvt_pk_bf16(kdv, 0.f) & 0xFFFFu); }
        ktw[i >> 1] = cvt_pk_bf16(ktv[0], ktv[1]);
    }
    *(LAS u32x4*)(kt + d * 72 + 8 * jg) = (u32x4){ktw[0], ktw[1], ktw[2], ktw[3]};
    gla_stage_vt(vt, vraw, tid);
    __syncthreads();
}
__device__ __forceinline__ void gla_prep_out(LAS unsigned char* lds, int b, int hh, int n, const bf16_t* BQ, const bf16_t* BK, const bf16_t* BV) {
    const int tid = opaque_tid(), row = tid >> 3, ch = (tid & 7) * 8;
    const size_t tok0 = (size_t)b * SEQ + n * 64;
    LAS bf16_t* qd = (LAS bf16_t*)(lds + GL_QD); LAS bf16_t* kd = (LAS bf16_t*)(lds + GL_KD); LAS bf16_t* vt = (LAS bf16_t*)(lds + GL_VT);
    u32x4 vraw[2];
    const u32x4 qw = *(const u32x4*)(BQ + (tok0 + row) * 256 + hh * 64 + ch), kw = *(const u32x4*)(BK + (tok0 + row) * 256 + hh * 64 + ch);
#pragma unroll
    for (int rep = 0; rep < 2; ++rep) { const int idx = tid + 512 * rep; vraw[rep] = *(const u32x4*)(BV + (tok0 + (idx >> 4)) * 512 + hh * 128 + (idx & 15) * 8); }
    *(LAS u32x4*)(qd + row * 72 + ch) = qw; *(LAS u32x4*)(kd + row * 72 + ch) = kw;
    gla_stage_vt(vt, vraw, tid);
    __syncthreads();
}

__device__ __forceinline__ void gla_state_item(LAS unsigned char* lds, const float* gw2, const float* gb2, int item, bf16_t* BQ, bf16_t* BK, const bf16_t* BV, const float* BLR, float* DECAY, float* GSTATE) {
    const int b = item >> 8, hh = (item >> 6) & 3, n = item & 63;
    gla_prep_state(lds, gw2, gb2, b, hh, n, BQ, BK, BV, BLR, DECAY);
    const int tid1 = opaque_tid(), lane = tid1 & 63, wave = tid1 >> 6, g = lane >> 5, c = lane & 31, mt = wave >> 1, nt = wave & 1;
    LAS bf16_t* kt = (LAS bf16_t*)(lds + GL_KT); LAS bf16_t* vt = (LAS bf16_t*)(lds + GL_VT);
    f32x16 acc;
#pragma unroll
    for (int r = 0; r < 16; ++r) acc[r] = 0.f;
#pragma unroll
    for (int ks = 0; ks < 4; ++ks) { const bf16x8 af = *(const LAS bf16x8*)(vt + (32 * mt + c) * 72 + ks * 16 + 8 * g); const bf16x8 bf = *(const LAS bf16x8*)(kt + (32 * nt + c) * 72 + ks * 16 + 8 * g);
        acc = __builtin_amdgcn_mfma_f32_32x32x16_bf16(af, bf, acc, 0, 0, 0); }
    float* dst = GSTATE + ((size_t)(b * 4 + hh) * 64 + n) * 8192;
#pragma unroll
    for (int r = 0; r < 16; ++r) { const int dv = 32 * mt + (r & 3) + 8 * (r >> 2) + 4 * g; dst[dv * 64 + 32 * nt + c] = acc[r]; }
    __syncthreads();
}

__device__ __forceinline__ void gla_out_item(LAS unsigned char* lds, const float* gw2, const float* gb2, int item, const bf16_t* BQ, const bf16_t* BK, const bf16_t* BV, const float* BLR, const bf16_t* BG,
                                              const bf16_t* SPREV, bf16_t* MIXIN) {
    const int b = item >> 8, hh = (item >> 6) & 3, n = item & 63;
    const int tid = opaque_tid(), lane = tid & 63, wave = tid >> 6, g = lane >> 5, c = lane & 31;
    bf16x8 spf[4]; u32x4 g0, g1;
    { const bf16_t* sp = SPREV + ((size_t)(b * 4 + hh) * 64 + n) * 8192 + (size_t)(32 * (wave & 3) + c) * 64 + 8 * g;
#pragma unroll
      for (int ks = 0; ks < 4; ++ks) spf[ks] = *(const bf16x8*)(sp + ks * 16);
      const size_t tokg = (size_t)b * SEQ + n * 64 + (tid >> 3);
      g0 = *(const u32x4*)(BG + tokg * 512 + hh * 128 + (tid & 7) * 16); g1 = *(const u32x4*)(BG + tokg * 512 + hh * 128 + (tid & 7) * 16 + 8); }
    gla_prep_out(lds, b, hh, n, BQ, BK, BV);
    LAS bf16_t* qd = (LAS bf16_t*)(lds + GL_QD); LAS bf16_t* kd = (LAS bf16_t*)(lds + GL_KD); LAS bf16_t* vt = (LAS bf16_t*)(lds + GL_VT); LAS bf16_t* P = (LAS bf16_t*)(lds + GL_P);
    LAS float* o = (LAS float*)(lds + GL_O);
    if (wave < 4) {
        const int mt = wave >> 1, nt = wave & 1;
        f32x16 acc;
#pragma unroll
        for (int r = 0; r < 16; ++r) acc[r] = 0.f;
        if (!(mt == 0 && nt == 1)) {
#pragma unroll
            for (int ks = 0; ks < 4; ++ks) { const bf16x8 af = *(const LAS bf16x8*)(qd + (32 * mt + c) * 72 + ks * 16 + 8 * g); const bf16x8 bf = *(const LAS bf16x8*)(kd + (32 * nt + c) * 72 + ks * 16 + 8 * g);
                acc = __builtin_amdgcn_mfma_f32_32x32x16_bf16(af, bf, acc, 0, 0, 0); }
        }
#pragma unroll
        for (int r = 0; r < 16; ++r) { const int i = 32 * mt + (r & 3) + 8 * (r >> 2) + 4 * g, j = 32 * nt + c; P[i * 72 + j] = f2bf(j <= i ? acc[r] : 0.f); }
    }
    __syncthreads();
    {
        const int mt = wave >> 2, nt = wave & 3;
        f32x16 acc;
#pragma unroll
        for (int r = 0; r < 16; ++r) acc[r] = 0.f;
#pragma unroll
        for (int ks = 0; ks < 4; ++ks) { const bf16x8 af = *(const LAS bf16x8*)(P + (32 * mt + c) * 72 + ks * 16 + 8 * g); const bf16x8 bf = *(const LAS bf16x8*)(vt + (32 * nt + c) * 72 + ks * 16 + 8 * g);
            acc = __builtin_amdgcn_mfma_f32_32x32x16_bf16(af, bf, acc, 0, 0, 0); }
#pragma unroll
        for (int ks = 0; ks < 4; ++ks) { const bf16x8 af = *(const LAS bf16x8*)(qd + (32 * mt + c) * 72 + ks * 16 + 8 * g); acc = __builtin_amdgcn_mfma_f32_32x32x16_bf16(af, spf[ks], acc, 0, 0, 0); }
#pragma unroll
        for (int r = 0; r < 16; ++r) { const int i = 32 * mt + (r & 3) + 8 * (r >> 2) + 4 * g; o[i * 132 + 32 * nt + c] = acc[r]; }
    }
    __syncthreads();
    {
        const int row = tid >> 3, part = tid & 7; float v[16]; float ss = 0.f;
#pragma unroll
        for (int k = 0; k < 16; ++k) { v[k] = o[row * 132 + part * 16 + k]; ss += v[k] * v[k]; }
        ss += __shfl_xor(ss, 1); ss += __shfl_xor(ss, 2); ss += __shfl_xor(ss, 4);
        const float r = rsqrtf(ss * (1.0f / 128.0f) + EPS);
        const size_t tok = (size_t)b * SEQ + n * 64 + row;
        const float gv[16] = {bflo(g0.x), bfhi(g0.x), bflo(g0.y), bfhi(g0.y), bflo(g0.z), bfhi(g0.z), bflo(g0.w), bfhi(g0.w),
                              bflo(g1.x), bfhi(g1.x), bflo(g1.y), bfhi(g1.y), bflo(g1.z), bfhi(g1.z), bflo(g1.w), bfhi(g1.w)};
        unsigned w[8];
#pragma unroll
        for (int k = 0; k < 8; ++k) w[k] = cvt_pk_bf16(v[2 * k] * r * gv[2 * k], v[2 * k + 1] * r * gv[2 * k + 1]);
        bf16_t* dp = MIXIN + tok * 1024 + 512 + hh * 128 + part * 16;
        *(u32x4*)dp = (u32x4){w[0], w[1], w[2], w[3]}; *(u32x4*)(dp + 8) = (u32x4){w[4], w[5], w[6], w[7]};
    }
    __syncthreads();
}

constexpr int AT_K0 = 0, AT_V0 = 9216, AT_STAGE = 18432, AT_BT = 2 * AT_STAGE;
constexpr float LOG2E = 1.4426950408889634f, AT_C1 = 0.125f * LOG2E, AT_THR = 8.0f;

template <bool NEAR>
__device__ __forceinline__ void attn_tile(const LAS bf16_t* Kt, const LAS bf16_t* Vt, const LAS float* btl, const bf16x8 (&qf)[4], f32x16& negm, f32x16& O0, f32x16& O1, float& m_ref, float& thr, f32pair_t& lsum,
                                          u64 mw, int tq, int key0, int g, int c) {
    const int pc = (c & 0x13) | ((c & 4) << 1) | ((c & 8) >> 1);
    f32x16 s0, s1;
#pragma unroll
    for (int ks = 0; ks < 4; ++ks) {
        const bf16x8 k0 = *(const LAS bf16x8*)(Kt + pc * 72 + ks * 16 + 8 * g), k1 = *(const LAS bf16x8*)(Kt + (32 + pc) * 72 + ks * 16 + 8 * g);
        if (ks == 0) {
            asm("v_mfma_f32_32x32x16_bf16 %0, %1, %2, %3" : "=&v"(s0) : "v"(k0), "v"(qf[0]), "v"(negm)); asm("v_mfma_f32_32x32x16_bf16 %0, %1, %2, %3" : "=&v"(s1) : "v"(k1), "v"(qf[0]), "v"(negm)); }
        else { s0 = __builtin_amdgcn_mfma_f32_32x32x16_bf16(k0, qf[ks], s0, 0, 0, 0); s1 = __builtin_amdgcn_mfma_f32_32x32x16_bf16(k1, qf[ks], s1, 0, 0, 0); }
    }
    const unsigned w0 = (unsigned)mw >> (8 * g), w1 = (unsigned)(mw >> 32) >> (8 * g);
    float x0[16], x1[16];
#pragma unroll
    for (int r = 0; r < 16; ++r) {
        if (NEAR) { const LAS float* pb = btl + (tq - key0 - 8 * g + 96 - 63);
            x0[r] = s0[r] + pb[63 - (16 * (r >> 3) + (r & 7))]; x1[r] = s1[r] + pb[63 - (16 * (r >> 3) + (r & 7) + 32)]; }
        else { x0[r] = s0[r]; x1[r] = s1[r]; }
    }
    float mx = fmaxf(fmaxf(x0[15], x0[14]), fmaxf(x1[15], x1[14]));
    asm("v_max3_f32 %0, %0, %1, %2\n\tv_max3_f32 %0, %0, %3, %4\n\tv_max3_f32 %0, %0, %5, %6\n\tv_max3_f32 %0, %0, %7, %8\n\tv_max3_f32 %0, %0, %9, %10\n\tv_max3_f32 %0, %0, %11, %12\n\tv_max3_f32 %0, %0, %13, %14"
        : "+v"(mx) : "v"(x0[0]), "v"(x1[0]), "v"(x0[1]), "v"(x1[1]), "v"(x0[2]), "v"(x1[2]), "v"(x0[3]), "v"(x1[3]), "v"(x0[4]), "v"(x1[4]), "v"(x0[5]), "v"(x1[5]), "v"(x0[6]), "v"(x1[6]));
    asm("v_max3_f32 %0, %0, %1, %2\n\tv_max3_f32 %0, %0, %3, %4\n\tv_max3_f32 %0, %0, %5, %6\n\tv_max3_f32 %0, %0, %7, %8\n\tv_max3_f32 %0, %0, %9, %10\n\tv_max3_f32 %0, %0, %11, %12\n\tv_max3_f32 %0, %0, %13, %14"
        : "+v"(mx) : "v"(x0[7]), "v"(x1[7]), "v"(x0[8]), "v"(x1[8]), "v"(x0[9]), "v"(x1[9]), "v"(x0[10]), "v"(x1[10]), "v"(x0[11]), "v"(x1[11]), "v"(x0[12]), "v"(x1[12]), "v"(x0[13]), "v"(x1[13]));
    if (__any(mx > thr)) {
        float ms = NEG_INF;
#pragma unroll
        for (int r = 0; r < 16; ++r) { const int bp = 16 * (r >> 3) + (r & 7);
            const float a0 = ((w0 >> bp) & 1u) ? x0[r] : NEG_INF, a1 = ((w1 >> bp) & 1u) ? x1[r] : NEG_INF; ms = fmaxf(ms, fmaxf(a0, a1)); }
        { const auto sw = __builtin_amdgcn_permlane32_swap(__float_as_uint(ms), __float_as_uint(ms), false, false); ms = fmaxf(__uint_as_float(sw[0]), __uint_as_float(sw[1])); }
        const bool unset = (thr == NEG_INF);
        const float delta = (ms == NEG_INF) ? 0.f : (unset ? ms : fmaxf(ms, 0.f));
        const float alpha = unset ? 1.0f : __builtin_amdgcn_exp2f(-delta);
#pragma unroll
        for (int r = 0; r < 16; ++r) { O0[r] *= alpha; O1[r] *= alpha; x0[r] -= delta; x1[r] -= delta; }
        lsum *= alpha; m_ref += delta; if (ms != NEG_INF) thr = AT_THR;
#pragma unroll
        for (int r = 0; r < 16; ++r) negm[r] = -m_ref;
    }
#pragma unroll
    for (int r = 0; r < 16; ++r) { const int bp = 16 * (r >> 3) + (r & 7);
        const float e0 = __builtin_amdgcn_exp2f(x0[r]), e1 = __builtin_amdgcn_exp2f(x1[r]);
        unsigned b0, b1;
        asm("v_bfe_i32 %0, %1, %2, 1" : "=v"(b0) : "v"(w0), "n"(bp)); asm("v_bfe_i32 %0, %1, %2, 1" : "=v"(b1) : "v"(w1), "n"(bp));
        x0[r] = __uint_as_float(__float_as_uint(e0) & b0); x1[r] = __uint_as_float(__float_as_uint(e1) & b1); }
#pragma unroll
    for (int s = 0; s < 4; ++s) {
        const float* xp = (s < 2) ? x0 : x1; const int o = 8 * (s & 1);
        u32x4 w; w.x = cvt_pk_bf16(xp[o + 0], xp[o + 1]); w.y = cvt_pk_bf16(xp[o + 2], xp[o + 3]); w.z = cvt_pk_bf16(xp[o + 4], xp[o + 5]); w.w = cvt_pk_bf16(xp[o + 6], xp[o + 7]);
        const bf16x8 pb = *(bf16x8*)&w;
        const bf16x8 v0 = *(const LAS bf16x8*)(Vt + c * 72 + s * 16 + 8 * g), v1 = *(const LAS bf16x8*)(Vt + (32 + c) * 72 + s * 16 + 8 * g);
        O0 = __builtin_amdgcn_mfma_f32_32x32x16_bf16(v0, pb, O0, 0, 0, 0); O1 = __builtin_amdgcn_mfma_f32_32x32x16_bf16(v1, pb, O1, 0, 0, 0);
#pragma unroll
        for (int i = 0; i < 8; i += 2) lsum += (f32pair_t){xp[o + i], xp[o + i + 1]};
    }
}

__device__ __forceinline__ void attn_item(LAS unsigned char* lds, const bf16_t* Q, const bf16_t* Kb, const bf16_t* VT, const bf16_t* AG, const u64* MASK, const float* btab, bf16_t* MIXIN,
                                          int b, int head, int qb, int tid) {
    const int lane = tid & 63, wave = __builtin_amdgcn_readfirstlane(tid >> 6), g = lane >> 5, c = lane & 31;
    const int tq0 = qb * 256 + wave * 32, tq = tq0 + c;
    const size_t tokq = (size_t)b * SEQ + tq;
    LAS float* btl = (LAS float*)(lds + AT_BT);
    if (tid < 320) { const int rel = tid - 96; btl[tid] = (rel >= 0 && rel < 128) ? (btab[rel * 8 + head] - btab[127 * 8 + head]) * LOG2E : 0.f; }
    bf16x8 qf[4];
#pragma unroll
    for (int ks = 0; ks < 4; ++ks) { const u32x4 qw = *(const u32x4*)(Q + tokq * 512 + head * 64 + ks * 16 + 8 * g);
        u32x4 sw; sw.x = cvt_pk_bf16(bflo(qw.x) * AT_C1, bfhi(qw.x) * AT_C1); sw.y = cvt_pk_bf16(bflo(qw.y) * AT_C1, bfhi(qw.y) * AT_C1);
        sw.z = cvt_pk_bf16(bflo(qw.z) * AT_C1, bfhi(qw.z) * AT_C1); sw.w = cvt_pk_bf16(bflo(qw.w) * AT_C1, bfhi(qw.w) * AT_C1); qf[ks] = *(bf16x8*)&sw; }
    f32x16 O0, O1, negm;
#pragma unroll
    for (int r = 0; r < 16; ++r) { O0[r] = 0.f; O1[r] = 0.f; negm[r] = 0.f; }
    float m_ref = 0.f, thr = NEG_INF; f32pair_t lsum = {0.f, 0.f};
    const int nt = 4 * qb + 4, my_last = 4 * qb + (wave >> 1);
    const int srow = tid >> 3, sch = tid & 7, sto = (srow * 72 + 8 * sch) * 2;
    const bf16_t* kg = Kb + ((size_t)b * SEQ + srow) * 512 + head * 64 + 8 * sch;
    const bf16_t* vg = VT + ((size_t)(b * 8 + head) * 64 + srow) * 4096 + 8 * sch;
    const u64* Mrow = MASK + (size_t)b * 64 * SEQ + tq;
    { const u32x4 kr = *(const u32x4*)kg, vr = *(const u32x4*)vg; *(LAS u32x4*)(lds + AT_K0 + sto) = kr; *(LAS u32x4*)(lds + AT_V0 + sto) = vr; }
    u64 mw = Mrow[0];
    __syncthreads();
    int ks_near = (tq0 - 175 + 63) >> 6; ks_near = ks_near < 0 ? 0 : ks_near;
#define AT_ITER(BODY) do { const bool more = (kt + 1 < nt); u32x4 kr, vr; u64 mwn = 0ull; \
        if (more) { kr = *(const u32x4*)(kg + (size_t)(kt + 1) * 64 * 512); vr = *(const u32x4*)(vg + (kt + 1) * 64); if (kt + 1 <= my_last) mwn = Mrow[(size_t)(kt + 1) * SEQ]; } \
        { const LAS bf16_t* Kt = (const LAS bf16_t*)(lds + (kt & 1) * AT_STAGE + AT_K0); const LAS bf16_t* Vt = (const LAS bf16_t*)(lds + (kt & 1) * AT_STAGE + AT_V0); BODY; } \
        if (more) { *(LAS u32x4*)(lds + ((kt + 1) & 1) * AT_STAGE + AT_K0 + sto) = kr; *(LAS u32x4*)(lds + ((kt + 1) & 1) * AT_STAGE + AT_V0 + sto) = vr; } \
        mw = mwn; __syncthreads(); } while (0)
    int kt = 0;
    if (wave >= 4) __builtin_amdgcn_s_setprio(1);
    for (; kt < ks_near; ++kt) AT_ITER(attn_tile<false>(Kt, Vt, btl, qf, negm, O0, O1, m_ref, thr, lsum, mw, tq, 64 * kt, g, c));
    for (; kt <= my_last; ++kt) AT_ITER(attn_tile<true>(Kt, Vt, btl, qf, negm, O0, O1, m_ref, thr, lsum, mw, tq, 64 * kt, g, c));
    for (; kt < nt; ++kt) AT_ITER((void)Kt; (void)Vt);
#undef AT_ITER
    __builtin_amdgcn_s_setprio(0);
    float inv;
    { const float l1 = lsum.x + lsum.y; const auto sw = __builtin_amdgcn_permlane32_swap(__float_as_uint(l1), __float_as_uint(l1), false, false); inv = 1.0f / (__uint_as_float(sw[0]) + __uint_as_float(sw[1])); }
#pragma unroll
    for (int mt = 0; mt < 2; ++mt)
#pragma unroll
        for (int rq = 0; rq < 4; ++rq) { const int d0 = 32 * mt + 8 * rq + 4 * g;
            const u32x2 gw = *(const u32x2*)(AG + tokq * 512 + head * 64 + d0);
            const float o0 = (mt ? O1[4 * rq + 0] : O0[4 * rq + 0]) * inv * bflo(gw.x), o1 = (mt ? O1[4 * rq + 1] : O0[4 * rq + 1]) * inv * bfhi(gw.x);
            const float o2 = (mt ? O1[4 * rq + 2] : O0[4 * rq + 2]) * inv * bflo(gw.y), o3 = (mt ? O1[4 * rq + 3] : O0[4 * rq + 3]) * inv * bfhi(gw.y);
            u32x2 ow; ow.x = cvt_pk_bf16(o0, o1); ow.y = cvt_pk_bf16(o2, o3);
            *(u32x2*)(MIXIN + tokq * 1024 + head * 64 + d0) = ow; }
}

constexpr int LDS_BYTES = 147456;
constexpr int MISC_OFF = 131072 + 8192;
constexpr int NPH = 26;

__global__ void __launch_bounds__(NTHREADS, 2) fwd_kernel(Args a) {
    extern __shared__ __attribute__((aligned(16))) unsigned char lds_raw[];
    LAS unsigned char* lds = (LAS unsigned char*)lds_raw;
    const int G = gridDim.x, wg = blockIdx.x;
    volatile LAS unsigned* misc = (volatile LAS unsigned*)(lds + MISC_OFF);
    if (threadIdx.x < 4) misc[threadIdx.x] = 0u;
    __syncthreads();
    XcdBarrier bar; bar.bar = nullptr; bar.x = 0; bar.st = misc;
    if (N_LAUNCHES == 1) bar = xcd_barrier_post((unsigned*)(get_args()->ws + WS_CTL), misc);
    int lo, hi; { ArgsP ap = get_args(); lo = ap->ph_lo; hi = ap->ph_hi; }
#define WSP(type, off) ((type*)(wsl + (off)))
#define IN(k) (lo <= (k) && (k) < hi)
#define SEAM(k) do { if (N_LAUNCHES == 1 && IN(k) && IN((k) + 1)) { XcdBarrier b_ = bar; asm volatile("" : "+s"(b_.bar), "+s"(b_.x)); xcd_barrier(b_); } } while (0)

    if (IN(0)) {
        ArgsP ap = get_args(); unsigned char* wsl = ap->ws;
        weight_phase((LAS float*)lds, ap, wsl);
        if (wg == 0) for (int i = opaque_tid(); i < 1024; i += NTHREADS) { const int rel = i >> 3, h = i & 7; WSP(float, WS_TAB)[i] = ap->rel_bias[t5_bucket(rel) * 8 + h]; }
    }
    SEAM(0);

#define LAYER_BODY(LAYER_) { constexpr int layer = (LAYER_); \
        const int pb = 1 + 6 * layer, e = layer >> 1; \
        constexpr bool even = (layer & 1) == 0; \
        if (IN(pb + 0)) { \
            ArgsP ap = get_args(); unsigned char* wsl = ap->ws; \
            const bf16_t* Wm = WSP(bf16_t, WS_WEIN) + ((size_t)e * NE + 4096) * 1024; \
            if (layer == 0) norm_misc_phase(lds, ap->x, nullptr, nullptr, nullptr, nullptr, WSP(bf16_t, WS_H), WSP(float, WS_XS), Wm, WSP(bf16_t, WS_IK), WSP(float, WS_IW), WSP(float, WS_BLR)); \
            else if (even) norm_misc_phase(lds, nullptr, WSP(bf16_t, WS_H), WSP(float, WS_XS), WSP(bf16_t, WS_MIX), ap->post_norm + (layer - 1) * DM, WSP(bf16_t, WS_H), WSP(float, WS_XS), Wm, WSP(bf16_t, WS_IK), WSP(float, WS_IW), WSP(float, WS_BLR)); \
            else norm_phase(nullptr, WSP(bf16_t, WS_H), WSP(float, WS_XS), WSP(bf16_t, WS_MIX), ap->post_norm + (layer - 1) * DM, WSP(bf16_t, WS_H), WSP(float, WS_XS), nullptr); \
        } \
        SEAM(pb + 0); \
        if (even) { \
            if (IN(pb + 1)) { \
                ArgsP ap = get_args(); unsigned char* wsl = ap->ws; \
                pg8::Gemm gm{WSP(bf16_t, WS_H), WSP(bf16_t, WS_WEIN) + (size_t)e * NE * 1024, T, 4096, 1024, 1024, 1 << 30, 0}; pg8::StaticOrder S; S.init(T, 4096, G, wg); \
                EpiEvenIn E{WSP(bf16_t, WS_Q), WSP(bf16_t, WS_K), WSP(bf16_t, WS_VT), WSP(bf16_t, WS_AG), WSP(bf16_t, WS_IQ), WSP(bf16_t, WS_BQ), WSP(bf16_t, WS_BK), WSP(bf16_t, WS_BV), WSP(bf16_t, WS_BG), \
                            WSP(bf16_t, WS_IK), WSP(float, WS_IW), WSP(float, WS_BLR)}; \
                pg8::gemm_phase(lds, gm, S, E); \
            } \
            SEAM(pb + 1); \
            if (IN(pb + 2)) { \
                ArgsP ap = get_args(); unsigned char* wsl = ap->ws; \
                { const int tid = opaque_tid(), lane = tid & 63, wave = __builtin_amdgcn_readfirstlane(tid >> 6); \
                  indexer_phase((LAS float*)lds, WSP(bf16_t, WS_IQ), WSP(bf16_t, WS_IK), WSP(float, WS_IW), WSP(u64, WS_MASK), wave, lane); } \
                { const float* gw2 = ap->even_gate_w2 + (size_t)e * 16 * 256; const float* gb2 = ap->even_gate_b2 + (size_t)e * 256; \
                  for (int it = wg; it < 1024; it += G) gla_state_item(lds, gw2, gb2, it, WSP(bf16_t, WS_BQ), WSP(bf16_t, WS_BK), WSP(bf16_t, WS_BV), WSP(float, WS_BLR), WSP(float, WS_DECAY), WSP(float, WS_MIXIN)); } \
            } \
            SEAM(pb + 2); \
            if (IN(pb + 3)) { \
                ArgsP ap = get_args(); unsigned char* wsl = ap->ws; \
                const float* GSTATE = WSP(float, WS_MIXIN); const float* DECAY = WSP(float, WS_DECAY); bf16_t* SPREV = WSP(bf16_t, WS_SPREV); \
                for (int el = wg * NTHREADS + opaque_tid(); el < 16 * 8192; el += G * NTHREADS) { \
                    const int bh = el >> 13, rem = el & 8191, dk = rem & 63; float Sv = 0.f; \
                    for (int n = 0; n < 64; ++n) { const size_t o = ((size_t)bh * 64 + n) * 8192 + rem; SPREV[o] = f2bf(Sv); Sv = DECAY[((size_t)bh * 64 + n) * 64 + dk] * Sv + GSTATE[o]; } \
                } \
            } \
            SEAM(pb + 3); \
            if (IN(pb + 4)) { \
                ArgsP ap = get_args(); unsigned char* wsl = ap->ws; \
                { const int tid = opaque_tid(); \
                  for (int it = wg; it < 512; it += G) { const int idx = it & 255, b = idx & 3, head = (idx >> 2) & 7, qbp = idx >> 5, qb = (it < 256) ? 15 - qbp : qbp; \
                      attn_item(lds, WSP(bf16_t, WS_Q), WSP(bf16_t, WS_K), WSP(bf16_t, WS_VT), WSP(bf16_t, WS_AG), WSP(u64, WS_MASK), WSP(float, WS_TAB), WSP(bf16_t, WS_MIXIN), b, head, qb, tid); } } \
                __syncthreads(); \
                { const float* gw2 = ap->even_gate_w2 + (size_t)e * 16 * 256; const float* gb2 = ap->even_gate_b2 + (size_t)e * 256; \
                  for (int it = wg; it < 1024; it += G) gla_out_item(lds, gw2, gb2, it, WSP(bf16_t, WS_BQ), WSP(bf16_t, WS_BK), WSP(bf16_t, WS_BV), WSP(float, WS_BLR), WSP(bf16_t, WS_BG), WSP(bf16_t, WS_SPREV), WSP(bf16_t, WS_MIXIN)); } \
            } \
            SEAM(pb + 4); \
        } else { \
            if (IN(pb + 1)) { \
                ArgsP ap = get_args(); unsigned char* wsl = ap->ws; \
                pg8::Gemm gm{WSP(bf16_t, WS_H), WSP(bf16_t, WS_WOIN) + (size_t)e * 2048 * 1024, T, 2048, 1024, 1024, 1 << 30, 0}; pg8::StaticOrder S; S.init(T, 2048, G, wg); \
                EpiOddIn E{WSP(bf16_t, WS_XR), WSP(bf16_t, WS_GS)}; \
                pg8::gemm_phase(lds, gm, S, E); \
            } \
            SEAM(pb + 1); \
            if (IN(pb + 2)) { \
                ArgsP ap = get_args(); unsigned char* wsl = ap->ws; \
                const bf16_t* XR = WSP(bf16_t, WS_XR); bf16_t* XC = WSP(bf16_t, WS_XC); \
                const float* cw = ap->odd_conv_w + (size_t)e * 4 * 1024; const float* cb = ap->odd_conv_b + (size_t)e * 1024; \
                { const int tid = opaque_tid(), c8 = (tid & 127) * 8; float wq[4][8], bq[8];   \
_Pragma("unroll") \
                  for (int k = 0; k < 8; ++k) { bq[k] = cb[c8 + k]; _Pragma("unroll") for (int j = 0; j < 4; ++j) wq[j][k] = cw[j * 1024 + c8 + k]; } \
                  for (int run = wg * 4 + (tid >> 7); run < T / 8; run += G * 4) { \
                    const int tok0 = run * 8, s0 = tok0 & 4095; float xw[11][8]; \
_Pragma("unroll") \
                    for (int i = 0; i < 11; ++i) { u32x4 w = (u32x4){0u, 0u, 0u, 0u}; if (s0 - 3 + i >= 0) w = *(const u32x4*)(XR + (size_t)(tok0 - 3 + i) * 1024 + c8); \
                        xw[i][0] = bflo(w.x); xw[i][1] = bfhi(w.x); xw[i][2] = bflo(w.y); xw[i][3] = bfhi(w.y); xw[i][4] = bflo(w.z); xw[i][5] = bfhi(w.z); xw[i][6] = bflo(w.w); xw[i][7] = bfhi(w.w); } \
_Pragma("unroll") \
                    for (int o = 0; o < 8; ++o) { float acc[8]; \
_Pragma("unroll") \
                        for (int k = 0; k < 8; ++k) acc[k] = bq[k] + wq[0][k] * xw[o][k] + wq[1][k] * xw[o + 1][k] + wq[2][k] * xw[o + 2][k] + wq[3][k] * xw[o + 3][k]; \
                        u32x4 ow; ow.x = cvt_pk_bf16(acc[0], acc[1]); ow.y = cvt_pk_bf16(acc[2], acc[3]); ow.z = cvt_pk_bf16(acc[4], acc[5]); ow.w = cvt_pk_bf16(acc[6], acc[7]); \
                        *(u32x4*)(XC + (size_t)(tok0 + o) * 1024 + c8) = ow; } \
                  } } \
            } \
            SEAM(pb + 2); \
            if (IN(pb + 3)) { \
                ArgsP ap = get_args(); unsigned char* wsl = ap->ws; \
                pg8::Gemm gm{WSP(bf16_t, WS_XC), WSP(bf16_t, WS_WOG) + (size_t)e * 2048 * 256, T, 2048, 256, 1024, 2, 512}; pg8::StaticOrder S; S.init(T, 2048, G, wg); \
                EpiGates E{ap->odd_b_a + (size_t)e * 1024, ap->odd_b_x + (size_t)e * 1024, ap->odd_lambda + (size_t)e * 1024, WSP(bf16_t, WS_XC), WSP(bf16_t, WS_LOGA), WSP(bf16_t, WS_U)}; \
                pg8::gemm_phase(lds, gm, S, E); \
            } \
            SEAM(pb + 3); \
            if (IN(pb + 4)) { \
                ArgsP ap = get_args(); unsigned char* wsl = ap->ws; \
                const bf16_t* LOGA = WSP(bf16_t, WS_LOGA); const bf16_t* U = WSP(bf16_t, WS_U); const bf16_t* GS = WSP(bf16_t, WS_GS); bf16_t* MIXIN = WSP(bf16_t, WS_MIXIN); \
                LAS float* sl = (LAS float*)lds; LAS float* hl = sl + 512; \
                const int tid = opaque_tid(); \
                for (int it = wg; it < 256; it += G) { \
                      \
                    const int xq = (it & 7) * 8 + ((it >> 3) >> 2), b = xq >> 4, ch = ((xq & 15) * 4 + ((it >> 3) & 3)) * 16 + (tid & 15), jc = tid >> 4; \
                    const size_t base = ((size_t)b * SEQ + jc * 128) * 1024 + ch, sbase = slab_idx(b * SEQ + jc * 128, ch); \
                    float hsum = 0.f, lsum = 0.f; \
                    for (int s0 = 0; s0 < 128; s0 += 16) { float la[16], uu[16]; \
                        _Pragma("unroll") for (int k = 0; k < 16; ++k) { la[k] = bf2f(LOGA[sbase + (size_t)(s0 + k) * 16]); uu[k] = bf2f(U[sbase + (size_t)(s0 + k) * 16]); } \
                        _Pragma("unroll") for (int k = 0; k < 16; ++k) { hsum = __builtin_amdgcn_exp2f(la[k]) * hsum + uu[k]; lsum += la[k]; } } \
                    sl[tid] = lsum; hl[tid] = hsum; \
                    __syncthreads(); \
                    float hin = 0.f; \
                    for (int cj = 0; cj < jc; ++cj) hin = __builtin_amdgcn_exp2f(sl[cj * 16 + (tid & 15)]) * hin + hl[cj * 16 + (tid & 15)]; \
                    float hv = hin; \
                    for (int s0 = 0; s0 < 128; s0 += 16) { float la[16], uu[16], gg[16]; \
                        _Pragma("unroll") for (int k = 0; k < 16; ++k) { la[k] = bf2f(LOGA[sbase + (size_t)(s0 + k) * 16]); uu[k] = bf2f(U[sbase + (size_t)(s0 + k) * 16]); gg[k] = bf2f(GS[sbase + (size_t)(s0 + k) * 16]); } \
                        _Pragma("unroll") for (int k = 0; k < 16; ++k) { hv = __builtin_amdgcn_exp2f(la[k]) * hv + uu[k]; MIXIN[base + (size_t)(s0 + k) * 1024] = f2bf(hv * gg[k]); } } \
                    __syncthreads(); \
                } \
            } \
            SEAM(pb + 4); \
        } \
        if (IN(pb + 5)) { \
            ArgsP ap = get_args(); unsigned char* wsl = ap->ws; \
            const bf16_t* W = (even ? WSP(bf16_t, WS_WEOUT) : WSP(bf16_t, WS_WOOUT)) + (size_t)e * 1024 * 1024; \
            pg8::Gemm gm{WSP(bf16_t, WS_MIXIN), W, T, 1024, 1024, 1024, 1 << 30, 0}; pg8::StaticOrder S; S.init(T, 1024, G, wg); \
            EpiMix E{WSP(bf16_t, WS_MIX)}; \
            pg8::gemm_phase(lds, gm, S, E); \
        } \
        SEAM(pb + 5); \
    }
    LAYER_BODY(0)
    LAYER_BODY(1)
    LAYER_BODY(2)
    LAYER_BODY(3)
#undef LAYER_BODY
    if (IN(25)) { ArgsP ap = get_args(); unsigned char* wsl = ap->ws; norm_phase(nullptr, WSP(bf16_t, WS_H), WSP(float, WS_XS), WSP(bf16_t, WS_MIX), ap->post_norm + 3 * DM, nullptr, nullptr, ap->out); }
#undef IN
#undef SEAM
#undef WSP
}

extern "C" void kernel_launch(void* const* d_in, const int* in_sizes, int n_in, void* d_out, int out_size, void* d_ws, size_t ws_size, hipStream_t stream) {
    static int grid = 0;
    if (grid == 0) {
        if (n_in != 17 || out_size != T * DM || ws_size < WS_END) { fprintf(stderr, "kernel_launch: unexpected sizes (n_in %d, out %d, ws %zu, need %zu)\n", n_in, out_size, ws_size, (size_t)WS_END); grid = -1; return; }
        int dev = 0, cus = 0, per_cu = 0;
        if (hipGetDevice(&dev) != hipSuccess || hipDeviceGetAttribute(&cus, hipDeviceAttributeMultiprocessorCount, dev) != hipSuccess) { grid = -1; return; }
        if (hipFuncSetAttribute((const void*)fwd_kernel, hipFuncAttributeMaxDynamicSharedMemorySize, LDS_BYTES) != hipSuccess) { fprintf(stderr, "kernel_launch: hipFuncSetAttribute failed\n"); grid = -1; return; }
        if (hipOccupancyMaxActiveBlocksPerMultiprocessor(&per_cu, (const void*)fwd_kernel, NTHREADS, LDS_BYTES) != hipSuccess || per_cu < 1) { fprintf(stderr, "kernel_launch: occupancy query says %d\n", per_cu); }
        (void)hipGetLastError();
        grid = cus;
    }
    if (grid < 0) return;
    (void)hipMemsetAsync((char*)d_ws + WS_CTL, 0, CTL_BYTES, stream);
    Args a{};
    a.x = (const float*)d_in[0]; a.rel_bias = (const float*)d_in[1]; a.pre_norm = (const float*)d_in[2]; a.post_norm = (const float*)d_in[3];
    a.even_w_in = (const float*)d_in[4]; a.even_gate_w2 = (const float*)d_in[5]; a.even_gate_b2 = (const float*)d_in[6]; a.even_w_out = (const float*)d_in[7];
    a.odd_w_in = (const float*)d_in[8]; a.odd_conv_w = (const float*)d_in[9]; a.odd_conv_b = (const float*)d_in[10]; a.odd_w_a = (const float*)d_in[11]; a.odd_b_a = (const float*)d_in[12];
    a.odd_w_x = (const float*)d_in[13]; a.odd_b_x = (const float*)d_in[14]; a.odd_lambda = (const float*)d_in[15]; a.odd_w_out = (const float*)d_in[16];
    a.out = (float*)d_out; a.ws = (unsigned char*)d_ws;
    if (N_LAUNCHES == 1) {
        a.ph_lo = 0; a.ph_hi = NPH;
        hipLaunchKernelGGL(fwd_kernel, dim3(grid), dim3(NTHREADS), LDS_BYTES, stream, a);
    } else {
        for (int ph = 0; ph < NPH; ++ph) { a.ph_lo = ph; a.ph_hi = ph + 1; hipLaunchKernelGGL(fwd_kernel, dim3(grid), dim3(NTHREADS), LDS_BYTES, stream, a); }
    }
}
```

```cpp
#include <hip/hip_runtime.h>
#include <stdint.h>
#include <stdio.h>

#ifndef N_LAUNCHES
#define N_LAUNCHES 1
#endif

#define LAS __attribute__((address_space(3)))
typedef unsigned short bf16_t;
typedef short bf16x8 __attribute__((ext_vector_type(8)));
typedef float f32x4 __attribute__((ext_vector_type(4)));
typedef float f32x2 __attribute__((ext_vector_type(2)));
typedef float f32x16 __attribute__((ext_vector_type(16)));
typedef unsigned u32x4 __attribute__((ext_vector_type(4)));
typedef unsigned u32x2 __attribute__((ext_vector_type(2)));
typedef unsigned long long u64;

constexpr int NB = 4, SEQ = 4096, T = NB * SEQ, DM = 1024;
constexpr int EVEN_IN = 4184, NE = 4352;
constexpr int NTHREADS = 512;
constexpr float EPS = 1e-6f;
constexpr float NEG_INF = -__builtin_inff();

constexpr size_t MB = 1024 * 1024;
constexpr size_t WS_CTL   = 0;
constexpr size_t CTL_BYTES = 65536;
constexpr size_t WS_WEIN  = WS_CTL + CTL_BYTES;
constexpr size_t WS_WEOUT = WS_WEIN + (size_t)2 * NE * 1024 * 2;
constexpr size_t WS_WOIN  = WS_WEOUT + 4 * MB;
constexpr size_t WS_WOG   = WS_WOIN + 8 * MB;
constexpr size_t WS_WOOUT = WS_WOG + 2 * MB;
constexpr size_t WS_TAB   = WS_WOOUT + 4 * MB;
constexpr size_t WS_XS    = WS_TAB + 4096;
constexpr size_t WS_H     = WS_XS + 65536;
constexpr size_t WS_MIXIN = WS_H + 32 * MB;
constexpr size_t WS_ACT   = WS_MIXIN + 32 * MB;
constexpr size_t WS_Q     = WS_ACT;
constexpr size_t WS_K     = WS_Q + 16 * MB;
constexpr size_t WS_VT    = WS_K + 16 * MB;
constexpr size_t WS_AG    = WS_VT + 16 * MB;
constexpr size_t WS_MIX   = WS_ACT;
constexpr size_t WS_IQ    = WS_AG + 16 * MB;
constexpr size_t WS_BQ    = WS_IQ + 16 * MB;
constexpr size_t WS_BK    = WS_BQ + 8 * MB;
constexpr size_t WS_BV    = WS_BK + 8 * MB;
constexpr size_t WS_BG    = WS_BV + 16 * MB;
constexpr size_t WS_IK    = WS_BG + 16 * MB;
constexpr size_t WS_IW    = WS_IK + 2 * MB;
constexpr size_t WS_BLR   = WS_IW + MB / 2;
constexpr size_t WS_MASK  = WS_BLR + MB;
constexpr size_t WS_SPREV = WS_MASK + 8 * MB;
constexpr size_t WS_DECAY = WS_SPREV + 16 * MB;
constexpr size_t WS_EVEN_END = WS_DECAY + MB / 4;
constexpr size_t WS_XR    = WS_ACT;
constexpr size_t WS_U     = WS_XR;
constexpr size_t WS_GS    = WS_XR + 32 * MB;
constexpr size_t WS_XC    = WS_GS + 32 * MB;
constexpr size_t WS_LOGA  = WS_XC + 32 * MB;
constexpr size_t WS_ODD_END = WS_LOGA + 32 * MB;
constexpr size_t WS_END   = WS_EVEN_END > WS_ODD_END ? WS_EVEN_END : WS_ODD_END;
static_assert(WS_END <= (size_t)256 * MB, "workspace map exceeds 256 MiB");

__device__ __forceinline__ float bf2f(unsigned v) { return __uint_as_float(v << 16); }
typedef __bf16 bf16pair_t __attribute__((ext_vector_type(2)));
typedef float f32pair_t __attribute__((ext_vector_type(2)));
__device__ __forceinline__ unsigned cvt_pk_bf16(float lo, float hi) { const f32pair_t v = {lo, hi}; const bf16pair_t b = __builtin_convertvector(v, bf16pair_t); return __builtin_bit_cast(unsigned, b); }
__device__ __forceinline__ bf16_t f2bf(float f) { return (bf16_t)cvt_pk_bf16(f, f); }
__device__ __forceinline__ float silu_f(float x) { return x / (1.0f + __expf(-x)); }
__device__ __forceinline__ float sigmoid_f(float x) { return 1.0f / (1.0f + __expf(-x)); }
__device__ __forceinline__ size_t slab_idx(int row, int ch) { return ((size_t)((row >> 12) * 64 + (ch >> 4)) * SEQ + (row & 4095)) * 16 + (ch & 15); }
__device__ __forceinline__ float log1p_01(float y) { const float ser = y * (1.0f - y * (0.5f - y * (0.33333334f - y * 0.25f))); return y < 0.03125f ? ser : __logf(1.0f + y); }
__device__ __forceinline__ float bflo(unsigned w) { return __uint_as_float(w << 16); }
__device__ __forceinline__ float bfhi(unsigned w) { return __uint_as_float(w & 0xFFFF0000u); }

__device__ __forceinline__ float relu_bits(float x) { const int i = (int)__float_as_uint(x); return __uint_as_float((unsigned)(i < 0 ? 0 : i)); }
__device__ __forceinline__ int opaque_tid() { int t = threadIdx.x; asm volatile("" : "+v"(t)); return t; }

__device__ __forceinline__ int wave_sum_i32(int v) {
    v += __builtin_amdgcn_update_dpp(0, v, 0xB1, 0xF, 0xF, true);
    v += __builtin_amdgcn_update_dpp(0, v, 0x4E, 0xF, 0xF, true);
    v += __builtin_amdgcn_update_dpp(0, v, 0x141, 0xF, 0xF, true);
    v += __builtin_amdgcn_update_dpp(0, v, 0x140, 0xF, 0xF, true);
    return __builtin_amdgcn_readlane(v, 0) + __builtin_amdgcn_readlane(v, 16) + __builtin_amdgcn_readlane(v, 32) + __builtin_amdgcn_readlane(v, 48);
}

__device__ __forceinline__ float wave_max_f32(float v) {
    v = fmaxf(v, __uint_as_float((unsigned)__builtin_amdgcn_update_dpp(0, (int)__float_as_uint(v), 0xB1, 0xF, 0xF, true)));
    v = fmaxf(v, __uint_as_float((unsigned)__builtin_amdgcn_update_dpp(0, (int)__float_as_uint(v), 0x4E, 0xF, 0xF, true)));
    v = fmaxf(v, __uint_as_float((unsigned)__builtin_amdgcn_update_dpp(0, (int)__float_as_uint(v), 0x141, 0xF, 0xF, true)));
    v = fmaxf(v, __uint_as_float((unsigned)__builtin_amdgcn_update_dpp(0, (int)__float_as_uint(v), 0x140, 0xF, 0xF, true)));
    const float a = __uint_as_float((unsigned)__builtin_amdgcn_readlane((int)__float_as_uint(v), 0)), b = __uint_as_float((unsigned)__builtin_amdgcn_readlane((int)__float_as_uint(v), 16));
    const float c = __uint_as_float((unsigned)__builtin_amdgcn_readlane((int)__float_as_uint(v), 32)), d = __uint_as_float((unsigned)__builtin_amdgcn_readlane((int)__float_as_uint(v), 48));
    return fmaxf(fmaxf(a, b), fmaxf(c, d));
}
__device__ __forceinline__ int wave_prefix_sum_i32(int v) {
    v += __builtin_amdgcn_update_dpp(0, v, 0x111, 0xF, 0xF, true);
    v += __builtin_amdgcn_update_dpp(0, v, 0x112, 0xF, 0xF, true);
    v += __builtin_amdgcn_update_dpp(0, v, 0x114, 0xF, 0xF, true);
    v += __builtin_amdgcn_update_dpp(0, v, 0x118, 0xF, 0xF, true);
    v += __builtin_amdgcn_update_dpp(0, v, 0x142, 0xA, 0xF, false);
    v += __builtin_amdgcn_update_dpp(0, v, 0x143, 0xC, 0xF, false);
    return v;
}

#define XB_TMO      128
#define XB_XCNT(j)  (256  + 64 * (j))
#define XB_XSUB(j)  (1280 + 64 * (j))
#define XB_XGEN(j)  (2304 + 64 * (j))
#define XB_TOP      3328
#define XB_TOPGEN   3392
#define XCD_BAR_WORDS 3456
#define XB_SPIN_CAP (1u << 18)

__device__ __forceinline__ unsigned xb_ld(unsigned* p)              { return __hip_atomic_load(p, __ATOMIC_RELAXED, __HIP_MEMORY_SCOPE_AGENT); }
__device__ __forceinline__ unsigned xb_add(unsigned* p, unsigned v) { return __hip_atomic_fetch_add(p, v, __ATOMIC_RELAXED, __HIP_MEMORY_SCOPE_AGENT); }
__device__ __forceinline__ unsigned xb_xcc_id() { return (unsigned)__builtin_amdgcn_s_getreg((3 << 11) | 20) & 0xFu; }
#define XB_SPIN(cond, bar) do { unsigned _sp = 0; while (cond) { __builtin_amdgcn_s_sleep(1); \
    if ((++_sp & 255u) == 0u) { if (xb_ld(&(bar)[XB_TMO])) break; if (_sp > XB_SPIN_CAP) { atomicAdd(&(bar)[XB_TMO], 1u); break; } } } } while (0)

struct XcdBarrier { unsigned* bar; unsigned x; volatile LAS unsigned* st; };

__device__ __forceinline__ XcdBarrier xcd_barrier_post(unsigned* bar, volatile LAS unsigned* st) {
    XcdBarrier b; b.bar = bar; b.x = xb_xcc_id(); b.st = st;
    if (threadIdx.x == 0) (void)xb_add(&bar[XB_XCNT(b.x)], 1u);
    return b;
}
__device__ __forceinline__ void xcd_barrier_complete(unsigned* bar, unsigned x, unsigned& nloc, unsigned& nx) {
    const unsigned G = gridDim.x * gridDim.y * gridDim.z;
    unsigned sum, cnt, mine, sp = 0u;
    for (;;) {
        sum = 0u; cnt = 0u; mine = 0u;
#pragma unroll
        for (unsigned j = 0; j < 16; ++j) { const unsigned c = xb_ld(&bar[XB_XCNT(j)]); sum += c; cnt += (c > 0u) ? 1u : 0u; mine = (j == x) ? c : mine; }
        if (sum == G) break;
        __builtin_amdgcn_s_sleep(1);
        if ((++sp & 255u) == 0u) { if (xb_ld(&bar[XB_TMO])) break; if (sp > XB_SPIN_CAP) { atomicAdd(&bar[XB_TMO], 1u); break; } }
    }
    nloc = mine > 0u ? mine : 1u; nx = cnt > 0u ? cnt : 1u;
}
__device__ __forceinline__ void xcd_barrier(const XcdBarrier& b) {
    asm volatile("s_waitcnt vmcnt(0)" ::: "memory");
    __syncthreads();
    if (threadIdx.x == 0) {
        unsigned* bar = b.bar;
        __builtin_amdgcn_s_waitcnt(0);
        unsigned nloc = b.st[0], nx = b.st[1];
        if (nloc == 0u) { xcd_barrier_complete(bar, b.x, nloc, nx); b.st[0] = nloc; b.st[1] = nx; }
        const unsigned old = xb_add(&bar[XB_XSUB(b.x)], 1u);
        const unsigned gen = old / nloc;
        if (old + 1u == (gen + 1u) * nloc) {
            __builtin_amdgcn_fence(__ATOMIC_RELEASE, "agent");
            asm volatile("s_waitcnt vmcnt(0)" ::: "memory");
            const unsigned og = xb_add(&bar[XB_TOP], 1u);
            const unsigned tg = og / nx;
            if (og + 1u == (tg + 1u) * nx) xb_add(&bar[XB_TOPGEN], 1u);
            else XB_SPIN(xb_ld(&bar[XB_TOPGEN]) == tg, bar);
            __builtin_amdgcn_fence(__ATOMIC_ACQUIRE, "agent");
            xb_add(&bar[XB_XGEN(b.x)], 1u);
            asm volatile("s_waitcnt vmcnt(0)" ::: "memory");
        } else {
            XB_SPIN(xb_ld(&bar[XB_XGEN(b.x)]) == gen, bar);
            __builtin_amdgcn_fence(__ATOMIC_ACQUIRE, "agent");
            asm volatile("s_waitcnt vmcnt(0)" ::: "memory");
        }
    }
    __syncthreads();
}

namespace pg8 {
constexpr int BM = 256, BK = 64, HALF = 128, HTB = HALF * BK * 2, STAGE_BYTES = 8 * HTB, NXCD = 8, WGM = 8;
__host__ __device__ __forceinline__ int lds_byte(int r, int c) { const int st = (r >> 4) * 2 + (c >> 5), rr = r & 15, cc = c & 31, ob = rr * 64 + cc * 2; return st * 1024 + (ob ^ (((ob >> 9) & 1) << 5)); }
__host__ __device__ __forceinline__ void stage_rc(int b, int& R, int& C) { const int st = b / 1024, sb = b % 1024, swz = sb ^ (((sb >> 9) & 1) << 5); R = (st >> 1) * 16 + swz / 64; C = (st & 1) * 32 + (swz % 64) / 2; }
__host__ __device__ __forceinline__ int perm32(int rho) { const int n = rho >> 4, i = rho & 15; return 8 * (i >> 2) + 4 * n + (i & 3); }

struct Unit { int pm, pn; };
struct Gemm { const bf16_t* A; const bf16_t* Bt; int M, N, K, lda, a_div, a_step; };

struct StaticOrder {
    int nM, nN, nwg, G, c;
    __host__ __device__ void init(int M, int N, int G_, int c_) { nM = M / BM; nN = N / BM; nwg = nM * nN; G = G_; c = c_; }
    __host__ __device__ bool next(int i, Unit& u) const {
        const long L = (long)i * G + c; if (L >= nwg) return false;
        int wgid = (int)L; { const int q = nwg / NXCD, r = nwg % NXCD, xcd = wgid % NXCD, off = wgid / NXCD; wgid = (xcd < r ? xcd * (q + 1) : r * (q + 1) + (xcd - r) * q) + off; }
        const int nig = WGM * nN, gid = wgid / nig, fm = gid * WGM, gsz = (nM - fm) < WGM ? (nM - fm) : WGM;
        u.pm = fm + ((wgid % nig) % gsz); u.pn = (wgid % nig) / gsz; return true;
    }
};

template <class Epi>
__device__ __forceinline__ void gemm_phase(LAS unsigned char* lds, const Gemm g, const StaticOrder& S, const Epi& E) {
    const int tid = opaque_tid(), wid = __builtin_amdgcn_readfirstlane(tid >> 6), lane = tid & 63, wr = wid >> 2, wc = wid & 3, fr = lane & 15, fq = lane >> 4;
    const int K = g.K, nt = K / BK, lda = g.lda;
    unsigned voffA[2], voffB[2];
#pragma unroll
    for (int i = 0; i < 2; ++i) { int R, C; stage_rc(tid * 16 + i * 8192, R, C); const int Rb = Epi::PERM ? ((R & ~31) + perm32(R & 31)) : R;
        voffA[i] = (unsigned)(R * lda + C) * 2u; voffB[i] = (unsigned)(Rb * K + C) * 2u; }
    const size_t kstep = (size_t)(BK * 2);
    const size_t hstepA = (size_t)HALF * lda * 2, hstepB = (size_t)HALF * K * 2;
    const size_t tstepA = 2 * hstepA, tstepB = 2 * hstepB;
    const unsigned ldsw = (unsigned)wid * 1024u;
    const int aoff = lds_byte(wr * 64 + fr, fq * 8), boff = lds_byte(wc * 32 + fr, fq * 8);
#define PG8_SA(b, h) (((b) * 2 + (h)) * HTB)
#define PG8_SB(b, h) ((4 + (b) * 2 + (h)) * HTB)
#define PG8_STAGE(bufoff, gbase, voff) do { _Pragma("unroll") for (int _i = 0; _i < 2; ++_i) \
        __builtin_amdgcn_global_load_lds((const unsigned*)((const char*)(gbase) + (voff)[_i]), (LAS unsigned*)(lds + (bufoff) + ldsw + _i * 8192), 16, 0, 0); } while (0)
#define PG8_LDA(dst, b, h) do { _Pragma("unroll") for (int m = 0; m < 4; ++m) _Pragma("unroll") for (int k = 0; k < 2; ++k) dst[m][k] = *(const LAS bf16x8*)(lds + PG8_SA(b, h) + aoff + m * 2048 + k * 1024); } while (0)
#define PG8_LDB(dst, b, h) do { _Pragma("unroll") for (int n = 0; n < 2; ++n) _Pragma("unroll") for (int k = 0; k < 2; ++k) dst[n][k] = *(const LAS bf16x8*)(lds + PG8_SB(b, h) + boff + n * 2048 + k * 1024); } while (0)
#define PG8_MMA(ai, bj, At, Bt) do { __builtin_amdgcn_s_setprio(1); _Pragma("unroll") for (int m = 0; m < 4; ++m) _Pragma("unroll") for (int n = 0; n < 2; ++n) _Pragma("unroll") for (int k = 0; k < 2; ++k) \
        acc[ai][bj][m][n] = __builtin_amdgcn_mfma_f32_16x16x32_bf16(Bt[n][k], At[m][k], acc[ai][bj][m][n], 0, 0, 0); __builtin_amdgcn_s_setprio(0); } while (0)
#define PG8_WAIT_V(n) asm volatile("s_waitcnt vmcnt(" #n ")" ::: "memory")
#define PG8_WAIT_L(n) asm volatile("s_waitcnt lgkmcnt(" #n ")" ::: "memory")
#define PG8_BAR __builtin_amdgcn_s_barrier()
#define PG8_SCHED __builtin_amdgcn_sched_barrier(0)
    Unit cur, nxt; int ui = 0;
    if (!S.next(0, cur)) return;
    f32x4 acc[2][2][4][2];
#pragma unroll
    for (int a = 0; a < 2; ++a)
#pragma unroll
        for (int b = 0; b < 2; ++b)
#pragma unroll
            for (int m = 0; m < 4; ++m)
#pragma unroll
                for (int n = 0; n < 2; ++n) acc[a][b][m][n] = (f32x4){0.f, 0.f, 0.f, 0.f};
    bf16x8 At[4][2], B0[2][2], B1[2][2];
    const char* cA = (const char*)g.A + (size_t)cur.pm * tstepA + (size_t)(cur.pn / g.a_div) * g.a_step; const char* cB = (const char*)g.Bt + (size_t)cur.pn * tstepB;
    PG8_STAGE(PG8_SB(0, 0), cB, voffB); PG8_STAGE(PG8_SA(0, 0), cA, voffA); PG8_STAGE(PG8_SB(0, 1), cB + hstepB, voffB); PG8_STAGE(PG8_SA(0, 1), cA + hstepA, voffA);
    if (wr == 1) PG8_BAR;
    PG8_WAIT_V(4); PG8_BAR;
    PG8_STAGE(PG8_SB(1, 0), cB + kstep, voffB); PG8_STAGE(PG8_SA(1, 0), cA + kstep, voffA); PG8_STAGE(PG8_SB(1, 1), cB + hstepB + kstep, voffB);
    PG8_WAIT_V(6); PG8_BAR;
    for (;;) {
        const bool has_next = S.next(ui + 1, nxt);
        const char* nA = has_next ? (const char*)g.A + (size_t)nxt.pm * tstepA + (size_t)(nxt.pn / g.a_div) * g.a_step : cA; const char* nB = has_next ? (const char*)g.Bt + (size_t)nxt.pn * tstepB : cB;
        for (int t = 0; t < nt; t += 2) {
            const bool last = (t == nt - 2);
            const char* a1 = cA + (size_t)(t + 1) * kstep;
            const char* a2 = last ? nA : cA + (size_t)(t + 2) * kstep; const char* b2 = last ? nB : cB + (size_t)(t + 2) * kstep;
            const char* a3 = a2 + kstep; const char* b3 = b2 + kstep;
            PG8_LDB(B0, 0, 0); PG8_SCHED; PG8_LDA(At, 0, 0); PG8_STAGE(PG8_SA(1, 1), a1 + hstepA, voffA);
            PG8_WAIT_L(8); PG8_BAR; PG8_WAIT_L(0); PG8_MMA(0, 0, At, B0); PG8_BAR; PG8_SCHED;
            PG8_LDB(B1, 0, 1); PG8_STAGE(PG8_SB(0, 0), b2, voffB);
            PG8_BAR; PG8_WAIT_L(0); PG8_MMA(0, 1, At, B1); PG8_BAR;
            PG8_LDA(At, 0, 1); PG8_STAGE(PG8_SA(0, 0), a2, voffA);
            PG8_BAR; PG8_WAIT_L(0); PG8_MMA(1, 0, At, B0); PG8_BAR; PG8_SCHED;
            PG8_STAGE(PG8_SB(0, 1), b2 + hstepB, voffB);
            PG8_WAIT_V(6); PG8_BAR; PG8_MMA(1, 1, At, B1); PG8_BAR;
            PG8_LDB(B0, 1, 0); PG8_SCHED; PG8_LDA(At, 1, 0); PG8_STAGE(PG8_SA(0, 1), a2 + hstepA, voffA);
            PG8_WAIT_L(8); PG8_BAR; PG8_WAIT_L(0); PG8_MMA(0, 0, At, B0); PG8_BAR; PG8_SCHED;
            PG8_LDB(B1, 1, 1); PG8_STAGE(PG8_SB(1, 0), b3, voffB);
            PG8_BAR; PG8_WAIT_L(0); PG8_MMA(0, 1, At, B1); PG8_BAR;
            PG8_LDA(At, 1, 1); PG8_STAGE(PG8_SA(1, 0), a3, voffA);
            PG8_BAR; PG8_WAIT_L(0); PG8_MMA(1, 0, At, B0); PG8_BAR; PG8_SCHED;
            PG8_STAGE(PG8_SB(1, 1), b3 + hstepB, voffB);
            PG8_WAIT_V(6); PG8_BAR; PG8_MMA(1, 1, At, B1); PG8_BAR;
        }
        E(acc, cur, wr, wc, fr, fq);
        if (!has_next) break;
#pragma unroll
        for (int a = 0; a < 2; ++a)
#pragma unroll
            for (int b = 0; b < 2; ++b)
#pragma unroll
                for (int m = 0; m < 4; ++m)
#pragma unroll
                    for (int n = 0; n < 2; ++n) acc[a][b][m][n] = (f32x4){0.f, 0.f, 0.f, 0.f};
        cur = nxt; cA = nA; cB = nB; ++ui;
    }
    PG8_WAIT_V(0);
    if (wr == 0) PG8_BAR;
    PG8_BAR;
#undef PG8_SA
#undef PG8_SB
#undef PG8_STAGE
#undef PG8_LDA
#undef PG8_LDB
#undef PG8_MMA
#undef PG8_WAIT_V
#undef PG8_WAIT_L
#undef PG8_BAR
#undef PG8_SCHED
}
}

struct EpiMix {
    static constexpr bool PERM = true;
    bf16_t* C;
    __device__ __forceinline__ void operator()(const f32x4 (&acc)[2][2][4][2], const pg8::Unit& u, int wr, int wc, int fr, int fq) const {
#pragma unroll
        for (int ai = 0; ai < 2; ++ai)
#pragma unroll
            for (int m = 0; m < 4; ++m) { const int row = u.pm * 256 + ai * 128 + wr * 64 + m * 16 + fr;
#pragma unroll
                for (int bj = 0; bj < 2; ++bj) { const f32x4 v0 = acc[ai][bj][m][0], v1 = acc[ai][bj][m][1];
                    u32x4 w; w.x = cvt_pk_bf16(v0[0], v0[1]); w.y = cvt_pk_bf16(v0[2], v0[3]); w.z = cvt_pk_bf16(v1[0], v1[1]); w.w = cvt_pk_bf16(v1[2], v1[3]);
                    *(u32x4*)(C + (size_t)row * 1024 + u.pn * 256 + bj * 128 + wc * 32 + 8 * fq) = w; } }
    }
};

constexpr float LOG2E_F = 1.4426950408889634f;
constexpr float IW_SCALE = 0.35355339059327373f * 0.125f;

struct EpiEvenIn {
    static constexpr bool PERM = true;
    bf16_t *Q, *Kb, *VT, *AG, *IQ, *BQ, *BK, *BV, *BG, *IK; float *IW, *BLR;
    __device__ __forceinline__ void operator()(const f32x4 (&acc)[2][2][4][2], const pg8::Unit& u, int wr, int wc, int fr, int fq) const {
        const int pn = u.pn;
        bf16_t* dst = Q; int ld = 512, col0 = 0, mode = 0;
        if (pn < 2) { dst = Q; col0 = pn * 256; }
        else if (pn < 4) { dst = Kb; col0 = (pn - 2) * 256; }
        else if (pn < 6) { mode = 2; col0 = (pn - 4) * 256; }
        else if (pn < 8) { dst = AG; col0 = (pn - 6) * 256; mode = 1; }
        else if (pn < 10) { dst = IQ; col0 = (pn - 8) * 256; }
        else if (pn == 10) { dst = BQ; ld = 256; }
        else if (pn == 11) { dst = BK; ld = 256; }
        else if (pn < 14) { dst = BV; col0 = (pn - 12) * 256; }
        else if (pn < 16) { dst = BG; col0 = (pn - 14) * 256; mode = 1; }
        else mode = 3;
#pragma unroll
        for (int ai = 0; ai < 2; ++ai)
#pragma unroll
            for (int m = 0; m < 4; ++m) {
                const int row = u.pm * 256 + ai * 128 + wr * 64 + m * 16 + fr;
#pragma unroll
                for (int bj = 0; bj < 2; ++bj) {
                    const int cb = bj * 128 + wc * 32 + 8 * fq;
                    f32x4 v0 = acc[ai][bj][m][0], v1 = acc[ai][bj][m][1];
                    if (mode <= 1) {
                        if (mode == 1) {
#pragma unroll
                            for (int j = 0; j < 4; ++j) { v0[j] = silu_f(v0[j]); v1[j] = silu_f(v1[j]); }
                        }
                        u32x4 w; w.x = cvt_pk_bf16(v0[0], v0[1]); w.y = cvt_pk_bf16(v0[2], v0[3]); w.z = cvt_pk_bf16(v1[0], v1[1]); w.w = cvt_pk_bf16(v1[2], v1[3]);
                        *(u32x4*)(dst + (size_t)row * ld + col0 + cb) = w;
                    } else if (mode == 2) {
                        const int c = col0 + cb, head = c >> 6, d = c & 63, b = row >> 12, s = row & 4095;
                        bf16_t* p = VT + ((size_t)(b * 8 + head) * 64 + d) * 4096 + s;
#pragma unroll
                        for (int j = 0; j < 4; ++j) { p[(size_t)j * 4096] = f2bf(v0[j]); p[(size_t)(j + 4) * 4096] = f2bf(v1[j]); }
                    } else {
                        if (cb < 64) {
                            u32x4 w; w.x = cvt_pk_bf16(v0[0], v0[1]); w.y = cvt_pk_bf16(v0[2], v0[3]); w.z = cvt_pk_bf16(v1[0], v1[1]); w.w = cvt_pk_bf16(v1[2], v1[3]);
                            const int q = cb >> 3, bb = row >> 12, sq = row & 4095;
                            *(u32x4*)(IK + ((((size_t)(bb * 128 + (sq >> 5)) * 4 + (q >> 1)) * 2 + (q & 1)) * 32 + (sq & 31)) * 8) = w;
                        } else if (cb == 64) {
                            *(f32x4*)(IW + (size_t)row * 8) = v0 * IW_SCALE; *(f32x4*)(IW + (size_t)row * 8 + 4) = v1 * IW_SCALE;
                        } else if (cb == 72 || cb == 80) {
                            *(f32x4*)(BLR + (size_t)row * 16 + (cb - 72)) = v0; *(f32x4*)(BLR + (size_t)row * 16 + (cb - 72) + 4) = v1;
                        }
                    }
                }
            }
    }
};

struct EpiOddIn {
    static constexpr bool PERM = true;
    bf16_t *XR, *GS;
    __device__ __forceinline__ void operator()(const f32x4 (&acc)[2][2][4][2], const pg8::Unit& u, int wr, int wc, int fr, int fq) const {
        const int pn = u.pn; const bool gate = pn >= 4;
        bf16_t* dst = gate ? GS : XR; const int col0 = (pn & 3) * 256;
#pragma unroll
        for (int ai = 0; ai < 2; ++ai)
#pragma unroll
            for (int m = 0; m < 4; ++m) {
                const int row = u.pm * 256 + ai * 128 + wr * 64 + m * 16 + fr;
#pragma unroll
                for (int bj = 0; bj < 2; ++bj) {
                    const int cb = bj * 128 + wc * 32 + 8 * fq;
                    f32x4 v0 = acc[ai][bj][m][0], v1 = acc[ai][bj][m][1];
                    if (gate) {
#pragma unroll
                        for (int j = 0; j < 4; ++j) { v0[j] = silu_f(v0[j]); v1[j] = silu_f(v1[j]); }
                    }
                    u32x4 w; w.x = cvt_pk_bf16(v0[0], v0[1]); w.y = cvt_pk_bf16(v0[2], v0[3]); w.z = cvt_pk_bf16(v1[0], v1[1]); w.w = cvt_pk_bf16(v1[2], v1[3]);
                    if (gate) *(u32x4*)(GS + slab_idx(row, col0 + cb)) = w;
                    else *(u32x4*)(XR + (size_t)row * 1024 + col0 + cb) = w;
                }
            }
    }
};

struct EpiGates {
    static constexpr bool PERM = true;
    const float *b_a, *b_x, *lam; const bf16_t* XC; bf16_t* LOGA; bf16_t* U;
    __device__ __forceinline__ void operator()(const f32x4 (&acc)[2][2][4][2], const pg8::Unit& u, int wr, int wc, int fr, int fq) const {
        const int chb = (u.pn >> 1) * 256 + (u.pn & 1) * 128 + wc * 32 + 8 * fq;
#pragma unroll
        for (int nh = 0; nh < 2; ++nh) {
            const int ch0 = chb + 4 * nh;
            const f32x4 lm = *(const f32x4*)(lam + ch0);
            const f32x4 nba = *(const f32x4*)(b_a + ch0) * (-LOG2E_F), nbx = *(const f32x4*)(b_x + ch0) * (-LOG2E_F);
            f32x4 c8;
#pragma unroll
            for (int j = 0; j < 4; ++j) c8[j] = (-8.0f * LOG2E_F) * (fmaxf(-lm[j], 0.f) + log1p_01(__expf(-fabsf(lm[j]))));
#pragma unroll
            for (int ai = 0; ai < 2; ++ai)
#pragma unroll
                for (int m = 0; m < 4; ++m) {
                    const int row = u.pm * 256 + ai * 128 + wr * 64 + m * 16 + fr;
                    const u32x2 xw = *(const u32x2*)(XC + (size_t)row * 1024 + ch0);
                    const float xv[4] = {bflo(xw.x), bfhi(xw.x), bflo(xw.y), bfhi(xw.y)};
                    f32x4 la; float uu[4];
#pragma unroll
                    for (int j = 0; j < 4; ++j) {
                        const float r = __builtin_amdgcn_rcpf(1.0f + __builtin_amdgcn_exp2f(__builtin_fmaf(acc[ai][0][m][nh][j], -LOG2E_F, nba[j])));
                        const float ig = __builtin_amdgcn_rcpf(1.0f + __builtin_amdgcn_exp2f(__builtin_fmaf(acc[ai][1][m][nh][j], -LOG2E_F, nbx[j])));
                        const float l2 = c8[j] * r, av = __builtin_amdgcn_exp2f(l2);
                        la[j] = l2;
                        uu[j] = __builtin_amdgcn_sqrtf(fmaxf(__builtin_fmaf(-av, av, 1.0f), 0.f)) * ig * xv[j];
                    }
                    { u32x2 lw; lw.x = cvt_pk_bf16(la[0], la[1]); lw.y = cvt_pk_bf16(la[2], la[3]); *(u32x2*)(LOGA + slab_idx(row, ch0)) = lw; }
                    u32x2 w; w.x = cvt_pk_bf16(uu[0], uu[1]); w.y = cvt_pk_bf16(uu[2], uu[3]);
                    *(u32x2*)(U + slab_idx(row, ch0)) = w;
                }
        }
    }
};

struct Args {
    const float* x; const float* rel_bias; const float* pre_norm; const float* post_norm;
    const float* even_w_in; const float* even_gate_w2; const float* even_gate_b2; const float* even_w_out;
    const float* odd_w_in; const float* odd_conv_w; const float* odd_conv_b; const float* odd_w_a; const float* odd_b_a;
    const float* odd_w_x; const float* odd_b_x; const float* odd_lambda; const float* odd_w_out;
    float* out; unsigned char* ws; int ph_lo, ph_hi;
};

typedef const Args __attribute__((address_space(4)))* ArgsP;
__device__ __forceinline__ ArgsP get_args() { ArgsP p = (ArgsP)__builtin_amdgcn_kernarg_segment_ptr(); asm volatile("" : "+s"(p)); return p; }

constexpr int WT_EIN = 2 * 68 * 16, WT_EOUT = 2 * 256, WT_OIN = 2 * 512, WT_OOUT = 2 * 256, WT_GATE = 2 * 128, WT_ALL = WT_EIN + WT_EOUT + WT_OIN + WT_OOUT + WT_GATE;
__device__ __forceinline__ void wtile_decode(int T, ArgsP ap, unsigned char* ws, int nl, int wn, const float*& colp, int& ld, bf16_t*& drow, int& K, const float*& ksc) {
    ksc = nullptr;
    if (T < WT_EIN) { const int e = T / 1088, r = T % 1088, tn = r % 68, tk = r / 68; K = 1024; ld = EVEN_IN;
        const int n = tn * 64 + nl; int c; bool ok = true; if (n < 2560) c = n; else if (n < 4096) c = n + 72; else if (n < 4168) c = n - 1536; else if (n < 4184) c = n; else { c = 0; ok = false; }
        ksc = ap->pre_norm + (size_t)(2 * e) * DM + tk * 64;
        colp = ok ? ap->even_w_in + ((size_t)e * 1024 + tk * 64) * EVEN_IN + c : nullptr;
        drow = (bf16_t*)(ws + WS_WEIN) + ((size_t)e * NE + tn * 64 + wn) * 1024 + tk * 64; return; }
    T -= WT_EIN;
    if (T < WT_EOUT) { const int e = T / 256, r = T % 256, tn = r % 16, tk = r / 16; K = 1024; ld = 1024;
        colp = ap->even_w_out + ((size_t)e * 1024 + tk * 64) * 1024 + tn * 64 + nl; drow = (bf16_t*)(ws + WS_WEOUT) + ((size_t)e * 1024 + tn * 64 + wn) * 1024 + tk * 64; return; }
    T -= WT_EOUT;
    if (T < WT_OIN) { const int e = T / 512, r = T % 512, tn = r % 32, tk = r / 32; K = 1024; ld = 2048;
        ksc = ap->pre_norm + (size_t)(2 * e + 1) * DM + tk * 64;
        colp = ap->odd_w_in + ((size_t)e * 1024 + tk * 64) * 2048 + tn * 64 + nl; drow = (bf16_t*)(ws + WS_WOIN) + ((size_t)e * 2048 + tn * 64 + wn) * 1024 + tk * 64; return; }
    T -= WT_OIN;
    if (T < WT_OOUT) { const int e = T / 256, r = T % 256, tn = r % 16, tk = r / 16; K = 1024; ld = 1024;
        colp = ap->odd_w_out + ((size_t)e * 1024 + tk * 64) * 1024 + tn * 64 + nl; drow = (bf16_t*)(ws + WS_WOOUT) + ((size_t)e * 1024 + tn * 64 + wn) * 1024 + tk * 64; return; }
    T -= WT_OOUT;
    {
        const int o = T / 128, r = T % 128, tn = r % 32, tk = r / 32; K = 256; ld = 256;
        const int cp = tn * 64, nb = cp >> 9, j = (cp >> 8) & 1, gs = (cp >> 7) & 1, e0 = j * 128 + (cp & 127);
        const float* src = gs ? ap->odd_w_x : ap->odd_w_a;
        colp = src + (((size_t)(o * 4 + nb)) * 256 + tk * 64) * 256 + e0 + nl; drow = (bf16_t*)(ws + WS_WOG) + ((size_t)o * 2048 + cp + wn) * 256 + tk * 64; }
}
__device__ __forceinline__ void weight_phase(LAS float* tile, ArgsP ap, unsigned char* ws) {
    const int tid = opaque_tid(), G = gridDim.x, nl = tid & 63, k0 = tid >> 6, wn = tid >> 3, wk = (tid & 7) * 8;
    float r[8]; const float* colp; const float* ksc; bf16_t* drow; int ld, K;
#define WT_LOAD() do { _Pragma("unroll") for (int i = 0; i < 8; ++i) r[i] = colp ? colp[(size_t)(k0 + 8 * i) * ld] * (ksc ? ksc[k0 + 8 * i] : 1.0f) : 0.f; } while (0)
    int T = blockIdx.x;
    if (T < WT_ALL) { wtile_decode(T, ap, ws, nl, wn, colp, ld, drow, K, ksc); WT_LOAD(); }
    for (; T < WT_ALL; T += G) {
        bf16_t* dcur = drow;
#pragma unroll
        for (int i = 0; i < 8; ++i) tile[(k0 + 8 * i) * 65 + nl] = r[i];
        __syncthreads();
        if (T + G < WT_ALL) { wtile_decode(T + G, ap, ws, nl, wn, colp, ld, drow, K, ksc); WT_LOAD(); }
        float v[8];
#pragma unroll
        for (int j = 0; j < 8; ++j) v[j] = tile[(wk + j) * 65 + wn];
        u32x4 w; w.x = cvt_pk_bf16(v[0], v[1]); w.y = cvt_pk_bf16(v[2], v[3]); w.z = cvt_pk_bf16(v[4], v[5]); w.w = cvt_pk_bf16(v[6], v[7]);
        *(u32x4*)(dcur + wk) = w;
        __syncthreads();
    }
#undef WT_LOAD
}

__device__ __forceinline__ int t5_bucket(int n) {
    if (n < 16) return n;
    int v = 16 + (int)(__logf((float)n / 16.0f) / 2.0794415416798357f * 16.0f);
    return v < 31 ? v : 31;
}

__device__ __forceinline__ void norm_phase(const float* xin, const bf16_t* xh_in, const float* s_in, const bf16_t* mix, const float* postw, bf16_t* xh_out, float* s_out, float* outf) {
    const int tid0 = opaque_tid(), lane = tid0 & 63, wave = tid0 >> 6;
    for (int row = blockIdx.x * 8 + wave; row < T; row += gridDim.x * 8) {
        f32x4 xv[4];
        if (xin) {
#pragma unroll
            for (int i = 0; i < 4; ++i) xv[i] = *(const f32x4*)(xin + (size_t)row * DM + lane * 4 + 256 * i);
        } else {
            const float sc = s_in[row];
#pragma unroll
            for (int i = 0; i < 4; ++i) { const u32x2 xw = *(const u32x2*)(xh_in + (size_t)row * DM + lane * 4 + 256 * i); xv[i] = (f32x4){bflo(xw.x), bfhi(xw.x), bflo(xw.y), bfhi(xw.y)} * sc; }
        }
        if (mix) {
            f32x4 mv[4]; float ss = 0.f;
#pragma unroll
            for (int i = 0; i < 4; ++i) { const u32x2 mw = *(const u32x2*)(mix + (size_t)row * DM + lane * 4 + 256 * i); mv[i] = (f32x4){bflo(mw.x), bfhi(mw.x), bflo(mw.y), bfhi(mw.y)};
                ss += mv[i][0] * mv[i][0] + mv[i][1] * mv[i][1] + mv[i][2] * mv[i][2] + mv[i][3] * mv[i][3]; }
#pragma unroll
            for (int o = 32; o >= 1; o >>= 1) ss += __shfl_xor(ss, o);
            const float r = rsqrtf(ss * (1.0f / DM) + EPS);
#pragma unroll
            for (int i = 0; i < 4; ++i) { const f32x4 w = *(const f32x4*)(postw + lane * 4 + 256 * i); xv[i] += mv[i] * r * w; }
        }
        if (outf) {
#pragma unroll
            for (int i = 0; i < 4; ++i) *(f32x4*)(outf + (size_t)row * DM + lane * 4 + 256 * i) = xv[i];
        } else {
            float ss = 0.f;
#pragma unroll
            for (int i = 0; i < 4; ++i) ss += xv[i][0] * xv[i][0] + xv[i][1] * xv[i][1] + xv[i][2] * xv[i][2] + xv[i][3] * xv[i][3];
#pragma unroll
            for (int o = 32; o >= 1; o >>= 1) ss += __shfl_xor(ss, o);
            const float ms = ss * (1.0f / DM) + EPS, r = rsqrtf(ms);
            if (lane == 0) s_out[row] = ms * r;
#pragma unroll
            for (int i = 0; i < 4; ++i) { const f32x4 y = xv[i] * r;
                u32x2 o2; o2.x = cvt_pk_bf16(y[0], y[1]); o2.y = cvt_pk_bf16(y[2], y[3]); *(u32x2*)(xh_out + (size_t)row * DM + lane * 4 + 256 * i) = o2; }
        }
    }
}

constexpr int NM_LD = 1032;
__device__ __forceinline__ void norm_misc_phase(LAS unsigned char* lds, const float* xin, const bf16_t* xh_in, const float* s_in, const bf16_t* mix, const float* postw, bf16_t* xh_out, float* s_out,
                                                const bf16_t* Wm  , bf16_t* IK, float* IW, float* BLR) {
    const int tid0 = opaque_tid(), lane = tid0 & 63, wave = __builtin_amdgcn_readfirstlane(tid0 >> 6);
    LAS bf16_t* xs = (LAS bf16_t*)lds;
    for (int pq = blockIdx.x; pq < T / 64; pq += gridDim.x) {
        for (int i = 0; i < 8; ++i) {
            const int rl = wave * 8 + i, row = pq * 64 + rl;
            f32x4 xv[4];
            if (xin) {
#pragma unroll
                for (int k = 0; k < 4; ++k) xv[k] = *(const f32x4*)(xin + (size_t)row * DM + lane * 4 + 256 * k);
            } else {
                const float sc = s_in[row];
#pragma unroll
                for (int k = 0; k < 4; ++k) { const u32x2 xw = *(const u32x2*)(xh_in + (size_t)row * DM + lane * 4 + 256 * k); xv[k] = (f32x4){bflo(xw.x), bfhi(xw.x), bflo(xw.y), bfhi(xw.y)} * sc; }
            }
            if (mix) {
                f32x4 mv[4]; float ss = 0.f;
#pragma unroll
                for (int k = 0; k < 4; ++k) { const u32x2 mw = *(const u32x2*)(mix + (size_t)row * DM + lane * 4 + 256 * k); mv[k] = (f32x4){bflo(mw.x), bfhi(mw.x), bflo(mw.y), bfhi(mw.y)};
                    ss += mv[k][0] * mv[k][0] + mv[k][1] * mv[k][1] + mv[k][2] * mv[k][2] + mv[k][3] * mv[k][3]; }
#pragma unroll
                for (int o = 32; o >= 1; o >>= 1) ss += __shfl_xor(ss, o);
                const float r = rsqrtf(ss * (1.0f / DM) + EPS);
#pragma unroll
                for (int k = 0; k < 4; ++k) { const f32x4 w = *(const f32x4*)(postw + lane * 4 + 256 * k); xv[k] += mv[k] * r * w; }
            }
            float ss = 0.f;
#pragma unroll
            for (int k = 0; k < 4; ++k) ss += xv[k][0] * xv[k][0] + xv[k][1] * xv[k][1] + xv[k][2] * xv[k][2] + xv[k][3] * xv[k][3];
#pragma unroll
            for (int o = 32; o >= 1; o >>= 1) ss += __shfl_xor(ss, o);
            const float ms = ss * (1.0f / DM) + EPS, r = rsqrtf(ms);
            if (lane == 0) s_out[row] = ms * r;
#pragma unroll
            for (int k = 0; k < 4; ++k) { const f32x4 y = xv[k] * r;
                u32x2 o2; o2.x = cvt_pk_bf16(y[0], y[1]); o2.y = cvt_pk_bf16(y[2], y[3]);
                *(u32x2*)(xh_out + (size_t)row * DM + lane * 4 + 256 * k) = o2; *(LAS u32x2*)(xs + rl * NM_LD + lane * 4 + 256 * k) = o2; }
        }
        __syncthreads();
        if (wave < 6) {
            const int n = lane & 15, kq = lane >> 4;
            f32x4 acc[4];
#pragma unroll
            for (int mt = 0; mt < 4; ++mt) acc[mt] = (f32x4){0.f, 0.f, 0.f, 0.f};
            const bf16_t* wrow = Wm + (size_t)(16 * wave + n) * 1024 + 8 * kq;
            for (int ks = 0; ks < 32; ks += 4) {
                bf16x8 bf[4];
#pragma unroll
                for (int u = 0; u < 4; ++u) bf[u] = *(const bf16x8*)(wrow + (ks + u) * 32);
#pragma unroll
                for (int u = 0; u < 4; ++u)
#pragma unroll
                    for (int mt = 0; mt < 4; ++mt) { const bf16x8 af = *(const LAS bf16x8*)(xs + (16 * mt + n) * NM_LD + (ks + u) * 32 + 8 * kq);
                        acc[mt] = __builtin_amdgcn_mfma_f32_16x16x32_bf16(af, bf[u], acc[mt], 0, 0, 0); }
            }
#pragma unroll
            for (int mt = 0; mt < 4; ++mt)
#pragma unroll
                for (int j = 0; j < 4; ++j) { const int row = pq * 64 + 16 * mt + 4 * kq + j; const float v = acc[mt][j];
                    if (wave < 4) { const int cc = 16 * wave + n, q = cc >> 3, bb = row >> 12, sq = row & 4095;
                        IK[((((size_t)(bb * 128 + (sq >> 5)) * 4 + (q >> 1)) * 2 + (q & 1)) * 32 + (sq & 31)) * 8 + (cc & 7)] = f2bf(v); }
                    else if (wave == 4) { if (n < 8) IW[(size_t)row * 8 + n] = v * IW_SCALE; else BLR[(size_t)row * 16 + (n - 8)] = v; }
                    else { if (n < 8) BLR[(size_t)row * 16 + 8 + n] = v; } }
        }
        __syncthreads();
    }
}

#define IDX_AF(AF, b_, t0_) do { \
        const int qi_ = 2 * ((c >> 2) & 1) + (c >> 4), hh_ = (c & 3) + 4 * ((c >> 3) & 1);   \
        _Pragma("unroll") for (int mt = 0; mt < 2; ++mt) { const size_t tq_ = (size_t)(b_) * SEQ + (t0_) + 4 * mt + qi_; \
            _Pragma("unroll") for (int ks = 0; ks < 4; ++ks) AF[mt][ks] = *(const bf16x8*)(IQ + tq_ * 512 + hh_ * 64 + ks * 16 + 8 * g); } } while (0)
#define IDX_WV(WV, b_, t0_) do { \
        _Pragma("unroll") for (int mt = 0; mt < 2; ++mt) _Pragma("unroll") for (int qq = 0; qq < 2; ++qq) { const size_t tq_ = (size_t)(b_) * SEQ + (t0_) + 4 * mt + 2 * g + qq; \
            const f32x4 w0_ = *(const f32x4*)(IW + tq_ * 8), w1_ = *(const f32x4*)(IW + tq_ * 8 + 4); \
            WV[mt][qq][0] = w0_[0]; WV[mt][qq][1] = w0_[1]; WV[mt][qq][2] = w0_[2]; WV[mt][qq][3] = w0_[3]; WV[mt][qq][4] = w1_[0]; WV[mt][qq][5] = w1_[1]; WV[mt][qq][6] = w1_[2]; WV[mt][qq][7] = w1_[3]; } } while (0)

__device__ __forceinline__ void indexer_phase(LAS float* sc, const bf16_t* IQ, const bf16_t* IK, const float* IW, u64* MASK, int wave, int lane) {
    const int g = lane >> 5, c = lane & 31, G = gridDim.x;
    bf16x8 af[2][4];
#define IDX_ITEM(k_) ((k_) * G + (((k_) & 1) ? (G - 1 - (int)blockIdx.x) : (int)blockIdx.x))
    { const int it0 = IDX_ITEM(0); if (it0 < 2048) IDX_AF(af, it0 & 3, (511 - (it0 >> 2)) * 8); }
        for (int kk = 0; kk * G < 2048; ++kk) {
    const int it = IDX_ITEM(kk); if (it >= 2048) break;
    const int b = it & 3, t0 = (511 - (it >> 2)) * 8;
    float wv[2][2][8];
    IDX_WV(wv, b, t0);
    const int ntiles = (t0 + 8 + 31) >> 5;
    const bf16_t* ikb = IK + (size_t)b * 128 * 2048 + (size_t)(g * 32 + c) * 8;
#define IDX_LOAD(buf, kt_) do { if ((kt_) < ntiles) { _Pragma("unroll") for (int ks = 0; ks < 4; ++ks) buf[ks] = *(const bf16x8*)(ikb + (size_t)(kt_) * 2048 + ks * 512); } } while (0)
#define IDX_TILE(buf, kt_) do { if ((kt_) < ntiles) { const int key = (kt_) * 32 + c; f32x16 a0, a1; \
        _Pragma("unroll") for (int r = 0; r < 16; ++r) { a0[r] = 0.f; a1[r] = 0.f; } \
        _Pragma("unroll") for (int ks = 0; ks < 4; ++ks) { a0 = __builtin_amdgcn_mfma_f32_32x32x16_bf16(af[0][ks], buf[ks], a0, 0, 0, 0); a1 = __builtin_amdgcn_mfma_f32_32x32x16_bf16(af[1][ks], buf[ks], a1, 0, 0, 0); } \
        _Pragma("unroll") for (int qq = 0; qq < 2; ++qq) { float s0 = 0.f, s1 = 0.f; \
            _Pragma("unroll") for (int h = 0; h < 8; ++h) { s0 += wv[0][qq][h] * relu_bits(a0[8 * qq + h]); s1 += wv[1][qq][h] * relu_bits(a1[8 * qq + h]); } \
            sc[(0 + 2 * g + qq) * 4096 + key] = s0; sc[(4 + 2 * g + qq) * 4096 + key] = s1; } } } while (0)
    {
        bf16x8 b0[4], b1[4], b2[4];
        IDX_LOAD(b0, wave); IDX_LOAD(b1, wave + 8);
        for (int kt = wave; kt < ntiles; kt += 24) {
            IDX_LOAD(b2, kt + 16); IDX_TILE(b0, kt);
            IDX_LOAD(b0, kt + 24); IDX_TILE(b1, kt + 8);
            IDX_LOAD(b1, kt + 32); IDX_TILE(b2, kt + 16);
        }
    }
#undef IDX_LOAD
#undef IDX_TILE
    __syncthreads();
    bf16x8 afn[2][4];
    { const int itn = IDX_ITEM(kk + 1); if ((kk + 1) * G < 2048 && itn < 2048) IDX_AF(afn, itn & 3, (511 - (itn >> 2)) * 8); }
    {
        const int t = t0 + wave, nvalid = t + 1, nreg = (nvalid + 63) >> 6, ngrp = (nreg + 7) >> 3;
        const int gfull = nvalid >> 9;
        LAS float* myrow = sc + wave * 4096;
        float sf[64];
#pragma unroll
        for (int jj = 0; jj < 8; ++jj) {
            if (jj < gfull) {
#pragma unroll
                for (int j8 = 0; j8 < 8; ++j8) sf[jj * 8 + j8] = myrow[64 * (jj * 8 + j8) + lane];
            } else if (jj < ngrp) {
#pragma unroll
                for (int j8 = 0; j8 < 8; ++j8) { const int j = jj * 8 + j8, kk = 64 * j + lane; const float v = myrow[kk]; sf[j] = (kk < nvalid) ? v : NEG_INF; }
            } else {
#pragma unroll
                for (int j8 = 0; j8 < 8; ++j8) sf[jj * 8 + j8] = NEG_INF;
            }
        }
        float thr_f = NEG_INF; int need = 0; bool ties = false;
#define CNT_GEF(valf, out) do { int c_ = 0; _Pragma("unroll") for (int jj = 0; jj < 8; ++jj) if (jj < ngrp) { _Pragma("unroll") for (int j8 = 0; j8 < 8; ++j8) c_ += (sf[jj * 8 + j8] >= (valf)) ? 1 : 0; } \
            (out) = wave_sum_i32(c_); } while (0)
        if (nvalid > 256) {
            float mx = NEG_INF, mn = -NEG_INF;
#pragma unroll
            for (int jj = 0; jj < 8; ++jj) { if (jj < gfull) {
#pragma unroll
                for (int j8 = 0; j8 < 8; j8 += 2) {
                    asm("v_max3_f32 %0, %0, %1, %2" : "+v"(mx) : "v"(sf[jj * 8 + j8]), "v"(sf[jj * 8 + j8 + 1])); asm("v_min3_f32 %0, %0, %1, %2" : "+v"(mn) : "v"(sf[jj * 8 + j8]), "v"(sf[jj * 8 + j8 + 1])); } }
              else if (jj < ngrp) {
#pragma unroll
                for (int j8 = 0; j8 < 8; ++j8) { const float v = sf[jj * 8 + j8]; mx = fmaxf(mx, v); mn = fminf(mn, v == NEG_INF ? -NEG_INF : v); } } }
            mx = wave_max_f32(mx); mn = -wave_max_f32(-mn);
            const float scale = (mx > mn) ? 3839.0f / (mx - mn) : 0.f;
            LAS unsigned* hist = (LAS unsigned*)myrow;
#pragma unroll
            for (int k = 0; k < 16; ++k) *(LAS u32x4*)(hist + 4 * lane + 256 * k) = (u32x4){0u, 0u, 0u, 0u};
            __builtin_amdgcn_fence(__ATOMIC_RELEASE, "wavefront");
#pragma unroll
            for (int jj = 0; jj < 8; ++jj) { if (jj < gfull) {
#pragma unroll
                for (int j8 = 0; j8 < 8; ++j8) { const float v = sf[jj * 8 + j8];
                    int bn = (int)((v - mn) * scale); bn = bn > 3839 ? 3839 : bn; __hip_atomic_fetch_add(hist + (bn >> 6) * 68 + (bn & 63), 1u, __ATOMIC_RELAXED, __HIP_MEMORY_SCOPE_WAVEFRONT); } }
              else if (jj < ngrp) {
#pragma unroll
                for (int j8 = 0; j8 < 8; ++j8) { const float v = sf[jj * 8 + j8];
                    if (v != NEG_INF) { int bn = (int)((v - mn) * scale); bn = bn > 3839 ? 3839 : bn; __hip_atomic_fetch_add(hist + (bn >> 6) * 68 + (bn & 63), 1u, __ATOMIC_RELAXED, __HIP_MEMORY_SCOPE_WAVEFRONT); } } } }
            __builtin_amdgcn_fence(__ATOMIC_ACQ_REL, "wavefront");
            int cs = 0;
            if (lane < 60) {
#pragma unroll
                for (int k = 0; k < 16; ++k) { const u32x4 h4 = *(const LAS u32x4*)(hist + lane * 68 + 4 * k); cs += (int)((h4.x + h4.y) + (h4.z + h4.w)); }
            }
            int C, Bl, cnt_above, nA;
            {
                const int pre = wave_prefix_sum_i32(cs), tot = __builtin_amdgcn_readlane(pre, 63), suf = tot - pre + cs;
                const u64 mk = __ballot(suf >= 256);
                C = 63 - __builtin_clzll(mk);
                const int above_c = __builtin_amdgcn_readlane(suf, C) - __builtin_amdgcn_readlane(cs, C);
                const int bs = (int)hist[C * 68 + lane];
                const int pre2 = wave_prefix_sum_i32(bs), tot2 = __builtin_amdgcn_readlane(pre2, 63), suf2 = tot2 - pre2 + bs;
                const u64 mk2 = __ballot(suf2 >= 256 - above_c);
                Bl = 63 - __builtin_clzll(mk2);
                nA = __builtin_amdgcn_readlane(bs, Bl);
                cnt_above = above_c + __builtin_amdgcn_readlane(suf2, Bl) - nA;
            }
            const int binA = C * 64 + Bl, need1 = 256 - cnt_above;
            if (nA <= 64) {
                unsigned cv = 0u; int pos = 0;
                const float invs = (mx - mn) * (1.0f / 3839.0f), lo_f = mn + ((float)binA - 0.5f) * invs, hi_f = mn + ((float)binA + 1.5f) * invs;
#pragma unroll
                for (int jj = 0; jj < 8; ++jj) if (jj < ngrp) {
#pragma unroll
                    for (int j8 = 0; j8 < 8; ++j8) { const float v = sf[jj * 8 + j8];
                        u64 m = __ballot(v >= lo_f && v < hi_f);
                        if (m) { int bn = (int)((v - mn) * scale); bn = bn > 3839 ? 3839 : bn; m = __ballot(v >= lo_f && v < hi_f && bn == binA); }
                        while (m) { const int l = __builtin_ctzll(m); m &= m - 1ull; const unsigned uu = (unsigned)__builtin_amdgcn_readlane((int)__float_as_uint(v), l);
                            const unsigned kv = (uu & 0x80000000u) ? ~uu : (uu | 0x80000000u); if (lane == pos) cv = kv; ++pos; } } }
                unsigned tc = 0u;
                for (int bit = 31; bit >= 0; --bit) { const unsigned cand = tc | (1u << bit); if (__popcll(__ballot(cv >= cand)) >= need1) tc = cand; }
                thr_f = __uint_as_float((tc & 0x80000000u) ? (tc ^ 0x80000000u) : ~tc);
                const int cgt = cnt_above + __popcll(__ballot(cv > tc)), ceq = __popcll(__ballot(cv == tc));
                need = 256 - cgt; ties = (ceq != need);
            } else {
                unsigned tc = 0u;
                for (int bit = 31; bit >= 0; --bit) { const unsigned cand = tc | (1u << bit); const float cf = __uint_as_float((cand & 0x80000000u) ? (cand ^ 0x80000000u) : ~cand);
                    int cnt; CNT_GEF(cf, cnt); if (cnt >= 256) tc = cand; }
                thr_f = __uint_as_float((tc & 0x80000000u) ? (tc ^ 0x80000000u) : ~tc);
                int cge, cg = 0;
                CNT_GEF(thr_f, cge);
#pragma unroll
                for (int jj = 0; jj < 8; ++jj) if (jj < ngrp) {
#pragma unroll
                    for (int j8 = 0; j8 < 8; ++j8) cg += (sf[jj * 8 + j8] > thr_f) ? 1 : 0; }
                const int cgt = wave_sum_i32(cg);
                need = 256 - cgt; ties = ((cge - cgt) != need);
            }
        }
#undef CNT_GEF
        u64 myword = 0ull;
        if (nvalid <= 256) {
#pragma unroll
            for (int j = 0; j < 4; ++j) { const u64 mm = __ballot(64 * j + lane < nvalid); if (lane == j) myword = mm; }
        } else if (!ties) {
#pragma unroll
            for (int jj = 0; jj < 8; ++jj) if (jj < ngrp) {
#pragma unroll
                for (int j8 = 0; j8 < 8; ++j8) { const int j = jj * 8 + j8; const u64 mm = __ballot(sf[j] >= thr_f); if (lane == j) myword = mm; if ((j & 3) == 3) __builtin_amdgcn_sched_barrier(0); } }
        } else {
            int base = 0;
#pragma unroll
            for (int j = 0; j < 64; ++j) { const bool eq = sf[j] == thr_f; const u64 em = __ballot(eq);
                const int rank = base + (int)__builtin_amdgcn_mbcnt_hi((unsigned)(em >> 32), __builtin_amdgcn_mbcnt_lo((unsigned)em, 0u));
                const u64 mm = __ballot(sf[j] > thr_f || (eq && rank < need)); base += __popcll(em);
                if (lane == j) myword = mm; __builtin_amdgcn_sched_barrier(0); }
        }
        LAS u64* mst = (LAS u64*)(sc + 32768);
        mst[lane * 8 + wave] = myword;
    }
    __syncthreads();
    { const int tid_ = wave * 64 + lane, kt_ = tid_ >> 3, q_ = tid_ & 7; const LAS u64* mst = (const LAS u64*)(sc + 32768);
      MASK[((size_t)b * 64 + kt_) * SEQ + t0 + q_] = mst[kt_ * 8 + q_]; }
#pragma unroll
    for (int mt = 0; mt < 2; ++mt) {
#pragma unroll
        for (int ks = 0; ks < 4; ++ks) af[mt][ks] = afn[mt][ks];
    }
    }
}
#undef IDX_AF
#undef IDX_WV
#undef IDX_ITEM

constexpr int GL_BLR = 0;
constexpr int GL_W2  = GL_BLR + 4096;
constexpr int GL_GP  = GL_W2 + 4096;
constexpr int GL_QD  = GL_GP + 2048;
constexpr int GL_KD  = GL_QD + 64 * 72 * 2;
constexpr int GL_KT  = GL_KD + 64 * 72 * 2;
constexpr int GL_VT  = GL_KT + 64 * 72 * 2;
constexpr int GL_P   = GL_VT + 128 * 72 * 2;
constexpr int GL_O   = GL_P + 64 * 72 * 2;
constexpr int GL_END = GL_O + 64 * 132 * 4;

__device__ __forceinline__ void gla_stage_vt(LAS bf16_t* vt, const u32x4 (&vraw)[2], int tid) {
#pragma unroll
    for (int rep = 0; rep < 2; ++rep) { const int idx = tid + 512 * rep, j = idx >> 4, dv8 = (idx & 15) * 8;
        const u32x4 w = vraw[rep];
        vt[(dv8 + 0) * 72 + j] = (bf16_t)(w.x & 0xFFFF); vt[(dv8 + 1) * 72 + j] = (bf16_t)(w.x >> 16);
        vt[(dv8 + 2) * 72 + j] = (bf16_t)(w.y & 0xFFFF); vt[(dv8 + 3) * 72 + j] = (bf16_t)(w.y >> 16);
        vt[(dv8 + 4) * 72 + j] = (bf16_t)(w.z & 0xFFFF); vt[(dv8 + 5) * 72 + j] = (bf16_t)(w.z >> 16);
        vt[(dv8 + 6) * 72 + j] = (bf16_t)(w.w & 0xFFFF); vt[(dv8 + 7) * 72 + j] = (bf16_t)(w.w >> 16); }
}
__device__ __forceinline__ void gla_prep_state(LAS unsigned char* lds, const float* gw2, const float* gb2, int b, int hh, int n,
                                               bf16_t* BQ, bf16_t* BK, const bf16_t* BV, const float* BLR, float* DECAY) {
    const int tid = opaque_tid(), d = tid & 63, jg = tid >> 6;
    const size_t tok0 = (size_t)b * SEQ + n * 64;
    LAS float* blr = (LAS float*)(lds + GL_BLR); LAS float* w2s = (LAS float*)(lds + GL_W2); LAS float* gp = (LAS float*)(lds + GL_GP);
    LAS bf16_t* kt = (LAS bf16_t*)(lds + GL_KT); LAS bf16_t* vt = (LAS bf16_t*)(lds + GL_VT);
    bf16_t kraw[8], qraw[8]; u32x4 vraw[2];
#pragma unroll
    for (int i = 0; i < 8; ++i) { kraw[i] = BK[(tok0 + 8 * jg + i) * 256 + hh * 64 + d]; qraw[i] = BQ[(tok0 + 8 * jg + i) * 256 + hh * 64 + d]; }
#pragma unroll
    for (int rep = 0; rep < 2; ++rep) { const int idx = tid + 512 * rep; vraw[rep] = *(const u32x4*)(BV + (tok0 + (idx >> 4)) * 512 + hh * 128 + (idx & 15) * 8); }
    if (tid < 256) { *(LAS f32x4*)(blr + tid * 4) = *(const f32x4*)(BLR + tok0 * 16 + tid * 4); }
    else { const int q = tid - 256, r = q >> 4, d4 = (q & 15) * 4; *(LAS f32x4*)(w2s + r * 64 + d4) = *(const f32x4*)(gw2 + (size_t)r * 256 + hh * 64 + d4); }
    __syncthreads();
    float cs[8];
    { const float b2 = gb2[hh * 64 + d]; float run = 0.f; float w2c[16];
#pragma unroll
      for (int r = 0; r < 16; ++r) w2c[r] = w2s[r * 64 + d];
#pragma unroll
      for (int i = 0; i < 8; ++i) { float z = b2;
#pragma unroll
          for (int q = 0; q < 4; ++q) { const f32x4 bl = *(const LAS f32x4*)(blr + (8 * jg + i) * 16 + 4 * q);
              z += bl[0] * w2c[4 * q + 0]; z += bl[1] * w2c[4 * q + 1]; z += bl[2] * w2c[4 * q + 2]; z += bl[3] * w2c[4 * q + 3]; }
          const float la = -(fmaxf(-z, 0.f) + __logf(1.0f + __expf(-fabsf(z)))) * (1.0f / 16.0f);
          run += la; cs[i] = run; }
      gp[jg * 64 + d] = run; }
    __syncthreads();
    float off = 0.f, glast = 0.f;
#pragma unroll
    for (int j = 0; j < 8; ++j) { const float v = gp[j * 64 + d]; if (j < jg) off += v; glast += v; }
    const float eglast = __expf(glast);
    if (jg == 0) DECAY[((size_t)(b * 4 + hh) * 64 + n) * 64 + d] = eglast;
    unsigned ktw[4];
#pragma unroll
    for (int i = 0; i < 8; i += 2) {
        float ktv[2];
#pragma unroll
        for (int ii = 0; ii < 2; ++ii) { const int j = 8 * jg + i + ii; const float G = off + cs[i + ii];
            const float kv = bf2f(kraw[i + ii]), qv = bf2f(qraw[i + ii]);
            const float eg = __expf(G), eng = __builtin_amdgcn_rcpf(eg), kdv = kv * eng;
            ktv[ii] = kdv * eglast;
            BQ[(tok0 + j) * 256 + hh * 64 + d] = (bf16_t)(cvt_pk_bf16(qv * 0.125f * eg, 0.f) & 0xFFFFu);
            BK[(tok0 + j) * 256 + hh * 64 + d] = (bf16_t)(cvt_pk_bf16(kdv, 0.f) & 0xFFFFu); }
        ktw[i >> 1] = cvt_pk_bf16(ktv[0], ktv[1]);
    }
    *(LAS u32x4*)(kt + d * 72 + 8 * jg) = (u32x4){ktw[0], ktw[1], ktw[2], ktw[3]};
    gla_stage_vt(vt, vraw, tid);
    __syncthreads();
}
__device__ __forceinline__ void gla_prep_out(LAS unsigned char* lds, int b, int hh, int n, const bf16_t* BQ, const bf16_t* BK, const bf16_t* BV) {
    const int tid = opaque_tid(), row = tid >> 3, ch = (tid & 7) * 8;
    const size_t tok0 = (size_t)b * SEQ + n * 64;
    LAS bf16_t* qd = (LAS bf16_t*)(lds + GL_QD); LAS bf16_t* kd = (LAS bf16_t*)(lds + GL_KD); LAS bf16_t* vt = (LAS bf16_t*)(lds + GL_VT);
    u32x4 vraw[2];
    const u32x4 qw = *(const u32x4*)(BQ + (tok0 + row) * 256 + hh * 64 + ch), kw = *(const u32x4*)(BK + (tok0 + row) * 256 + hh * 64 + ch);
#pragma unroll
    for (int rep = 0; rep < 2; ++rep) { const int idx = tid + 512 * rep; vraw[rep] = *(const u32x4*)(BV + (tok0 + (idx >> 4)) * 512 + hh * 128 + (idx & 15) * 8); }
    *(LAS u32x4*)(qd + row * 72 + ch) = qw; *(LAS u32x4*)(kd + row * 72 + ch) = kw;
    gla_stage_vt(vt, vraw, tid);
    __syncthreads();
}

__device__ __forceinline__ void gla_state_item(LAS unsigned char* lds, const float* gw2, const float* gb2, int item, bf16_t* BQ, bf16_t* BK, const bf16_t* BV, const float* BLR, float* DECAY, float* GSTATE) {
    const int b = item >> 8, hh = (item >> 6) & 3, n = item & 63;
    gla_prep_state(lds, gw2, gb2, b, hh, n, BQ, BK, BV, BLR, DECAY);
    const int tid1 = opaque_tid(), lane = tid1 & 63, wave = tid1 >> 6, g = lane >> 5, c = lane & 31, mt = wave >> 1, nt = wave & 1;
    LAS bf16_t* kt = (LAS bf16_t*)(lds + GL_KT); LAS bf16_t* vt = (LAS bf16_t*)(lds + GL_VT);
    f32x16 acc;
#pragma unroll
    for (int r = 0; r < 16; ++r) acc[r] = 0.f;
#pragma unroll
    for (int ks = 0; ks < 4; ++ks) { const bf16x8 af = *(const LAS bf16x8*)(vt + (32 * mt + c) * 72 + ks * 16 + 8 * g); const bf16x8 bf = *(const LAS bf16x8*)(kt + (32 * nt + c) * 72 + ks * 16 + 8 * g);
        acc = __builtin_amdgcn_mfma_f32_32x32x16_bf16(af, bf, acc, 0, 0, 0); }
    float* dst = GSTATE + ((size_t)(b * 4 + hh) * 64 + n) * 8192;
#pragma unroll
    for (int r = 0; r < 16; ++r) { const int dv = 32 * mt + (r & 3) + 8 * (r >> 2) + 4 * g; dst[dv * 64 + 32 * nt + c] = acc[r]; }
    __syncthreads();
}

__device__ __forceinline__ void gla_out_item(LAS unsigned char* lds, const float* gw2, const float* gb2, int item, const bf16_t* BQ, const bf16_t* BK, const bf16_t* BV, const float* BLR, const bf16_t* BG,
                                              const bf16_t* SPREV, bf16_t* MIXIN) {
    const int b = item >> 8, hh = (item >> 6) & 3, n = item & 63;
    const int tid = opaque_tid(), lane = tid & 63, wave = tid >> 6, g = lane >> 5, c = lane & 31;
    bf16x8 spf[4]; u32x4 g0, g1;
    { const bf16_t* sp = SPREV + ((size_t)(b * 4 + hh) * 64 + n) * 8192 + (size_t)(32 * (wave & 3) + c) * 64 + 8 * g;
#pragma unroll
      for (int ks = 0; ks < 4; ++ks) spf[ks] = *(const bf16x8*)(sp + ks * 16);
      const size_t tokg = (size_t)b * SEQ + n * 64 + (tid >> 3);
      g0 = *(const u32x4*)(BG + tokg * 512 + hh * 128 + (tid & 7) * 16); g1 = *(const u32x4*)(BG + tokg * 512 + hh * 128 + (tid & 7) * 16 + 8); }
    gla_prep_out(lds, b, hh, n, BQ, BK, BV);
    LAS bf16_t* qd = (LAS bf16_t*)(lds + GL_QD); LAS bf16_t* kd = (LAS bf16_t*)(lds + GL_KD); LAS bf16_t* vt = (LAS bf16_t*)(lds + GL_VT); LAS bf16_t* P = (LAS bf16_t*)(lds + GL_P);
    LAS float* o = (LAS float*)(lds + GL_O);
    if (wave < 4) {
        const int mt = wave >> 1, nt = wave & 1;
        f32x16 acc;
#pragma unroll
        for (int r = 0; r < 16; ++r) acc[r] = 0.f;
        if (!(mt == 0 && nt == 1)) {
#pragma unroll
            for (int ks = 0; ks < 4; ++ks) { const bf16x8 af = *(const LAS bf16x8*)(qd + (32 * mt + c) * 72 + ks * 16 + 8 * g); const bf16x8 bf = *(const LAS bf16x8*)(kd + (32 * nt + c) * 72 + ks * 16 + 8 * g);
                acc = __builtin_amdgcn_mfma_f32_32x32x16_bf16(af, bf, acc, 0, 0, 0); }
        }
#pragma unroll
        for (int r = 0; r < 16; ++r) { const int i = 32 * mt + (r & 3) + 8 * (r >> 2) + 4 * g, j = 32 * nt + c; P[i * 72 + j] = f2bf(j <= i ? acc[r] : 0.f); }
    }
    __syncthreads();
    {
        const int mt = wave >> 2, nt = wave & 3;
        f32x16 acc;
#pragma unroll
        for (int r = 0; r < 16; ++r) acc[r] = 0.f;
#pragma unroll
        for (int ks = 0; ks < 4; ++ks) { const bf16x8 af = *(const LAS bf16x8*)(P + (32 * mt + c) * 72 + ks * 16 + 8 * g); const bf16x8 bf = *(const LAS bf16x8*)(vt + (32 * nt + c) * 72 + ks * 16 + 8 * g);
            acc = __builtin_amdgcn_mfma_f32_32x32x16_bf16(af, bf, acc, 0, 0, 0); }
#pragma unroll
        for (int ks = 0; ks < 4; ++ks) { const bf16x8 af = *(const LAS bf16x8*)(qd + (32 * mt + c) * 72 + ks * 16 + 8 * g); acc = __builtin_amdgcn_mfma_f32_32x32x16_bf16(af, spf[ks], acc, 0, 0, 0); }
#pragma unroll
        for (int r = 0; r < 16; ++r) { const int i = 32 * mt + (r & 3) + 8 * (r >> 2) + 4 * g; o[i * 132 + 32 * nt + c] = acc[r]; }
    }
    __syncthreads();
    {
        const int row = tid >> 3, part = tid & 7; float v[16]; float ss = 0.f;
#pragma unroll
        for (int k = 0; k < 16; ++k) { v[k] = o[row * 132 + part * 16 + k]; ss += v[k] * v[k]; }
        ss += __shfl_xor(ss, 1); ss += __shfl_xor(ss, 2); ss += __shfl_xor(ss, 4);
        const float r = rsqrtf(ss * (1.0f / 128.0f) + EPS);
        const size_t tok = (size_t)b * SEQ + n * 64 + row;
        const float gv[16] = {bflo(g0.x), bfhi(g0.x), bflo(g0.y), bfhi(g0.y), bflo(g0.z), bfhi(g0.z), bflo(g0.w), bfhi(g0.w),
                              bflo(g1.x), bfhi(g1.x), bflo(g1.y), bfhi(g1.y), bflo(g1.z), bfhi(g1.z), bflo(g1.w), bfhi(g1.w)};
        unsigned w[8];
#pragma unroll
        for (int k = 0; k < 8; ++k) w[k] = cvt_pk_bf16(v[2 * k] * r * gv[2 * k], v[2 * k + 1] * r * gv[2 * k + 1]);
        bf16_t* dp = MIXIN + tok * 1024 + 512 + hh * 128 + part * 16;
        *(u32x4*)dp = (u32x4){w[0], w[1], w[2], w[3]}; *(u32x4*)(dp + 8) = (u32x4){w[4], w[5], w[6], w[7]};
    }
    __syncthreads();
}

constexpr int AT_K0 = 0, AT_V0 = 9216, AT_STAGE = 18432, AT_BT = 2 * AT_STAGE;
constexpr float LOG2E = 1.4426950408889634f, AT_C1 = 0.125f * LOG2E, AT_THR = 8.0f;

template <bool NEAR>
__device__ __forceinline__ void attn_tile(const LAS bf16_t* Kt, const LAS bf16_t* Vt, const LAS float* btl, const bf16x8 (&qf)[4], f32x16& negm, f32x16& O0, f32x16& O1, float& m_ref, float& thr, f32pair_t& lsum,
                                          u64 mw, int tq, int key0, int g, int c) {
    const int pc = (c & 0x13) | ((c & 4) << 1) | ((c & 8) >> 1);
    f32x16 s0, s1;
#pragma unroll
    for (int ks = 0; ks < 4; ++ks) {
        const bf16x8 k0 = *(const LAS bf16x8*)(Kt + pc * 72 + ks * 16 + 8 * g), k1 = *(const LAS bf16x8*)(Kt + (32 + pc) * 72 + ks * 16 + 8 * g);
        if (ks == 0) {
            asm("v_mfma_f32_32x32x16_bf16 %0, %1, %2, %3" : "=&v"(s0) : "v"(k0), "v"(qf[0]), "v"(negm)); asm("v_mfma_f32_32x32x16_bf16 %0, %1, %2, %3" : "=&v"(s1) : "v"(k1), "v"(qf[0]), "v"(negm)); }
        else { s0 = __builtin_amdgcn_mfma_f32_32x32x16_bf16(k0, qf[ks], s0, 0, 0, 0); s1 = __builtin_amdgcn_mfma_f32_32x32x16_bf16(k1, qf[ks], s1, 0, 0, 0); }
    }
    const unsigned w0 = (unsigned)mw >> (8 * g), w1 = (unsigned)(mw >> 32) >> (8 * g);
    float x0[16], x1[16];
#pragma unroll
    for (int r = 0; r < 16; ++r) {
        if (NEAR) { const LAS float* pb = btl + (tq - key0 - 8 * g + 96 - 63);
            x0[r] = s0[r] + pb[63 - (16 * (r >> 3) + (r & 7))]; x1[r] = s1[r] + pb[63 - (16 * (r >> 3) + (r & 7) + 32)]; }
        else { x0[r] = s0[r]; x1[r] = s1[r]; }
    }
    float mx = fmaxf(fmaxf(x0[15], x0[14]), fmaxf(x1[15], x1[14]));
    asm("v_max3_f32 %0, %0, %1, %2\n\tv_max3_f32 %0, %0, %3, %4\n\tv_max3_f32 %0, %0, %5, %6\n\tv_max3_f32 %0, %0, %7, %8\n\tv_max3_f32 %0, %0, %9, %10\n\tv_max3_f32 %0, %0, %11, %12\n\tv_max3_f32 %0, %0, %13, %14"
        : "+v"(mx) : "v"(x0[0]), "v"(x1[0]), "v"(x0[1]), "v"(x1[1]), "v"(x0[2]), "v"(x1[2]), "v"(x0[3]), "v"(x1[3]), "v"(x0[4]), "v"(x1[4]), "v"(x0[5]), "v"(x1[5]), "v"(x0[6]), "v"(x1[6]));
    asm("v_max3_f32 %0, %0, %1, %2\n\tv_max3_f32 %0, %0, %3, %4\n\tv_max3_f32 %0, %0, %5, %6\n\tv_max3_f32 %0, %0, %7, %8\n\tv_max3_f32 %0, %0, %9, %10\n\tv_max3_f32 %0, %0, %11, %12\n\tv_max3_f32 %0, %0, %13, %14"
        : "+v"(mx) : "v"(x0[7]), "v"(x1[7]), "v"(x0[8]), "v"(x1[8]), "v"(x0[9]), "v"(x1[9]), "v"(x0[10]), "v"(x1[10]), "v"(x0[11]), "v"(x1[11]), "v"(x0[12]), "v"(x1[12]), "v"(x0[13]), "v"(x1[13]));
    if (__any(mx > thr)) {
        float ms = NEG_INF;
#pragma unroll
        for (int r = 0; r < 16; ++r) { const int bp = 16 * (r >> 3) + (r & 7);
            const float a0 = ((w0 >> bp) & 1u) ? x0[r] : NEG_INF, a1 = ((w1 >> bp) & 1u) ? x1[r] : NEG_INF; ms = fmaxf(ms, fmaxf(a0, a1)); }
        { const auto sw = __builtin_amdgcn_permlane32_swap(__float_as_uint(ms), __float_as_uint(ms), false, false); ms = fmaxf(__uint_as_float(sw[0]), __uint_as_float(sw[1])); }
        const bool unset = (thr == NEG_INF);
        const float delta = (ms == NEG_INF) ? 0.f : (unset ? ms : fmaxf(ms, 0.f));
        const float alpha = unset ? 1.0f : __builtin_amdgcn_exp2f(-delta);
#pragma unroll
        for (int r = 0; r < 16; ++r) { O0[r] *= alpha; O1[r] *= alpha; x0[r] -= delta; x1[r] -= delta; }
        lsum *= alpha; m_ref += delta; if (ms != NEG_INF) thr = AT_THR;
#pragma unroll
        for (int r = 0; r < 16; ++r) negm[r] = -m_ref;
    }
#pragma unroll
    for (int r = 0; r < 16; ++r) { const int bp = 16 * (r >> 3) + (r & 7);
        const float e0 = __builtin_amdgcn_exp2f(x0[r]), e1 = __builtin_amdgcn_exp2f(x1[r]);
        unsigned b0, b1;
        asm("v_bfe_i32 %0, %1, %2, 1" : "=v"(b0) : "v"(w0), "n"(bp)); asm("v_bfe_i32 %0, %1, %2, 1" : "=v"(b1) : "v"(w1), "n"(bp));
        x0[r] = __uint_as_float(__float_as_uint(e0) & b0); x1[r] = __uint_as_float(__float_as_uint(e1) & b1); }
#pragma unroll
    for (int s = 0; s < 4; ++s) {
        const float* xp = (s < 2) ? x0 : x1; const int o = 8 * (s & 1);
        u32x4 w; w.x = cvt_pk_bf16(xp[o + 0], xp[o + 1]); w.y = cvt_pk_bf16(xp[o + 2], xp[o + 3]); w.z = cvt_pk_bf16(xp[o + 4], xp[o + 5]); w.w = cvt_pk_bf16(xp[o + 6], xp[o + 7]);
        const bf16x8 pb = *(bf16x8*)&w;
        const bf16x8 v0 = *(const LAS bf16x8*)(Vt + c * 72 + s * 16 + 8 * g), v1 = *(const LAS bf16x8*)(Vt + (32 + c) * 72 + s * 16 + 8 * g);
        O0 = __builtin_amdgcn_mfma_f32_32x32x16_bf16(v0, pb, O0, 0, 0, 0); O1 = __builtin_amdgcn_mfma_f32_32x32x16_bf16(v1, pb, O1, 0, 0, 0);
#pragma unroll
        for (int i = 0; i < 8; i += 2) lsum += (f32pair_t){xp[o + i], xp[o + i + 1]};
    }
}

__device__ __forceinline__ void attn_item(LAS unsigned char* lds, const bf16_t* Q, const bf16_t* Kb, const bf16_t* VT, const bf16_t* AG, const u64* MASK, const float* btab, bf16_t* MIXIN,
                                          int b, int head, int qb, int tid) {
    const int lane = tid & 63, wave = __builtin_amdgcn_readfirstlane(tid >> 6), g = lane >> 5, c = lane & 31;
    const int tq0 = qb * 256 + wave * 32, tq = tq0 + c;
    const size_t tokq = (size_t)b * SEQ + tq;
    LAS float* btl = (LAS float*)(lds + AT_BT);
    if (tid < 320) { const int rel = tid - 96; btl[tid] = (rel >= 0 && rel < 128) ? (btab[rel * 8 + head] - btab[127 * 8 + head]) * LOG2E : 0.f; }
    bf16x8 qf[4];
#pragma unroll
    for (int ks = 0; ks < 4; ++ks) { const u32x4 qw = *(const u32x4*)(Q + tokq * 512 + head * 64 + ks * 16 + 8 * g);
        u32x4 sw; sw.x = cvt_pk_bf16(bflo(qw.x) * AT_C1, bfhi(qw.x) * AT_C1); sw.y = cvt_pk_bf16(bflo(qw.y) * AT_C1, bfhi(qw.y) * AT_C1);
        sw.z = cvt_pk_bf16(bflo(qw.z) * AT_C1, bfhi(qw.z) * AT_C1); sw.w = cvt_pk_bf16(bflo(qw.w) * AT_C1, bfhi(qw.w) * AT_C1); qf[ks] = *(bf16x8*)&sw; }
    f32x16 O0, O1, negm;
#pragma unroll
    for (int r = 0; r < 16; ++r) { O0[r] = 0.f; O1[r] = 0.f; negm[r] = 0.f; }
    float m_ref = 0.f, thr = NEG_INF; f32pair_t lsum = {0.f, 0.f};
    const int nt = 4 * qb + 4, my_last = 4 * qb + (wave >> 1);
    const int srow = tid >> 3, sch = tid & 7, sto = (srow * 72 + 8 * sch) * 2;
    const bf16_t* kg = Kb + ((size_t)b * SEQ + srow) * 512 + head * 64 + 8 * sch;
    const bf16_t* vg = VT + ((size_t)(b * 8 + head) * 64 + srow) * 4096 + 8 * sch;
    const u64* Mrow = MASK + (size_t)b * 64 * SEQ + tq;
    { const u32x4 kr = *(const u32x4*)kg, vr = *(const u32x4*)vg; *(LAS u32x4*)(lds + AT_K0 + sto) = kr; *(LAS u32x4*)(lds + AT_V0 + sto) = vr; }
    u64 mw = Mrow[0];
    __syncthreads();
    int ks_near = (tq0 - 175 + 63) >> 6; ks_near = ks_near < 0 ? 0 : ks_near;
#define AT_ITER(BODY) do { const bool more = (kt + 1 < nt); u32x4 kr, vr; u64 mwn = 0ull; \
        if (more) { kr = *(const u32x4*)(kg + (size_t)(kt + 1) * 64 * 512); vr = *(const u32x4*)(vg + (kt + 1) * 64); if (kt + 1 <= my_last) mwn = Mrow[(size_t)(kt + 1) * SEQ]; } \
        { const LAS bf16_t* Kt = (const LAS bf16_t*)(lds + (kt & 1) * AT_STAGE + AT_K0); const LAS bf16_t* Vt = (const LAS bf16_t*)(lds + (kt & 1) * AT_STAGE + AT_V0); BODY; } \
        if (more) { *(LAS u32x4*)(lds + ((kt + 1) & 1) * AT_STAGE + AT_K0 + sto) = kr; *(LAS u32x4*)(lds + ((kt + 1) & 1) * AT_STAGE + AT_V0 + sto) = vr; } \
        mw = mwn; __syncthreads(); } while (0)
    int kt = 0;
    if (wave >= 4) __builtin_amdgcn_s_setprio(1);
    for (; kt < ks_near; ++kt) AT_ITER(attn_tile<false>(Kt, Vt, btl, qf, negm, O0, O1, m_ref, thr, lsum, mw, tq, 64 * kt, g, c));
    for (; kt <= my_last; ++kt) AT_ITER(attn_tile<true>(Kt, Vt, btl, qf, negm, O0, O1, m_ref, thr, lsum, mw, tq, 64 * kt, g, c));
    for (; kt < nt; ++kt) AT_ITER((void)Kt; (void)Vt);
#undef AT_ITER
    __builtin_amdgcn_s_setprio(0);
    float inv;
    { const float l1 = lsum.x + lsum.y; const auto sw = __builtin_amdgcn_permlane32_swap(__float_as_uint(l1), __float_as_uint(l1), false, false); inv = 1.0f / (__uint_as_float(sw[0]) + __uint_as_float(sw[1])); }
#pragma unroll
    for (int mt = 0; mt < 2; ++mt)
#pragma unroll
        for (int rq = 0; rq < 4; ++rq) { const int d0 = 32 * mt + 8 * rq + 4 * g;
            const u32x2 gw = *(const u32x2*)(AG + tokq * 512 + head * 64 + d0);
            const float o0 = (mt ? O1[4 * rq + 0] : O0[4 * rq + 0]) * inv * bflo(gw.x), o1 = (mt ? O1[4 * rq + 1] : O0[4 * rq + 1]) * inv * bfhi(gw.x);
            const float o2 = (mt ? O1[4 * rq + 2] : O0[4 * rq + 2]) * inv * bflo(gw.y), o3 = (mt ? O1[4 * rq + 3] : O0[4 * rq + 3]) * inv * bfhi(gw.y);
            u32x2 ow; ow.x = cvt_pk_bf16(o0, o1); ow.y = cvt_pk_bf16(o2, o3);
            *(u32x2*)(MIXIN + tokq * 1024 + head * 64 + d0) = ow; }
}

constexpr int LDS_BYTES = 147456;
constexpr int MISC_OFF = 131072 + 8192;
constexpr int NPH = 26;

__global__ void __launch_bounds__(NTHREADS, 2) fwd_kernel(Args a) {
    extern __shared__ __attribute__((aligned(16))) unsigned char lds_raw[];
    LAS unsigned char* lds = (LAS unsigned char*)lds_raw;
    const int G = gridDim.x, wg = blockIdx.x;
    volatile LAS unsigned* misc = (volatile LAS unsigned*)(lds + MISC_OFF);
    if (threadIdx.x < 4) misc[threadIdx.x] = 0u;
    __syncthreads();
    XcdBarrier bar; bar.bar = nullptr; bar.x = 0; bar.st = misc;
    if (N_LAUNCHES == 1) bar = xcd_barrier_post((unsigned*)(get_args()->ws + WS_CTL), misc);
    int lo, hi; { ArgsP ap = get_args(); lo = ap->ph_lo; hi = ap->ph_hi; }
#define WSP(type, off) ((type*)(wsl + (off)))
#define IN(k) (lo <= (k) && (k) < hi)
#define SEAM(k) do { if (N_LAUNCHES == 1 && IN(k) && IN((k) + 1)) { XcdBarrier b_ = bar; asm volatile("" : "+s"(b_.bar), "+s"(b_.x)); xcd_barrier(b_); } } while (0)

    if (IN(0)) {
        ArgsP ap = get_args(); unsigned char* wsl = ap->ws;
        weight_phase((LAS float*)lds, ap, wsl);
        if (wg == 0) for (int i = opaque_tid(); i < 1024; i += NTHREADS) { const int rel = i >> 3, h = i & 7; WSP(float, WS_TAB)[i] = ap->rel_bias[t5_bucket(rel) * 8 + h]; }
    }
    SEAM(0);

#define LAYER_BODY(LAYER_) { constexpr int layer = (LAYER_); \
        const int pb = 1 + 6 * layer, e = layer >> 1; \
        constexpr bool even = (layer & 1) == 0; \
        if (IN(pb + 0)) { \
            ArgsP ap = get_args(); unsigned char* wsl = ap->ws; \
            const bf16_t* Wm = WSP(bf16_t, WS_WEIN) + ((size_t)e * NE + 4096) * 1024; \
            if (layer == 0) norm_misc_phase(lds, ap->x, nullptr, nullptr, nullptr, nullptr, WSP(bf16_t, WS_H), WSP(float, WS_XS), Wm, WSP(bf16_t, WS_IK), WSP(float, WS_IW), WSP(float, WS_BLR)); \
            else if (even) norm_misc_phase(lds, nullptr, WSP(bf16_t, WS_H), WSP(float, WS_XS), WSP(bf16_t, WS_MIX), ap->post_norm + (layer - 1) * DM, WSP(bf16_t, WS_H), WSP(float, WS_XS), Wm, WSP(bf16_t, WS_IK), WSP(float, WS_IW), WSP(float, WS_BLR)); \
            else norm_phase(nullptr, WSP(bf16_t, WS_H), WSP(float, WS_XS), WSP(bf16_t, WS_MIX), ap->post_norm + (layer - 1) * DM, WSP(bf16_t, WS_H), WSP(float, WS_XS), nullptr); \
        } \
        SEAM(pb + 0); \
        if (even) { \
            if (IN(pb + 1)) { \
                ArgsP ap = get_args(); unsigned char* wsl = ap->ws; \
                pg8::Gemm gm{WSP(bf16_t, WS_H), WSP(bf16_t, WS_WEIN) + (size_t)e * NE * 1024, T, 4096, 1024, 1024, 1 << 30, 0}; pg8::StaticOrder S; S.init(T, 4096, G, wg); \
                EpiEvenIn E{WSP(bf16_t, WS_Q), WSP(bf16_t, WS_K), WSP(bf16_t, WS_VT), WSP(bf16_t, WS_AG), WSP(bf16_t, WS_IQ), WSP(bf16_t, WS_BQ), WSP(bf16_t, WS_BK), WSP(bf16_t, WS_BV), WSP(bf16_t, WS_BG), \
                            WSP(bf16_t, WS_IK), WSP(float, WS_IW), WSP(float, WS_BLR)}; \
                pg8::gemm_phase(lds, gm, S, E); \
            } \
            SEAM(pb + 1); \
            if (IN(pb + 2)) { \
                ArgsP ap = get_args(); unsigned char* wsl = ap->ws; \
                { const int tid = opaque_tid(), lane = tid & 63, wave = __builtin_amdgcn_readfirstlane(tid >> 6); \
                  indexer_phase((LAS float*)lds, WSP(bf16_t, WS_IQ), WSP(bf16_t, WS_IK), WSP(float, WS_IW), WSP(u64, WS_MASK), wave, lane); } \
                { const float* gw2 = ap->even_gate_w2 + (size_t)e * 16 * 256; const float* gb2 = ap->even_gate_b2 + (size_t)e * 256; \
                  for (int it = wg; it < 1024; it += G) gla_state_item(lds, gw2, gb2, it, WSP(bf16_t, WS_BQ), WSP(bf16_t, WS_BK), WSP(bf16_t, WS_BV), WSP(float, WS_BLR), WSP(float, WS_DECAY), WSP(float, WS_MIXIN)); } \
            } \
            SEAM(pb + 2); \
            if (IN(pb + 3)) { \
                ArgsP ap = get_args(); unsigned char* wsl = ap->ws; \
                const float* GSTATE = WSP(float, WS_MIXIN); const float* DECAY = WSP(float, WS_DECAY); bf16_t* SPREV = WSP(bf16_t, WS_SPREV); \
                for (int el = wg * NTHREADS + opaque_tid(); el < 16 * 8192; el += G * NTHREADS) { \
                    const int bh = el >> 13, rem = el & 8191, dk = rem & 63; float Sv = 0.f; \
                    for (int n = 0; n < 64; ++n) { const size_t o = ((size_t)bh * 64 + n) * 8192 + rem; SPREV[o] = f2bf(Sv); Sv = DECAY[((size_t)bh * 64 + n) * 64 + dk] * Sv + GSTATE[o]; } \
                } \
            } \
            SEAM(pb + 3); \
            if (IN(pb + 4)) { \
                ArgsP ap = get_args(); unsigned char* wsl = ap->ws; \
                { const int tid = opaque_tid(); \
                  for (int it = wg; it < 512; it += G) { const int idx = it & 255, b = idx & 3, head = (idx >> 2) & 7, qbp = idx >> 5, qb = (it < 256) ? 15 - qbp : qbp; \
                      attn_item(lds, WSP(bf16_t, WS_Q), WSP(bf16_t, WS_K), WSP(bf16_t, WS_VT), WSP(bf16_t, WS_AG), WSP(u64, WS_MASK), WSP(float, WS_TAB), WSP(bf16_t, WS_MIXIN), b, head, qb, tid); } } \
                __syncthreads(); \
                { const float* gw2 = ap->even_gate_w2 + (size_t)e * 16 * 256; const float* gb2 = ap->even_gate_b2 + (size_t)e * 256; \
                  for (int it = wg; it < 1024; it += G) gla_out_item(lds, gw2, gb2, it, WSP(bf16_t, WS_BQ), WSP(bf16_t, WS_BK), WSP(bf16_t, WS_BV), WSP(float, WS_BLR), WSP(bf16_t, WS_BG), WSP(bf16_t, WS_SPREV), WSP(bf16_t, WS_MIXIN)); } \
            } \
            SEAM(pb + 4); \
        } else { \
            if (IN(pb + 1)) { \
                ArgsP ap = get_args(); unsigned char* wsl = ap->ws; \
                pg8::Gemm gm{WSP(bf16_t, WS_H), WSP(bf16_t, WS_WOIN) + (size_t)e * 2048 * 1024, T, 2048, 1024, 1024, 1 << 30, 0}; pg8::StaticOrder S; S.init(T, 2048, G, wg); \
                EpiOddIn E{WSP(bf16_t, WS_XR), WSP(bf16_t, WS_GS)}; \
                pg8::gemm_phase(lds, gm, S, E); \
            } \
            SEAM(pb + 1); \
            if (IN(pb + 2)) { \
                ArgsP ap = get_args(); unsigned char* wsl = ap->ws; \
                const bf16_t* XR = WSP(bf16_t, WS_XR); bf16_t* XC = WSP(bf16_t, WS_XC); \
                const float* cw = ap->odd_conv_w + (size_t)e * 4 * 1024; const float* cb = ap->odd_conv_b + (size_t)e * 1024; \
                { const int tid = opaque_tid(), c8 = (tid & 127) * 8; float wq[4][8], bq[8];   \
_Pragma("unroll") \
                  for (int k = 0; k < 8; ++k) { bq[k] = cb[c8 + k]; _Pragma("unroll") for (int j = 0; j < 4; ++j) wq[j][k] = cw[j * 1024 + c8 + k]; } \
                  for (int run = wg * 4 + (tid >> 7); run < T / 8; run += G * 4) { \
                    const int tok0 = run * 8, s0 = tok0 & 4095; float xw[11][8]; \
_Pragma("unroll") \
                    for (int i = 0; i < 11; ++i) { u32x4 w = (u32x4){0u, 0u, 0u, 0u}; if (s0 - 3 + i >= 0) w = *(const u32x4*)(XR + (size_t)(tok0 - 3 + i) * 1024 + c8); \
                        xw[i][0] = bflo(w.x); xw[i][1] = bfhi(w.x); xw[i][2] = bflo(w.y); xw[i][3] = bfhi(w.y); xw[i][4] = bflo(w.z); xw[i][5] = bfhi(w.z); xw[i][6] = bflo(w.w); xw[i][7] = bfhi(w.w); } \
_Pragma("unroll") \
                    for (int o = 0; o < 8; ++o) { float acc[8]; \
_Pragma("unroll") \
                        for (int k = 0; k < 8; ++k) acc[k] = bq[k] + wq[0][k] * xw[o][k] + wq[1][k] * xw[o + 1][k] + wq[2][k] * xw[o + 2][k] + wq[3][k] * xw[o + 3][k]; \
                        u32x4 ow; ow.x = cvt_pk_bf16(acc[0], acc[1]); ow.y = cvt_pk_bf16(acc[2], acc[3]); ow.z = cvt_pk_bf16(acc[4], acc[5]); ow.w = cvt_pk_bf16(acc[6], acc[7]); \
                        *(u32x4*)(XC + (size_t)(tok0 + o) * 1024 + c8) = ow; } \
                  } } \
            } \
            SEAM(pb + 2); \
            if (IN(pb + 3)) { \
                ArgsP ap = get_args(); unsigned char* wsl = ap->ws; \
                pg8::Gemm gm{WSP(bf16_t, WS_XC), WSP(bf16_t, WS_WOG) + (size_t)e * 2048 * 256, T, 2048, 256, 1024, 2, 512}; pg8::StaticOrder S; S.init(T, 2048, G, wg); \
                EpiGates E{ap->odd_b_a + (size_t)e * 1024, ap->odd_b_x + (size_t)e * 1024, ap->odd_lambda + (size_t)e * 1024, WSP(bf16_t, WS_XC), WSP(bf16_t, WS_LOGA), WSP(bf16_t, WS_U)}; \
                pg8::gemm_phase(lds, gm, S, E); \
            } \
            SEAM(pb + 3); \
            if (IN(pb + 4)) { \
                ArgsP ap = get_args(); unsigned char* wsl = ap->ws; \
                const bf16_t* LOGA = WSP(bf16_t, WS_LOGA); const bf16_t* U = WSP(bf16_t, WS_U); const bf16_t* GS = WSP(bf16_t, WS_GS); bf16_t* MIXIN = WSP(bf16_t, WS_MIXIN); \
                LAS float* sl = (LAS float*)lds; LAS float* hl = sl + 512; \
                const int tid = opaque_tid(); \
                for (int it = wg; it < 256; it += G) { \
                      \
                    const int xq = (it & 7) * 8 + ((it >> 3) >> 2), b = xq >> 4, ch = ((xq & 15) * 4 + ((it >> 3) & 3)) * 16 + (tid & 15), jc = tid >> 4; \
                    const size_t base = ((size_t)b * SEQ + jc * 128) * 1024 + ch, sbase = slab_idx(b * SEQ + jc * 128, ch); \
                    float hsum = 0.f, lsum = 0.f; \
                    for (int s0 = 0; s0 < 128; s0 += 16) { float la[16], uu[16]; \
                        _Pragma("unroll") for (int k = 0; k < 16; ++k) { la[k] = bf2f(LOGA[sbase + (size_t)(s0 + k) * 16]); uu[k] = bf2f(U[sbase + (size_t)(s0 + k) * 16]); } \
                        _Pragma("unroll") for (int k = 0; k < 16; ++k) { hsum = __builtin_amdgcn_exp2f(la[k]) * hsum + uu[k]; lsum += la[k]; } } \
                    sl[tid] = lsum; hl[tid] = hsum; \
                    __syncthreads(); \
                    float hin = 0.f; \
                    for (int cj = 0; cj < jc; ++cj) hin = __builtin_amdgcn_exp2f(sl[cj * 16 + (tid & 15)]) * hin + hl[cj * 16 + (tid & 15)]; \
                    float hv = hin; \
                    for (int s0 = 0; s0 < 128; s0 += 16) { float la[16], uu[16], gg[16]; \
                        _Pragma("unroll") for (int k = 0; k < 16; ++k) { la[k] = bf2f(LOGA[sbase + (size_t)(s0 + k) * 16]); uu[k] = bf2f(U[sbase + (size_t)(s0 + k) * 16]); gg[k] = bf2f(GS[sbase + (size_t)(s0 + k) * 16]); } \
                        _Pragma("unroll") for (int k = 0; k < 16; ++k) { hv = __builtin_amdgcn_exp2f(la[k]) * hv + uu[k]; MIXIN[base + (size_t)(s0 + k) * 1024] = f2bf(hv * gg[k]); } } \
                    __syncthreads(); \
                } \
            } \
            SEAM(pb + 4); \
        } \
        if (IN(pb + 5)) { \
            ArgsP ap = get_args(); unsigned char* wsl = ap->ws; \
            const bf16_t* W = (even ? WSP(bf16_t, WS_WEOUT) : WSP(bf16_t, WS_WOOUT)) + (size_t)e * 1024 * 1024; \
            pg8::Gemm gm{WSP(bf16_t, WS_MIXIN), W, T, 1024, 1024, 1024, 1 << 30, 0}; pg8::StaticOrder S; S.init(T, 1024, G, wg); \
            EpiMix E{WSP(bf16_t, WS_MIX)}; \
            pg8::gemm_phase(lds, gm, S, E); \
        } \
        SEAM(pb + 5); \
    }
    LAYER_BODY(0)
    LAYER_BODY(1)
    LAYER_BODY(2)
    LAYER_BODY(3)
#undef LAYER_BODY
    if (IN(25)) { ArgsP ap = get_args(); unsigned char* wsl = ap->ws; norm_phase(nullptr, WSP(bf16_t, WS_H), WSP(float, WS_XS), WSP(bf16_t, WS_MIX), ap->post_norm + 3 * DM, nullptr, nullptr, ap->out); }
#undef IN
#undef SEAM
#undef WSP
}

extern "C" void kernel_launch(void* const* d_in, const int* in_sizes, int n_in, void* d_out, int out_size, void* d_ws, size_t ws_size, hipStream_t stream) {
    static int grid = 0;
    if (grid == 0) {
        if (n_in != 17 || out_size != T * DM || ws_size < WS_END) { fprintf(stderr, "kernel_launch: unexpected sizes (n_in %d, out %d, ws %zu, need %zu)\n", n_in, out_size, ws_size, (size_t)WS_END); grid = -1; return; }
        int dev = 0, cus = 0, per_cu = 0;
        if (hipGetDevice(&dev) != hipSuccess || hipDeviceGetAttribute(&cus, hipDeviceAttributeMultiprocessorCount, dev) != hipSuccess) { grid = -1; return; }
        if (hipFuncSetAttribute((const void*)fwd_kernel, hipFuncAttributeMaxDynamicSharedMemorySize, LDS_BYTES) != hipSuccess) { fprintf(stderr, "kernel_launch: hipFuncSetAttribute failed\n"); grid = -1; return; }
        if (hipOccupancyMaxActiveBlocksPerMultiprocessor(&per_cu, (const void*)fwd_kernel, NTHREADS, LDS_BYTES) != hipSuccess || per_cu < 1) { fprintf(stderr, "kernel_launch: occupancy query says %d\n", per_cu); }
        (void)hipGetLastError();
        grid = cus;
    }
    if (grid < 0) return;
    (void)hipMemsetAsync((char*)d_ws + WS_CTL, 0, CTL_BYTES, stream);
    Args a{};
    a.x = (const float*)d_in[0]; a.rel_bias = (const float*)d_in[1]; a.pre_norm = (const float*)d_in[2]; a.post_norm = (const float*)d_in[3];
    a.even_w_in = (const float*)d_in[4]; a.even_gate_w2 = (const float*)d_in[5]; a.even_gate_b2 = (const float*)d_in[6]; a.even_w_out = (const float*)d_in[7];
    a.odd_w_in = (const float*)d_in[8]; a.odd_conv_w = (const float*)d_in[9]; a.odd_conv_b = (const float*)d_in[10]; a.odd_w_a = (const float*)d_in[11]; a.odd_b_a = (const float*)d_in[12];
    a.odd_w_x = (const float*)d_in[13]; a.odd_b_x = (const float*)d_in[14]; a.odd_lambda = (const float*)d_in[15]; a.odd_w_out = (const float*)d_in[16];
    a.out = (float*)d_out; a.ws = (unsigned char*)d_ws;
    if (N_LAUNCHES == 1) {
        a.ph_lo = 0; a.ph_hi = NPH;
        hipLaunchKernelGGL(fwd_kernel, dim3(grid), dim3(NTHREADS), LDS_BYTES, stream, a);
    } else {
        for (int ph = 0; ph < NPH; ++ph) { a.ph_lo = ph; a.ph_hi = ph + 1; hipLaunchKernelGGL(fwd_kernel, dim3(grid), dim3(NTHREADS), LDS_BYTES, stream, a); }
    }
}
```

```cpp
#include <hip/hip_runtime.h>
#include <stdint.h>
#include <stdio.h>

#ifndef N_LAUNCHES
#define N_LAUNCHES 1
#endif

#define LAS __attribute__((address_space(3)))
typedef unsigned short bf16_t;
typedef short bf16x8 __attribute__((ext_vector_type(8)));
typedef float f32x4 __attribute__((ext_vector_type(4)));
typedef float f32x2 __attribute__((ext_vector_type(2)));
typedef float f32x16 __attribute__((ext_vector_type(16)));
typedef unsigned u32x4 __attribute__((ext_vector_type(4)));
typedef unsigned u32x2 __attribute__((ext_vector_type(2)));
typedef unsigned long long u64;

constexpr int NB = 4, SEQ = 4096, T = NB * SEQ, DM = 1024;
constexpr int EVEN_IN = 4184, NE = 4352;
constexpr int NTHREADS = 512;
constexpr float EPS = 1e-6f;
constexpr float NEG_INF = -__builtin_inff();

constexpr size_t MB = 1024 * 1024;
constexpr size_t WS_CTL   = 0;
constexpr size_t CTL_BYTES = 65536;
constexpr size_t WS_WEIN  = WS_CTL + CTL_BYTES;
constexpr size_t WS_WEOUT = WS_WEIN + (size_t)2 * NE * 1024 * 2;
constexpr size_t WS_WOIN  = WS_WEOUT + 4 * MB;
constexpr size_t WS_WOG   = WS_WOIN + 8 * MB;
constexpr size_t WS_WOOUT = WS_WOG + 2 * MB;
constexpr size_t WS_TAB   = WS_WOOUT + 4 * MB;
constexpr size_t WS_XS    = WS_TAB + 4096;
constexpr size_t WS_H     = WS_XS + 65536;
constexpr size_t WS_MIXIN = WS_H + 32 * MB;
constexpr size_t WS_ACT   = WS_MIXIN + 32 * MB;
constexpr size_t WS_Q     = WS_ACT;
constexpr size_t WS_K     = WS_Q + 16 * MB;
constexpr size_t WS_VT    = WS_K + 16 * MB;
constexpr size_t WS_AG    = WS_VT + 16 * MB;
constexpr size_t WS_MIX   = WS_ACT;
constexpr size_t WS_IQ    = WS_AG + 16 * MB;
constexpr size_t WS_BQ    = WS_IQ + 16 * MB;
constexpr size_t WS_BK    = WS_BQ + 8 * MB;
constexpr size_t WS_BV    = WS_BK + 8 * MB;
constexpr size_t WS_BG    = WS_BV + 16 * MB;
constexpr size_t WS_IK    = WS_BG + 16 * MB;
constexpr size_t WS_IW    = WS_IK + 2 * MB;
constexpr size_t WS_BLR   = WS_IW + MB / 2;
constexpr size_t WS_MASK  = WS_BLR + MB;
constexpr size_t WS_SPREV = WS_MASK + 8 * MB;
constexpr size_t WS_DECAY = WS_SPREV + 16 * MB;
constexpr size_t WS_EVEN_END = WS_DECAY + MB / 4;
constexpr size_t WS_XR    = WS_ACT;
constexpr size_t WS_U     = WS_XR;
constexpr size_t WS_GS    = WS_XR + 32 * MB;
constexpr size_t WS_XC    = WS_GS + 32 * MB;
constexpr size_t WS_LOGA  = WS_XC + 32 * MB;
constexpr size_t WS_ODD_END = WS_LOGA + 32 * MB;
constexpr size_t WS_END   = WS_EVEN_END > WS_ODD_END ? WS_EVEN_END : WS_ODD_END;
static_assert(WS_END <= (size_t)256 * MB, "workspace map exceeds 256 MiB");

__device__ __forceinline__ float bf2f(unsigned v) { return __uint_as_float(v << 16); }
typedef __bf16 bf16pair_t __attribute__((ext_vector_type(2)));
typedef float f32pair_t __attribute__((ext_vector_type(2)));
__device__ __forceinline__ unsigned cvt_pk_bf16(float lo, float hi) { const f32pair_t v = {lo, hi}; const bf16pair_t b = __builtin_convertvector(v, bf16pair_t); return __builtin_bit_cast(unsigned, b); }
__device__ __forceinline__ bf16_t f2bf(float f) { return (bf16_t)cvt_pk_bf16(f, f); }
__device__ __forceinline__ float silu_f(float x) { return x * __builtin_amdgcn_rcpf(1.0f + __builtin_amdgcn_exp2f(x * -1.4426950408889634f)); }
__device__ __forceinline__ float sigmoid_f(float x) { return __builtin_amdgcn_rcpf(1.0f + __builtin_amdgcn_exp2f(x * -1.4426950408889634f)); }
__device__ __forceinline__ size_t slab_idx(int row, int ch) { return ((size_t)((row >> 12) * 64 + (ch >> 4)) * SEQ + (row & 4095)) * 16 + (ch & 15); }
__device__ __forceinline__ float log1p_01(float y) { const float ser = y * (1.0f - y * (0.5f - y * (0.33333334f - y * 0.25f))); return y < 0.03125f ? ser : __logf(1.0f + y); }
__device__ __forceinline__ float bflo(unsigned w) { return __uint_as_float(w << 16); }
__device__ __forceinline__ float bfhi(unsigned w) { return __uint_as_float(w & 0xFFFF0000u); }

__device__ __forceinline__ float relu_bits(float x) { const int i = (int)__float_as_uint(x); return __uint_as_float((unsigned)(i < 0 ? 0 : i)); }
__device__ __forceinline__ int opaque_tid() { int t = threadIdx.x; asm volatile("" : "+v"(t)); return t; }

__device__ __forceinline__ int wave_sum_i32(int v) {
    v += __builtin_amdgcn_update_dpp(0, v, 0xB1, 0xF, 0xF, true);
    v += __builtin_amdgcn_update_dpp(0, v, 0x4E, 0xF, 0xF, true);
    v += __builtin_amdgcn_update_dpp(0, v, 0x141, 0xF, 0xF, true);
    v += __builtin_amdgcn_update_dpp(0, v, 0x140, 0xF, 0xF, true);
    return __builtin_amdgcn_readlane(v, 0) + __builtin_amdgcn_readlane(v, 16) + __builtin_amdgcn_readlane(v, 32) + __builtin_amdgcn_readlane(v, 48);
}

__device__ __forceinline__ float wave_max_f32(float v) {
    v = fmaxf(v, __uint_as_float((unsigned)__builtin_amdgcn_update_dpp(0, (int)__float_as_uint(v), 0xB1, 0xF, 0xF, true)));
    v = fmaxf(v, __uint_as_float((unsigned)__builtin_amdgcn_update_dpp(0, (int)__float_as_uint(v), 0x4E, 0xF, 0xF, true)));
    v = fmaxf(v, __uint_as_float((unsigned)__builtin_amdgcn_update_dpp(0, (int)__float_as_uint(v), 0x141, 0xF, 0xF, true)));
    v = fmaxf(v, __uint_as_float((unsigned)__builtin_amdgcn_update_dpp(0, (int)__float_as_uint(v), 0x140, 0xF, 0xF, true)));
    const float a = __uint_as_float((unsigned)__builtin_amdgcn_readlane((int)__float_as_uint(v), 0)), b = __uint_as_float((unsigned)__builtin_amdgcn_readlane((int)__float_as_uint(v), 16));
    const float c = __uint_as_float((unsigned)__builtin_amdgcn_readlane((int)__float_as_uint(v), 32)), d = __uint_as_float((unsigned)__builtin_amdgcn_readlane((int)__float_as_uint(v), 48));
    return fmaxf(fmaxf(a, b), fmaxf(c, d));
}
__device__ __forceinline__ int wave_prefix_sum_i32(int v) {
    v += __builtin_amdgcn_update_dpp(0, v, 0x111, 0xF, 0xF, true);
    v += __builtin_amdgcn_update_dpp(0, v, 0x112, 0xF, 0xF, true);
    v += __builtin_amdgcn_update_dpp(0, v, 0x114, 0xF, 0xF, true);
    v += __builtin_amdgcn_update_dpp(0, v, 0x118, 0xF, 0xF, true);
    v += __builtin_amdgcn_update_dpp(0, v, 0x142, 0xA, 0xF, false);
    v += __builtin_amdgcn_update_dpp(0, v, 0x143, 0xC, 0xF, false);
    return v;
}

#define XB_TMO      128
#define XB_XCNT(j)  (256  + 64 * (j))
#define XB_XSUB(j)  (1280 + 64 * (j))
#define XB_XGEN(j)  (2304 + 64 * (j))
#define XB_TOP      3328
#define XB_TOPGEN   3392
#define XCD_BAR_WORDS 3456
#define XB_SPIN_CAP (1u << 18)

__device__ __forceinline__ unsigned xb_ld(unsigned* p)              { return __hip_atomic_load(p, __ATOMIC_RELAXED, __HIP_MEMORY_SCOPE_AGENT); }
__device__ __forceinline__ unsigned xb_add(unsigned* p, unsigned v) { return __hip_atomic_fetch_add(p, v, __ATOMIC_RELAXED, __HIP_MEMORY_SCOPE_AGENT); }
__device__ __forceinline__ unsigned xb_xcc_id() { return (unsigned)__builtin_amdgcn_s_getreg((3 << 11) | 20) & 0xFu; }
#define XB_SPIN(cond, bar) do { unsigned _sp = 0; while (cond) { __builtin_amdgcn_s_sleep(1); \
    if ((++_sp & 255u) == 0u) { if (xb_ld(&(bar)[XB_TMO])) break; if (_sp > XB_SPIN_CAP) { atomicAdd(&(bar)[XB_TMO], 1u); break; } } } } while (0)

struct XcdBarrier { unsigned* bar; unsigned x; volatile LAS unsigned* st; };

__device__ __forceinline__ XcdBarrier xcd_barrier_post(unsigned* bar, volatile LAS unsigned* st) {
    XcdBarrier b; b.bar = bar; b.x = xb_xcc_id(); b.st = st;
    if (threadIdx.x == 0) (void)xb_add(&bar[XB_XCNT(b.x)], 1u);
    return b;
}
__device__ __forceinline__ void xcd_barrier_complete(unsigned* bar, unsigned x, unsigned& nloc, unsigned& nx) {
    const unsigned G = gridDim.x * gridDim.y * gridDim.z;
    unsigned sum, cnt, mine, sp = 0u;
    for (;;) {
        sum = 0u; cnt = 0u; mine = 0u;
#pragma unroll
        for (unsigned j = 0; j < 16; ++j) { const unsigned c = xb_ld(&bar[XB_XCNT(j)]); sum += c; cnt += (c > 0u) ? 1u : 0u; mine = (j == x) ? c : mine; }
        if (sum == G) break;
        __builtin_amdgcn_s_sleep(1);
        if ((++sp & 255u) == 0u) { if (xb_ld(&bar[XB_TMO])) break; if (sp > XB_SPIN_CAP) { atomicAdd(&bar[XB_TMO], 1u); break; } }
    }
    nloc = mine > 0u ? mine : 1u; nx = cnt > 0u ? cnt : 1u;
}
__device__ __forceinline__ void xcd_barrier(const XcdBarrier& b) {
    asm volatile("s_waitcnt vmcnt(0)" ::: "memory");
    __syncthreads();
    if (threadIdx.x == 0) {
        unsigned* bar = b.bar;
        __builtin_amdgcn_s_waitcnt(0);
        unsigned nloc = b.st[0], nx = b.st[1];
        if (nloc == 0u) { xcd_barrier_complete(bar, b.x, nloc, nx); b.st[0] = nloc; b.st[1] = nx; }
        const unsigned old = xb_add(&bar[XB_XSUB(b.x)], 1u);
        const unsigned gen = old / nloc;
        if (old + 1u == (gen + 1u) * nloc) {
            __builtin_amdgcn_fence(__ATOMIC_RELEASE, "agent");
            asm volatile("s_waitcnt vmcnt(0)" ::: "memory");
            const unsigned og = xb_add(&bar[XB_TOP], 1u);
            const unsigned tg = og / nx;
            if (og + 1u == (tg + 1u) * nx) xb_add(&bar[XB_TOPGEN], 1u);
            else XB_SPIN(xb_ld(&bar[XB_TOPGEN]) == tg, bar);
            __builtin_amdgcn_fence(__ATOMIC_ACQUIRE, "agent");
            xb_add(&bar[XB_XGEN(b.x)], 1u);
            asm volatile("s_waitcnt vmcnt(0)" ::: "memory");
        } else {
            XB_SPIN(xb_ld(&bar[XB_XGEN(b.x)]) == gen, bar);
            __builtin_amdgcn_fence(__ATOMIC_ACQUIRE, "agent");
            asm volatile("s_waitcnt vmcnt(0)" ::: "memory");
        }
    }
    __syncthreads();
}

namespace pg8 {
constexpr int BM = 256, BK = 64, HALF = 128, HTB = HALF * BK * 2, STAGE_BYTES = 8 * HTB, NXCD = 8, WGM = 8;
__host__ __device__ __forceinline__ int lds_byte(int r, int c) { const int st = (r >> 4) * 2 + (c >> 5), rr = r & 15, cc = c & 31, ob = rr * 64 + cc * 2; return st * 1024 + (ob ^ (((ob >> 9) & 1) << 5)); }
__host__ __device__ __forceinline__ void stage_rc(int b, int& R, int& C) { const int st = b / 1024, sb = b % 1024, swz = sb ^ (((sb >> 9) & 1) << 5); R = (st >> 1) * 16 + swz / 64; C = (st & 1) * 32 + (swz % 64) / 2; }
__host__ __device__ __forceinline__ int perm32(int rho) { const int n = rho >> 4, i = rho & 15; return 8 * (i >> 2) + 4 * n + (i & 3); }

struct Unit { int pm, pn; };
struct Gemm { const bf16_t* A; const bf16_t* Bt; int M, N, K, lda, a_div, a_step; };

struct StaticOrder {
    int nM, nN, nwg, G, c;
    __host__ __device__ void init(int M, int N, int G_, int c_) { nM = M / BM; nN = N / BM; nwg = nM * nN; G = G_; c = c_; }
    __host__ __device__ bool next(int i, Unit& u) const {
        const long L = (long)i * G + c; if (L >= nwg) return false;
        int wgid = (int)L; { const int q = nwg / NXCD, r = nwg % NXCD, xcd = wgid % NXCD, off = wgid / NXCD; wgid = (xcd < r ? xcd * (q + 1) : r * (q + 1) + (xcd - r) * q) + off; }
        const int nig = WGM * nN, gid = wgid / nig, fm = gid * WGM, gsz = (nM - fm) < WGM ? (nM - fm) : WGM;
        u.pm = fm + ((wgid % nig) % gsz); u.pn = (wgid % nig) / gsz; return true;
    }
};

template <class Epi>
__device__ __forceinline__ void gemm_phase(LAS unsigned char* lds, const Gemm g, const StaticOrder& S, const Epi& E) {
    const int tid = opaque_tid(), wid = __builtin_amdgcn_readfirstlane(tid >> 6), lane = tid & 63, wr = wid >> 2, wc = wid & 3, fr = lane & 15, fq = lane >> 4;
    const int K = g.K, nt = K / BK, lda = g.lda;
    unsigned voffA[2], voffB[2];
#pragma unroll
    for (int i = 0; i < 2; ++i) { int R, C; stage_rc(tid * 16 + i * 8192, R, C); const int Rb = Epi::PERM ? ((R & ~31) + perm32(R & 31)) : R;
        voffA[i] = (unsigned)(R * lda + C) * 2u; voffB[i] = (unsigned)(Rb * K + C) * 2u; }
    const size_t kstep = (size_t)(BK * 2);
    const size_t hstepA = (size_t)HALF * lda * 2, hstepB = (size_t)HALF * K * 2;
    const size_t tstepA = 2 * hstepA, tstepB = 2 * hstepB;
    const unsigned ldsw = (unsigned)wid * 1024u;
    const int aoff = lds_byte(wr * 64 + fr, fq * 8), boff = lds_byte(wc * 32 + fr, fq * 8);
#define PG8_SA(b, h) (((b) * 2 + (h)) * HTB)
#define PG8_SB(b, h) ((4 + (b) * 2 + (h)) * HTB)
#define PG8_STAGE(bufoff, gbase, voff) do { _Pragma("unroll") for (int _i = 0; _i < 2; ++_i) \
        __builtin_amdgcn_global_load_lds((const unsigned*)((const char*)(gbase) + (voff)[_i]), (LAS unsigned*)(lds + (bufoff) + ldsw + _i * 8192), 16, 0, 0); } while (0)
#define PG8_LDA(dst, b, h) do { _Pragma("unroll") for (int m = 0; m < 4; ++m) _Pragma("unroll") for (int k = 0; k < 2; ++k) dst[m][k] = *(const LAS bf16x8*)(lds + PG8_SA(b, h) + aoff + m * 2048 + k * 1024); } while (0)
#define PG8_LDB(dst, b, h) do { _Pragma("unroll") for (int n = 0; n < 2; ++n) _Pragma("unroll") for (int k = 0; k < 2; ++k) dst[n][k] = *(const LAS bf16x8*)(lds + PG8_SB(b, h) + boff + n * 2048 + k * 1024); } while (0)
#define PG8_MMA(ai, bj, At, Bt) do { __builtin_amdgcn_s_setprio(1); _Pragma("unroll") for (int m = 0; m < 4; ++m) _Pragma("unroll") for (int n = 0; n < 2; ++n) _Pragma("unroll") for (int k = 0; k < 2; ++k) \
        acc[ai][bj][m][n] = __builtin_amdgcn_mfma_f32_16x16x32_bf16(Bt[n][k], At[m][k], acc[ai][bj][m][n], 0, 0, 0); __builtin_amdgcn_s_setprio(0); } while (0)
#define PG8_WAIT_V(n) asm volatile("s_waitcnt vmcnt(" #n ")" ::: "memory")
#define PG8_WAIT_L(n) asm volatile("s_waitcnt lgkmcnt(" #n ")" ::: "memory")
#define PG8_BAR __builtin_amdgcn_s_barrier()
#define PG8_SCHED __builtin_amdgcn_sched_barrier(0)
    Unit cur, nxt; int ui = 0;
    if (!S.next(0, cur)) return;
    f32x4 acc[2][2][4][2];
#pragma unroll
    for (int a = 0; a < 2; ++a)
#pragma unroll
        for (int b = 0; b < 2; ++b)
#pragma unroll
            for (int m = 0; m < 4; ++m)
#pragma unroll
                for (int n = 0; n < 2; ++n) acc[a][b][m][n] = (f32x4){0.f, 0.f, 0.f, 0.f};
    bf16x8 At[4][2], B0[2][2], B1[2][2];
    const char* cA = (const char*)g.A + (size_t)cur.pm * tstepA + (size_t)(cur.pn / g.a_div) * g.a_step; const char* cB = (const char*)g.Bt + (size_t)cur.pn * tstepB;
    PG8_STAGE(PG8_SB(0, 0), cB, voffB); PG8_STAGE(PG8_SA(0, 0), cA, voffA); PG8_STAGE(PG8_SB(0, 1), cB + hstepB, voffB); PG8_STAGE(PG8_SA(0, 1), cA + hstepA, voffA);
    if (wr == 1) PG8_BAR;
    PG8_WAIT_V(4); PG8_BAR;
    PG8_STAGE(PG8_SB(1, 0), cB + kstep, voffB); PG8_STAGE(PG8_SA(1, 0), cA + kstep, voffA); PG8_STAGE(PG8_SB(1, 1), cB + hstepB + kstep, voffB);
    PG8_WAIT_V(6); PG8_BAR;
    for (;;) {
        const bool has_next = S.next(ui + 1, nxt);
        const char* nA = has_next ? (const char*)g.A + (size_t)nxt.pm * tstepA + (size_t)(nxt.pn / g.a_div) * g.a_step : cA; const char* nB = has_next ? (const char*)g.Bt + (size_t)nxt.pn * tstepB : cB;
        for (int t = 0; t < nt; t += 2) {
            const bool last = (t == nt - 2);
            const char* a1 = cA + (size_t)(t + 1) * kstep;
            const char* a2 = last ? nA : cA + (size_t)(t + 2) * kstep; const char* b2 = last ? nB : cB + (size_t)(t + 2) * kstep;
            const char* a3 = a2 + kstep; const char* b3 = b2 + kstep;
            PG8_LDB(B0, 0, 0); PG8_SCHED; PG8_LDA(At, 0, 0); PG8_STAGE(PG8_SA(1, 1), a1 + hstepA, voffA);
            PG8_WAIT_L(8); PG8_BAR; PG8_WAIT_L(0); PG8_MMA(0, 0, At, B0); PG8_BAR; PG8_SCHED;
            PG8_LDB(B1, 0, 1); PG8_STAGE(PG8_SB(0, 0), b2, voffB);
            PG8_BAR; PG8_WAIT_L(0); PG8_MMA(0, 1, At, B1); PG8_BAR;
            PG8_LDA(At, 0, 1); PG8_STAGE(PG8_SA(0, 0), a2, voffA);
            PG8_BAR; PG8_WAIT_L(0); PG8_MMA(1, 0, At, B0); PG8_BAR; PG8_SCHED;
            PG8_STAGE(PG8_SB(0, 1), b2 + hstepB, voffB);
            PG8_WAIT_V(6); PG8_BAR; PG8_MMA(1, 1, At, B1); PG8_BAR;
            PG8_LDB(B0, 1, 0); PG8_SCHED; PG8_LDA(At, 1, 0); PG8_STAGE(PG8_SA(0, 1), a2 + hstepA, voffA);
            PG8_WAIT_L(8); PG8_BAR; PG8_WAIT_L(0); PG8_MMA(0, 0, At, B0); PG8_BAR; PG8_SCHED;
            PG8_LDB(B1, 1, 1); PG8_STAGE(PG8_SB(1, 0), b3, voffB);
            PG8_BAR; PG8_WAIT_L(0); PG8_MMA(0, 1, At, B1); PG8_BAR;
            PG8_LDA(At, 1, 1); PG8_STAGE(PG8_SA(1, 0), a3, voffA);
            PG8_BAR; PG8_WAIT_L(0); PG8_MMA(1, 0, At, B0); PG8_BAR; PG8_SCHED;
            PG8_STAGE(PG8_SB(1, 1), b3 + hstepB, voffB);
            PG8_WAIT_V(6); PG8_BAR; PG8_MMA(1, 1, At, B1); PG8_BAR;
        }
        E(acc, cur, wr, wc, fr, fq);
        if (!has_next) break;
#pragma unroll
        for (int a = 0; a < 2; ++a)
#pragma unroll
            for (int b = 0; b < 2; ++b)
#pragma unroll
                for (int m = 0; m < 4; ++m)
#pragma unroll
                    for (int n = 0; n < 2; ++n) acc[a][b][m][n] = (f32x4){0.f, 0.f, 0.f, 0.f};
        cur = nxt; cA = nA; cB = nB; ++ui;
    }
    PG8_WAIT_V(0);
    if (wr == 0) PG8_BAR;
    PG8_BAR;
#undef PG8_SA
#undef PG8_SB
#undef PG8_STAGE
#undef PG8_LDA
#undef PG8_LDB
#undef PG8_MMA
#undef PG8_WAIT_V
#undef PG8_WAIT_L
#undef PG8_BAR
#undef PG8_SCHED
}
}

struct EpiMix {
    static constexpr bool PERM = true;
    bf16_t* C;
    __device__ __forceinline__ void operator()(const f32x4 (&acc)[2][2][4][2], const pg8::Unit& u, int wr, int wc, int fr, int fq) const {
#pragma unroll
        for (int ai = 0; ai < 2; ++ai)
#pragma unroll
            for (int m = 0; m < 4; ++m) { const int row = u.pm * 256 + ai * 128 + wr * 64 + m * 16 + fr;
#pragma unroll
                for (int bj = 0; bj < 2; ++bj) { const f32x4 v0 = acc[ai][bj][m][0], v1 = acc[ai][bj][m][1];
                    u32x4 w; w.x = cvt_pk_bf16(v0[0], v0[1]); w.y = cvt_pk_bf16(v0[2], v0[3]); w.z = cvt_pk_bf16(v1[0], v1[1]); w.w = cvt_pk_bf16(v1[2], v1[3]);
                    *(u32x4*)(C + (size_t)row * 1024 + u.pn * 256 + bj * 128 + wc * 32 + 8 * fq) = w; } }
    }
};

constexpr float LOG2E_F = 1.4426950408889634f;
constexpr float IW_SCALE = 0.35355339059327373f * 0.125f;

struct EpiEvenIn {
    static constexpr bool PERM = true;
    bf16_t *Q, *Kb, *VT, *AG, *IQ, *BQ, *BK, *BV, *BG, *IK; float *IW, *BLR;
    __device__ __forceinline__ void operator()(const f32x4 (&acc)[2][2][4][2], const pg8::Unit& u, int wr, int wc, int fr, int fq) const {
        const int pn = u.pn;
        bf16_t* dst = Q; int ld = 512, col0 = 0, mode = 0;
        if (pn < 2) { dst = Q; col0 = pn * 256; }
        else if (pn < 4) { dst = Kb; col0 = (pn - 2) * 256; }
        else if (pn < 6) { mode = 2; col0 = (pn - 4) * 256; }
        else if (pn < 8) { dst = AG; col0 = (pn - 6) * 256; mode = 1; }
        else if (pn < 10) { dst = IQ; col0 = (pn - 8) * 256; }
        else if (pn == 10) { dst = BQ; ld = 256; }
        else if (pn == 11) { dst = BK; ld = 256; }
        else if (pn < 14) { dst = BV; col0 = (pn - 12) * 256; }
        else if (pn < 16) { dst = BG; col0 = (pn - 14) * 256; mode = 1; }
        else mode = 3;
#pragma unroll
        for (int ai = 0; ai < 2; ++ai)
#pragma unroll
            for (int m = 0; m < 4; ++m) {
                const int row = u.pm * 256 + ai * 128 + wr * 64 + m * 16 + fr;
#pragma unroll
                for (int bj = 0; bj < 2; ++bj) {
                    const int cb = bj * 128 + wc * 32 + 8 * fq;
                    f32x4 v0 = acc[ai][bj][m][0], v1 = acc[ai][bj][m][1];
                    if (mode <= 1) {
                        if (mode == 1) {
#pragma unroll
                            for (int j = 0; j < 4; ++j) { v0[j] = silu_f(v0[j]); v1[j] = silu_f(v1[j]); }
                        }
                        u32x4 w; w.x = cvt_pk_bf16(v0[0], v0[1]); w.y = cvt_pk_bf16(v0[2], v0[3]); w.z = cvt_pk_bf16(v1[0], v1[1]); w.w = cvt_pk_bf16(v1[2], v1[3]);
                        *(u32x4*)(dst + (size_t)row * ld + col0 + cb) = w;
                    } else if (mode == 2) {
                        const int c = col0 + cb, head = c >> 6, d = c & 63, b = row >> 12, s = row & 4095;
                        bf16_t* p = VT + ((size_t)(b * 8 + head) * 64 + d) * 4096 + s;
#pragma unroll
                        for (int j = 0; j < 4; ++j) { p[(size_t)j * 4096] = f2bf(v0[j]); p[(size_t)(j + 4) * 4096] = f2bf(v1[j]); }
                    } else {
                        if (cb < 64) {
                            u32x4 w; w.x = cvt_pk_bf16(v0[0], v0[1]); w.y = cvt_pk_bf16(v0[2], v0[3]); w.z = cvt_pk_bf16(v1[0], v1[1]); w.w = cvt_pk_bf16(v1[2], v1[3]);
                            const int q = cb >> 3, bb = row >> 12, sq = row & 4095;
                            *(u32x4*)(IK + ((((size_t)(bb * 128 + (sq >> 5)) * 4 + (q >> 1)) * 2 + (q & 1)) * 32 + (sq & 31)) * 8) = w;
                        } else if (cb == 64) {
                            *(f32x4*)(IW + (size_t)row * 8) = v0 * IW_SCALE; *(f32x4*)(IW + (size_t)row * 8 + 4) = v1 * IW_SCALE;
                        } else if (cb == 72 || cb == 80) {
                            *(f32x4*)(BLR + (size_t)row * 16 + (cb - 72)) = v0; *(f32x4*)(BLR + (size_t)row * 16 + (cb - 72) + 4) = v1;
                        }
                    }
                }
            }
    }
};

struct EpiOddIn {
    static constexpr bool PERM = true;
    bf16_t *XR, *GS;
    __device__ __forceinline__ void operator()(const f32x4 (&acc)[2][2][4][2], const pg8::Unit& u, int wr, int wc, int fr, int fq) const {
        const int pn = u.pn; const bool gate = pn >= 4;
        bf16_t* dst = gate ? GS : XR; const int col0 = (pn & 3) * 256;
#pragma unroll
        for (int ai = 0; ai < 2; ++ai)
#pragma unroll
            for (int m = 0; m < 4; ++m) {
                const int row = u.pm * 256 + ai * 128 + wr * 64 + m * 16 + fr;
#pragma unroll
                for (int bj = 0; bj < 2; ++bj) {
                    const int cb = bj * 128 + wc * 32 + 8 * fq;
                    f32x4 v0 = acc[ai][bj][m][0], v1 = acc[ai][bj][m][1];
                    if (gate) {
#pragma unroll
                        for (int j = 0; j < 4; ++j) { v0[j] = silu_f(v0[j]); v1[j] = silu_f(v1[j]); }
                    }
                    u32x4 w; w.x = cvt_pk_bf16(v0[0], v0[1]); w.y = cvt_pk_bf16(v0[2], v0[3]); w.z = cvt_pk_bf16(v1[0], v1[1]); w.w = cvt_pk_bf16(v1[2], v1[3]);
                    if (gate) *(u32x4*)(GS + slab_idx(row, col0 + cb)) = w;
                    else *(u32x4*)(XR + (size_t)row * 1024 + col0 + cb) = w;
                }
            }
    }
};

struct EpiGates {
    static constexpr bool PERM = true;
    const float *b_a, *b_x, *lam; const bf16_t* XC; bf16_t* LOGA; bf16_t* U;
    __device__ __forceinline__ void operator()(const f32x4 (&acc)[2][2][4][2], const pg8::Unit& u, int wr, int wc, int fr, int fq) const {
        const int chb = (u.pn >> 1) * 256 + (u.pn & 1) * 128 + wc * 32 + 8 * fq;
#pragma unroll
        for (int nh = 0; nh < 2; ++nh) {
            const int ch0 = chb + 4 * nh;
            const f32x4 lm = *(const f32x4*)(lam + ch0);
            const f32x4 nba = *(const f32x4*)(b_a + ch0) * (-LOG2E_F), nbx = *(const f32x4*)(b_x + ch0) * (-LOG2E_F);
            f32x4 c8;
#pragma unroll
            for (int j = 0; j < 4; ++j) c8[j] = (-8.0f * LOG2E_F) * (fmaxf(-lm[j], 0.f) + log1p_01(__expf(-fabsf(lm[j]))));
#pragma unroll
            for (int ai = 0; ai < 2; ++ai)
#pragma unroll
                for (int m = 0; m < 4; ++m) {
                    const int row = u.pm * 256 + ai * 128 + wr * 64 + m * 16 + fr;
                    const u32x2 xw = *(const u32x2*)(XC + (size_t)row * 1024 + ch0);
                    const float xv[4] = {bflo(xw.x), bfhi(xw.x), bflo(xw.y), bfhi(xw.y)};
                    f32x4 la; float uu[4];
#pragma unroll
                    for (int j = 0; j < 4; ++j) {
                        const float r = __builtin_amdgcn_rcpf(1.0f + __builtin_amdgcn_exp2f(__builtin_fmaf(acc[ai][0][m][nh][j], -LOG2E_F, nba[j])));
                        const float ig = __builtin_amdgcn_rcpf(1.0f + __builtin_amdgcn_exp2f(__builtin_fmaf(acc[ai][1][m][nh][j], -LOG2E_F, nbx[j])));
                        const float l2 = c8[j] * r, av = __builtin_amdgcn_exp2f(l2);
                        la[j] = l2;
                        uu[j] = __builtin_amdgcn_sqrtf(fmaxf(__builtin_fmaf(-av, av, 1.0f), 0.f)) * ig * xv[j];
                    }
                    { u32x2 lw; lw.x = cvt_pk_bf16(la[0], la[1]); lw.y = cvt_pk_bf16(la[2], la[3]); *(u32x2*)(LOGA + slab_idx(row, ch0)) = lw; }
                    u32x2 w; w.x = cvt_pk_bf16(uu[0], uu[1]); w.y = cvt_pk_bf16(uu[2], uu[3]);
                    *(u32x2*)(U + slab_idx(row, ch0)) = w;
                }
        }
    }
};

struct Args {
    const float* x; const float* rel_bias; const float* pre_norm; const float* post_norm;
    const float* even_w_in; const float* even_gate_w2; const float* even_gate_b2; const float* even_w_out;
    const float* odd_w_in; const float* odd_conv_w; const float* odd_conv_b; const float* odd_w_a; const float* odd_b_a;
    const float* odd_w_x; const float* odd_b_x; const float* odd_lambda; const float* odd_w_out;
    float* out; unsigned char* ws; int ph_lo, ph_hi;
};

typedef const Args __attribute__((address_space(4)))* ArgsP;
__device__ __forceinline__ ArgsP get_args() { ArgsP p = (ArgsP)__builtin_amdgcn_kernarg_segment_ptr(); asm volatile("" : "+s"(p)); return p; }

constexpr int WT_EIN = 2 * 68 * 16, WT_EOUT = 2 * 256, WT_OIN = 2 * 512, WT_OOUT = 2 * 256, WT_GATE = 2 * 128, WT_ALL = WT_EIN + WT_EOUT + WT_OIN + WT_OOUT + WT_GATE;
__device__ __forceinline__ void wtile_decode(int T, ArgsP ap, unsigned char* ws, int nl, int wn, const float*& colp, int& ld, bf16_t*& drow, int& K, const float*& ksc) {
    ksc = nullptr;
    if (T < WT_EIN) { const int e = T / 1088, r = T % 1088, tn = r % 68, tk = r / 68; K = 1024; ld = EVEN_IN;
        const int n = tn * 64 + nl; int c; bool ok = true; if (n < 2560) c = n; else if (n < 4096) c = n + 72; else if (n < 4168) c = n - 1536; else if (n < 4184) c = n; else { c = 0; ok = false; }
        ksc = ap->pre_norm + (size_t)(2 * e) * DM + tk * 64;
        colp = ok ? ap->even_w_in + ((size_t)e * 1024 + tk * 64) * EVEN_IN + c : nullptr;
        drow = (bf16_t*)(ws + WS_WEIN) + ((size_t)e * NE + tn * 64 + wn) * 1024 + tk * 64; return; }
    T -= WT_EIN;
    if (T < WT_EOUT) { const int e = T / 256, r = T % 256, tn = r % 16, tk = r / 16; K = 1024; ld = 1024;
        colp = ap->even_w_out + ((size_t)e * 1024 + tk * 64) * 1024 + tn * 64 + nl; drow = (bf16_t*)(ws + WS_WEOUT) + ((size_t)e * 1024 + tn * 64 + wn) * 1024 + tk * 64; return; }
    T -= WT_EOUT;
    if (T < WT_OIN) { const int e = T / 512, r = T % 512, tn = r % 32, tk = r / 32; K = 1024; ld = 2048;
        ksc = ap->pre_norm + (size_t)(2 * e + 1) * DM + tk * 64;
        colp = ap->odd_w_in + ((size_t)e * 1024 + tk * 64) * 2048 + tn * 64 + nl; drow = (bf16_t*)(ws + WS_WOIN) + ((size_t)e * 2048 + tn * 64 + wn) * 1024 + tk * 64; return; }
    T -= WT_OIN;
    if (T < WT_OOUT) { const int e = T / 256, r = T % 256, tn = r % 16, tk = r / 16; K = 1024; ld = 1024;
        colp = ap->odd_w_out + ((size_t)e * 1024 + tk * 64) * 1024 + tn * 64 + nl; drow = (bf16_t*)(ws + WS_WOOUT) + ((size_t)e * 1024 + tn * 64 + wn) * 1024 + tk * 64; return; }
    T -= WT_OOUT;
    {
        const int o = T / 128, r = T % 128, tn = r % 32, tk = r / 32; K = 256; ld = 256;
        const int cp = tn * 64, nb = cp >> 9, j = (cp >> 8) & 1, gs = (cp >> 7) & 1, e0 = j * 128 + (cp & 127);
        const float* src = gs ? ap->odd_w_x : ap->odd_w_a;
        colp = src + (((size_t)(o * 4 + nb)) * 256 + tk * 64) * 256 + e0 + nl; drow = (bf16_t*)(ws + WS_WOG) + ((size_t)o * 2048 + cp + wn) * 256 + tk * 64; }
}
__device__ __forceinline__ void weight_phase(LAS float* tile, ArgsP ap, unsigned char* ws) {
    const int tid = opaque_tid(), G = gridDim.x, nl = tid & 63, k0 = tid >> 6, wn = tid >> 3, wk = (tid & 7) * 8;
    float r[8]; const float* colp; const float* ksc; bf16_t* drow; int ld, K;
#define WT_LOAD() do { _Pragma("unroll") for (int i = 0; i < 8; ++i) r[i] = colp ? colp[(size_t)(k0 + 8 * i) * ld] * (ksc ? ksc[k0 + 8 * i] : 1.0f) : 0.f; } while (0)
    int T = blockIdx.x;
    if (T < WT_ALL) { wtile_decode(T, ap, ws, nl, wn, colp, ld, drow, K, ksc); WT_LOAD(); }
    for (; T < WT_ALL; T += G) {
        bf16_t* dcur = drow;
#pragma unroll
        for (int i = 0; i < 8; ++i) tile[(k0 + 8 * i) * 65 + nl] = r[i];
        __syncthreads();
        if (T + G < WT_ALL) { wtile_decode(T + G, ap, ws, nl, wn, colp, ld, drow, K, ksc); WT_LOAD(); }
        float v[8];
#pragma unroll
        for (int j = 0; j < 8; ++j) v[j] = tile[(wk + j) * 65 + wn];
        u32x4 w; w.x = cvt_pk_bf16(v[0], v[1]); w.y = cvt_pk_bf16(v[2], v[3]); w.z = cvt_pk_bf16(v[4], v[5]); w.w = cvt_pk_bf16(v[6], v[7]);
        *(u32x4*)(dcur + wk) = w;
        __syncthreads();
    }
#undef WT_LOAD
}

__device__ __forceinline__ int t5_bucket(int n) {
    if (n < 16) return n;
    int v = 16 + (int)(__logf((float)n / 16.0f) / 2.0794415416798357f * 16.0f);
    return v < 31 ? v : 31;
}

__device__ __forceinline__ void norm_phase(const float* xin, const bf16_t* xh_in, const float* s_in, const bf16_t* mix, const float* postw, bf16_t* xh_out, float* s_out, float* outf) {
    const int tid0 = opaque_tid(), lane = tid0 & 63, wave = tid0 >> 6;
    for (int row = blockIdx.x * 8 + wave; row < T; row += gridDim.x * 8) {
        f32x4 xv[4];
        if (xin) {
#pragma unroll
            for (int i = 0; i < 4; ++i) xv[i] = *(const f32x4*)(xin + (size_t)row * DM + lane * 4 + 256 * i);
        } else {
            const float sc = s_in[row];
#pragma unroll
            for (int i = 0; i < 4; ++i) { const u32x2 xw = *(const u32x2*)(xh_in + (size_t)row * DM + lane * 4 + 256 * i); xv[i] = (f32x4){bflo(xw.x), bfhi(xw.x), bflo(xw.y), bfhi(xw.y)} * sc; }
        }
        if (mix) {
            f32x4 mv[4]; float ss = 0.f;
#pragma unroll
            for (int i = 0; i < 4; ++i) { const u32x2 mw = *(const u32x2*)(mix + (size_t)row * DM + lane * 4 + 256 * i); mv[i] = (f32x4){bflo(mw.x), bfhi(mw.x), bflo(mw.y), bfhi(mw.y)};
                ss += mv[i][0] * mv[i][0] + mv[i][1] * mv[i][1] + mv[i][2] * mv[i][2] + mv[i][3] * mv[i][3]; }
#pragma unroll
            for (int o = 32; o >= 1; o >>= 1) ss += __shfl_xor(ss, o);
            const float r = rsqrtf(ss * (1.0f / DM) + EPS);
#pragma unroll
            for (int i = 0; i < 4; ++i) { const f32x4 w = *(const f32x4*)(postw + lane * 4 + 256 * i); xv[i] += mv[i] * r * w; }
        }
        if (outf) {
#pragma unroll
            for (int i = 0; i < 4; ++i) *(f32x4*)(outf + (size_t)row * DM + lane * 4 + 256 * i) = xv[i];
        } else {
            float ss = 0.f;
#pragma unroll
            for (int i = 0; i < 4; ++i) ss += xv[i][0] * xv[i][0] + xv[i][1] * xv[i][1] + xv[i][2] * xv[i][2] + xv[i][3] * xv[i][3];
#pragma unroll
            for (int o = 32; o >= 1; o >>= 1) ss += __shfl_xor(ss, o);
            const float ms = ss * (1.0f / DM) + EPS, r = rsqrtf(ms);
            if (lane == 0) s_out[row] = ms * r;
#pragma unroll
            for (int i = 0; i < 4; ++i) { const f32x4 y = xv[i] * r;
                u32x2 o2; o2.x = cvt_pk_bf16(y[0], y[1]); o2.y = cvt_pk_bf16(y[2], y[3]); *(u32x2*)(xh_out + (size_t)row * DM + lane * 4 + 256 * i) = o2; }
        }
    }
}

constexpr int NM_LD = 1032;
__device__ __forceinline__ void norm_misc_phase(LAS unsigned char* lds, const float* xin, const bf16_t* xh_in, const float* s_in, const bf16_t* mix, const float* postw, bf16_t* xh_out, float* s_out,
                                                const bf16_t* Wm  , bf16_t* IK, float* IW, float* BLR) {
    const int tid0 = opaque_tid(), lane = tid0 & 63, wave = __builtin_amdgcn_readfirstlane(tid0 >> 6);
    LAS bf16_t* xs = (LAS bf16_t*)lds;
    for (int pq = blockIdx.x; pq < T / 64; pq += gridDim.x) {
        for (int i = 0; i < 8; ++i) {
            const int rl = wave * 8 + i, row = pq * 64 + rl;
            f32x4 xv[4];
            if (xin) {
#pragma unroll
                for (int k = 0; k < 4; ++k) xv[k] = *(const f32x4*)(xin + (size_t)row * DM + lane * 4 + 256 * k);
            } else {
                const float sc = s_in[row];
#pragma unroll
                for (int k = 0; k < 4; ++k) { const u32x2 xw = *(const u32x2*)(xh_in + (size_t)row * DM + lane * 4 + 256 * k); xv[k] = (f32x4){bflo(xw.x), bfhi(xw.x), bflo(xw.y), bfhi(xw.y)} * sc; }
            }
            if (mix) {
                f32x4 mv[4]; float ss = 0.f;
#pragma unroll
                for (int k = 0; k < 4; ++k) { const u32x2 mw = *(const u32x2*)(mix + (size_t)row * DM + lane * 4 + 256 * k); mv[k] = (f32x4){bflo(mw.x), bfhi(mw.x), bflo(mw.y), bfhi(mw.y)};
                    ss += mv[k][0] * mv[k][0] + mv[k][1] * mv[k][1] + mv[k][2] * mv[k][2] + mv[k][3] * mv[k][3]; }
#pragma unroll
                for (int o = 32; o >= 1; o >>= 1) ss += __shfl_xor(ss, o);
                const float r = rsqrtf(ss * (1.0f / DM) + EPS);
#pragma unroll
                for (int k = 0; k < 4; ++k) { const f32x4 w = *(const f32x4*)(postw + lane * 4 + 256 * k); xv[k] += mv[k] * r * w; }
            }
            float ss = 0.f;
#pragma unroll
            for (int k = 0; k < 4; ++k) ss += xv[k][0] * xv[k][0] + xv[k][1] * xv[k][1] + xv[k][2] * xv[k][2] + xv[k][3] * xv[k][3];
#pragma unroll
            for (int o = 32; o >= 1; o >>= 1) ss += __shfl_xor(ss, o);
            const float ms = ss * (1.0f / DM) + EPS, r = rsqrtf(ms);
            if (lane == 0) s_out[row] = ms * r;
#pragma unroll
            for (int k = 0; k < 4; ++k) { const f32x4 y = xv[k] * r;
                u32x2 o2; o2.x = cvt_pk_bf16(y[0], y[1]); o2.y = cvt_pk_bf16(y[2], y[3]);
                *(u32x2*)(xh_out + (size_t)row * DM + lane * 4 + 256 * k) = o2; *(LAS u32x2*)(xs + rl * NM_LD + lane * 4 + 256 * k) = o2; }
        }
        __syncthreads();
        if (wave < 6) {
            const int n = lane & 15, kq = lane >> 4;
            f32x4 acc[4];
#pragma unroll
            for (int mt = 0; mt < 4; ++mt) acc[mt] = (f32x4){0.f, 0.f, 0.f, 0.f};
            const bf16_t* wrow = Wm + (size_t)(16 * wave + n) * 1024 + 8 * kq;
            for (int ks = 0; ks < 32; ks += 4) {
                bf16x8 bf[4];
#pragma unroll
                for (int u = 0; u < 4; ++u) bf[u] = *(const bf16x8*)(wrow + (ks + u) * 32);
#pragma unroll
                for (int u = 0; u < 4; ++u)
#pragma unroll
                    for (int mt = 0; mt < 4; ++mt) { const bf16x8 af = *(const LAS bf16x8*)(xs + (16 * mt + n) * NM_LD + (ks + u) * 32 + 8 * kq);
                        acc[mt] = __builtin_amdgcn_mfma_f32_16x16x32_bf16(af, bf[u], acc[mt], 0, 0, 0); }
            }
#pragma unroll
            for (int mt = 0; mt < 4; ++mt)
#pragma unroll
                for (int j = 0; j < 4; ++j) { const int row = pq * 64 + 16 * mt + 4 * kq + j; const float v = acc[mt][j];
                    if (wave < 4) { const int cc = 16 * wave + n, q = cc >> 3, bb = row >> 12, sq = row & 4095;
                        IK[((((size_t)(bb * 128 + (sq >> 5)) * 4 + (q >> 1)) * 2 + (q & 1)) * 32 + (sq & 31)) * 8 + (cc & 7)] = f2bf(v); }
                    else if (wave == 4) { if (n < 8) IW[(size_t)row * 8 + n] = v * IW_SCALE; else BLR[(size_t)row * 16 + (n - 8)] = v; }
                    else { if (n < 8) BLR[(size_t)row * 16 + 8 + n] = v; } }
        }
        __syncthreads();
    }
}

#define IDX_AF(AF, b_, t0_) do { \
        const int qi_ = 2 * ((c >> 2) & 1) + (c >> 4), hh_ = (c & 3) + 4 * ((c >> 3) & 1);   \
        _Pragma("unroll") for (int mt = 0; mt < 2; ++mt) { const size_t tq_ = (size_t)(b_) * SEQ + (t0_) + 4 * mt + qi_; \
            _Pragma("unroll") for (int ks = 0; ks < 4; ++ks) AF[mt][ks] = *(const bf16x8*)(IQ + tq_ * 512 + hh_ * 64 + ks * 16 + 8 * g); } } while (0)
#define IDX_WV(WV, b_, t0_) do { \
        _Pragma("unroll") for (int mt = 0; mt < 2; ++mt) _Pragma("unroll") for (int qq = 0; qq < 2; ++qq) { const size_t tq_ = (size_t)(b_) * SEQ + (t0_) + 4 * mt + 2 * g + qq; \
            const f32x4 w0_ = *(const f32x4*)(IW + tq_ * 8), w1_ = *(const f32x4*)(IW + tq_ * 8 + 4); \
            WV[mt][qq][0] = w0_[0]; WV[mt][qq][1] = w0_[1]; WV[mt][qq][2] = w0_[2]; WV[mt][qq][3] = w0_[3]; WV[mt][qq][4] = w1_[0]; WV[mt][qq][5] = w1_[1]; WV[mt][qq][6] = w1_[2]; WV[mt][qq][7] = w1_[3]; } } while (0)

__device__ __forceinline__ void indexer_phase(LAS float* sc, const bf16_t* IQ, const bf16_t* IK, const float* IW, u64* MASK, int wave, int lane) {
    const int g = lane >> 5, c = lane & 31, G = gridDim.x;
    bf16x8 af[2][4];
#define IDX_ITEM(k_) ((k_) * G + (((k_) & 1) ? (G - 1 - (int)blockIdx.x) : (int)blockIdx.x))
    { const int it0 = IDX_ITEM(0); if (it0 < 2048) IDX_AF(af, it0 & 3, (511 - (it0 >> 2)) * 8); }
        for (int kk = 0; kk * G < 2048; ++kk) {
    const int it = IDX_ITEM(kk); if (it >= 2048) break;
    const int b = it & 3, t0 = (511 - (it >> 2)) * 8;
    float wv[2][2][8];
    IDX_WV(wv, b, t0);
    const int ntiles = (t0 + 8 + 31) >> 5;
    const bf16_t* ikb = IK + (size_t)b * 128 * 2048 + (size_t)(g * 32 + c) * 8;
#define IDX_LOAD(buf, kt_) do { if ((kt_) < ntiles) { _Pragma("unroll") for (int ks = 0; ks < 4; ++ks) buf[ks] = *(const bf16x8*)(ikb + (size_t)(kt_) * 2048 + ks * 512); } } while (0)
#define IDX_TILE(buf, kt_) do { if ((kt_) < ntiles) { const int key = (kt_) * 32 + c; f32x16 a0, a1; \
        _Pragma("unroll") for (int r = 0; r < 16; ++r) { a0[r] = 0.f; a1[r] = 0.f; } \
        _Pragma("unroll") for (int ks = 0; ks < 4; ++ks) { a0 = __builtin_amdgcn_mfma_f32_32x32x16_bf16(af[0][ks], buf[ks], a0, 0, 0, 0); a1 = __builtin_amdgcn_mfma_f32_32x32x16_bf16(af[1][ks], buf[ks], a1, 0, 0, 0); } \
        _Pragma("unroll") for (int qq = 0; qq < 2; ++qq) { float s0 = 0.f, s1 = 0.f; \
            _Pragma("unroll") for (int h = 0; h < 8; ++h) { s0 += wv[0][qq][h] * relu_bits(a0[8 * qq + h]); s1 += wv[1][qq][h] * relu_bits(a1[8 * qq + h]); } \
            sc[(0 + 2 * g + qq) * 4096 + key] = s0; sc[(4 + 2 * g + qq) * 4096 + key] = s1; } } } while (0)
    {
        bf16x8 b0[4], b1[4], b2[4];
        IDX_LOAD(b0, wave); IDX_LOAD(b1, wave + 8);
        for (int kt = wave; kt < ntiles; kt += 24) {
            IDX_LOAD(b2, kt + 16); IDX_TILE(b0, kt);
            IDX_LOAD(b0, kt + 24); IDX_TILE(b1, kt + 8);
            IDX_LOAD(b1, kt + 32); IDX_TILE(b2, kt + 16);
        }
    }
#undef IDX_LOAD
#undef IDX_TILE
    __syncthreads();
    bf16x8 afn[2][4];
    { const int itn = IDX_ITEM(kk + 1); if ((kk + 1) * G < 2048 && itn < 2048) IDX_AF(afn, itn & 3, (511 - (itn >> 2)) * 8); }
    {
        const int t = t0 + wave, nvalid = t + 1, nreg = (nvalid + 63) >> 6, ngrp = (nreg + 7) >> 3;
        const int gfull = nvalid >> 9;
        LAS float* myrow = sc + wave * 4096;
        float sf[64];
#pragma unroll
        for (int jj = 0; jj < 8; ++jj) {
            if (jj < gfull) {
#pragma unroll
                for (int j8 = 0; j8 < 8; ++j8) sf[jj * 8 + j8] = myrow[64 * (jj * 8 + j8) + lane];
            } else if (jj < ngrp) {
#pragma unroll
                for (int j8 = 0; j8 < 8; ++j8) { const int j = jj * 8 + j8, kk = 64 * j + lane; const float v = myrow[kk]; sf[j] = (kk < nvalid) ? v : NEG_INF; }
            } else {
#pragma unroll
                for (int j8 = 0; j8 < 8; ++j8) sf[jj * 8 + j8] = NEG_INF;
            }
        }
        float thr_f = NEG_INF; int need = 0; bool ties = false;
#define CNT_GEF(valf, out) do { int c_ = 0; _Pragma("unroll") for (int jj = 0; jj < 8; ++jj) if (jj < ngrp) { _Pragma("unroll") for (int j8 = 0; j8 < 8; ++j8) c_ += (sf[jj * 8 + j8] >= (valf)) ? 1 : 0; } \
            (out) = wave_sum_i32(c_); } while (0)
        if (nvalid > 256) {
            float mx = NEG_INF, mn = -NEG_INF;
#pragma unroll
            for (int jj = 0; jj < 8; ++jj) { if (jj < gfull) {
#pragma unroll
                for (int j8 = 0; j8 < 8; j8 += 2) {
                    asm("v_max3_f32 %0, %0, %1, %2" : "+v"(mx) : "v"(sf[jj * 8 + j8]), "v"(sf[jj * 8 + j8 + 1])); asm("v_min3_f32 %0, %0, %1, %2" : "+v"(mn) : "v"(sf[jj * 8 + j8]), "v"(sf[jj * 8 + j8 + 1])); } }
              else if (jj < ngrp) {
#pragma unroll
                for (int j8 = 0; j8 < 8; ++j8) { const float v = sf[jj * 8 + j8]; mx = fmaxf(mx, v); mn = fminf(mn, v == NEG_INF ? -NEG_INF : v); } } }
            mx = wave_max_f32(mx); mn = -wave_max_f32(-mn);
            const float scale = (mx > mn) ? 3839.0f / (mx - mn) : 0.f;
            LAS unsigned* hist = (LAS unsigned*)myrow;
#pragma unroll
            for (int k = 0; k < 16; ++k) *(LAS u32x4*)(hist + 4 * lane + 256 * k) = (u32x4){0u, 0u, 0u, 0u};
            __builtin_amdgcn_fence(__ATOMIC_RELEASE, "wavefront");
#pragma unroll
            for (int jj = 0; jj < 8; ++jj) { if (jj < gfull) {
#pragma unroll
                for (int j8 = 0; j8 < 8; ++j8) { const float v = sf[jj * 8 + j8];
                    int bn = (int)((v - mn) * scale); bn = bn > 3839 ? 3839 : bn; __hip_atomic_fetch_add(hist + (bn >> 6) * 68 + (bn & 63), 1u, __ATOMIC_RELAXED, __HIP_MEMORY_SCOPE_WAVEFRONT); } }
              else if (jj < ngrp) {
#pragma unroll
                for (int j8 = 0; j8 < 8; ++j8) { const float v = sf[jj * 8 + j8];
                    if (v != NEG_INF) { int bn = (int)((v - mn) * scale); bn = bn > 3839 ? 3839 : bn; __hip_atomic_fetch_add(hist + (bn >> 6) * 68 + (bn & 63), 1u, __ATOMIC_RELAXED, __HIP_MEMORY_SCOPE_WAVEFRONT); } } } }
            __builtin_amdgcn_fence(__ATOMIC_ACQ_REL, "wavefront");
            int cs = 0;
            if (lane < 60) {
#pragma unroll
                for (int k = 0; k < 16; ++k) { const u32x4 h4 = *(const LAS u32x4*)(hist + lane * 68 + 4 * k); cs += (int)((h4.x + h4.y) + (h4.z + h4.w)); }
            }
            int C, Bl, cnt_above, nA;
            {
                const int pre = wave_prefix_sum_i32(cs), tot = __builtin_amdgcn_readlane(pre, 63), suf = tot - pre + cs;
                const u64 mk = __ballot(suf >= 256);
                C = 63 - __builtin_clzll(mk);
                const int above_c = __builtin_amdgcn_readlane(suf, C) - __builtin_amdgcn_readlane(cs, C);
                const int bs = (int)hist[C * 68 + lane];
                const int pre2 = wave_prefix_sum_i32(bs), tot2 = __builtin_amdgcn_readlane(pre2, 63), suf2 = tot2 - pre2 + bs;
                const u64 mk2 = __ballot(suf2 >= 256 - above_c);
                Bl = 63 - __builtin_clzll(mk2);
                nA = __builtin_amdgcn_readlane(bs, Bl);
                cnt_above = above_c + __builtin_amdgcn_readlane(suf2, Bl) - nA;
            }
            const int binA = C * 64 + Bl, need1 = 256 - cnt_above;
            if (nA <= 64) {
                unsigned cv = 0u; int pos = 0;
                const float invs = (mx - mn) * (1.0f / 3839.0f), lo_f = mn + ((float)binA - 0.5f) * invs, hi_f = mn + ((float)binA + 1.5f) * invs;
#pragma unroll
                for (int jj = 0; jj < 8; ++jj) if (jj < ngrp) {
#pragma unroll
                    for (int j8 = 0; j8 < 8; ++j8) { const float v = sf[jj * 8 + j8];
                        u64 m = __ballot(v >= lo_f && v < hi_f);
                        if (m) { int bn = (int)((v - mn) * scale); bn = bn > 3839 ? 3839 : bn; m = __ballot(v >= lo_f && v < hi_f && bn == binA); }
                        while (m) { const int l = __builtin_ctzll(m); m &= m - 1ull; const unsigned uu = (unsigned)__builtin_amdgcn_readlane((int)__float_as_uint(v), l);
                            const unsigned kv = (uu & 0x80000000u) ? ~uu : (uu | 0x80000000u); if (lane == pos) cv = kv; ++pos; } } }
                unsigned tc = 0u;
                for (int bit = 31; bit >= 0; --bit) { const unsigned cand = tc | (1u << bit); if (__popcll(__ballot(cv >= cand)) >= need1) tc = cand; }
                thr_f = __uint_as_float((tc & 0x80000000u) ? (tc ^ 0x80000000u) : ~tc);
                const int cgt = cnt_above + __popcll(__ballot(cv > tc)), ceq = __popcll(__ballot(cv == tc));
                need = 256 - cgt; ties = (ceq != need);
            } else {
                unsigned tc = 0u;
                for (int bit = 31; bit >= 0; --bit) { const unsigned cand = tc | (1u << bit); const float cf = __uint_as_float((cand & 0x80000000u) ? (cand ^ 0x80000000u) : ~cand);
                    int cnt; CNT_GEF(cf, cnt); if (cnt >= 256) tc = cand; }
                thr_f = __uint_as_float((tc & 0x80000000u) ? (tc ^ 0x80000000u) : ~tc);
                int cge, cg = 0;
                CNT_GEF(thr_f, cge);
#pragma unroll
                for (int jj = 0; jj < 8; ++jj) if (jj < ngrp) {
#pragma unroll
                    for (int j8 = 0; j8 < 8; ++j8) cg += (sf[jj * 8 + j8] > thr_f) ? 1 : 0; }
                const int cgt = wave_sum_i32(cg);
                need = 256 - cgt; ties = ((cge - cgt) != need);
            }
        }
#undef CNT_GEF
        u64 myword = 0ull;
        if (nvalid <= 256) {
#pragma unroll
            for (int j = 0; j < 4; ++j) { const u64 mm = __ballot(64 * j + lane < nvalid); if (lane == j) myword = mm; }
        } else if (!ties) {
#pragma unroll
            for (int jj = 0; jj < 8; ++jj) if (jj < ngrp) {
#pragma unroll
                for (int j8 = 0; j8 < 8; ++j8) { const int j = jj * 8 + j8; const u64 mm = __ballot(sf[j] >= thr_f); if (lane == j) myword = mm; if ((j & 3) == 3) __builtin_amdgcn_sched_barrier(0); } }
        } else {
            int base = 0;
#pragma unroll
            for (int j = 0; j < 64; ++j) { const bool eq = sf[j] == thr_f; const u64 em = __ballot(eq);
                const int rank = base + (int)__builtin_amdgcn_mbcnt_hi((unsigned)(em >> 32), __builtin_amdgcn_mbcnt_lo((unsigned)em, 0u));
                const u64 mm = __ballot(sf[j] > thr_f || (eq && rank < need)); base += __popcll(em);
                if (lane == j) myword = mm; __builtin_amdgcn_sched_barrier(0); }
        }
        LAS u64* mst = (LAS u64*)(sc + 32768);
        mst[lane * 8 + wave] = myword;
    }
    __syncthreads();
    { const int tid_ = wave * 64 + lane, kt_ = tid_ >> 3, q_ = tid_ & 7; const LAS u64* mst = (const LAS u64*)(sc + 32768);
      MASK[((size_t)b * 64 + kt_) * SEQ + t0 + q_] = mst[kt_ * 8 + q_]; }
#pragma unroll
    for (int mt = 0; mt < 2; ++mt) {
#pragma unroll
        for (int ks = 0; ks < 4; ++ks) af[mt][ks] = afn[mt][ks];
    }
    }
}
#undef IDX_AF
#undef IDX_WV
#undef IDX_ITEM

constexpr int GL_BLR = 0;
constexpr int GL_W2  = GL_BLR + 4096;
constexpr int GL_GP  = GL_W2 + 4096;
constexpr int GL_QD  = GL_GP + 2048;
constexpr int GL_KD  = GL_QD + 64 * 72 * 2;
constexpr int GL_KT  = GL_KD + 64 * 72 * 2;
constexpr int GL_VT  = GL_KT + 64 * 72 * 2;
constexpr int GL_P   = GL_VT + 128 * 72 * 2;
constexpr int GL_O   = GL_P + 64 * 72 * 2;
constexpr int GL_END = GL_O + 64 * 132 * 4;

__device__ __forceinline__ void gla_stage_vt(LAS bf16_t* vt, const u32x4 (&vraw)[2], int tid) {
#pragma unroll
    for (int rep = 0; rep < 2; ++rep) { const int idx = tid + 512 * rep, j = idx >> 4, dv8 = (idx & 15) * 8;
        const u32x4 w = vraw[rep];
        vt[(dv8 + 0) * 72 + j] = (bf16_t)(w.x & 0xFFFF); vt[(dv8 + 1) * 72 + j] = (bf16_t)(w.x >> 16);
        vt[(dv8 + 2) * 72 + j] = (bf16_t)(w.y & 0xFFFF); vt[(dv8 + 3) * 72 + j] = (bf16_t)(w.y >> 16);
        vt[(dv8 + 4) * 72 + j] = (bf16_t)(w.z & 0xFFFF); vt[(dv8 + 5) * 72 + j] = (bf16_t)(w.z >> 16);
        vt[(dv8 + 6) * 72 + j] = (bf16_t)(w.w & 0xFFFF); vt[(dv8 + 7) * 72 + j] = (bf16_t)(w.w >> 16); }
}
__device__ __forceinline__ void gla_prep_state(LAS unsigned char* lds, const float* gw2, const float* gb2, int b, int hh, int n,
                                               bf16_t* BQ, bf16_t* BK, const bf16_t* BV, const float* BLR, float* DECAY) {
    const int tid = opaque_tid(), d = tid & 63, jg = tid >> 6;
    const size_t tok0 = (size_t)b * SEQ + n * 64;
    LAS float* blr = (LAS float*)(lds + GL_BLR); LAS float* w2s = (LAS float*)(lds + GL_W2); LAS float* gp = (LAS float*)(lds + GL_GP);
    LAS bf16_t* kt = (LAS bf16_t*)(lds + GL_KT); LAS bf16_t* vt = (LAS bf16_t*)(lds + GL_VT);
    bf16_t kraw[8], qraw[8]; u32x4 vraw[2];
#pragma unroll
    for (int i = 0; i < 8; ++i) { kraw[i] = BK[(tok0 + 8 * jg + i) * 256 + hh * 64 + d]; qraw[i] = BQ[(tok0 + 8 * jg + i) * 256 + hh * 64 + d]; }
#pragma unroll
    for (int rep = 0; rep < 2; ++rep) { const int idx = tid + 512 * rep; vraw[rep] = *(const u32x4*)(BV + (tok0 + (idx >> 4)) * 512 + hh * 128 + (idx & 15) * 8); }
    if (tid < 256) { *(LAS f32x4*)(blr + tid * 4) = *(const f32x4*)(BLR + tok0 * 16 + tid * 4); }
    else { const int q = tid - 256, r = q >> 4, d4 = (q & 15) * 4; *(LAS f32x4*)(w2s + r * 64 + d4) = *(const f32x4*)(gw2 + (size_t)r * 256 + hh * 64 + d4); }
    __syncthreads();
    float cs[8];
    { const float b2 = gb2[hh * 64 + d]; float run = 0.f; float w2c[16];
#pragma unroll
      for (int r = 0; r < 16; ++r) w2c[r] = w2s[r * 64 + d];
#pragma unroll
      for (int i = 0; i < 8; ++i) { float z = b2;
#pragma unroll
          for (int q = 0; q < 4; ++q) { const f32x4 bl = *(const LAS f32x4*)(blr + (8 * jg + i) * 16 + 4 * q);
              z += bl[0] * w2c[4 * q + 0]; z += bl[1] * w2c[4 * q + 1]; z += bl[2] * w2c[4 * q + 2]; z += bl[3] * w2c[4 * q + 3]; }
          const float la = -(fmaxf(-z, 0.f) + __logf(1.0f + __expf(-fabsf(z)))) * (1.0f / 16.0f);
          run += la; cs[i] = run; }
      gp[jg * 64 + d] = run; }
    __syncthreads();
    float off = 0.f, glast = 0.f;
#pragma unroll
    for (int j = 0; j < 8; ++j) { const float v = gp[j * 64 + d]; if (j < jg) off += v; glast += v; }
    const float eglast = __expf(glast);
    if (jg == 0) DECAY[((size_t)(b * 4 + hh) * 64 + n) * 64 + d] = eglast;
    unsigned ktw[4];
#pragma unroll
    for (int i = 0; i < 8; i += 2) {
        float ktv[2];
#pragma unroll
        for (int ii = 0; ii < 2; ++ii) { const int j = 8 * jg + i + ii; const float G = off + cs[i + ii];
            const float kv = bf2f(kraw[i + ii]), qv = bf2f(qraw[i + ii]);
            const float eg = __expf(G), eng = __builtin_amdgcn_rcpf(eg), kdv = kv * eng;
            ktv[ii] = kdv * eglast;
            BQ[(tok0 + j) * 256 + hh * 64 + d] = (bf16_t)(cvt_pk_bf16(qv * 0.125f * eg, 0.f) & 0xFFFFu);
            BK[(tok0 + j) * 256 + hh * 64 + d] = (bf16_t)(cvt_pk_bf16(kdv, 0.f) & 0xFFFFu); }
        ktw[i >> 1] = cvt_pk_bf16(ktv[0], ktv[1]);
    }
    *(LAS u32x4*)(kt + d * 72 + 8 * jg) = (u32x4){ktw[0], ktw[1], ktw[2], ktw[3]};
    gla_stage_vt(vt, vraw, tid);
    __syncthreads();
}
__device__ __forceinline__ void gla_prep_out(LAS unsigned char* lds, int b, int hh, int n, const bf16_t* BQ, const bf16_t* BK, const bf16_t* BV) {
    const int tid = opaque_tid(), row = tid >> 3, ch = (tid & 7) * 8;
    const size_t tok0 = (size_t)b * SEQ + n * 64;
    LAS bf16_t* qd = (LAS bf16_t*)(lds + GL_QD); LAS bf16_t* kd = (LAS bf16_t*)(lds + GL_KD); LAS bf16_t* vt = (LAS bf16_t*)(lds + GL_VT);
    u32x4 vraw[2];
    const u32x4 qw = *(const u32x4*)(BQ + (tok0 + row) * 256 + hh * 64 + ch), kw = *(const u32x4*)(BK + (tok0 + row) * 256 + hh * 64 + ch);
#pragma unroll
    for (int rep = 0; rep < 2; ++rep) { const int idx = tid + 512 * rep; vraw[rep] = *(const u32x4*)(BV + (tok0 + (idx >> 4)) * 512 + hh * 128 + (idx & 15) * 8); }
    *(LAS u32x4*)(qd + row * 72 + ch) = qw; *(LAS u32x4*)(kd + row * 72 + ch) = kw;
    gla_stage_vt(vt, vraw, tid);
    __syncthreads();
}

__device__ __forceinline__ void gla_state_item(LAS unsigned char* lds, const float* gw2, const float* gb2, int item, bf16_t* BQ, bf16_t* BK, const bf16_t* BV, const float* BLR, float* DECAY, float* GSTATE) {
    const int b = item >> 8, hh = (item >> 6) & 3, n = item & 63;
    gla_prep_state(lds, gw2, gb2, b, hh, n, BQ, BK, BV, BLR, DECAY);
    const int tid1 = opaque_tid(), lane = tid1 & 63, wave = tid1 >> 6, g = lane >> 5, c = lane & 31, mt = wave >> 1, nt = wave & 1;
    LAS bf16_t* kt = (LAS bf16_t*)(lds + GL_KT); LAS bf16_t* vt = (LAS bf16_t*)(lds + GL_VT);
    f32x16 acc;
#pragma unroll
    for (int r = 0; r < 16; ++r) acc[r] = 0.f;
#pragma unroll
    for (int ks = 0; ks < 4; ++ks) { const bf16x8 af = *(const LAS bf16x8*)(vt + (32 * mt + c) * 72 + ks * 16 + 8 * g); const bf16x8 bf = *(const LAS bf16x8*)(kt + (32 * nt + c) * 72 + ks * 16 + 8 * g);
        acc = __builtin_amdgcn_mfma_f32_32x32x16_bf16(af, bf, acc, 0, 0, 0); }
    float* dst = GSTATE + ((size_t)(b * 4 + hh) * 64 + n) * 8192;
#pragma unroll
    for (int r = 0; r < 16; ++r) { const int dv = 32 * mt + (r & 3) + 8 * (r >> 2) + 4 * g; dst[dv * 64 + 32 * nt + c] = acc[r]; }
    __syncthreads();
}

__device__ __forceinline__ void gla_out_item(LAS unsigned char* lds, const float* gw2, const float* gb2, int item, const bf16_t* BQ, const bf16_t* BK, const bf16_t* BV, const float* BLR, const bf16_t* BG,
                                              const bf16_t* SPREV, bf16_t* MIXIN) {
    const int b = item >> 8, hh = (item >> 6) & 3, n = item & 63;
    const int tid = opaque_tid(), lane = tid & 63, wave = tid >> 6, g = lane >> 5, c = lane & 31;
    bf16x8 spf[4]; u32x4 g0, g1;
    { const bf16_t* sp = SPREV + ((size_t)(b * 4 + hh) * 64 + n) * 8192 + (size_t)(32 * (wave & 3) + c) * 64 + 8 * g;
#pragma unroll
      for (int ks = 0; ks < 4; ++ks) spf[ks] = *(const bf16x8*)(sp + ks * 16);
      const size_t tokg = (size_t)b * SEQ + n * 64 + (tid >> 3);
      g0 = *(const u32x4*)(BG + tokg * 512 + hh * 128 + (tid & 7) * 16); g1 = *(const u32x4*)(BG + tokg * 512 + hh * 128 + (tid & 7) * 16 + 8); }
    gla_prep_out(lds, b, hh, n, BQ, BK, BV);
    LAS bf16_t* qd = (LAS bf16_t*)(lds + GL_QD); LAS bf16_t* kd = (LAS bf16_t*)(lds + GL_KD); LAS bf16_t* vt = (LAS bf16_t*)(lds + GL_VT); LAS bf16_t* P = (LAS bf16_t*)(lds + GL_P);
    LAS float* o = (LAS float*)(lds + GL_O);
    if (wave < 4) {
        const int mt = wave >> 1, nt = wave & 1;
        f32x16 acc;
#pragma unroll
        for (int r = 0; r < 16; ++r) acc[r] = 0.f;
        if (!(mt == 0 && nt == 1)) {
#pragma unroll
            for (int ks = 0; ks < 4; ++ks) { const bf16x8 af = *(const LAS bf16x8*)(qd + (32 * mt + c) * 72 + ks * 16 + 8 * g); const bf16x8 bf = *(const LAS bf16x8*)(kd + (32 * nt + c) * 72 + ks * 16 + 8 * g);
                acc = __builtin_amdgcn_mfma_f32_32x32x16_bf16(af, bf, acc, 0, 0, 0); }
        }
#pragma unroll
        for (int r = 0; r < 16; ++r) { const int i = 32 * mt + (r & 3) + 8 * (r >> 2) + 4 * g, j = 32 * nt + c; P[i * 72 + j] = f2bf(j <= i ? acc[r] : 0.f); }
    }
    __syncthreads();
    {
        const int mt = wave >> 2, nt = wave & 3;
        f32x16 acc;
#pragma unroll
        for (int r = 0; r < 16; ++r) acc[r] = 0.f;
#pragma unroll
        for (int ks = 0; ks < 4; ++ks) { const bf16x8 af = *(const LAS bf16x8*)(P + (32 * mt + c) * 72 + ks * 16 + 8 * g); const bf16x8 bf = *(const LAS bf16x8*)(vt + (32 * nt + c) * 72 + ks * 16 + 8 * g);
            acc = __builtin_amdgcn_mfma_f32_32x32x16_bf16(af, bf, acc, 0, 0, 0); }
#pragma unroll
        for (int ks = 0; ks < 4; ++ks) { const bf16x8 af = *(const LAS bf16x8*)(qd + (32 * mt + c) * 72 + ks * 16 + 8 * g); acc = __builtin_amdgcn_mfma_f32_32x32x16_bf16(af, spf[ks], acc, 0, 0, 0); }
#pragma unroll
        for (int r = 0; r < 16; ++r) { const int i = 32 * mt + (r & 3) + 8 * (r >> 2) + 4 * g; o[i * 132 + 32 * nt + c] = acc[r]; }
    }
    __syncthreads();
    {
        const int row = tid >> 3, part = tid & 7; float v[16]; float ss = 0.f;
#pragma unroll
        for (int k = 0; k < 16; ++k) { v[k] = o[row * 132 + part * 16 + k]; ss += v[k] * v[k]; }
        ss += __shfl_xor(ss, 1); ss += __shfl_xor(ss, 2); ss += __shfl_xor(ss, 4);
        const float r = rsqrtf(ss * (1.0f / 128.0f) + EPS);
        const size_t tok = (size_t)b * SEQ + n * 64 + row;
        const float gv[16] = {bflo(g0.x), bfhi(g0.x), bflo(g0.y), bfhi(g0.y), bflo(g0.z), bfhi(g0.z), bflo(g0.w), bfhi(g0.w),
                              bflo(g1.x), bfhi(g1.x), bflo(g1.y), bfhi(g1.y), bflo(g1.z), bfhi(g1.z), bflo(g1.w), bfhi(g1.w)};
        unsigned w[8];
#pragma unroll
        for (int k = 0; k < 8; ++k) w[k] = cvt_pk_bf16(v[2 * k] * r * gv[2 * k], v[2 * k + 1] * r * gv[2 * k + 1]);
        bf16_t* dp = MIXIN + tok * 1024 + 512 + hh * 128 + part * 16;
        *(u32x4*)dp = (u32x4){w[0], w[1], w[2], w[3]}; *(u32x4*)(dp + 8) = (u32x4){w[4], w[5], w[6], w[7]};
    }
    __syncthreads();
}

constexpr int AT_K0 = 0, AT_V0 = 9216, AT_STAGE = 18432, AT_BT = 2 * AT_STAGE;
constexpr float LOG2E = 1.4426950408889634f, AT_C1 = 0.125f * LOG2E, AT_THR = 8.0f;

template <bool NEAR>
__device__ __forceinline__ void attn_tile(const LAS bf16_t* Kt, const LAS bf16_t* Vt, const LAS float* btl, const bf16x8 (&qf)[4], f32x16& negm, f32x16& O0, f32x16& O1, float& m_ref, float& thr, f32pair_t& lsum,
                                          u64 mw, int tq, int key0, int g, int c) {
    const int pc = (c & 0x13) | ((c & 4) << 1) | ((c & 8) >> 1);
    f32x16 s0, s1;
#pragma unroll
    for (int ks = 0; ks < 4; ++ks) {
        const bf16x8 k0 = *(const LAS bf16x8*)(Kt + pc * 72 + ks * 16 + 8 * g), k1 = *(const LAS bf16x8*)(Kt + (32 + pc) * 72 + ks * 16 + 8 * g);
        if (ks == 0) {
            asm("v_mfma_f32_32x32x16_bf16 %0, %1, %2, %3" : "=&v"(s0) : "v"(k0), "v"(qf[0]), "v"(negm)); asm("v_mfma_f32_32x32x16_bf16 %0, %1, %2, %3" : "=&v"(s1) : "v"(k1), "v"(qf[0]), "v"(negm)); }
        else { s0 = __builtin_amdgcn_mfma_f32_32x32x16_bf16(k0, qf[ks], s0, 0, 0, 0); s1 = __builtin_amdgcn_mfma_f32_32x32x16_bf16(k1, qf[ks], s1, 0, 0, 0); }
    }
    const unsigned w0 = (unsigned)mw >> (8 * g), w1 = (unsigned)(mw >> 32) >> (8 * g);
    float x0[16], x1[16];
#pragma unroll
    for (int r = 0; r < 16; ++r) {
        if (NEAR) { const LAS float* pb = btl + (tq - key0 - 8 * g + 96 - 63);
            x0[r] = s0[r] + pb[63 - (16 * (r >> 3) + (r & 7))]; x1[r] = s1[r] + pb[63 - (16 * (r >> 3) + (r & 7) + 32)]; }
        else { x0[r] = s0[r]; x1[r] = s1[r]; }
    }
    float mx = fmaxf(fmaxf(x0[15], x0[14]), fmaxf(x1[15], x1[14]));
    asm("v_max3_f32 %0, %0, %1, %2\n\tv_max3_f32 %0, %0, %3, %4\n\tv_max3_f32 %0, %0, %5, %6\n\tv_max3_f32 %0, %0, %7, %8\n\tv_max3_f32 %0, %0, %9, %10\n\tv_max3_f32 %0, %0, %11, %12\n\tv_max3_f32 %0, %0, %13, %14"
        : "+v"(mx) : "v"(x0[0]), "v"(x1[0]), "v"(x0[1]), "v"(x1[1]), "v"(x0[2]), "v"(x1[2]), "v"(x0[3]), "v"(x1[3]), "v"(x0[4]), "v"(x1[4]), "v"(x0[5]), "v"(x1[5]), "v"(x0[6]), "v"(x1[6]));
    asm("v_max3_f32 %0, %0, %1, %2\n\tv_max3_f32 %0, %0, %3, %4\n\tv_max3_f32 %0, %0, %5, %6\n\tv_max3_f32 %0, %0, %7, %8\n\tv_max3_f32 %0, %0, %9, %10\n\tv_max3_f32 %0, %0, %11, %12\n\tv_max3_f32 %0, %0, %13, %14"
        : "+v"(mx) : "v"(x0[7]), "v"(x1[7]), "v"(x0[8]), "v"(x1[8]), "v"(x0[9]), "v"(x1[9]), "v"(x0[10]), "v"(x1[10]), "v"(x0[11]), "v"(x1[11]), "v"(x0[12]), "v"(x1[12]), "v"(x0[13]), "v"(x1[13]));
    if (__any(mx > thr)) {
        float ms = NEG_INF;
#pragma unroll
        for (int r = 0; r < 16; ++r) { const int bp = 16 * (r >> 3) + (r & 7);
            const float a0 = ((w0 >> bp) & 1u) ? x0[r] : NEG_INF, a1 = ((w1 >> bp) & 1u) ? x1[r] : NEG_INF; ms = fmaxf(ms, fmaxf(a0, a1)); }
        { const auto sw = __builtin_amdgcn_permlane32_swap(__float_as_uint(ms), __float_as_uint(ms), false, false); ms = fmaxf(__uint_as_float(sw[0]), __uint_as_float(sw[1])); }
        const bool unset = (thr == NEG_INF);
        const float delta = (ms == NEG_INF) ? 0.f : (unset ? ms : fmaxf(ms, 0.f));
        const float alpha = unset ? 1.0f : __builtin_amdgcn_exp2f(-delta);
#pragma unroll
        for (int r = 0; r < 16; ++r) { O0[r] *= alpha; O1[r] *= alpha; x0[r] -= delta; x1[r] -= delta; }
        lsum *= alpha; m_ref += delta; if (ms != NEG_INF) thr = AT_THR;
#pragma unroll
        for (int r = 0; r < 16; ++r) negm[r] = -m_ref;
    }
#pragma unroll
    for (int r = 0; r < 16; ++r) { const int bp = 16 * (r >> 3) + (r & 7);
        const float e0 = __builtin_amdgcn_exp2f(x0[r]), e1 = __builtin_amdgcn_exp2f(x1[r]);
        unsigned b0, b1;
        asm("v_bfe_i32 %0, %1, %2, 1" : "=v"(b0) : "v"(w0), "n"(bp)); asm("v_bfe_i32 %0, %1, %2, 1" : "=v"(b1) : "v"(w1), "n"(bp));
        x0[r] = __uint_as_float(__float_as_uint(e0) & b0); x1[r] = __uint_as_float(__float_as_uint(e1) & b1); }
#pragma unroll
    for (int s = 0; s < 4; ++s) {
        const float* xp = (s < 2) ? x0 : x1; const int o = 8 * (s & 1);
        u32x4 w; w.x = cvt_pk_bf16(xp[o + 0], xp[o + 1]); w.y = cvt_pk_bf16(xp[o + 2], xp[o + 3]); w.z = cvt_pk_bf16(xp[o + 4], xp[o + 5]); w.w = cvt_pk_bf16(xp[o + 6], xp[o + 7]);
        const bf16x8 pb = *(bf16x8*)&w;
        const bf16x8 v0 = *(const LAS bf16x8*)(Vt + c * 72 + s * 16 + 8 * g), v1 = *(const LAS bf16x8*)(Vt + (32 + c) * 72 + s * 16 + 8 * g);
        O0 = __builtin_amdgcn_mfma_f32_32x32x16_bf16(v0, pb, O0, 0, 0, 0); O1 = __builtin_amdgcn_mfma_f32_32x32x16_bf16(v1, pb, O1, 0, 0, 0);
#pragma unroll
        for (int i = 0; i < 8; i += 2) lsum += (f32pair_t){xp[o + i], xp[o + i + 1]};
    }
}

__device__ __forceinline__ void attn_item(LAS unsigned char* lds, const bf16_t* Q, const bf16_t* Kb, const bf16_t* VT, const bf16_t* AG, const u64* MASK, const float* btab, bf16_t* MIXIN,
                                          int b, int head, int qb, int tid) {
    const int lane = tid & 63, wave = __builtin_amdgcn_readfirstlane(tid >> 6), g = lane >> 5, c = lane & 31;
    const int tq0 = qb * 256 + wave * 32, tq = tq0 + c;
    const size_t tokq = (size_t)b * SEQ + tq;
    LAS float* btl = (LAS float*)(lds + AT_BT);
    if (tid < 320) { const int rel = tid - 96; btl[tid] = (rel >= 0 && rel < 128) ? (btab[rel * 8 + head] - btab[127 * 8 + head]) * LOG2E : 0.f; }
    bf16x8 qf[4];
#pragma unroll
    for (int ks = 0; ks < 4; ++ks) { const u32x4 qw = *(const u32x4*)(Q + tokq * 512 + head * 64 + ks * 16 + 8 * g);
        u32x4 sw; sw.x = cvt_pk_bf16(bflo(qw.x) * AT_C1, bfhi(qw.x) * AT_C1); sw.y = cvt_pk_bf16(bflo(qw.y) * AT_C1, bfhi(qw.y) * AT_C1);
        sw.z = cvt_pk_bf16(bflo(qw.z) * AT_C1, bfhi(qw.z) * AT_C1); sw.w = cvt_pk_bf16(bflo(qw.w) * AT_C1, bfhi(qw.w) * AT_C1); qf[ks] = *(bf16x8*)&sw; }
    f32x16 O0, O1, negm;
#pragma unroll
    for (int r = 0; r < 16; ++r) { O0[r] = 0.f; O1[r] = 0.f; negm[r] = 0.f; }
    float m_ref = 0.f, thr = NEG_INF; f32pair_t lsum = {0.f, 0.f};
    const int nt = 4 * qb + 4, my_last = 4 * qb + (wave >> 1);
    const int srow = tid >> 3, sch = tid & 7, sto = (srow * 72 + 8 * sch) * 2;
    const bf16_t* kg = Kb + ((size_t)b * SEQ + srow) * 512 + head * 64 + 8 * sch;
    const bf16_t* vg = VT + ((size_t)(b * 8 + head) * 64 + srow) * 4096 + 8 * sch;
    const u64* Mrow = MASK + (size_t)b * 64 * SEQ + tq;
    { const u32x4 kr = *(const u32x4*)kg, vr = *(const u32x4*)vg; *(LAS u32x4*)(lds + AT_K0 + sto) = kr; *(LAS u32x4*)(lds + AT_V0 + sto) = vr; }
    u64 mw = Mrow[0];
    __syncthreads();
    int ks_near = (tq0 - 175 + 63) >> 6; ks_near = ks_near < 0 ? 0 : ks_near;
#define AT_ITER(BODY) do { const bool more = (kt + 1 < nt); u32x4 kr, vr; u64 mwn = 0ull; \
        if (more) { kr = *(const u32x4*)(kg + (size_t)(kt + 1) * 64 * 512); vr = *(const u32x4*)(vg + (kt + 1) * 64); if (kt + 1 <= my_last) mwn = Mrow[(size_t)(kt + 1) * SEQ]; } \
        { const LAS bf16_t* Kt = (const LAS bf16_t*)(lds + (kt & 1) * AT_STAGE + AT_K0); const LAS bf16_t* Vt = (const LAS bf16_t*)(lds + (kt & 1) * AT_STAGE + AT_V0); BODY; } \
        if (more) { *(LAS u32x4*)(lds + ((kt + 1) & 1) * AT_STAGE + AT_K0 + sto) = kr; *(LAS u32x4*)(lds + ((kt + 1) & 1) * AT_STAGE + AT_V0 + sto) = vr; } \
        mw = mwn; __syncthreads(); } while (0)
    int kt = 0;
    if (wave >= 4) __builtin_amdgcn_s_setprio(1);
    for (; kt < ks_near; ++kt) AT_ITER(attn_tile<false>(Kt, Vt, btl, qf, negm, O0, O1, m_ref, thr, lsum, mw, tq, 64 * kt, g, c));
    for (; kt <= my_last; ++kt) AT_ITER(attn_tile<true>(Kt, Vt, btl, qf, negm, O0, O1, m_ref, thr, lsum, mw, tq, 64 * kt, g, c));
    for (; kt < nt; ++kt) AT_ITER((void)Kt; (void)Vt);
#undef AT_ITER
    __builtin_amdgcn_s_setprio(0);
    float inv;
    { const float l1 = lsum.x + lsum.y; const auto sw = __builtin_amdgcn_permlane32_swap(__float_as_uint(l1), __float_as_uint(l1), false, false); inv = 1.0f / (__uint_as_float(sw[0]) + __uint_as_float(sw[1])); }
#pragma unroll
    for (int mt = 0; mt < 2; ++mt)
#pragma unroll
        for (int rq = 0; rq < 4; ++rq) { const int d0 = 32 * mt + 8 * rq + 4 * g;
            const u32x2 gw = *(const u32x2*)(AG + tokq * 512 + head * 64 + d0);
            const float o0 = (mt ? O1[4 * rq + 0] : O0[4 * rq + 0]) * inv * bflo(gw.x), o1 = (mt ? O1[4 * rq + 1] : O0[4 * rq + 1]) * inv * bfhi(gw.x);
            const float o2 = (mt ? O1[4 * rq + 2] : O0[4 * rq + 2]) * inv * bflo(gw.y), o3 = (mt ? O1[4 * rq + 3] : O0[4 * rq + 3]) * inv * bfhi(gw.y);
            u32x2 ow; ow.x = cvt_pk_bf16(o0, o1); ow.y = cvt_pk_bf16(o2, o3);
            *(u32x2*)(MIXIN + tokq * 1024 + head * 64 + d0) = ow; }
}

constexpr int LDS_BYTES = 147456;
constexpr int MISC_OFF = 131072 + 8192;
constexpr int NPH = 26;

__global__ void __launch_bounds__(NTHREADS, 2) fwd_kernel(Args a) {
    extern __shared__ __attribute__((aligned(16))) unsigned char lds_raw[];
    LAS unsigned char* lds = (LAS unsigned char*)lds_raw;
    const int G = gridDim.x, wg = blockIdx.x;
    volatile LAS unsigned* misc = (volatile LAS unsigned*)(lds + MISC_OFF);
    if (threadIdx.x < 4) misc[threadIdx.x] = 0u;
    __syncthreads();
    XcdBarrier bar; bar.bar = nullptr; bar.x = 0; bar.st = misc;
    if (N_LAUNCHES == 1) bar = xcd_barrier_post((unsigned*)(get_args()->ws + WS_CTL), misc);
    int lo, hi; { ArgsP ap = get_args(); lo = ap->ph_lo; hi = ap->ph_hi; }
#define WSP(type, off) ((type*)(wsl + (off)))
#define IN(k) (lo <= (k) && (k) < hi)
#define SEAM(k) do { if (N_LAUNCHES == 1 && IN(k) && IN((k) + 1)) { XcdBarrier b_ = bar; asm volatile("" : "+s"(b_.bar), "+s"(b_.x)); xcd_barrier(b_); } } while (0)

    if (IN(0)) {
        ArgsP ap = get_args(); unsigned char* wsl = ap->ws;
        weight_phase((LAS float*)lds, ap, wsl);
        if (wg == 0) for (int i = opaque_tid(); i < 1024; i += NTHREADS) { const int rel = i >> 3, h = i & 7; WSP(float, WS_TAB)[i] = ap->rel_bias[t5_bucket(rel) * 8 + h]; }
    }
    SEAM(0);

#define LAYER_BODY(LAYER_) { constexpr int layer = (LAYER_); \
        const int pb = 1 + 6 * layer, e = layer >> 1; \
        constexpr bool even = (layer & 1) == 0; \
        if (IN(pb + 0)) { \
            ArgsP ap = get_args(); unsigned char* wsl = ap->ws; \
            const bf16_t* Wm = WSP(bf16_t, WS_WEIN) + ((size_t)e * NE + 4096) * 1024; \
            if (layer == 0) norm_misc_phase(lds, ap->x, nullptr, nullptr, nullptr, nullptr, WSP(bf16_t, WS_H), WSP(float, WS_XS), Wm, WSP(bf16_t, WS_IK), WSP(float, WS_IW), WSP(float, WS_BLR)); \
            else if (even) norm_misc_phase(lds, nullptr, WSP(bf16_t, WS_H), WSP(float, WS_XS), WSP(bf16_t, WS_MIX), ap->post_norm + (layer - 1) * DM, WSP(bf16_t, WS_H), WSP(float, WS_XS), Wm, WSP(bf16_t, WS_IK), WSP(float, WS_IW), WSP(float, WS_BLR)); \
            else norm_phase(nullptr, WSP(bf16_t, WS_H), WSP(float, WS_XS), WSP(bf16_t, WS_MIX), ap->post_norm + (layer - 1) * DM, WSP(bf16_t, WS_H), WSP(float, WS_XS), nullptr); \
        } \
        SEAM(pb + 0); \
        if (even) { \
            if (IN(pb + 1)) { \
                ArgsP ap = get_args(); unsigned char* wsl = ap->ws; \
                pg8::Gemm gm{WSP(bf16_t, WS_H), WSP(bf16_t, WS_WEIN) + (size_t)e * NE * 1024, T, 4096, 1024, 1024, 1 << 30, 0}; pg8::StaticOrder S; S.init(T, 4096, G, wg); \
                EpiEvenIn E{WSP(bf16_t, WS_Q), WSP(bf16_t, WS_K), WSP(bf16_t, WS_VT), WSP(bf16_t, WS_AG), WSP(bf16_t, WS_IQ), WSP(bf16_t, WS_BQ), WSP(bf16_t, WS_BK), WSP(bf16_t, WS_BV), WSP(bf16_t, WS_BG), \
                            WSP(bf16_t, WS_IK), WSP(float, WS_IW), WSP(float, WS_BLR)}; \
                pg8::gemm_phase(lds, gm, S, E); \
            } \
            SEAM(pb + 1); \
            if (IN(pb + 2)) { \
                ArgsP ap = get_args(); unsigned char* wsl = ap->ws; \
                { const int tid = opaque_tid(), lane = tid & 63, wave = __builtin_amdgcn_readfirstlane(tid >> 6); \
                  indexer_phase((LAS float*)lds, WSP(bf16_t, WS_IQ), WSP(bf16_t, WS_IK), WSP(float, WS_IW), WSP(u64, WS_MASK), wave, lane); } \
                { const float* gw2 = ap->even_gate_w2 + (size_t)e * 16 * 256; const float* gb2 = ap->even_gate_b2 + (size_t)e * 256; \
                  for (int it = wg; it < 1024; it += G) gla_state_item(lds, gw2, gb2, it, WSP(bf16_t, WS_BQ), WSP(bf16_t, WS_BK), WSP(bf16_t, WS_BV), WSP(float, WS_BLR), WSP(float, WS_DECAY), WSP(float, WS_MIXIN)); } \
            } \
            SEAM(pb + 2); \
            if (IN(pb + 3)) { \
                ArgsP ap = get_args(); unsigned char* wsl = ap->ws; \
                const float* GSTATE = WSP(float, WS_MIXIN); const float* DECAY = WSP(float, WS_DECAY); bf16_t* SPREV = WSP(bf16_t, WS_SPREV); \
                for (int el = wg * NTHREADS + opaque_tid(); el < 16 * 8192; el += G * NTHREADS) { \
                    const int bh = el >> 13, rem = el & 8191, dk = rem & 63; float Sv = 0.f; \
                    for (int n = 0; n < 64; ++n) { const size_t o = ((size_t)bh * 64 + n) * 8192 + rem; SPREV[o] = f2bf(Sv); Sv = DECAY[((size_t)bh * 64 + n) * 64 + dk] * Sv + GSTATE[o]; } \
                } \
            } \
            SEAM(pb + 3); \
            if (IN(pb + 4)) { \
                ArgsP ap = get_args(); unsigned char* wsl = ap->ws; \
                { const int tid = opaque_tid(); \
                  for (int it = wg; it < 512; it += G) { const int idx = it & 255, b = idx & 3, head = (idx >> 2) & 7, qbp = idx >> 5, qb = (it < 256) ? 15 - qbp : qbp; \
                      attn_item(lds, WSP(bf16_t, WS_Q), WSP(bf16_t, WS_K), WSP(bf16_t, WS_VT), WSP(bf16_t, WS_AG), WSP(u64, WS_MASK), WSP(float, WS_TAB), WSP(bf16_t, WS_MIXIN), b, head, qb, tid); } } \
                __syncthreads(); \
                { const float* gw2 = ap->even_gate_w2 + (size_t)e * 16 * 256; const float* gb2 = ap->even_gate_b2 + (size_t)e * 256; \
                  for (int it = wg; it < 1024; it += G) gla_out_item(lds, gw2, gb2, it, WSP(bf16_t, WS_BQ), WSP(bf16_t, WS_BK), WSP(bf16_t, WS_BV), WSP(float, WS_BLR), WSP(bf16_t, WS_BG), WSP(bf16_t, WS_SPREV), WSP(bf16_t, WS_MIXIN)); } \
            } \
            SEAM(pb + 4); \
        } else { \
            if (IN(pb + 1)) { \
                ArgsP ap = get_args(); unsigned char* wsl = ap->ws; \
                pg8::Gemm gm{WSP(bf16_t, WS_H), WSP(bf16_t, WS_WOIN) + (size_t)e * 2048 * 1024, T, 2048, 1024, 1024, 1 << 30, 0}; pg8::StaticOrder S; S.init(T, 2048, G, wg); \
                EpiOddIn E{WSP(bf16_t, WS_XR), WSP(bf16_t, WS_GS)}; \
                pg8::gemm_phase(lds, gm, S, E); \
            } \
            SEAM(pb + 1); \
            if (IN(pb + 2)) { \
                ArgsP ap = get_args(); unsigned char* wsl = ap->ws; \
                const bf16_t* XR = WSP(bf16_t, WS_XR); bf16_t* XC = WSP(bf16_t, WS_XC); \
                const float* cw = ap->odd_conv_w + (size_t)e * 4 * 1024; const float* cb = ap->odd_conv_b + (size_t)e * 1024; \
                { const int tid = opaque_tid(), c8 = (tid & 127) * 8; float wq[4][8], bq[8];   \
_Pragma("unroll") \
                  for (int k = 0; k < 8; ++k) { bq[k] = cb[c8 + k]; _Pragma("unroll") for (int j = 0; j < 4; ++j) wq[j][k] = cw[j * 1024 + c8 + k]; } \
                  for (int run = wg * 4 + (tid >> 7); run < T / 8; run += G * 4) { \
                    const int tok0 = run * 8, s0 = tok0 & 4095; float xw[11][8]; \
_Pragma("unroll") \
                    for (int i = 0; i < 11; ++i) { u32x4 w = (u32x4){0u, 0u, 0u, 0u}; if (s0 - 3 + i >= 0) w = *(const u32x4*)(XR + (size_t)(tok0 - 3 + i) * 1024 + c8); \
                        xw[i][0] = bflo(w.x); xw[i][1] = bfhi(w.x); xw[i][2] = bflo(w.y); xw[i][3] = bfhi(w.y); xw[i][4] = bflo(w.z); xw[i][5] = bfhi(w.z); xw[i][6] = bflo(w.w); xw[i][7] = bfhi(w.w); } \
_Pragma("unroll") \
                    for (int o = 0; o < 8; ++o) { float acc[8]; \
_Pragma("unroll") \
                        for (int k = 0; k < 8; ++k) acc[k] = bq[k] + wq[0][k] * xw[o][k] + wq[1][k] * xw[o + 1][k] + wq[2][k] * xw[o + 2][k] + wq[3][k] * xw[o + 3][k]; \
                        u32x4 ow; ow.x = cvt_pk_bf16(acc[0], acc[1]); ow.y = cvt_pk_bf16(acc[2], acc[3]); ow.z = cvt_pk_bf16(acc[4], acc[5]); ow.w = cvt_pk_bf16(acc[6], acc[7]); \
                        *(u32x4*)(XC + (size_t)(tok0 + o) * 1024 + c8) = ow; } \
                  } } \
            } \
            SEAM(pb + 2); \
            if (IN(pb + 3)) { \
                ArgsP ap = get_args(); unsigned char* wsl = ap->ws; \
                pg8::Gemm gm{WSP(bf16_t, WS_XC), WSP(bf16_t, WS_WOG) + (size_t)e * 2048 * 256, T, 2048, 256, 1024, 2, 512}; pg8::StaticOrder S; S.init(T, 2048, G, wg); \
                EpiGates E{ap->odd_b_a + (size_t)e * 1024, ap->odd_b_x + (size_t)e * 1024, ap->odd_lambda + (size_t)e * 1024, WSP(bf16_t, WS_XC), WSP(bf16_t, WS_LOGA), WSP(bf16_t, WS_U)}; \
                pg8::gemm_phase(lds, gm, S, E); \
            } \
            SEAM(pb + 3); \
            if (IN(pb + 4)) { \
                ArgsP ap = get_args(); unsigned char* wsl = ap->ws; \
                const bf16_t* LOGA = WSP(bf16_t, WS_LOGA); const bf16_t* U = WSP(bf16_t, WS_U); const bf16_t* GS = WSP(bf16_t, WS_GS); bf16_t* MIXIN = WSP(bf16_t, WS_MIXIN); \
                LAS float* sl = (LAS float*)lds; LAS float* hl = sl + 512; \
                const int tid = opaque_tid(); \
                for (int it = wg; it < 256; it += G) { \
                      \
                    const int xq = (it & 7) * 8 + ((it >> 3) >> 2), b = xq >> 4, ch = ((xq & 15) * 4 + ((it >> 3) & 3)) * 16 + (tid & 15), jc = tid >> 4; \
                    const size_t base = ((size_t)b * SEQ + jc * 128) * 1024 + ch, sbase = slab_idx(b * SEQ + jc * 128, ch); \
                    float hsum = 0.f, lsum = 0.f; \
                    for (int s0 = 0; s0 < 128; s0 += 16) { float la[16], uu[16]; \
                        _Pragma("unroll") for (int k = 0; k < 16; ++k) { la[k] = bf2f(LOGA[sbase + (size_t)(s0 + k) * 16]); uu[k] = bf2f(U[sbase + (size_t)(s0 + k) * 16]); } \
                        _Pragma("unroll") for (int k = 0; k < 16; ++k) { hsum = __builtin_amdgcn_exp2f(la[k]) * hsum + uu[k]; lsum += la[k]; } } \
                    sl[tid] = lsum; hl[tid] = hsum; \
                    __syncthreads(); \
                    float hin = 0.f; \
                    for (int cj = 0; cj < jc; ++cj) hin = __builtin_amdgcn_exp2f(sl[cj * 16 + (tid & 15)]) * hin + hl[cj * 16 + (tid & 15)]; \
                    float hv = hin; \
                    for (int s0 = 0; s0 < 128; s0 += 16) { float la[16], uu[16], gg[16]; \
                        _Pragma("unroll") for (int k = 0; k < 16; ++k) { la[k] = bf2f(LOGA[sbase + (size_t)(s0 + k) * 16]); uu[k] = bf2f(U[sbase + (size_t)(s0 + k) * 16]); gg[k] = bf2f(GS[sbase + (size_t)(s0 + k) * 16]); } \
                        _Pragma("unroll") for (int k = 0; k < 16; ++k) { hv = __builtin_amdgcn_exp2f(la[k]) * hv + uu[k]; MIXIN[base + (size_t)(s0 + k) * 1024] = f2bf(hv * gg[k]); } } \
                    __syncthreads(); \
                } \
            } \
            SEAM(pb + 4); \
        } \
        if (IN(pb + 5)) { \
            ArgsP ap = get_args(); unsigned char* wsl = ap->ws; \
            const bf16_t* W = (even ? WSP(bf16_t, WS_WEOUT) : WSP(bf16_t, WS_WOOUT)) + (size_t)e * 1024 * 1024; \
            pg8::Gemm gm{WSP(bf16_t, WS_MIXIN), W, T, 1024, 1024, 1024, 1 << 30, 0}; pg8::StaticOrder S; S.init(T, 1024, G, wg); \
            EpiMix E{WSP(bf16_t, WS_MIX)}; \
            pg8::gemm_phase(lds, gm, S, E); \
        } \
        SEAM(pb + 5); \
    }
    LAYER_BODY(0)
    LAYER_BODY(1)
    LAYER_BODY(2)
    LAYER_BODY(3)
#undef LAYER_BODY
    if (IN(25)) { ArgsP ap = get_args(); unsigned char* wsl = ap->ws; norm_phase(nullptr, WSP(bf16_t, WS_H), WSP(float, WS_XS), WSP(bf16_t, WS_MIX), ap->post_norm + 3 * DM, nullptr, nullptr, ap->out); }
#undef IN
#undef SEAM
#undef WSP
}

extern "C" void kernel_launch(void* const* d_in, const int* in_sizes, int n_in, void* d_out, int out_size, void* d_ws, size_t ws_size, hipStream_t stream) {
    static int grid = 0;
    if (grid == 0) {
        if (n_in != 17 || out_size != T * DM || ws_size < WS_END) { fprintf(stderr, "kernel_launch: unexpected sizes (n_in %d, out %d, ws %zu, need %zu)\n", n_in, out_size, ws_size, (size_t)WS_END); grid = -1; return; }
        int dev = 0, cus = 0, per_cu = 0;
        if (hipGetDevice(&dev) != hipSuccess || hipDeviceGetAttribute(&cus, hipDeviceAttributeMultiprocessorCount, dev) != hipSuccess) { grid = -1; return; }
        if (hipFuncSetAttribute((const void*)fwd_kernel, hipFuncAttributeMaxDynamicSharedMemorySize, LDS_BYTES) != hipSuccess) { fprintf(stderr, "kernel_launch: hipFuncSetAttribute failed\n"); grid = -1; return; }
        if (hipOccupancyMaxActiveBlocksPerMultiprocessor(&per_cu, (const void*)fwd_kernel, NTHREADS, LDS_BYTES) != hipSuccess || per_cu < 1) { fprintf(stderr, "kernel_launch: occupancy query says %d\n", per_cu); }
        (void)hipGetLastError();
        grid = cus;
    }
    if (grid < 0) return;
    (void)hipMemsetAsync((char*)d_ws + WS_CTL, 0, CTL_BYTES, stream);
    Args a{};
    a.x = (const float*)d_in[0]; a.rel_bias = (const float*)d_in[1]; a.pre_norm = (const float*)d_in[2]; a.post_norm = (const float*)d_in[3];
    a.even_w_in = (const float*)d_in[4]; a.even_gate_w2 = (const float*)d_in[5]; a.even_gate_b2 = (const float*)d_in[6]; a.even_w_out = (const float*)d_in[7];
    a.odd_w_in = (const float*)d_in[8]; a.odd_conv_w = (const float*)d_in[9]; a.odd_conv_b = (const float*)d_in[10]; a.odd_w_a = (const float*)d_in[11]; a.odd_b_a = (const float*)d_in[12];
    a.odd_w_x = (const float*)d_in[13]; a.odd_b_x = (const float*)d_in[14]; a.odd_lambda = (const float*)d_in[15]; a.odd_w_out = (const float*)d_in[16];
    a.out = (float*)d_out; a.ws = (unsigned char*)d_ws;
    if (N_LAUNCHES == 1) {
        a.ph_lo = 0; a.ph_hi = NPH;
        hipLaunchKernelGGL(fwd_kernel, dim3(grid), dim3(NTHREADS), LDS_BYTES, stream, a);
    } else {
        for (int ph = 0; ph < NPH; ++ph) { a.ph_lo = ph; a.ph_hi = ph + 1; hipLaunchKernelGGL(fwd_kernel, dim3(grid), dim3(NTHREADS), LDS_BYTES, stream, a); }
    }
}
```

```cpp
#include <hip/hip_runtime.h>
#include <stdint.h>
#include <stdio.h>

#ifndef N_LAUNCHES
#define N_LAUNCHES 1
#endif

#define LAS __attribute__((address_space(3)))
typedef unsigned short bf16_t;
typedef short bf16x8 __attribute__((ext_vector_type(8)));
typedef float f32x4 __attribute__((ext_vector_type(4)));
typedef float f32x2 __attribute__((ext_vector_type(2)));
typedef float f32x16 __attribute__((ext_vector_type(16)));
typedef unsigned u32x4 __attribute__((ext_vector_type(4)));
typedef unsigned u32x2 __attribute__((ext_vector_type(2)));
typedef unsigned long long u64;

constexpr int NB = 4, SEQ = 4096, T = NB * SEQ, DM = 1024;
constexpr int EVEN_IN = 4184, NE = 4352;
constexpr int NTHREADS = 512;
constexpr float EPS = 1e-6f;
constexpr float NEG_INF = -__builtin_inff();

constexpr size_t MB = 1024 * 1024;
constexpr size_t WS_CTL   = 0;
constexpr size_t CTL_BYTES = 65536;
constexpr size_t WS_WEIN  = WS_CTL + CTL_BYTES;
constexpr size_t WS_WEOUT = WS_WEIN + (size_t)2 * NE * 1024 * 2;
constexpr size_t WS_WOIN  = WS_WEOUT + 4 * MB;
constexpr size_t WS_WOG   = WS_WOIN + 8 * MB;
constexpr size_t WS_WOOUT = WS_WOG + 2 * MB;
constexpr size_t WS_TAB   = WS_WOOUT + 4 * MB;
constexpr size_t WS_XS    = WS_TAB + 4096;
constexpr size_t WS_H     = WS_XS + 65536;
constexpr size_t WS_MIXIN = WS_H + 32 * MB;
constexpr size_t WS_ACT   = WS_MIXIN + 32 * MB;
constexpr size_t WS_Q     = WS_ACT;
constexpr size_t WS_K     = WS_Q + 16 * MB;
constexpr size_t WS_VT    = WS_K + 16 * MB;
constexpr size_t WS_AG    = WS_VT + 16 * MB;
constexpr size_t WS_MIX   = WS_ACT;
constexpr size_t WS_IQ    = WS_AG + 16 * MB;
constexpr size_t WS_BQ    = WS_IQ + 16 * MB;
constexpr size_t WS_BK    = WS_BQ + 8 * MB;
constexpr size_t WS_BV    = WS_BK + 8 * MB;
constexpr size_t WS_BG    = WS_BV + 16 * MB;
constexpr size_t WS_IK    = WS_BG + 16 * MB;
constexpr size_t WS_IW    = WS_IK + 2 * MB;
constexpr size_t WS_BLR   = WS_IW + MB / 2;
constexpr size_t WS_MASK  = WS_BLR + MB;
constexpr size_t WS_SPREV = WS_MASK + 8 * MB;
constexpr size_t WS_DECAY = WS_SPREV + 16 * MB;
constexpr size_t WS_EVEN_END = WS_DECAY + MB / 4;
constexpr size_t WS_XR    = WS_ACT;
constexpr size_t WS_U     = WS_XR;
constexpr size_t WS_GS    = WS_XR + 32 * MB;
constexpr size_t WS_XC    = WS_GS + 32 * MB;
constexpr size_t WS_LOGA  = WS_XC + 32 * MB;
constexpr size_t WS_ODD_END = WS_LOGA + 32 * MB;
constexpr size_t WS_END   = WS_EVEN_END > WS_ODD_END ? WS_EVEN_END : WS_ODD_END;
static_assert(WS_END <= (size_t)256 * MB, "workspace map exceeds 256 MiB");

__device__ __forceinline__ float bf2f(unsigned v) { return __uint_as_float(v << 16); }
typedef __bf16 bf16pair_t __attribute__((ext_vector_type(2)));
typedef float f32pair_t __attribute__((ext_vector_type(2)));
__device__ __forceinline__ unsigned cvt_pk_bf16(float lo, float hi) { const f32pair_t v = {lo, hi}; const bf16pair_t b = __builtin_convertvector(v, bf16pair_t); return __builtin_bit_cast(unsigned, b); }
__device__ __forceinline__ bf16_t f2bf(float f) { return (bf16_t)cvt_pk_bf16(f, f); }
__device__ __forceinline__ float silu_f(float x) { return x * __builtin_amdgcn_rcpf(1.0f + __builtin_amdgcn_exp2f(x * -1.4426950408889634f)); }
__device__ __forceinline__ float sigmoid_f(float x) { return __builtin_amdgcn_rcpf(1.0f + __builtin_amdgcn_exp2f(x * -1.4426950408889634f)); }
__device__ __forceinline__ size_t slab_idx(int row, int ch) { return ((size_t)((row >> 12) * 64 + (ch >> 4)) * SEQ + (row & 4095)) * 16 + (ch & 15); }
__device__ __forceinline__ float log1p_01(float y) { const float ser = y * (1.0f - y * (0.5f - y * (0.33333334f - y * 0.25f))); return y < 0.03125f ? ser : __logf(1.0f + y); }
__device__ __forceinline__ float bflo(unsigned w) { return __uint_as_float(w << 16); }
__device__ __forceinline__ float bfhi(unsigned w) { return __uint_as_float(w & 0xFFFF0000u); }

__device__ __forceinline__ float relu_bits(float x) { const int i = (int)__float_as_uint(x); return __uint_as_float((unsigned)(i < 0 ? 0 : i)); }
__device__ __forceinline__ int opaque_tid() { int t = threadIdx.x; asm volatile("" : "+v"(t)); return t; }

__device__ __forceinline__ int wave_sum_i32(int v) {
    v += __builtin_amdgcn_update_dpp(0, v, 0xB1, 0xF, 0xF, true);
    v += __builtin_amdgcn_update_dpp(0, v, 0x4E, 0xF, 0xF, true);
    v += __builtin_amdgcn_update_dpp(0, v, 0x141, 0xF, 0xF, true);
    v += __builtin_amdgcn_update_dpp(0, v, 0x140, 0xF, 0xF, true);
    return __builtin_amdgcn_readlane(v, 0) + __builtin_amdgcn_readlane(v, 16) + __builtin_amdgcn_readlane(v, 32) + __builtin_amdgcn_readlane(v, 48);
}

__device__ __forceinline__ float wave_max_f32(float v) {
    v = fmaxf(v, __uint_as_float((unsigned)__builtin_amdgcn_update_dpp(0, (int)__float_as_uint(v), 0xB1, 0xF, 0xF, true)));
    v = fmaxf(v, __uint_as_float((unsigned)__builtin_amdgcn_update_dpp(0, (int)__float_as_uint(v), 0x4E, 0xF, 0xF, true)));
    v = fmaxf(v, __uint_as_float((unsigned)__builtin_amdgcn_update_dpp(0, (int)__float_as_uint(v), 0x141, 0xF, 0xF, true)));
    v = fmaxf(v, __uint_as_float((unsigned)__builtin_amdgcn_update_dpp(0, (int)__float_as_uint(v), 0x140, 0xF, 0xF, true)));
    const float a = __uint_as_float((unsigned)__builtin_amdgcn_readlane((int)__float_as_uint(v), 0)), b = __uint_as_float((unsigned)__builtin_amdgcn_readlane((int)__float_as_uint(v), 16));
    const float c = __uint_as_float((unsigned)__builtin_amdgcn_readlane((int)__float_as_uint(v), 32)), d = __uint_as_float((unsigned)__builtin_amdgcn_readlane((int)__float_as_uint(v), 48));
    return fmaxf(fmaxf(a, b), fmaxf(c, d));
}
__device__ __forceinline__ int wave_prefix_sum_i32(int v) {
    v += __builtin_amdgcn_update_dpp(0, v, 0x111, 0xF, 0xF, true);
    v += __builtin_amdgcn_update_dpp(0, v, 0x112, 0xF, 0xF, true);
    v += __builtin_amdgcn_update_dpp(0, v, 0x114, 0xF, 0xF, true);
    v += __builtin_amdgcn_update_dpp(0, v, 0x118, 0xF, 0xF, true);
    v += __builtin_amdgcn_update_dpp(0, v, 0x142, 0xA, 0xF, false);
    v += __builtin_amdgcn_update_dpp(0, v, 0x143, 0xC, 0xF, false);
    return v;
}

#define XB_TMO      128
#define XB_XCNT(j)  (256  + 64 * (j))
#define XB_XSUB(j)  (1280 + 64 * (j))
#define XB_XGEN(j)  (2304 + 64 * (j))
#define XB_TOP      3328
#define XB_TOPGEN   3392
#define XCD_BAR_WORDS 3456
#define XB_SPIN_CAP (1u << 18)

__device__ __forceinline__ unsigned xb_ld(unsigned* p)              { return __hip_atomic_load(p, __ATOMIC_RELAXED, __HIP_MEMORY_SCOPE_AGENT); }
__device__ __forceinline__ unsigned xb_add(unsigned* p, unsigned v) { return __hip_atomic_fetch_add(p, v, __ATOMIC_RELAXED, __HIP_MEMORY_SCOPE_AGENT); }
__device__ __forceinline__ unsigned xb_xcc_id() { return (unsigned)__builtin_amdgcn_s_getreg((3 << 11) | 20) & 0xFu; }
#define XB_SPIN(cond, bar) do { unsigned _sp = 0; while (cond) { __builtin_amdgcn_s_sleep(1); \
    if ((++_sp & 255u) == 0u) { if (xb_ld(&(bar)[XB_TMO])) break; if (_sp > XB_SPIN_CAP) { atomicAdd(&(bar)[XB_TMO], 1u); break; } } } } while (0)

struct XcdBarrier { unsigned* bar; unsigned x; volatile LAS unsigned* st; };

__device__ __forceinline__ XcdBarrier xcd_barrier_post(unsigned* bar, volatile LAS unsigned* st) {
    XcdBarrier b; b.bar = bar; b.x = xb_xcc_id(); b.st = st;
    if (threadIdx.x == 0) (void)xb_add(&bar[XB_XCNT(b.x)], 1u);
    return b;
}
__device__ __forceinline__ void xcd_barrier_complete(unsigned* bar, unsigned x, unsigned& nloc, unsigned& nx) {
    const unsigned G = gridDim.x * gridDim.y * gridDim.z;
    unsigned sum, cnt, mine, sp = 0u;
    for (;;) {
        sum = 0u; cnt = 0u; mine = 0u;
#pragma unroll
        for (unsigned j = 0; j < 16; ++j) { const unsigned c = xb_ld(&bar[XB_XCNT(j)]); sum += c; cnt += (c > 0u) ? 1u : 0u; mine = (j == x) ? c : mine; }
        if (sum == G) break;
        __builtin_amdgcn_s_sleep(1);
        if ((++sp & 255u) == 0u) { if (xb_ld(&bar[XB_TMO])) break; if (sp > XB_SPIN_CAP) { atomicAdd(&bar[XB_TMO], 1u); break; } }
    }
    nloc = mine > 0u ? mine : 1u; nx = cnt > 0u ? cnt : 1u;
}
__device__ __forceinline__ void xcd_barrier(const XcdBarrier& b) {
    asm volatile("s_waitcnt vmcnt(0)" ::: "memory");
    __syncthreads();
    if (threadIdx.x == 0) {
        unsigned* bar = b.bar;
        __builtin_amdgcn_s_waitcnt(0);
        unsigned nloc = b.st[0], nx = b.st[1];
        if (nloc == 0u) { xcd_barrier_complete(bar, b.x, nloc, nx); b.st[0] = nloc; b.st[1] = nx; }
        const unsigned old = xb_add(&bar[XB_XSUB(b.x)], 1u);
        const unsigned gen = old / nloc;
        if (old + 1u == (gen + 1u) * nloc) {
            __builtin_amdgcn_fence(__ATOMIC_RELEASE, "agent");
            asm volatile("s_waitcnt vmcnt(0)" ::: "memory");
            const unsigned og = xb_add(&bar[XB_TOP], 1u);
            const unsigned tg = og / nx;
            if (og + 1u == (tg + 1u) * nx) xb_add(&bar[XB_TOPGEN], 1u);
            else XB_SPIN(xb_ld(&bar[XB_TOPGEN]) == tg, bar);
            __builtin_amdgcn_fence(__ATOMIC_ACQUIRE, "agent");
            xb_add(&bar[XB_XGEN(b.x)], 1u);
            asm volatile("s_waitcnt vmcnt(0)" ::: "memory");
        } else {
            XB_SPIN(xb_ld(&bar[XB_XGEN(b.x)]) == gen, bar);
            __builtin_amdgcn_fence(__ATOMIC_ACQUIRE, "agent");
            asm volatile("s_waitcnt vmcnt(0)" ::: "memory");
        }
    }
    __syncthreads();
}

namespace pg8 {
constexpr int BM = 256, BK = 64, HALF = 128, HTB = HALF * BK * 2, STAGE_BYTES = 8 * HTB, NXCD = 8, WGM = 8;
__host__ __device__ __forceinline__ int lds_byte(int r, int c) { const int st = (r >> 4) * 2 + (c >> 5), rr = r & 15, cc = c & 31, ob = rr * 64 + cc * 2; return st * 1024 + (ob ^ (((ob >> 9) & 1) << 5)); }
__host__ __device__ __forceinline__ void stage_rc(int b, int& R, int& C) { const int st = b / 1024, sb = b % 1024, swz = sb ^ (((sb >> 9) & 1) << 5); R = (st >> 1) * 16 + swz / 64; C = (st & 1) * 32 + (swz % 64) / 2; }
__host__ __device__ __forceinline__ int perm32(int rho) { const int n = rho >> 4, i = rho & 15; return 8 * (i >> 2) + 4 * n + (i & 3); }

struct Unit { int pm, pn; };
struct Gemm { const bf16_t* A; const bf16_t* Bt; int M, N, K, lda, a_div, a_step; };

struct StaticOrder {
    int nM, nN, nwg, G, c;
    __host__ __device__ void init(int M, int N, int G_, int c_) { nM = M / BM; nN = N / BM; nwg = nM * nN; G = G_; c = c_; }
    __host__ __device__ bool next(int i, Unit& u) const {
        const long L = (long)i * G + c; if (L >= nwg) return false;
        int wgid = (int)L; { const int q = nwg / NXCD, r = nwg % NXCD, xcd = wgid % NXCD, off = wgid / NXCD; wgid = (xcd < r ? xcd * (q + 1) : r * (q + 1) + (xcd - r) * q) + off; }
        const int nig = WGM * nN, gid = wgid / nig, fm = gid * WGM, gsz = (nM - fm) < WGM ? (nM - fm) : WGM;
        u.pm = fm + ((wgid % nig) % gsz); u.pn = (wgid % nig) / gsz; return true;
    }
};

template <class Epi>
__device__ __forceinline__ void gemm_phase(LAS unsigned char* lds, const Gemm g, const StaticOrder& S, const Epi& E) {
    const int tid = opaque_tid(), wid = __builtin_amdgcn_readfirstlane(tid >> 6), lane = tid & 63, wr = wid >> 2, wc = wid & 3, fr = lane & 15, fq = lane >> 4;
    const int K = g.K, nt = K / BK, lda = g.lda;
    unsigned voffA[2], voffB[2];
#pragma unroll
    for (int i = 0; i < 2; ++i) { int R, C; stage_rc(tid * 16 + i * 8192, R, C); const int Rb = Epi::PERM ? ((R & ~31) + perm32(R & 31)) : R;
        voffA[i] = (unsigned)(R * lda + C) * 2u; voffB[i] = (unsigned)(Rb * K + C) * 2u; }
    const size_t kstep = (size_t)(BK * 2);
    const size_t hstepA = (size_t)HALF * lda * 2, hstepB = (size_t)HALF * K * 2;
    const size_t tstepA = 2 * hstepA, tstepB = 2 * hstepB;
    const unsigned ldsw = (unsigned)wid * 1024u;
    const int aoff = lds_byte(wr * 64 + fr, fq * 8), boff = lds_byte(wc * 32 + fr, fq * 8);
#define PG8_SA(b, h) (((b) * 2 + (h)) * HTB)
#define PG8_SB(b, h) ((4 + (b) * 2 + (h)) * HTB)
#define PG8_STAGE(bufoff, gbase, voff) do { _Pragma("unroll") for (int _i = 0; _i < 2; ++_i) \
        __builtin_amdgcn_global_load_lds((const unsigned*)((const char*)(gbase) + (voff)[_i]), (LAS unsigned*)(lds + (bufoff) + ldsw + _i * 8192), 16, 0, 0); } while (0)
#define PG8_LDA(dst, b, h) do { _Pragma("unroll") for (int m = 0; m < 4; ++m) _Pragma("unroll") for (int k = 0; k < 2; ++k) dst[m][k] = *(const LAS bf16x8*)(lds + PG8_SA(b, h) + aoff + m * 2048 + k * 1024); } while (0)
#define PG8_LDB(dst, b, h) do { _Pragma("unroll") for (int n = 0; n < 2; ++n) _Pragma("unroll") for (int k = 0; k < 2; ++k) dst[n][k] = *(const LAS bf16x8*)(lds + PG8_SB(b, h) + boff + n * 2048 + k * 1024); } while (0)
#define PG8_MMA(ai, bj, At, Bt) do { __builtin_amdgcn_s_setprio(1); _Pragma("unroll") for (int m = 0; m < 4; ++m) _Pragma("unroll") for (int n = 0; n < 2; ++n) _Pragma("unroll") for (int k = 0; k < 2; ++k) \
        acc[ai][bj][m][n] = __builtin_amdgcn_mfma_f32_16x16x32_bf16(Bt[n][k], At[m][k], acc[ai][bj][m][n], 0, 0, 0); __builtin_amdgcn_s_setprio(0); } while (0)
#define PG8_WAIT_V(n) asm volatile("s_waitcnt vmcnt(" #n ")" ::: "memory")
#define PG8_WAIT_L(n) asm volatile("s_waitcnt lgkmcnt(" #n ")" ::: "memory")
#define PG8_BAR __builtin_amdgcn_s_barrier()
#define PG8_SCHED __builtin_amdgcn_sched_barrier(0)
    Unit cur, nxt; int ui = 0;
    if (!S.next(0, cur)) return;
    f32x4 acc[2][2][4][2];
#pragma unroll
    for (int a = 0; a < 2; ++a)
#pragma unroll
        for (int b = 0; b < 2; ++b)
#pragma unroll
            for (int m = 0; m < 4; ++m)
#pragma unroll
                for (int n = 0; n < 2; ++n) acc[a][b][m][n] = (f32x4){0.f, 0.f, 0.f, 0.f};
    bf16x8 At[4][2], B0[2][2], B1[2][2];
    const char* cA = (const char*)g.A + (size_t)cur.pm * tstepA + (size_t)(cur.pn / g.a_div) * g.a_step; const char* cB = (const char*)g.Bt + (size_t)cur.pn * tstepB;
    PG8_STAGE(PG8_SB(0, 0), cB, voffB); PG8_STAGE(PG8_SA(0, 0), cA, voffA); PG8_STAGE(PG8_SB(0, 1), cB + hstepB, voffB); PG8_STAGE(PG8_SA(0, 1), cA + hstepA, voffA);
    if (wr == 1) PG8_BAR;
    PG8_WAIT_V(4); PG8_BAR;
    PG8_STAGE(PG8_SB(1, 0), cB + kstep, voffB); PG8_STAGE(PG8_SA(1, 0), cA + kstep, voffA); PG8_STAGE(PG8_SB(1, 1), cB + hstepB + kstep, voffB);
    PG8_WAIT_V(6); PG8_BAR;
    for (;;) {
        const bool has_next = S.next(ui + 1, nxt);
        const char* nA = has_next ? (const char*)g.A + (size_t)nxt.pm * tstepA + (size_t)(nxt.pn / g.a_div) * g.a_step : cA; const char* nB = has_next ? (const char*)g.Bt + (size_t)nxt.pn * tstepB : cB;
        for (int t = 0; t < nt; t += 2) {
            const bool last = (t == nt - 2);
            const char* a1 = cA + (size_t)(t + 1) * kstep;
            const char* a2 = last ? nA : cA + (size_t)(t + 2) * kstep; const char* b2 = last ? nB : cB + (size_t)(t + 2) * kstep;
            const char* a3 = a2 + kstep; const char* b3 = b2 + kstep;
            PG8_LDB(B0, 0, 0); PG8_SCHED; PG8_LDA(At, 0, 0); PG8_STAGE(PG8_SA(1, 1), a1 + hstepA, voffA);
            PG8_WAIT_L(8); PG8_BAR; PG8_WAIT_L(0); PG8_MMA(0, 0, At, B0); PG8_BAR; PG8_SCHED;
            PG8_LDB(B1, 0, 1); PG8_STAGE(PG8_SB(0, 0), b2, voffB);
            PG8_BAR; PG8_WAIT_L(0); PG8_MMA(0, 1, At, B1); PG8_BAR;
            PG8_LDA(At, 0, 1); PG8_STAGE(PG8_SA(0, 0), a2, voffA);
            PG8_BAR; PG8_WAIT_L(0); PG8_MMA(1, 0, At, B0); PG8_BAR; PG8_SCHED;
            PG8_STAGE(PG8_SB(0, 1), b2 + hstepB, voffB);
            PG8_WAIT_V(6); PG8_BAR; PG8_MMA(1, 1, At, B1); PG8_BAR;
            PG8_LDB(B0, 1, 0); PG8_SCHED; PG8_LDA(At, 1, 0); PG8_STAGE(PG8_SA(0, 1), a2 + hstepA, voffA);
            PG8_WAIT_L(8); PG8_BAR; PG8_WAIT_L(0); PG8_MMA(0, 0, At, B0); PG8_BAR; PG8_SCHED;
            PG8_LDB(B1, 1, 1); PG8_STAGE(PG8_SB(1, 0), b3, voffB);
            PG8_BAR; PG8_WAIT_L(0); PG8_MMA(0, 1, At, B1); PG8_BAR;
            PG8_LDA(At, 1, 1); PG8_STAGE(PG8_SA(1, 0), a3, voffA);
            PG8_BAR; PG8_WAIT_L(0); PG8_MMA(1, 0, At, B0); PG8_BAR; PG8_SCHED;
            PG8_STAGE(PG8_SB(1, 1), b3 + hstepB, voffB);
            PG8_WAIT_V(6); PG8_BAR; PG8_MMA(1, 1, At, B1); PG8_BAR;
        }
        E(acc, cur, wr, wc, fr, fq);
        if (!has_next) break;
#pragma unroll
        for (int a = 0; a < 2; ++a)
#pragma unroll
            for (int b = 0; b < 2; ++b)
#pragma unroll
                for (int m = 0; m < 4; ++m)
#pragma unroll
                    for (int n = 0; n < 2; ++n) acc[a][b][m][n] = (f32x4){0.f, 0.f, 0.f, 0.f};
        cur = nxt; cA = nA; cB = nB; ++ui;
    }
    PG8_WAIT_V(0);
    if (wr == 0) PG8_BAR;
    PG8_BAR;
#undef PG8_SA
#undef PG8_SB
#undef PG8_STAGE
#undef PG8_LDA
#undef PG8_LDB
#undef PG8_MMA
#undef PG8_WAIT_V
#undef PG8_WAIT_L
#undef PG8_BAR
#undef PG8_SCHED
}
}

struct EpiMix {
    static constexpr bool PERM = true;
    bf16_t* C;
    __device__ __forceinline__ void operator()(const f32x4 (&acc)[2][2][4][2], const pg8::Unit& u, int wr, int wc, int fr, int fq) const {
#pragma unroll
        for (int ai = 0; ai < 2; ++ai)
#pragma unroll
            for (int m = 0; m < 4; ++m) { const int row = u.pm * 256 + ai * 128 + wr * 64 + m * 16 + fr;
#pragma unroll
                for (int bj = 0; bj < 2; ++bj) { const f32x4 v0 = acc[ai][bj][m][0], v1 = acc[ai][bj][m][1];
                    u32x4 w; w.x = cvt_pk_bf16(v0[0], v0[1]); w.y = cvt_pk_bf16(v0[2], v0[3]); w.z = cvt_pk_bf16(v1[0], v1[1]); w.w = cvt_pk_bf16(v1[2], v1[3]);
                    *(u32x4*)(C + (size_t)row * 1024 + u.pn * 256 + bj * 128 + wc * 32 + 8 * fq) = w; } }
    }
};

constexpr float LOG2E_F = 1.4426950408889634f;
constexpr float IW_SCALE = 0.35355339059327373f * 0.125f;

struct EpiEvenIn {
    static constexpr bool PERM = true;
    bf16_t *Q, *Kb, *VT, *AG, *IQ, *BQ, *BK, *BV, *BG, *IK; float *IW, *BLR;
    __device__ __forceinline__ void operator()(const f32x4 (&acc)[2][2][4][2], const pg8::Unit& u, int wr, int wc, int fr, int fq) const {
        const int pn = u.pn;
        bf16_t* dst = Q; int ld = 512, col0 = 0, mode = 0;
        if (pn < 2) { dst = Q; col0 = pn * 256; }
        else if (pn < 4) { dst = Kb; col0 = (pn - 2) * 256; }
        else if (pn < 6) { mode = 2; col0 = (pn - 4) * 256; }
        else if (pn < 8) { dst = AG; col0 = (pn - 6) * 256; mode = 1; }
        else if (pn < 10) { dst = IQ; col0 = (pn - 8) * 256; }
        else if (pn == 10) { dst = BQ; ld = 256; }
        else if (pn == 11) { dst = BK; ld = 256; }
        else if (pn < 14) { dst = BV; col0 = (pn - 12) * 256; }
        else if (pn < 16) { dst = BG; col0 = (pn - 14) * 256; mode = 1; }
        else mode = 3;
#pragma unroll
        for (int ai = 0; ai < 2; ++ai)
#pragma unroll
            for (int m = 0; m < 4; ++m) {
                const int row = u.pm * 256 + ai * 128 + wr * 64 + m * 16 + fr;
#pragma unroll
                for (int bj = 0; bj < 2; ++bj) {
                    const int cb = bj * 128 + wc * 32 + 8 * fq;
                    f32x4 v0 = acc[ai][bj][m][0], v1 = acc[ai][bj][m][1];
                    if (mode <= 1) {
                        if (mode == 1) {
#pragma unroll
                            for (int j = 0; j < 4; ++j) { v0[j] = silu_f(v0[j]); v1[j] = silu_f(v1[j]); }
                        }
                        u32x4 w; w.x = cvt_pk_bf16(v0[0], v0[1]); w.y = cvt_pk_bf16(v0[2], v0[3]); w.z = cvt_pk_bf16(v1[0], v1[1]); w.w = cvt_pk_bf16(v1[2], v1[3]);
                        *(u32x4*)(dst + (size_t)row * ld + col0 + cb) = w;
                    } else if (mode == 2) {
                        const int c = col0 + cb, head = c >> 6, d = c & 63, b = row >> 12, s = row & 4095;
                        bf16_t* p = VT + ((size_t)(b * 8 + head) * 64 + d) * 4096 + s;
#pragma unroll
                        for (int j = 0; j < 4; ++j) { p[(size_t)j * 4096] = f2bf(v0[j]); p[(size_t)(j + 4) * 4096] = f2bf(v1[j]); }
                    } else {
                        if (cb < 64) {
                            u32x4 w; w.x = cvt_pk_bf16(v0[0], v0[1]); w.y = cvt_pk_bf16(v0[2], v0[3]); w.z = cvt_pk_bf16(v1[0], v1[1]); w.w = cvt_pk_bf16(v1[2], v1[3]);
                            const int q = cb >> 3, bb = row >> 12, sq = row & 4095;
                            *(u32x4*)(IK + ((((size_t)(bb * 128 + (sq >> 5)) * 4 + (q >> 1)) * 2 + (q & 1)) * 32 + (sq & 31)) * 8) = w;
                        } else if (cb == 64) {
                            *(f32x4*)(IW + (size_t)row * 8) = v0 * IW_SCALE; *(f32x4*)(IW + (size_t)row * 8 + 4) = v1 * IW_SCALE;
                        } else if (cb == 72 || cb == 80) {
                            *(f32x4*)(BLR + (size_t)row * 16 + (cb - 72)) = v0; *(f32x4*)(BLR + (size_t)row * 16 + (cb - 72) + 4) = v1;
                        }
                    }
                }
            }
    }
};

struct EpiOddIn {
    static constexpr bool PERM = true;
    bf16_t *XR, *GS;
    __device__ __forceinline__ void operator()(const f32x4 (&acc)[2][2][4][2], const pg8::Unit& u, int wr, int wc, int fr, int fq) const {
        const int pn = u.pn; const bool gate = pn >= 4;
        bf16_t* dst = gate ? GS : XR; const int col0 = (pn & 3) * 256;
#pragma unroll
        for (int ai = 0; ai < 2; ++ai)
#pragma unroll
            for (int m = 0; m < 4; ++m) {
                const int row = u.pm * 256 + ai * 128 + wr * 64 + m * 16 + fr;
#pragma unroll
                for (int bj = 0; bj < 2; ++bj) {
                    const int cb = bj * 128 + wc * 32 + 8 * fq;
                    f32x4 v0 = acc[ai][bj][m][0], v1 = acc[ai][bj][m][1];
                    if (gate) {
#pragma unroll
                        for (int j = 0; j < 4; ++j) { v0[j] = silu_f(v0[j]); v1[j] = silu_f(v1[j]); }
                    }
                    u32x4 w; w.x = cvt_pk_bf16(v0[0], v0[1]); w.y = cvt_pk_bf16(v0[2], v0[3]); w.z = cvt_pk_bf16(v1[0], v1[1]); w.w = cvt_pk_bf16(v1[2], v1[3]);
                    if (gate) *(u32x4*)(GS + slab_idx(row, col0 + cb)) = w;
                    else *(u32x4*)(XR + (size_t)row * 1024 + col0 + cb) = w;
                }
            }
    }
};

struct EpiGates {
    static constexpr bool PERM = true;
    const float *b_a, *b_x, *lam; const bf16_t* XC; bf16_t* LOGA; bf16_t* U;
    __device__ __forceinline__ void operator()(const f32x4 (&acc)[2][2][4][2], const pg8::Unit& u, int wr, int wc, int fr, int fq) const {
        const int chb = (u.pn >> 1) * 256 + (u.pn & 1) * 128 + wc * 32 + 8 * fq;
#pragma unroll
        for (int nh = 0; nh < 2; ++nh) {
            const int ch0 = chb + 4 * nh;
            const f32x4 lm = *(const f32x4*)(lam + ch0);
            const f32x4 nba = *(const f32x4*)(b_a + ch0) * (-LOG2E_F), nbx = *(const f32x4*)(b_x + ch0) * (-LOG2E_F);
            f32x4 c8;
#pragma unroll
            for (int j = 0; j < 4; ++j) c8[j] = (-8.0f * LOG2E_F) * (fmaxf(-lm[j], 0.f) + log1p_01(__expf(-fabsf(lm[j]))));
#pragma unroll
            for (int ai = 0; ai < 2; ++ai)
#pragma unroll
                for (int m = 0; m < 4; ++m) {
                    const int row = u.pm * 256 + ai * 128 + wr * 64 + m * 16 + fr;
                    const u32x2 xw = *(const u32x2*)(XC + (size_t)row * 1024 + ch0);
                    const float xv[4] = {bflo(xw.x), bfhi(xw.x), bflo(xw.y), bfhi(xw.y)};
                    f32x4 la; float uu[4];
#pragma unroll
                    for (int j = 0; j < 4; ++j) {
                        const float r = __builtin_amdgcn_rcpf(1.0f + __builtin_amdgcn_exp2f(__builtin_fmaf(acc[ai][0][m][nh][j], -LOG2E_F, nba[j])));
                        const float ig = __builtin_amdgcn_rcpf(1.0f + __builtin_amdgcn_exp2f(__builtin_fmaf(acc[ai][1][m][nh][j], -LOG2E_F, nbx[j])));
                        const float l2 = c8[j] * r, av = __builtin_amdgcn_exp2f(l2);
                        la[j] = l2;
                        uu[j] = __builtin_amdgcn_sqrtf(fmaxf(__builtin_fmaf(-av, av, 1.0f), 0.f)) * ig * xv[j];
                    }
                    { u32x2 lw; lw.x = cvt_pk_bf16(la[0], la[1]); lw.y = cvt_pk_bf16(la[2], la[3]); *(u32x2*)(LOGA + slab_idx(row, ch0)) = lw; }
                    u32x2 w; w.x = cvt_pk_bf16(uu[0], uu[1]); w.y = cvt_pk_bf16(uu[2], uu[3]);
                    *(u32x2*)(U + slab_idx(row, ch0)) = w;
                }
        }
    }
};

struct Args {
    const float* x; const float* rel_bias; const float* pre_norm; const float* post_norm;
    const float* even_w_in; const float* even_gate_w2; const float* even_gate_b2; const float* even_w_out;
    const float* odd_w_in; const float* odd_conv_w; const float* odd_conv_b; const float* odd_w_a; const float* odd_b_a;
    const float* odd_w_x; const float* odd_b_x; const float* odd_lambda; const float* odd_w_out;
    float* out; unsigned char* ws; int ph_lo, ph_hi;
};

typedef const Args __attribute__((address_space(4)))* ArgsP;
__device__ __forceinline__ ArgsP get_args() { ArgsP p = (ArgsP)__builtin_amdgcn_kernarg_segment_ptr(); asm volatile("" : "+s"(p)); return p; }

constexpr int WT_EIN = 2 * 68 * 16, WT_EOUT = 2 * 256, WT_OIN = 2 * 512, WT_OOUT = 2 * 256, WT_GATE = 2 * 128, WT_ALL = WT_EIN + WT_EOUT + WT_OIN + WT_OOUT + WT_GATE;
__device__ __forceinline__ void wtile_decode(int T, ArgsP ap, unsigned char* ws, int nl, int wn, const float*& colp, int& ld, bf16_t*& drow, int& K, const float*& ksc) {
    ksc = nullptr;
    if (T < WT_EIN) { const int e = T / 1088, r = T % 1088, tn = r % 68, tk = r / 68; K = 1024; ld = EVEN_IN;
        const int n = tn * 64 + nl; int c; bool ok = true; if (n < 2560) c = n; else if (n < 4096) c = n + 72; else if (n < 4168) c = n - 1536; else if (n < 4184) c = n; else { c = 0; ok = false; }
        ksc = ap->pre_norm + (size_t)(2 * e) * DM + tk * 64;
        colp = ok ? ap->even_w_in + ((size_t)e * 1024 + tk * 64) * EVEN_IN + c : nullptr;
        drow = (bf16_t*)(ws + WS_WEIN) + ((size_t)e * NE + tn * 64 + wn) * 1024 + tk * 64; return; }
    T -= WT_EIN;
    if (T < WT_EOUT) { const int e = T / 256, r = T % 256, tn = r % 16, tk = r / 16; K = 1024; ld = 1024;
        colp = ap->even_w_out + ((size_t)e * 1024 + tk * 64) * 1024 + tn * 64 + nl; drow = (bf16_t*)(ws + WS_WEOUT) + ((size_t)e * 1024 + tn * 64 + wn) * 1024 + tk * 64; return; }
    T -= WT_EOUT;
    if (T < WT_OIN) { const int e = T / 512, r = T % 512, tn = r % 32, tk = r / 32; K = 1024; ld = 2048;
        ksc = ap->pre_norm + (size_t)(2 * e + 1) * DM + tk * 64;
        colp = ap->odd_w_in + ((size_t)e * 1024 + tk * 64) * 2048 + tn * 64 + nl; drow = (bf16_t*)(ws + WS_WOIN) + ((size_t)e * 2048 + tn * 64 + wn) * 1024 + tk * 64; return; }
    T -= WT_OIN;
    if (T < WT_OOUT) { const int e = T / 256, r = T % 256, tn = r % 16, tk = r / 16; K = 1024; ld = 1024;
        colp = ap->odd_w_out + ((size_t)e * 1024 + tk * 64) * 1024 + tn * 64 + nl; drow = (bf16_t*)(ws + WS_WOOUT) + ((size_t)e * 1024 + tn * 64 + wn) * 1024 + tk * 64; return; }
    T -= WT_OOUT;
    {
        const int o = T / 128, r = T % 128, tn = r % 32, tk = r / 32; K = 256; ld = 256;
        const int cp = tn * 64, nb = cp >> 9, j = (cp >> 8) & 1, gs = (cp >> 7) & 1, e0 = j * 128 + (cp & 127);
        const float* src = gs ? ap->odd_w_x : ap->odd_w_a;
        colp = src + (((size_t)(o * 4 + nb)) * 256 + tk * 64) * 256 + e0 + nl; drow = (bf16_t*)(ws + WS_WOG) + ((size_t)o * 2048 + cp + wn) * 256 + tk * 64; }
}
__device__ __forceinline__ void weight_phase(LAS float* tile, ArgsP ap, unsigned char* ws) {
    constexpr int TS = 64 * 65;
    const int tid = opaque_tid(), G = gridDim.x, lane = tid & 63, w = tid >> 6, sub = lane >> 4, n4 = (lane & 15) * 4, wn = tid >> 3, wk = (tid & 7) * 8;
    f32x4 r[8]; const float* colp; const float* ksc; bf16_t* dd; int ld, K;
#define WT_LOAD() do { _Pragma("unroll") for (int i = 0; i < 8; ++i) { if (colp) { const f32x4 q_ = *(const f32x4*)(colp + (size_t)(w + 8 * i) * ld); r[i] = q_ * (ksc ? ksc[w + 8 * i] : 1.0f); } \
            else r[i] = (f32x4){0.f, 0.f, 0.f, 0.f}; } } while (0)
    int M = blockIdx.x;
    if (M < WT_ALL / 4) { wtile_decode(4 * M + sub, ap, ws, n4, 0, colp, ld, dd, K, ksc); WT_LOAD(); }
    for (; M < WT_ALL / 4; M += G) {
#pragma unroll
        for (int i = 0; i < 8; ++i) { LAS float* p = tile + sub * TS + (w + 8 * i) * 65 + n4; p[0] = r[i][0]; p[1] = r[i][1]; p[2] = r[i][2]; p[3] = r[i][3]; }
        __syncthreads();
        const int Mc = M;
        if (M + G < WT_ALL / 4) { wtile_decode(4 * (M + G) + sub, ap, ws, n4, 0, colp, ld, dd, K, ksc); WT_LOAD(); }
#pragma unroll
        for (int j = 0; j < 4; ++j) {
            const float* c2; const float* k2; bf16_t* drow; int l2, K2;
            wtile_decode(4 * Mc + j, ap, ws, 0, wn, c2, l2, drow, K2, k2);
            float v[8];
#pragma unroll
            for (int q = 0; q < 8; ++q) v[q] = tile[j * TS + (wk + q) * 65 + wn];
            u32x4 wv; wv.x = cvt_pk_bf16(v[0], v[1]); wv.y = cvt_pk_bf16(v[2], v[3]); wv.z = cvt_pk_bf16(v[4], v[5]); wv.w = cvt_pk_bf16(v[6], v[7]);
            *(u32x4*)(drow + wk) = wv; }
        __syncthreads();
    }
#undef WT_LOAD
}

__device__ __forceinline__ int t5_bucket(int n) {
    if (n < 16) return n;
    int v = 16 + (int)(__logf((float)n / 16.0f) / 2.0794415416798357f * 16.0f);
    return v < 31 ? v : 31;
}

__device__ __forceinline__ void norm_phase(const float* xin, const bf16_t* xh_in, const float* s_in, const bf16_t* mix, const float* postw, bf16_t* xh_out, float* s_out, float* outf) {
    const int tid0 = opaque_tid(), lane = tid0 & 63, wave = tid0 >> 6;
    for (int row = blockIdx.x * 8 + wave; row < T; row += gridDim.x * 8) {
        f32x4 xv[4];
        if (xin) {
#pragma unroll
            for (int i = 0; i < 4; ++i) xv[i] = *(const f32x4*)(xin + (size_t)row * DM + lane * 4 + 256 * i);
        } else {
            const float sc = s_in[row];
#pragma unroll
            for (int i = 0; i < 4; ++i) { const u32x2 xw = *(const u32x2*)(xh_in + (size_t)row * DM + lane * 4 + 256 * i); xv[i] = (f32x4){bflo(xw.x), bfhi(xw.x), bflo(xw.y), bfhi(xw.y)} * sc; }
        }
        if (mix) {
            f32x4 mv[4]; float ss = 0.f;
#pragma unroll
            for (int i = 0; i < 4; ++i) { const u32x2 mw = *(const u32x2*)(mix + (size_t)row * DM + lane * 4 + 256 * i); mv[i] = (f32x4){bflo(mw.x), bfhi(mw.x), bflo(mw.y), bfhi(mw.y)};
                ss += mv[i][0] * mv[i][0] + mv[i][1] * mv[i][1] + mv[i][2] * mv[i][2] + mv[i][3] * mv[i][3]; }
#pragma unroll
            for (int o = 32; o >= 1; o >>= 1) ss += __shfl_xor(ss, o);
            const float r = rsqrtf(ss * (1.0f / DM) + EPS);
#pragma unroll
            for (int i = 0; i < 4; ++i) { const f32x4 w = *(const f32x4*)(postw + lane * 4 + 256 * i); xv[i] += mv[i] * r * w; }
        }
        if (outf) {
#pragma unroll
            for (int i = 0; i < 4; ++i) *(f32x4*)(outf + (size_t)row * DM + lane * 4 + 256 * i) = xv[i];
        } else {
            float ss = 0.f;
#pragma unroll
            for (int i = 0; i < 4; ++i) ss += xv[i][0] * xv[i][0] + xv[i][1] * xv[i][1] + xv[i][2] * xv[i][2] + xv[i][3] * xv[i][3];
#pragma unroll
            for (int o = 32; o >= 1; o >>= 1) ss += __shfl_xor(ss, o);
            const float ms = ss * (1.0f / DM) + EPS, r = rsqrtf(ms);
            if (lane == 0) s_out[row] = ms * r;
#pragma unroll
            for (int i = 0; i < 4; ++i) { const f32x4 y = xv[i] * r;
                u32x2 o2; o2.x = cvt_pk_bf16(y[0], y[1]); o2.y = cvt_pk_bf16(y[2], y[3]); *(u32x2*)(xh_out + (size_t)row * DM + lane * 4 + 256 * i) = o2; }
        }
    }
}

constexpr int NM_LD = 1032;
__device__ __forceinline__ void norm_misc_phase(LAS unsigned char* lds, const float* xin, const bf16_t* xh_in, const float* s_in, const bf16_t* mix, const float* postw, bf16_t* xh_out, float* s_out,
                                                const bf16_t* Wm  , bf16_t* IK, float* IW, float* BLR) {
    const int tid0 = opaque_tid(), lane = tid0 & 63, wave = __builtin_amdgcn_readfirstlane(tid0 >> 6);
    LAS bf16_t* xs = (LAS bf16_t*)lds;
    for (int pq = blockIdx.x; pq < T / 64; pq += gridDim.x) {
        for (int i = 0; i < 8; ++i) {
            const int rl = wave * 8 + i, row = pq * 64 + rl;
            f32x4 xv[4];
            if (xin) {
#pragma unroll
                for (int k = 0; k < 4; ++k) xv[k] = *(const f32x4*)(xin + (size_t)row * DM + lane * 4 + 256 * k);
            } else {
                const float sc = s_in[row];
#pragma unroll
                for (int k = 0; k < 4; ++k) { const u32x2 xw = *(const u32x2*)(xh_in + (size_t)row * DM + lane * 4 + 256 * k); xv[k] = (f32x4){bflo(xw.x), bfhi(xw.x), bflo(xw.y), bfhi(xw.y)} * sc; }
            }
            if (mix) {
                f32x4 mv[4]; float ss = 0.f;
#pragma unroll
                for (int k = 0; k < 4; ++k) { const u32x2 mw = *(const u32x2*)(mix + (size_t)row * DM + lane * 4 + 256 * k); mv[k] = (f32x4){bflo(mw.x), bfhi(mw.x), bflo(mw.y), bfhi(mw.y)};
                    ss += mv[k][0] * mv[k][0] + mv[k][1] * mv[k][1] + mv[k][2] * mv[k][2] + mv[k][3] * mv[k][3]; }
#pragma unroll
                for (int o = 32; o >= 1; o >>= 1) ss += __shfl_xor(ss, o);
                const float r = rsqrtf(ss * (1.0f / DM) + EPS);
#pragma unroll
                for (int k = 0; k < 4; ++k) { const f32x4 w = *(const f32x4*)(postw + lane * 4 + 256 * k); xv[k] += mv[k] * r * w; }
            }
            float ss = 0.f;
#pragma unroll
            for (int k = 0; k < 4; ++k) ss += xv[k][0] * xv[k][0] + xv[k][1] * xv[k][1] + xv[k][2] * xv[k][2] + xv[k][3] * xv[k][3];
#pragma unroll
            for (int o = 32; o >= 1; o >>= 1) ss += __shfl_xor(ss, o);
            const float ms = ss * (1.0f / DM) + EPS, r = rsqrtf(ms);
            if (lane == 0) s_out[row] = ms * r;
#pragma unroll
            for (int k = 0; k < 4; ++k) { const f32x4 y = xv[k] * r;
                u32x2 o2; o2.x = cvt_pk_bf16(y[0], y[1]); o2.y = cvt_pk_bf16(y[2], y[3]);
                *(u32x2*)(xh_out + (size_t)row * DM + lane * 4 + 256 * k) = o2; *(LAS u32x2*)(xs + rl * NM_LD + lane * 4 + 256 * k) = o2; }
        }
        __syncthreads();
        if (wave < 6) {
            const int n = lane & 15, kq = lane >> 4;
            f32x4 acc[4];
#pragma unroll
            for (int mt = 0; mt < 4; ++mt) acc[mt] = (f32x4){0.f, 0.f, 0.f, 0.f};
            const bf16_t* wrow = Wm + (size_t)(16 * wave + n) * 1024 + 8 * kq;
            for (int ks = 0; ks < 32; ks += 4) {
                bf16x8 bf[4];
#pragma unroll
                for (int u = 0; u < 4; ++u) bf[u] = *(const bf16x8*)(wrow + (ks + u) * 32);
#pragma unroll
                for (int u = 0; u < 4; ++u)
#pragma unroll
                    for (int mt = 0; mt < 4; ++mt) { const bf16x8 af = *(const LAS bf16x8*)(xs + (16 * mt + n) * NM_LD + (ks + u) * 32 + 8 * kq);
                        acc[mt] = __builtin_amdgcn_mfma_f32_16x16x32_bf16(af, bf[u], acc[mt], 0, 0, 0); }
            }
#pragma unroll
            for (int mt = 0; mt < 4; ++mt)
#pragma unroll
                for (int j = 0; j < 4; ++j) { const int row = pq * 64 + 16 * mt + 4 * kq + j; const float v = acc[mt][j];
                    if (wave < 4) { const int cc = 16 * wave + n, q = cc >> 3, bb = row >> 12, sq = row & 4095;
                        IK[((((size_t)(bb * 128 + (sq >> 5)) * 4 + (q >> 1)) * 2 + (q & 1)) * 32 + (sq & 31)) * 8 + (cc & 7)] = f2bf(v); }
                    else if (wave == 4) { if (n < 8) IW[(size_t)row * 8 + n] = v * IW_SCALE; else BLR[(size_t)row * 16 + (n - 8)] = v; }
                    else { if (n < 8) BLR[(size_t)row * 16 + 8 + n] = v; } }
        }
        __syncthreads();
    }
}

#define IDX_AF(AF, b_, t0_) do { \
        const int qi_ = 2 * ((c >> 2) & 1) + (c >> 4), hh_ = (c & 3) + 4 * ((c >> 3) & 1);   \
        _Pragma("unroll") for (int mt = 0; mt < 2; ++mt) { const size_t tq_ = (size_t)(b_) * SEQ + (t0_) + 4 * mt + qi_; \
            _Pragma("unroll") for (int ks = 0; ks < 4; ++ks) AF[mt][ks] = *(const bf16x8*)(IQ + tq_ * 512 + hh_ * 64 + ks * 16 + 8 * g); } } while (0)
#define IDX_WV(WV, b_, t0_) do { \
        _Pragma("unroll") for (int mt = 0; mt < 2; ++mt) _Pragma("unroll") for (int qq = 0; qq < 2; ++qq) { const size_t tq_ = (size_t)(b_) * SEQ + (t0_) + 4 * mt + 2 * g + qq; \
            const f32x4 w0_ = *(const f32x4*)(IW + tq_ * 8), w1_ = *(const f32x4*)(IW + tq_ * 8 + 4); \
            WV[mt][qq][0] = w0_[0]; WV[mt][qq][1] = w0_[1]; WV[mt][qq][2] = w0_[2]; WV[mt][qq][3] = w0_[3]; WV[mt][qq][4] = w1_[0]; WV[mt][qq][5] = w1_[1]; WV[mt][qq][6] = w1_[2]; WV[mt][qq][7] = w1_[3]; } } while (0)

__device__ __forceinline__ void indexer_phase(LAS float* sc, const bf16_t* IQ, const bf16_t* IK, const float* IW, u64* MASK, int wave, int lane) {
    const int g = lane >> 5, c = lane & 31, G = gridDim.x;
    bf16x8 af[2][4];
#define IDX_ITEM(k_) ((k_) * G + (((k_) & 1) ? (G - 1 - (int)blockIdx.x) : (int)blockIdx.x))
    { const int it0 = IDX_ITEM(0); if (it0 < 2048) IDX_AF(af, it0 & 3, (511 - (it0 >> 2)) * 8); }
        for (int kk = 0; kk * G < 2048; ++kk) {
    const int it = IDX_ITEM(kk); if (it >= 2048) break;
    const int b = it & 3, t0 = (511 - (it >> 2)) * 8;
    float wv[2][2][8];
    IDX_WV(wv, b, t0);
    const int ntiles = (t0 + 8 + 31) >> 5;
    const bf16_t* ikb = IK + (size_t)b * 128 * 2048 + (size_t)(g * 32 + c) * 8;
#define IDX_LOAD(buf, kt_) do { if ((kt_) < ntiles) { _Pragma("unroll") for (int ks = 0; ks < 4; ++ks) buf[ks] = *(const bf16x8*)(ikb + (size_t)(kt_) * 2048 + ks * 512); } } while (0)
#define IDX_TILE(buf, kt_) do { if ((kt_) < ntiles) { const int key = (kt_) * 32 + c; f32x16 a0, a1; \
        _Pragma("unroll") for (int r = 0; r < 16; ++r) { a0[r] = 0.f; a1[r] = 0.f; } \
        _Pragma("unroll") for (int ks = 0; ks < 4; ++ks) { a0 = __builtin_amdgcn_mfma_f32_32x32x16_bf16(af[0][ks], buf[ks], a0, 0, 0, 0); a1 = __builtin_amdgcn_mfma_f32_32x32x16_bf16(af[1][ks], buf[ks], a1, 0, 0, 0); } \
        _Pragma("unroll") for (int qq = 0; qq < 2; ++qq) { float s0 = 0.f, s1 = 0.f; \
            _Pragma("unroll") for (int h = 0; h < 8; ++h) { s0 += wv[0][qq][h] * relu_bits(a0[8 * qq + h]); s1 += wv[1][qq][h] * relu_bits(a1[8 * qq + h]); } \
            sc[(0 + 2 * g + qq) * 4096 + key] = s0; sc[(4 + 2 * g + qq) * 4096 + key] = s1; } } } while (0)
    {
        bf16x8 b0[4], b1[4], b2[4];
        IDX_LOAD(b0, wave); IDX_LOAD(b1, wave + 8);
        for (int kt = wave; kt < ntiles; kt += 24) {
            IDX_LOAD(b2, kt + 16); IDX_TILE(b0, kt);
            IDX_LOAD(b0, kt + 24); IDX_TILE(b1, kt + 8);
            IDX_LOAD(b1, kt + 32); IDX_TILE(b2, kt + 16);
        }
    }
#undef IDX_LOAD
#undef IDX_TILE
    __syncthreads();
    bf16x8 afn[2][4];
    { const int itn = IDX_ITEM(kk + 1); if ((kk + 1) * G < 2048 && itn < 2048) IDX_AF(afn, itn & 3, (511 - (itn >> 2)) * 8); }
    {
        const int t = t0 + wave, nvalid = t + 1, nreg = (nvalid + 63) >> 6, ngrp = (nreg + 7) >> 3;
        const int gfull = nvalid >> 9;
        LAS float* myrow = sc + wave * 4096;
        float sf[64];
#pragma unroll
        for (int jj = 0; jj < 8; ++jj) {
            if (jj < gfull) {
#pragma unroll
                for (int j8 = 0; j8 < 8; ++j8) sf[jj * 8 + j8] = myrow[64 * (jj * 8 + j8) + lane];
            } else if (jj < ngrp) {
#pragma unroll
                for (int j8 = 0; j8 < 8; ++j8) { const int j = jj * 8 + j8, kk = 64 * j + lane; const float v = myrow[kk]; sf[j] = (kk < nvalid) ? v : NEG_INF; }
            } else {
#pragma unroll
                for (int j8 = 0; j8 < 8; ++j8) sf[jj * 8 + j8] = NEG_INF;
            }
        }
        float thr_f = NEG_INF; int need = 0; bool ties = false;
#define CNT_GEF(valf, out) do { int c_ = 0; _Pragma("unroll") for (int jj = 0; jj < 8; ++jj) if (jj < ngrp) { _Pragma("unroll") for (int j8 = 0; j8 < 8; ++j8) c_ += (sf[jj * 8 + j8] >= (valf)) ? 1 : 0; } \
            (out) = wave_sum_i32(c_); } while (0)
        if (nvalid > 256) {
            float mx = NEG_INF, mn = -NEG_INF;
#pragma unroll
            for (int jj = 0; jj < 8; ++jj) { if (jj < gfull) {
#pragma unroll
                for (int j8 = 0; j8 < 8; j8 += 2) {
                    asm("v_max3_f32 %0, %0, %1, %2" : "+v"(mx) : "v"(sf[jj * 8 + j8]), "v"(sf[jj * 8 + j8 + 1])); asm("v_min3_f32 %0, %0, %1, %2" : "+v"(mn) : "v"(sf[jj * 8 + j8]), "v"(sf[jj * 8 + j8 + 1])); } }
              else if (jj < ngrp) {
#pragma unroll
                for (int j8 = 0; j8 < 8; ++j8) { const float v = sf[jj * 8 + j8]; mx = fmaxf(mx, v); mn = fminf(mn, v == NEG_INF ? -NEG_INF : v); } } }
            mx = wave_max_f32(mx); mn = -wave_max_f32(-mn);
            const float scale = (mx > mn) ? 3839.0f / (mx - mn) : 0.f;
            LAS unsigned* hist = (LAS unsigned*)myrow;
#pragma unroll
            for (int k = 0; k < 16; ++k) *(LAS u32x4*)(hist + 4 * lane + 256 * k) = (u32x4){0u, 0u, 0u, 0u};
            __builtin_amdgcn_fence(__ATOMIC_RELEASE, "wavefront");
#pragma unroll
            for (int jj = 0; jj < 8; ++jj) { if (jj < gfull) {
#pragma unroll
                for (int j8 = 0; j8 < 8; ++j8) { const float v = sf[jj * 8 + j8];
                    int bn = (int)((v - mn) * scale); bn = bn > 3839 ? 3839 : bn; __hip_atomic_fetch_add(hist + (bn >> 6) * 68 + (bn & 63), 1u, __ATOMIC_RELAXED, __HIP_MEMORY_SCOPE_WAVEFRONT); } }
              else if (jj < ngrp) {
#pragma unroll
                for (int j8 = 0; j8 < 8; ++j8) { const float v = sf[jj * 8 + j8];
                    if (v != NEG_INF) { int bn = (int)((v - mn) * scale); bn = bn > 3839 ? 3839 : bn; __hip_atomic_fetch_add(hist + (bn >> 6) * 68 + (bn & 63), 1u, __ATOMIC_RELAXED, __HIP_MEMORY_SCOPE_WAVEFRONT); } } } }
            __builtin_amdgcn_fence(__ATOMIC_ACQ_REL, "wavefront");
            int cs = 0;
            if (lane < 60) {
#pragma unroll
                for (int k = 0; k < 16; ++k) { const u32x4 h4 = *(const LAS u32x4*)(hist + lane * 68 + 4 * k); cs += (int)((h4.x + h4.y) + (h4.z + h4.w)); }
            }
            int C, Bl, cnt_above, nA;
            {
                const int pre = wave_prefix_sum_i32(cs), tot = __builtin_amdgcn_readlane(pre, 63), suf = tot - pre + cs;
                const u64 mk = __ballot(suf >= 256);
                C = 63 - __builtin_clzll(mk);
                const int above_c = __builtin_amdgcn_readlane(suf, C) - __builtin_amdgcn_readlane(cs, C);
                const int bs = (int)hist[C * 68 + lane];
                const int pre2 = wave_prefix_sum_i32(bs), tot2 = __builtin_amdgcn_readlane(pre2, 63), suf2 = tot2 - pre2 + bs;
                const u64 mk2 = __ballot(suf2 >= 256 - above_c);
                Bl = 63 - __builtin_clzll(mk2);
                nA = __builtin_amdgcn_readlane(bs, Bl);
                cnt_above = above_c + __builtin_amdgcn_readlane(suf2, Bl) - nA;
            }
            const int binA = C * 64 + Bl, need1 = 256 - cnt_above;
            if (nA <= 64) {
                unsigned cv = 0u; int pos = 0;
                const float invs = (mx - mn) * (1.0f / 3839.0f), lo_f = mn + ((float)binA - 0.5f) * invs, hi_f = mn + ((float)binA + 1.5f) * invs;
#pragma unroll
                for (int jj = 0; jj < 8; ++jj) if (jj < ngrp) {
#pragma unroll
                    for (int j8 = 0; j8 < 8; ++j8) { const float v = sf[jj * 8 + j8];
                        u64 m = __ballot(v >= lo_f && v < hi_f);
                        if (m) { int bn = (int)((v - mn) * scale); bn = bn > 3839 ? 3839 : bn; m = __ballot(v >= lo_f && v < hi_f && bn == binA); }
                        while (m) { const int l = __builtin_ctzll(m); m &= m - 1ull; const unsigned uu = (unsigned)__builtin_amdgcn_readlane((int)__float_as_uint(v), l);
                            const unsigned kv = (uu & 0x80000000u) ? ~uu : (uu | 0x80000000u); if (lane == pos) cv = kv; ++pos; } } }
                unsigned tc = 0u;
                for (int bit = 31; bit >= 0; --bit) { const unsigned cand = tc | (1u << bit); if (__popcll(__ballot(cv >= cand)) >= need1) tc = cand; }
                thr_f = __uint_as_float((tc & 0x80000000u) ? (tc ^ 0x80000000u) : ~tc);
                const int cgt = cnt_above + __popcll(__ballot(cv > tc)), ceq = __popcll(__ballot(cv == tc));
                need = 256 - cgt; ties = (ceq != need);
            } else {
                unsigned tc = 0u;
                for (int bit = 31; bit >= 0; --bit) { const unsigned cand = tc | (1u << bit); const float cf = __uint_as_float((cand & 0x80000000u) ? (cand ^ 0x80000000u) : ~cand);
                    int cnt; CNT_GEF(cf, cnt); if (cnt >= 256) tc = cand; }
                thr_f = __uint_as_float((tc & 0x80000000u) ? (tc ^ 0x80000000u) : ~tc);
                int cge, cg = 0;
                CNT_GEF(thr_f, cge);
#pragma unroll
                for (int jj = 0; jj < 8; ++jj) if (jj < ngrp) {
#pragma unroll
                    for (int j8 = 0; j8 < 8; ++j8) cg += (sf[jj * 8 + j8] > thr_f) ? 1 : 0; }
                const int cgt = wave_sum_i32(cg);
                need = 256 - cgt; ties = ((cge - cgt) != need);
            }
        }
#undef CNT_GEF
        u64 myword = 0ull;
        if (nvalid <= 256) {
#pragma unroll
            for (int j = 0; j < 4; ++j) { const u64 mm = __ballot(64 * j + lane < nvalid); if (lane == j) myword = mm; }
        } else if (!ties) {
#pragma unroll
            for (int jj = 0; jj < 8; ++jj) if (jj < ngrp) {
#pragma unroll
                for (int j8 = 0; j8 < 8; ++j8) { const int j = jj * 8 + j8; const u64 mm = __ballot(sf[j] >= thr_f); if (lane == j) myword = mm; if ((j & 3) == 3) __builtin_amdgcn_sched_barrier(0); } }
        } else {
            int base = 0;
#pragma unroll
            for (int j = 0; j < 64; ++j) { const bool eq = sf[j] == thr_f; const u64 em = __ballot(eq);
                const int rank = base + (int)__builtin_amdgcn_mbcnt_hi((unsigned)(em >> 32), __builtin_amdgcn_mbcnt_lo((unsigned)em, 0u));
                const u64 mm = __ballot(sf[j] > thr_f || (eq && rank < need)); base += __popcll(em);
                if (lane == j) myword = mm; __builtin_amdgcn_sched_barrier(0); }
        }
        LAS u64* mst = (LAS u64*)(sc + 32768);
        mst[lane * 8 + wave] = myword;
    }
    __syncthreads();
    { const int tid_ = wave * 64 + lane, kt_ = tid_ >> 3, q_ = tid_ & 7; const LAS u64* mst = (const LAS u64*)(sc + 32768);
      MASK[((size_t)b * 64 + kt_) * SEQ + t0 + q_] = mst[kt_ * 8 + q_]; }
#pragma unroll
    for (int mt = 0; mt < 2; ++mt) {
#pragma unroll
        for (int ks = 0; ks < 4; ++ks) af[mt][ks] = afn[mt][ks];
    }
    }
}
#undef IDX_AF
#undef IDX_WV
#undef IDX_ITEM

constexpr int GL_BLR = 0;
constexpr int GL_W2  = GL_BLR + 4096;
constexpr int GL_GP  = GL_W2 + 4096;
constexpr int GL_QD  = GL_GP + 2048;
constexpr int GL_KD  = GL_QD + 64 * 72 * 2;
constexpr int GL_KT  = GL_KD + 64 * 72 * 2;
constexpr int GL_VT  = GL_KT + 64 * 72 * 2;
constexpr int GL_P   = GL_VT + 128 * 72 * 2;
constexpr int GL_O   = GL_P + 64 * 72 * 2;
constexpr int GL_END = GL_O + 64 * 132 * 4;

__device__ __forceinline__ void gla_stage_vt(LAS bf16_t* vt, const u32x4 (&vraw)[2], int tid) {
#pragma unroll
    for (int rep = 0; rep < 2; ++rep) { const int idx = tid + 512 * rep, j = idx >> 4, dv8 = (idx & 15) * 8;
        const u32x4 w = vraw[rep];
        vt[(dv8 + 0) * 72 + j] = (bf16_t)(w.x & 0xFFFF); vt[(dv8 + 1) * 72 + j] = (bf16_t)(w.x >> 16);
        vt[(dv8 + 2) * 72 + j] = (bf16_t)(w.y & 0xFFFF); vt[(dv8 + 3) * 72 + j] = (bf16_t)(w.y >> 16);
        vt[(dv8 + 4) * 72 + j] = (bf16_t)(w.z & 0xFFFF); vt[(dv8 + 5) * 72 + j] = (bf16_t)(w.z >> 16);
        vt[(dv8 + 6) * 72 + j] = (bf16_t)(w.w & 0xFFFF); vt[(dv8 + 7) * 72 + j] = (bf16_t)(w.w >> 16); }
}
__device__ __forceinline__ void gla_prep_state(LAS unsigned char* lds, const float* gw2, const float* gb2, int b, int hh, int n,
                                               bf16_t* BQ, bf16_t* BK, const bf16_t* BV, const float* BLR, float* DECAY) {
    const int tid = opaque_tid(), d = tid & 63, jg = tid >> 6;
    const size_t tok0 = (size_t)b * SEQ + n * 64;
    LAS float* blr = (LAS float*)(lds + GL_BLR); LAS float* w2s = (LAS float*)(lds + GL_W2); LAS float* gp = (LAS float*)(lds + GL_GP);
    LAS bf16_t* kt = (LAS bf16_t*)(lds + GL_KT); LAS bf16_t* vt = (LAS bf16_t*)(lds + GL_VT);
    bf16_t kraw[8], qraw[8]; u32x4 vraw[2];
#pragma unroll
    for (int i = 0; i < 8; ++i) { kraw[i] = BK[(tok0 + 8 * jg + i) * 256 + hh * 64 + d]; qraw[i] = BQ[(tok0 + 8 * jg + i) * 256 + hh * 64 + d]; }
#pragma unroll
    for (int rep = 0; rep < 2; ++rep) { const int idx = tid + 512 * rep; vraw[rep] = *(const u32x4*)(BV + (tok0 + (idx >> 4)) * 512 + hh * 128 + (idx & 15) * 8); }
    if (tid < 256) { *(LAS f32x4*)(blr + tid * 4) = *(const f32x4*)(BLR + tok0 * 16 + tid * 4); }
    else { const int q = tid - 256, r = q >> 4, d4 = (q & 15) * 4; *(LAS f32x4*)(w2s + r * 64 + d4) = *(const f32x4*)(gw2 + (size_t)r * 256 + hh * 64 + d4); }
    __syncthreads();
    float cs[8];
    { const float b2 = gb2[hh * 64 + d]; float run = 0.f; float w2c[16];
#pragma unroll
      for (int r = 0; r < 16; ++r) w2c[r] = w2s[r * 64 + d];
#pragma unroll
      for (int i = 0; i < 8; ++i) { float z = b2;
#pragma unroll
          for (int q = 0; q < 4; ++q) { const f32x4 bl = *(const LAS f32x4*)(blr + (8 * jg + i) * 16 + 4 * q);
              z += bl[0] * w2c[4 * q + 0]; z += bl[1] * w2c[4 * q + 1]; z += bl[2] * w2c[4 * q + 2]; z += bl[3] * w2c[4 * q + 3]; }
          const float la = -(fmaxf(-z, 0.f) + __logf(1.0f + __expf(-fabsf(z)))) * (1.0f / 16.0f);
          run += la; cs[i] = run; }
      gp[jg * 64 + d] = run; }
    __syncthreads();
    float off = 0.f, glast = 0.f;
#pragma unroll
    for (int j = 0; j < 8; ++j) { const float v = gp[j * 64 + d]; if (j < jg) off += v; glast += v; }
    const float eglast = __expf(glast);
    if (jg == 0) DECAY[((size_t)(b * 4 + hh) * 64 + n) * 64 + d] = eglast;
    unsigned ktw[4];
#pragma unroll
    for (int i = 0; i < 8; i += 2) {
        float ktv[2];
#pragma unroll
        for (int ii = 0; ii < 2; ++ii) { const int j = 8 * jg + i + ii; const float G = off + cs[i + ii];
            const float kv = bf2f(kraw[i + ii]), qv = bf2f(qraw[i + ii]);
            const float eg = __expf(G), eng = __builtin_amdgcn_rcpf(eg), kdv = kv * eng;
            ktv[ii] = kdv * eglast;
            BQ[(tok0 + j) * 256 + hh * 64 + d] = (bf16_t)(cvt_pk_bf16(qv * 0.125f * eg, 0.f) & 0xFFFFu);
            BK[(tok0 + j) * 256 + hh * 64 + d] = (bf16_t)(cvt_pk_bf16(kdv, 0.f) & 0xFFFFu); }
        ktw[i >> 1] = cvt_pk_bf16(ktv[0], ktv[1]);
    }
    *(LAS u32x4*)(kt + d * 72 + 8 * jg) = (u32x4){ktw[0], ktw[1], ktw[2], ktw[3]};
    gla_stage_vt(vt, vraw, tid);
    __syncthreads();
}
__device__ __forceinline__ void gla_prep_out(LAS unsigned char* lds, int b, int hh, int n, const bf16_t* BQ, const bf16_t* BK, const bf16_t* BV) {
    const int tid = opaque_tid(), row = tid >> 3, ch = (tid & 7) * 8;
    const size_t tok0 = (size_t)b * SEQ + n * 64;
    LAS bf16_t* qd = (LAS bf16_t*)(lds + GL_QD); LAS bf16_t* kd = (LAS bf16_t*)(lds + GL_KD); LAS bf16_t* vt = (LAS bf16_t*)(lds + GL_VT);
    u32x4 vraw[2];
    const u32x4 qw = *(const u32x4*)(BQ + (tok0 + row) * 256 + hh * 64 + ch), kw = *(const u32x4*)(BK + (tok0 + row) * 256 + hh * 64 + ch);
#pragma unroll
    for (int rep = 0; rep < 2; ++rep) { const int idx = tid + 512 * rep; vraw[rep] = *(const u32x4*)(BV + (tok0 + (idx >> 4)) * 512 + hh * 128 + (idx & 15) * 8); }
    *(LAS u32x4*)(qd + row * 72 + ch) = qw; *(LAS u32x4*)(kd + row * 72 + ch) = kw;
    gla_stage_vt(vt, vraw, tid);
    __syncthreads();
}

__device__ __forceinline__ void gla_state_item(LAS unsigned char* lds, const float* gw2, const float* gb2, int item, bf16_t* BQ, bf16_t* BK, const bf16_t* BV, const float* BLR, float* DECAY, float* GSTATE) {
    const int b = item >> 8, hh = (item >> 6) & 3, n = item & 63;
    gla_prep_state(lds, gw2, gb2, b, hh, n, BQ, BK, BV, BLR, DECAY);
    const int tid1 = opaque_tid(), lane = tid1 & 63, wave = tid1 >> 6, g = lane >> 5, c = lane & 31, mt = wave >> 1, nt = wave & 1;
    LAS bf16_t* kt = (LAS bf16_t*)(lds + GL_KT); LAS bf16_t* vt = (LAS bf16_t*)(lds + GL_VT);
    f32x16 acc;
#pragma unroll
    for (int r = 0; r < 16; ++r) acc[r] = 0.f;
#pragma unroll
    for (int ks = 0; ks < 4; ++ks) { const bf16x8 af = *(const LAS bf16x8*)(vt + (32 * mt + c) * 72 + ks * 16 + 8 * g); const bf16x8 bf = *(const LAS bf16x8*)(kt + (32 * nt + c) * 72 + ks * 16 + 8 * g);
        acc = __builtin_amdgcn_mfma_f32_32x32x16_bf16(af, bf, acc, 0, 0, 0); }
    float* dst = GSTATE + ((size_t)(b * 4 + hh) * 64 + n) * 8192;
#pragma unroll
    for (int r = 0; r < 16; ++r) { const int dv = 32 * mt + (r & 3) + 8 * (r >> 2) + 4 * g; dst[dv * 64 + 32 * nt + c] = acc[r]; }
    __syncthreads();
}

__device__ __forceinline__ void gla_out_item(LAS unsigned char* lds, const float* gw2, const float* gb2, int item, const bf16_t* BQ, const bf16_t* BK, const bf16_t* BV, const float* BLR, const bf16_t* BG,
                                              const bf16_t* SPREV, bf16_t* MIXIN) {
    const int b = item >> 8, hh = (item >> 6) & 3, n = item & 63;
    const int tid = opaque_tid(), lane = tid & 63, wave = tid >> 6, g = lane >> 5, c = lane & 31;
    bf16x8 spf[4]; u32x4 g0, g1;
    { const bf16_t* sp = SPREV + ((size_t)(b * 4 + hh) * 64 + n) * 8192 + (size_t)(32 * (wave & 3) + c) * 64 + 8 * g;
#pragma unroll
      for (int ks = 0; ks < 4; ++ks) spf[ks] = *(const bf16x8*)(sp + ks * 16);
      const size_t tokg = (size_t)b * SEQ + n * 64 + (tid >> 3);
      g0 = *(const u32x4*)(BG + tokg * 512 + hh * 128 + (tid & 7) * 16); g1 = *(const u32x4*)(BG + tokg * 512 + hh * 128 + (tid & 7) * 16 + 8); }
    gla_prep_out(lds, b, hh, n, BQ, BK, BV);
    LAS bf16_t* qd = (LAS bf16_t*)(lds + GL_QD); LAS bf16_t* kd = (LAS bf16_t*)(lds + GL_KD); LAS bf16_t* vt = (LAS bf16_t*)(lds + GL_VT); LAS bf16_t* P = (LAS bf16_t*)(lds + GL_P);
    LAS float* o = (LAS float*)(lds + GL_O);
    if (wave < 4) {
        const int mt = wave >> 1, nt = wave & 1;
        f32x16 acc;
#pragma unroll
        for (int r = 0; r < 16; ++r) acc[r] = 0.f;
        if (!(mt == 0 && nt == 1)) {
#pragma unroll
            for (int ks = 0; ks < 4; ++ks) { const bf16x8 af = *(const LAS bf16x8*)(qd + (32 * mt + c) * 72 + ks * 16 + 8 * g); const bf16x8 bf = *(const LAS bf16x8*)(kd + (32 * nt + c) * 72 + ks * 16 + 8 * g);
                acc = __builtin_amdgcn_mfma_f32_32x32x16_bf16(af, bf, acc, 0, 0, 0); }
        }
#pragma unroll
        for (int r = 0; r < 16; ++r) { const int i = 32 * mt + (r & 3) + 8 * (r >> 2) + 4 * g, j = 32 * nt + c; P[i * 72 + j] = f2bf(j <= i ? acc[r] : 0.f); }
    }
    __syncthreads();
    {
        const int mt = wave >> 2, nt = wave & 3;
        f32x16 acc;
#pragma unroll
        for (int r = 0; r < 16; ++r) acc[r] = 0.f;
#pragma unroll
        for (int ks = 0; ks < 4; ++ks) { const bf16x8 af = *(const LAS bf16x8*)(P + (32 * mt + c) * 72 + ks * 16 + 8 * g); const bf16x8 bf = *(const LAS bf16x8*)(vt + (32 * nt + c) * 72 + ks * 16 + 8 * g);
            acc = __builtin_amdgcn_mfma_f32_32x32x16_bf16(af, bf, acc, 0, 0, 0); }
#pragma unroll
        for (int ks = 0; ks < 4; ++ks) { const bf16x8 af = *(const LAS bf16x8*)(qd + (32 * mt + c) * 72 + ks * 16 + 8 * g); acc = __builtin_amdgcn_mfma_f32_32x32x16_bf16(af, spf[ks], acc, 0, 0, 0); }
#pragma unroll
        for (int r = 0; r < 16; ++r) { const int i = 32 * mt + (r & 3) + 8 * (r >> 2) + 4 * g; o[i * 132 + 32 * nt + c] = acc[r]; }
    }
    __syncthreads();
    {
        const int row = tid >> 3, part = tid & 7; float v[16]; float ss = 0.f;
#pragma unroll
        for (int k = 0; k < 16; ++k) { v[k] = o[row * 132 + part * 16 + k]; ss += v[k] * v[k]; }
        ss += __shfl_xor(ss, 1); ss += __shfl_xor(ss, 2); ss += __shfl_xor(ss, 4);
        const float r = rsqrtf(ss * (1.0f / 128.0f) + EPS);
        const size_t tok = (size_t)b * SEQ + n * 64 + row;
        const float gv[16] = {bflo(g0.x), bfhi(g0.x), bflo(g0.y), bfhi(g0.y), bflo(g0.z), bfhi(g0.z), bflo(g0.w), bfhi(g0.w),
                              bflo(g1.x), bfhi(g1.x), bflo(g1.y), bfhi(g1.y), bflo(g1.z), bfhi(g1.z), bflo(g1.w), bfhi(g1.w)};
        unsigned w[8];
#pragma unroll
        for (int k = 0; k < 8; ++k) w[k] = cvt_pk_bf16(v[2 * k] * r * gv[2 * k], v[2 * k + 1] * r * gv[2 * k + 1]);
        bf16_t* dp = MIXIN + tok * 1024 + 512 + hh * 128 + part * 16;
        *(u32x4*)dp = (u32x4){w[0], w[1], w[2], w[3]}; *(u32x4*)(dp + 8) = (u32x4){w[4], w[5], w[6], w[7]};
    }
    __syncthreads();
}

constexpr int AT_K0 = 0, AT_V0 = 9216, AT_STAGE = 18432, AT_BT = 2 * AT_STAGE;
constexpr float LOG2E = 1.4426950408889634f, AT_C1 = 0.125f * LOG2E, AT_THR = 8.0f;

template <bool NEAR>
__device__ __forceinline__ void attn_tile(const LAS bf16_t* Kt, const LAS bf16_t* Vt, const LAS float* btl, const bf16x8 (&qf)[4], f32x16& negm, f32x16& O0, f32x16& O1, float& m_ref, float& thr, f32pair_t& lsum,
                                          u64 mw, int tq, int key0, int g, int c) {
    const int pc = (c & 0x13) | ((c & 4) << 1) | ((c & 8) >> 1);
    f32x16 s0, s1;
#pragma unroll
    for (int ks = 0; ks < 4; ++ks) {
        const bf16x8 k0 = *(const LAS bf16x8*)(Kt + pc * 72 + ks * 16 + 8 * g), k1 = *(const LAS bf16x8*)(Kt + (32 + pc) * 72 + ks * 16 + 8 * g);
        if (ks == 0) {
            asm("v_mfma_f32_32x32x16_bf16 %0, %1, %2, %3" : "=&v"(s0) : "v"(k0), "v"(qf[0]), "v"(negm)); asm("v_mfma_f32_32x32x16_bf16 %0, %1, %2, %3" : "=&v"(s1) : "v"(k1), "v"(qf[0]), "v"(negm)); }
        else { s0 = __builtin_amdgcn_mfma_f32_32x32x16_bf16(k0, qf[ks], s0, 0, 0, 0); s1 = __builtin_amdgcn_mfma_f32_32x32x16_bf16(k1, qf[ks], s1, 0, 0, 0); }
    }
    const unsigned w0 = (unsigned)mw >> (8 * g), w1 = (unsigned)(mw >> 32) >> (8 * g);
    float x0[16], x1[16];
#pragma unroll
    for (int r = 0; r < 16; ++r) {
        if (NEAR) { const LAS float* pb = btl + (tq - key0 - 8 * g + 96 - 63);
            x0[r] = s0[r] + pb[63 - (16 * (r >> 3) + (r & 7))]; x1[r] = s1[r] + pb[63 - (16 * (r >> 3) + (r & 7) + 32)]; }
        else { x0[r] = s0[r]; x1[r] = s1[r]; }
    }
    float mx = fmaxf(fmaxf(x0[15], x0[14]), fmaxf(x1[15], x1[14]));
    asm("v_max3_f32 %0, %0, %1, %2\n\tv_max3_f32 %0, %0, %3, %4\n\tv_max3_f32 %0, %0, %5, %6\n\tv_max3_f32 %0, %0, %7, %8\n\tv_max3_f32 %0, %0, %9, %10\n\tv_max3_f32 %0, %0, %11, %12\n\tv_max3_f32 %0, %0, %13, %14"
        : "+v"(mx) : "v"(x0[0]), "v"(x1[0]), "v"(x0[1]), "v"(x1[1]), "v"(x0[2]), "v"(x1[2]), "v"(x0[3]), "v"(x1[3]), "v"(x0[4]), "v"(x1[4]), "v"(x0[5]), "v"(x1[5]), "v"(x0[6]), "v"(x1[6]));
    asm("v_max3_f32 %0, %0, %1, %2\n\tv_max3_f32 %0, %0, %3, %4\n\tv_max3_f32 %0, %0, %5, %6\n\tv_max3_f32 %0, %0, %7, %8\n\tv_max3_f32 %0, %0, %9, %10\n\tv_max3_f32 %0, %0, %11, %12\n\tv_max3_f32 %0, %0, %13, %14"
        : "+v"(mx) : "v"(x0[7]), "v"(x1[7]), "v"(x0[8]), "v"(x1[8]), "v"(x0[9]), "v"(x1[9]), "v"(x0[10]), "v"(x1[10]), "v"(x0[11]), "v"(x1[11]), "v"(x0[12]), "v"(x1[12]), "v"(x0[13]), "v"(x1[13]));
    if (__any(mx > thr)) {
        float ms = NEG_INF;
#pragma unroll
        for (int r = 0; r < 16; ++r) { const int bp = 16 * (r >> 3) + (r & 7);
            const float a0 = ((w0 >> bp) & 1u) ? x0[r] : NEG_INF, a1 = ((w1 >> bp) & 1u) ? x1[r] : NEG_INF; ms = fmaxf(ms, fmaxf(a0, a1)); }
        { const auto sw = __builtin_amdgcn_permlane32_swap(__float_as_uint(ms), __float_as_uint(ms), false, false); ms = fmaxf(__uint_as_float(sw[0]), __uint_as_float(sw[1])); }
        const bool unset = (thr == NEG_INF);
        const float delta = (ms == NEG_INF) ? 0.f : (unset ? ms : fmaxf(ms, 0.f));
        const float alpha = unset ? 1.0f : __builtin_amdgcn_exp2f(-delta);
#pragma unroll
        for (int r = 0; r < 16; ++r) { O0[r] *= alpha; O1[r] *= alpha; x0[r] -= delta; x1[r] -= delta; }
        lsum *= alpha; m_ref += delta; if (ms != NEG_INF) thr = AT_THR;
#pragma unroll
        for (int r = 0; r < 16; ++r) negm[r] = -m_ref;
    }
#pragma unroll
    for (int r = 0; r < 16; ++r) { const int bp = 16 * (r >> 3) + (r & 7);
        const float e0 = __builtin_amdgcn_exp2f(x0[r]), e1 = __builtin_amdgcn_exp2f(x1[r]);
        unsigned b0, b1;
        asm("v_bfe_i32 %0, %1, %2, 1" : "=v"(b0) : "v"(w0), "n"(bp)); asm("v_bfe_i32 %0, %1, %2, 1" : "=v"(b1) : "v"(w1), "n"(bp));
        x0[r] = __uint_as_float(__float_as_uint(e0) & b0); x1[r] = __uint_as_float(__float_as_uint(e1) & b1); }
#pragma unroll
    for (int s = 0; s < 4; ++s) {
        const float* xp = (s < 2) ? x0 : x1; const int o = 8 * (s & 1);
        u32x4 w; w.x = cvt_pk_bf16(xp[o + 0], xp[o + 1]); w.y = cvt_pk_bf16(xp[o + 2], xp[o + 3]); w.z = cvt_pk_bf16(xp[o + 4], xp[o + 5]); w.w = cvt_pk_bf16(xp[o + 6], xp[o + 7]);
        const bf16x8 pb = *(bf16x8*)&w;
        const bf16x8 v0 = *(const LAS bf16x8*)(Vt + c * 72 + s * 16 + 8 * g), v1 = *(const LAS bf16x8*)(Vt + (32 + c) * 72 + s * 16 + 8 * g);
        O0 = __builtin_amdgcn_mfma_f32_32x32x16_bf16(v0, pb, O0, 0, 0, 0); O1 = __builtin_amdgcn_mfma_f32_32x32x16_bf16(v1, pb, O1, 0, 0, 0);
#pragma unroll
        for (int i = 0; i < 8; i += 2) lsum += (f32pair_t){xp[o + i], xp[o + i + 1]};
    }
}

__device__ __forceinline__ void attn_item(LAS unsigned char* lds, const bf16_t* Q, const bf16_t* Kb, const bf16_t* VT, const bf16_t* AG, const u64* MASK, const float* btab, bf16_t* MIXIN,
                                          int b, int head, int qb, int tid) {
    const int lane = tid & 63, wave = __builtin_amdgcn_readfirstlane(tid >> 6), g = lane >> 5, c = lane & 31;
    const int tq0 = qb * 256 + wave * 32, tq = tq0 + c;
    const size_t tokq = (size_t)b * SEQ + tq;
    LAS float* btl = (LAS float*)(lds + AT_BT);
    if (tid < 320) { const int rel = tid - 96; btl[tid] = (rel >= 0 && rel < 128) ? (btab[rel * 8 + head] - btab[127 * 8 + head]) * LOG2E : 0.f; }
    bf16x8 qf[4];
#pragma unroll
    for (int ks = 0; ks < 4; ++ks) { const u32x4 qw = *(const u32x4*)(Q + tokq * 512 + head * 64 + ks * 16 + 8 * g);
        u32x4 sw; sw.x = cvt_pk_bf16(bflo(qw.x) * AT_C1, bfhi(qw.x) * AT_C1); sw.y = cvt_pk_bf16(bflo(qw.y) * AT_C1, bfhi(qw.y) * AT_C1);
        sw.z = cvt_pk_bf16(bflo(qw.z) * AT_C1, bfhi(qw.z) * AT_C1); sw.w = cvt_pk_bf16(bflo(qw.w) * AT_C1, bfhi(qw.w) * AT_C1); qf[ks] = *(bf16x8*)&sw; }
    f32x16 O0, O1, negm;
#pragma unroll
    for (int r = 0; r < 16; ++r) { O0[r] = 0.f; O1[r] = 0.f; negm[r] = 0.f; }
    float m_ref = 0.f, thr = NEG_INF; f32pair_t lsum = {0.f, 0.f};
    const int nt = 4 * qb + 4, my_last = 4 * qb + (wave >> 1);
    const int srow = tid >> 3, sch = tid & 7, sto = (srow * 72 + 8 * sch) * 2;
    const bf16_t* kg = Kb + ((size_t)b * SEQ + srow) * 512 + head * 64 + 8 * sch;
    const bf16_t* vg = VT + ((size_t)(b * 8 + head) * 64 + srow) * 4096 + 8 * sch;
    const u64* Mrow = MASK + (size_t)b * 64 * SEQ + tq;
    { const u32x4 kr = *(const u32x4*)kg, vr = *(const u32x4*)vg; *(LAS u32x4*)(lds + AT_K0 + sto) = kr; *(LAS u32x4*)(lds + AT_V0 + sto) = vr; }
    u64 mw = Mrow[0];
    __syncthreads();
    int ks_near = (tq0 - 175 + 63) >> 6; ks_near = ks_near < 0 ? 0 : ks_near;
#define AT_ITER(BODY) do { const bool more = (kt + 1 < nt); u32x4 kr, vr; u64 mwn = 0ull; \
        if (more) { kr = *(const u32x4*)(kg + (size_t)(kt + 1) * 64 * 512); vr = *(const u32x4*)(vg + (kt + 1) * 64); if (kt + 1 <= my_last) mwn = Mrow[(size_t)(kt + 1) * SEQ]; } \
        { const LAS bf16_t* Kt = (const LAS bf16_t*)(lds + (kt & 1) * AT_STAGE + AT_K0); const LAS bf16_t* Vt = (const LAS bf16_t*)(lds + (kt & 1) * AT_STAGE + AT_V0); BODY; } \
        if (more) { *(LAS u32x4*)(lds + ((kt + 1) & 1) * AT_STAGE + AT_K0 + sto) = kr; *(LAS u32x4*)(lds + ((kt + 1) & 1) * AT_STAGE + AT_V0 + sto) = vr; } \
        mw = mwn; __syncthreads(); } while (0)
    int kt = 0;
    if (wave >= 4) __builtin_amdgcn_s_setprio(1);
    for (; kt < ks_near; ++kt) AT_ITER(attn_tile<false>(Kt, Vt, btl, qf, negm, O0, O1, m_ref, thr, lsum, mw, tq, 64 * kt, g, c));
    for (; kt <= my_last; ++kt) AT_ITER(attn_tile<true>(Kt, Vt, btl, qf, negm, O0, O1, m_ref, thr, lsum, mw, tq, 64 * kt, g, c));
    for (; kt < nt; ++kt) AT_ITER((void)Kt; (void)Vt);
#undef AT_ITER
    __builtin_amdgcn_s_setprio(0);
    float inv;
    { const float l1 = lsum.x + lsum.y; const auto sw = __builtin_amdgcn_permlane32_swap(__float_as_uint(l1), __float_as_uint(l1), false, false); inv = 1.0f / (__uint_as_float(sw[0]) + __uint_as_float(sw[1])); }
#pragma unroll
    for (int mt = 0; mt < 2; ++mt)
#pragma unroll
        for (int rq = 0; rq < 4; ++rq) { const int d0 = 32 * mt + 8 * rq + 4 * g;
            const u32x2 gw = *(const u32x2*)(AG + tokq * 512 + head * 64 + d0);
            const float o0 = (mt ? O1[4 * rq + 0] : O0[4 * rq + 0]) * inv * bflo(gw.x), o1 = (mt ? O1[4 * rq + 1] : O0[4 * rq + 1]) * inv * bfhi(gw.x);
            const float o2 = (mt ? O1[4 * rq + 2] : O0[4 * rq + 2]) * inv * bflo(gw.y), o3 = (mt ? O1[4 * rq + 3] : O0[4 * rq + 3]) * inv * bfhi(gw.y);
            u32x2 ow; ow.x = cvt_pk_bf16(o0, o1); ow.y = cvt_pk_bf16(o2, o3);
            *(u32x2*)(MIXIN + tokq * 1024 + head * 64 + d0) = ow; }
}

constexpr int LDS_BYTES = 147456;
constexpr int MISC_OFF = 131072 + 8192;
constexpr int NPH = 26;

__global__ void __launch_bounds__(NTHREADS, 2) fwd_kernel(Args a) {
    extern __shared__ __attribute__((aligned(16))) unsigned char lds_raw[];
    LAS unsigned char* lds = (LAS unsigned char*)lds_raw;
    const int G = gridDim.x, wg = blockIdx.x;
    volatile LAS unsigned* misc = (volatile LAS unsigned*)(lds + MISC_OFF);
    if (threadIdx.x < 4) misc[threadIdx.x] = 0u;
    __syncthreads();
    XcdBarrier bar; bar.bar = nullptr; bar.x = 0; bar.st = misc;
    if (N_LAUNCHES == 1) bar = xcd_barrier_post((unsigned*)(get_args()->ws + WS_CTL), misc);
    int lo, hi; { ArgsP ap = get_args(); lo = ap->ph_lo; hi = ap->ph_hi; }
#define WSP(type, off) ((type*)(wsl + (off)))
#define IN(k) (lo <= (k) && (k) < hi)
#define SEAM(k) do { if (N_LAUNCHES == 1 && IN(k) && IN((k) + 1)) { XcdBarrier b_ = bar; asm volatile("" : "+s"(b_.bar), "+s"(b_.x)); xcd_barrier(b_); } } while (0)

    if (IN(0)) {
        ArgsP ap = get_args(); unsigned char* wsl = ap->ws;
        weight_phase((LAS float*)lds, ap, wsl);
        if (wg == 0) for (int i = opaque_tid(); i < 1024; i += NTHREADS) { const int rel = i >> 3, h = i & 7; WSP(float, WS_TAB)[i] = ap->rel_bias[t5_bucket(rel) * 8 + h]; }
    }
    SEAM(0);

#define LAYER_BODY(LAYER_) { constexpr int layer = (LAYER_); \
        const int pb = 1 + 6 * layer, e = layer >> 1; \
        constexpr bool even = (layer & 1) == 0; \
        if (IN(pb + 0)) { \
            ArgsP ap = get_args(); unsigned char* wsl = ap->ws; \
            const bf16_t* Wm = WSP(bf16_t, WS_WEIN) + ((size_t)e * NE + 4096) * 1024; \
            if (layer == 0) norm_misc_phase(lds, ap->x, nullptr, nullptr, nullptr, nullptr, WSP(bf16_t, WS_H), WSP(float, WS_XS), Wm, WSP(bf16_t, WS_IK), WSP(float, WS_IW), WSP(float, WS_BLR)); \
            else if (even) norm_misc_phase(lds, nullptr, WSP(bf16_t, WS_H), WSP(float, WS_XS), WSP(bf16_t, WS_MIX), ap->post_norm + (layer - 1) * DM, WSP(bf16_t, WS_H), WSP(float, WS_XS), Wm, WSP(bf16_t, WS_IK), WSP(float, WS_IW), WSP(float, WS_BLR)); \
            else norm_phase(nullptr, WSP(bf16_t, WS_H), WSP(float, WS_XS), WSP(bf16_t, WS_MIX), ap->post_norm + (layer - 1) * DM, WSP(bf16_t, WS_H), WSP(float, WS_XS), nullptr); \
        } \
        SEAM(pb + 0); \
        if (even) { \
            if (IN(pb + 1)) { \
                ArgsP ap = get_args(); unsigned char* wsl = ap->ws; \
                pg8::Gemm gm{WSP(bf16_t, WS_H), WSP(bf16_t, WS_WEIN) + (size_t)e * NE * 1024, T, 4096, 1024, 1024, 1 << 30, 0}; pg8::StaticOrder S; S.init(T, 4096, G, wg); \
                EpiEvenIn E{WSP(bf16_t, WS_Q), WSP(bf16_t, WS_K), WSP(bf16_t, WS_VT), WSP(bf16_t, WS_AG), WSP(bf16_t, WS_IQ), WSP(bf16_t, WS_BQ), WSP(bf16_t, WS_BK), WSP(bf16_t, WS_BV), WSP(bf16_t, WS_BG), \
                            WSP(bf16_t, WS_IK), WSP(float, WS_IW), WSP(float, WS_BLR)}; \
                pg8::gemm_phase(lds, gm, S, E); \
            } \
            SEAM(pb + 1); \
            if (IN(pb + 2)) { \
                ArgsP ap = get_args(); unsigned char* wsl = ap->ws; \
                { const int tid = opaque_tid(), lane = tid & 63, wave = __builtin_amdgcn_readfirstlane(tid >> 6); \
                  indexer_phase((LAS float*)lds, WSP(bf16_t, WS_IQ), WSP(bf16_t, WS_IK), WSP(float, WS_IW), WSP(u64, WS_MASK), wave, lane); } \
                { const float* gw2 = ap->even_gate_w2 + (size_t)e * 16 * 256; const float* gb2 = ap->even_gate_b2 + (size_t)e * 256; \
                  for (int it = wg; it < 1024; it += G) gla_state_item(lds, gw2, gb2, it, WSP(bf16_t, WS_BQ), WSP(bf16_t, WS_BK), WSP(bf16_t, WS_BV), WSP(float, WS_BLR), WSP(float, WS_DECAY), WSP(float, WS_MIXIN)); } \
            } \
            SEAM(pb + 2); \
            if (IN(pb + 3)) { \
                ArgsP ap = get_args(); unsigned char* wsl = ap->ws; \
                const float* GSTATE = WSP(float, WS_MIXIN); const float* DECAY = WSP(float, WS_DECAY); bf16_t* SPREV = WSP(bf16_t, WS_SPREV); \
                for (int el = wg * NTHREADS + opaque_tid(); el < 16 * 8192; el += G * NTHREADS) { \
                    const int bh = el >> 13, rem = el & 8191, dk = rem & 63; float Sv = 0.f; \
                    for (int n = 0; n < 64; ++n) { const size_t o = ((size_t)bh * 64 + n) * 8192 + rem; SPREV[o] = f2bf(Sv); Sv = DECAY[((size_t)bh * 64 + n) * 64 + dk] * Sv + GSTATE[o]; } \
                } \
            } \
            SEAM(pb + 3); \
            if (IN(pb + 4)) { \
                ArgsP ap = get_args(); unsigned char* wsl = ap->ws; \
                { const int tid = opaque_tid(); \
                  for (int it = wg; it < 512; it += G) { const int idx = it & 255, b = idx & 3, head = (idx >> 2) & 7, qbp = idx >> 5, qb = (it < 256) ? 15 - qbp : qbp; \
                      attn_item(lds, WSP(bf16_t, WS_Q), WSP(bf16_t, WS_K), WSP(bf16_t, WS_VT), WSP(bf16_t, WS_AG), WSP(u64, WS_MASK), WSP(float, WS_TAB), WSP(bf16_t, WS_MIXIN), b, head, qb, tid); } } \
                __syncthreads(); \
                { const float* gw2 = ap->even_gate_w2 + (size_t)e * 16 * 256; const float* gb2 = ap->even_gate_b2 + (size_t)e * 256; \
                  for (int it = wg; it < 1024; it += G) gla_out_item(lds, gw2, gb2, it, WSP(bf16_t, WS_BQ), WSP(bf16_t, WS_BK), WSP(bf16_t, WS_BV), WSP(float, WS_BLR), WSP(bf16_t, WS_BG), WSP(bf16_t, WS_SPREV), WSP(bf16_t, WS_MIXIN)); } \
            } \
            SEAM(pb + 4); \
        } else { \
            if (IN(pb + 1)) { \
                ArgsP ap = get_args(); unsigned char* wsl = ap->ws; \
                pg8::Gemm gm{WSP(bf16_t, WS_H), WSP(bf16_t, WS_WOIN) + (size_t)e * 2048 * 1024, T, 2048, 1024, 1024, 1 << 30, 0}; pg8::StaticOrder S; S.init(T, 2048, G, wg); \
                EpiOddIn E{WSP(bf16_t, WS_XR), WSP(bf16_t, WS_GS)}; \
                pg8::gemm_phase(lds, gm, S, E); \
            } \
            SEAM(pb + 1); \
            if (IN(pb + 2)) { \
                ArgsP ap = get_args(); unsigned char* wsl = ap->ws; \
                const bf16_t* XR = WSP(bf16_t, WS_XR); bf16_t* XC = WSP(bf16_t, WS_XC); \
                const float* cw = ap->odd_conv_w + (size_t)e * 4 * 1024; const float* cb = ap->odd_conv_b + (size_t)e * 1024; \
                { const int tid = opaque_tid(), c8 = (tid & 127) * 8; float wq[4][8], bq[8];   \
_Pragma("unroll") \
                  for (int k = 0; k < 8; ++k) { bq[k] = cb[c8 + k]; _Pragma("unroll") for (int j = 0; j < 4; ++j) wq[j][k] = cw[j * 1024 + c8 + k]; } \
                  for (int run = wg * 4 + (tid >> 7); run < T / 8; run += G * 4) { \
                    const int tok0 = run * 8, s0 = tok0 & 4095; float xw[11][8]; \
_Pragma("unroll") \
                    for (int i = 0; i < 11; ++i) { u32x4 w = (u32x4){0u, 0u, 0u, 0u}; if (s0 - 3 + i >= 0) w = *(const u32x4*)(XR + (size_t)(tok0 - 3 + i) * 1024 + c8); \
                        xw[i][0] = bflo(w.x); xw[i][1] = bfhi(w.x); xw[i][2] = bflo(w.y); xw[i][3] = bfhi(w.y); xw[i][4] = bflo(w.z); xw[i][5] = bfhi(w.z); xw[i][6] = bflo(w.w); xw[i][7] = bfhi(w.w); } \
_Pragma("unroll") \
                    for (int o = 0; o < 8; ++o) { float acc[8]; \
_Pragma("unroll") \
                        for (int k = 0; k < 8; ++k) acc[k] = bq[k] + wq[0][k] * xw[o][k] + wq[1][k] * xw[o + 1][k] + wq[2][k] * xw[o + 2][k] + wq[3][k] * xw[o + 3][k]; \
                        u32x4 ow; ow.x = cvt_pk_bf16(acc[0], acc[1]); ow.y = cvt_pk_bf16(acc[2], acc[3]); ow.z = cvt_pk_bf16(acc[4], acc[5]); ow.w = cvt_pk_bf16(acc[6], acc[7]); \
                        *(u32x4*)(XC + (size_t)(tok0 + o) * 1024 + c8) = ow; } \
                  } } \
            } \
            SEAM(pb + 2); \
            if (IN(pb + 3)) { \
                ArgsP ap = get_args(); unsigned char* wsl = ap->ws; \
                pg8::Gemm gm{WSP(bf16_t, WS_XC), WSP(bf16_t, WS_WOG) + (size_t)e * 2048 * 256, T, 2048, 256, 1024, 2, 512}; pg8::StaticOrder S; S.init(T, 2048, G, wg); \
                EpiGates E{ap->odd_b_a + (size_t)e * 1024, ap->odd_b_x + (size_t)e * 1024, ap->odd_lambda + (size_t)e * 1024, WSP(bf16_t, WS_XC), WSP(bf16_t, WS_LOGA), WSP(bf16_t, WS_U)}; \
                pg8::gemm_phase(lds, gm, S, E); \
            } \
            SEAM(pb + 3); \
            if (IN(pb + 4)) { \
                ArgsP ap = get_args(); unsigned char* wsl = ap->ws; \
                const bf16_t* LOGA = WSP(bf16_t, WS_LOGA); const bf16_t* U = WSP(bf16_t, WS_U); const bf16_t* GS = WSP(bf16_t, WS_GS); bf16_t* MIXIN = WSP(bf16_t, WS_MIXIN); \
                LAS float* sl = (LAS float*)lds; LAS float* hl = sl + 512; \
                const int tid = opaque_tid(); \
                for (int it = wg; it < 256; it += G) { \
                      \
                    const int xq = (it & 7) * 8 + ((it >> 3) >> 2), b = xq >> 4, ch = ((xq & 15) * 4 + ((it >> 3) & 3)) * 16 + (tid & 15), jc = tid >> 4; \
                    const size_t base = ((size_t)b * SEQ + jc * 128) * 1024 + ch, sbase = slab_idx(b * SEQ + jc * 128, ch); \
                    float hsum = 0.f, lsum = 0.f; \
                    for (int s0 = 0; s0 < 128; s0 += 16) { float la[16], uu[16]; \
                        _Pragma("unroll") for (int k = 0; k < 16; ++k) { la[k] = bf2f(LOGA[sbase + (size_t)(s0 + k) * 16]); uu[k] = bf2f(U[sbase + (size_t)(s0 + k) * 16]); } \
                        _Pragma("unroll") for (int k = 0; k < 16; ++k) { hsum = __builtin_amdgcn_exp2f(la[k]) * hsum + uu[k]; lsum += la[k]; } } \
                    sl[tid] = lsum; hl[tid] = hsum; \
                    __syncthreads(); \
                    float hin = 0.f; \
                    for (int cj = 0; cj < jc; ++cj) hin = __builtin_amdgcn_exp2f(sl[cj * 16 + (tid & 15)]) * hin + hl[cj * 16 + (tid & 15)]; \
                    float hv = hin; \
                    for (int s0 = 0; s0 < 128; s0 += 16) { float la[16], uu[16], gg[16]; \
                        _Pragma("unroll") for (int k = 0; k < 16; ++k) { la[k] = bf2f(LOGA[sbase + (size_t)(s0 + k) * 16]); uu[k] = bf2f(U[sbase + (size_t)(s0 + k) * 16]); gg[k] = bf2f(GS[sbase + (size_t)(s0 + k) * 16]); } \
                        _Pragma("unroll") for (int k = 0; k < 16; ++k) { hv = __builtin_amdgcn_exp2f(la[k]) * hv + uu[k]; MIXIN[base + (size_t)(s0 + k) * 1024] = f2bf(hv * gg[k]); } } \
                    __syncthreads(); \
                } \
            } \
            SEAM(pb + 4); \
        } \
        if (IN(pb + 5)) { \
            ArgsP ap = get_args(); unsigned char* wsl = ap->ws; \
            const bf16_t* W = (even ? WSP(bf16_t, WS_WEOUT) : WSP(bf16_t, WS_WOOUT)) + (size_t)e * 1024 * 1024; \
            pg8::Gemm gm{WSP(bf16_t, WS_MIXIN), W, T, 1024, 1024, 1024, 1 << 30, 0}; pg8::StaticOrder S; S.init(T, 1024, G, wg); \
            EpiMix E{WSP(bf16_t, WS_MIX)}; \
            pg8::gemm_phase(lds, gm, S, E); \
        } \
        SEAM(pb + 5); \
    }
    LAYER_BODY(0)
    LAYER_BODY(1)
    LAYER_BODY(2)
    LAYER_BODY(3)
#undef LAYER_BODY
    if (IN(25)) { ArgsP ap = get_args(); unsigned char* wsl = ap->ws; norm_phase(nullptr, WSP(bf16_t, WS_H), WSP(float, WS_XS), WSP(bf16_t, WS_MIX), ap->post_norm + 3 * DM, nullptr, nullptr, ap->out); }
#undef IN
#undef SEAM
#undef WSP
}

extern "C" void kernel_launch(void* const* d_in, const int* in_sizes, int n_in, void* d_out, int out_size, void* d_ws, size_t ws_size, hipStream_t stream) {
    static int grid = 0;
    if (grid == 0) {
        if (n_in != 17 || out_size != T * DM || ws_size < WS_END) { fprintf(stderr, "kernel_launch: unexpected sizes (n_in %d, out %d, ws %zu, need %zu)\n", n_in, out_size, ws_size, (size_t)WS_END); grid = -1; return; }
        int dev = 0, cus = 0, per_cu = 0;
        if (hipGetDevice(&dev) != hipSuccess || hipDeviceGetAttribute(&cus, hipDeviceAttributeMultiprocessorCount, dev) != hipSuccess) { grid = -1; return; }
        if (hipFuncSetAttribute((const void*)fwd_kernel, hipFuncAttributeMaxDynamicSharedMemorySize, LDS_BYTES) != hipSuccess) { fprintf(stderr, "kernel_launch: hipFuncSetAttribute failed\n"); grid = -1; return; }
        if (hipOccupancyMaxActiveBlocksPerMultiprocessor(&per_cu, (const void*)fwd_kernel, NTHREADS, LDS_BYTES) != hipSuccess || per_cu < 1) { fprintf(stderr, "kernel_launch: occupancy query says %d\n", per_cu); }
        (void)hipGetLastError();
        grid = cus;
    }
    if (grid < 0) return;
    (void)hipMemsetAsync((char*)d_ws + WS_CTL, 0, CTL_BYTES, stream);
    Args a{};
    a.x = (const float*)d_in[0]; a.rel_bias = (const float*)d_in[1]; a.pre_norm = (const float*)d_in[2]; a.post_norm = (const float*)d_in[3];
    a.even_w_in = (const float*)d_in[4]; a.even_gate_w2 = (const float*)d_in[5]; a.even_gate_b2 = (const float*)d_in[6]; a.even_w_out = (const float*)d_in[7];
    a.odd_w_in = (const float*)d_in[8]; a.odd_conv_w = (const float*)d_in[9]; a.odd_conv_b = (const float*)d_in[10]; a.odd_w_a = (const float*)d_in[11]; a.odd_b_a = (const float*)d_in[12];
    a.odd_w_x = (const float*)d_in[13]; a.odd_b_x = (const float*)d_in[14]; a.odd_lambda = (const float*)d_in[15]; a.odd_w_out = (const float*)d_in[16];
    a.out = (float*)d_out; a.ws = (unsigned char*)d_ws;
    if (N_LAUNCHES == 1) {
        a.ph_lo = 0; a.ph_hi = NPH;
        hipLaunchKernelGGL(fwd_kernel, dim3(grid), dim3(NTHREADS), LDS_BYTES, stream, a);
    } else {
        for (int ph = 0; ph < NPH; ++ph) { a.ph_lo = ph; a.ph_hi = ph + 1; hipLaunchKernelGGL(fwd_kernel, dim3(grid), dim3(NTHREADS), LDS_BYTES, stream, a); }
    }
}
```
